# Optimizing an MI355X kernel written in HIP

```python
import math
import jax, jax.numpy as jnp
from jax import lax
import numpy as np

D_MODEL = 2048
BATCH = 2
SEQ = 8192
DEPTH = 2

N_MIXERS = 2
ROPE_THETA = 500000.0
ROPE_FRACTION = 4
DEEPNORM_ALPHA = (2 * DEPTH) ** 0.25
DEEPNORM_BETA = (8 * DEPTH) ** -0.25
LN_EPS = 1e-5

DA_HEADS = 8
DA_HEAD_DIM = D_MODEL // DA_HEADS // 2
DA_Q_BLOCK = 128

MB_HEADS = 16
MB_HEAD_DIM = D_MODEL // MB_HEADS
MB_BLOCK = 256
MB_TOPK = 3
MB_Q_CHUNK = 16

N_EXPERTS = 64
TOP_K = 8
N_GROUPS = 8
TOPK_GROUPS = 4
D_EXPERT = 512
D_SHARED = 512
ROUTED_SCALE = 2.5

kernel_name = "hybrid_diffattn_moba_moe_deepnorm"


def layer_norm(x, g, b):
    xf = x.astype(jnp.float32)
    mu = xf.mean(-1, keepdims=True)
    var = jnp.square(xf - mu).mean(-1, keepdims=True)
    return ((xf - mu) * lax.rsqrt(var + LN_EPS) * g.astype(jnp.float32) + b.astype(jnp.float32)).astype(x.dtype)


def rms_norm(x, g):
    xf = x.astype(jnp.float32)
    return (xf * lax.rsqrt(jnp.mean(xf * xf, -1, keepdims=True) + LN_EPS) * g.astype(jnp.float32)).astype(x.dtype)


def rope_tables(positions, head_dim):
    rot = head_dim // ROPE_FRACTION
    inv_freq = ROPE_THETA ** (-jnp.arange(0, rot, 2, dtype=jnp.float32) / rot)
    ang = positions.astype(jnp.float32)[..., None] * inv_freq
    return jnp.cos(ang)[:, :, None, :], jnp.sin(ang)[:, :, None, :]


def apply_partial_rope(x, cos, sin):
    rot = 2 * cos.shape[-1]
    xr = x[..., :rot].astype(jnp.float32)
    x1, x2 = xr[..., : rot // 2], xr[..., rot // 2:]
    xr = jnp.concatenate([x1 * cos - x2 * sin, x2 * cos + x1 * sin], axis=-1).astype(x.dtype)
    return jnp.concatenate([xr, x[..., rot:]], axis=-1)


def diff_attention(x, positions, w_in, w_out, lq1, lk1, lq2, lk2, subln_g, lambda_init):
    B, S, _ = x.shape
    H, hd = DA_HEADS, DA_HEAD_DIM
    qkv = x @ w_in
    q, k, v = jnp.split(qkv, [2 * H * hd, 4 * H * hd], axis=-1)
    cos, sin = rope_tables(positions, hd)
    q = apply_partial_rope(q.reshape(B, S, 2 * H, hd), cos, sin) * (hd ** -0.5)
    k = apply_partial_rope(k.reshape(B, S, 2 * H, hd), cos, sin)
    v = v.reshape(B, S, H, 2 * hd)
    f32 = jnp.float32
    lam = (jnp.exp(jnp.sum(lq1.astype(f32) * lk1.astype(f32)))
           - jnp.exp(jnp.sum(lq2.astype(f32) * lk2.astype(f32))) + lambda_init)
    k_pos = jnp.arange(S)

    def q_block(i):
        start = i * DA_Q_BLOCK
        qb = lax.dynamic_slice_in_dim(q, start, DA_Q_BLOCK, axis=1)
        s = jnp.einsum('bqmd,bkmd->bmqk', qb, k).astype(f32)
        q_pos = start + jnp.arange(DA_Q_BLOCK)
        s = jnp.where(k_pos[None, :] <= q_pos[:, None], s, -jnp.inf)
        p = jax.nn.softmax(s, axis=-1).reshape(B, H, 2, DA_Q_BLOCK, S)
        a = (p[:, :, 0] - lam * p[:, :, 1]).astype(v.dtype)
        return jnp.einsum('bhqk,bkhe->bqhe', a, v)

    o = lax.map(q_block, jnp.arange(S // DA_Q_BLOCK))
    o = o.transpose(1, 0, 2, 3, 4).reshape(B, S, H, 2 * hd)
    o = rms_norm(o, subln_g) * (1.0 - lambda_init)
    return o.reshape(B, S, H * 2 * hd) @ w_out


def moba_attention(x, positions, w_in, w_out):
    B, S, _ = x.shape
    H, hd = MB_HEADS, MB_HEAD_DIM
    q, k, v = jnp.split(x @ w_in, 3, axis=-1)
    cos, sin = rope_tables(positions, hd)
    q = apply_partial_rope(q.reshape(B, S, H, hd), cos, sin) * (hd ** -0.5)
    k = apply_partial_rope(k.reshape(B, S, H, hd), cos, sin)
    v = v.reshape(B, S, H, hd)
    nb = -(-S // MB_BLOCK)
    pad = nb * MB_BLOCK - S
    q = q.transpose(0, 2, 1, 3)
    kb = jnp.pad(k, ((0, 0), (0, pad), (0, 0), (0, 0))).transpose(0, 2, 1, 3).reshape(B, H, nb, MB_BLOCK, hd)
    vb = jnp.pad(v, ((0, 0), (0, pad), (0, 0), (0, 0))).transpose(0, 2, 1, 3).reshape(B, H, nb, MB_BLOCK, hd)
    k_mean = kb.astype(jnp.float32).mean(axis=3).astype(kb.dtype)
    k_sel = min(MB_TOPK, nb)
    blk_ids = jnp.arange(nb)
    l_ids = jnp.arange(MB_BLOCK)
    gather_blocks = jax.vmap(jax.vmap(lambda t, idx: t[idx]))

    def q_chunk(c):
        start = c * MB_Q_CHUNK
        j = start // MB_BLOCK
        qc = lax.dynamic_slice_in_dim(q, start, MB_Q_CHUNK, axis=2)
        q_pos = start + jnp.arange(MB_Q_CHUNK)
        gate = jnp.einsum('bhqd,bhnd->bhqn', qc, k_mean).astype(jnp.float32)
        gate = jnp.where(blk_ids < j, gate, -jnp.inf)
        _, idx = lax.top_k(gate, k_sel)
        valid = idx < j
        kg = gather_blocks(kb, idx)
        vg = gather_blocks(vb, idx)
        s_sel = jnp.einsum('bhqd,bhqkld->bhqkl', qc, kg).astype(jnp.float32)
        s_sel = jnp.where(valid[..., None], s_sel, -jnp.inf).reshape(B, H, MB_Q_CHUNK, k_sel * MB_BLOCK)
        ko = lax.dynamic_index_in_dim(kb, j, axis=2, keepdims=False)
        vo = lax.dynamic_index_in_dim(vb, j, axis=2, keepdims=False)
        s_own = jnp.einsum('bhqd,bhld->bhql', qc, ko).astype(jnp.float32)
        s_own = jnp.where((j * MB_BLOCK + l_ids)[None, :] <= q_pos[:, None], s_own, -jnp.inf)
        p = jax.nn.softmax(jnp.concatenate([s_sel, s_own], axis=-1), axis=-1).astype(v.dtype)
        p_sel = p[..., : k_sel * MB_BLOCK].reshape(B, H, MB_Q_CHUNK, k_sel, MB_BLOCK)
        p_own = p[..., k_sel * MB_BLOCK:]
        return (jnp.einsum('bhqkl,bhqkld->bhqd', p_sel, vg)
                + jnp.einsum('bhql,bhld->bhqd', p_own, vo))

    o = lax.map(q_chunk, jnp.arange(S // MB_Q_CHUNK))
    o = o.transpose(1, 0, 3, 2, 4).reshape(B, S, H * hd)
    return o @ w_out


def swiglu(t, wg, wu, wd):
    return (jax.nn.silu(t @ wg) * (t @ wu)) @ wd


def moe(x, w_router, router_bias, w_gate, w_up, w_down, ws_gate, ws_up, ws_down):
    B, S, D = x.shape
    t = x.reshape(B * S, D)
    T = t.shape[0]
    f32 = jnp.float32
    scores = jax.nn.sigmoid((t @ w_router).astype(f32))
    biased = scores + router_bias.astype(f32)
    per_group = N_EXPERTS // N_GROUPS
    group_score = lax.top_k(biased.reshape(T, N_GROUPS, per_group), 2)[0].sum(-1)
    _, gidx = lax.top_k(group_score, TOPK_GROUPS)
    gmask = jax.nn.one_hot(gidx, N_GROUPS, dtype=f32).sum(1) > 0
    masked = jnp.where(jnp.repeat(gmask, per_group, axis=1), biased, -jnp.inf)
    _, eidx = lax.top_k(masked, TOP_K)
    w = jnp.take_along_axis(scores, eidx, axis=1)
    w = w / w.sum(-1, keepdims=True) * ROUTED_SCALE
    gates = jnp.einsum('tk,tke->te', w, jax.nn.one_hot(eidx, N_EXPERTS, dtype=f32))

    def add_expert(acc, p):
        wg, wu, wd, g = p
        return acc + swiglu(t, wg, wu, wd).astype(f32) * g[:, None], None

    routed, _ = lax.scan(add_expert, jnp.zeros((T, D), f32), (w_gate, w_up, w_down, gates.T))
    out = routed.astype(x.dtype) + swiglu(t, ws_gate, ws_up, ws_down)
    return out.reshape(B, S, D)


def setup_inputs(seed: int = 0) -> dict:
    key = jax.random.key(seed)
    ks = jax.random.split(key, 24)
    D = D_MODEL
    n_a = (DEPTH + 1) // 2
    n_b = DEPTH // 2
    f32 = jnp.float32

    def nrm(k, shape, fan_in, scale=1.0):
        return jax.random.normal(k, shape, f32) * (scale * fan_in ** -0.5)

    def small(k, shape, s):
        return jax.random.normal(k, shape, f32) * s

    da_width = 4 * DA_HEADS * DA_HEAD_DIM + DA_HEADS * 2 * DA_HEAD_DIM
    mb_width = MB_HEADS * MB_HEAD_DIM
    return {
        "x": jax.random.normal(ks[0], (BATCH, SEQ, D), f32),
        "positions": (jax.random.randint(ks[1], (BATCH, 1), 0, 1024, dtype=jnp.int32)
                      + jnp.arange(SEQ, dtype=jnp.int32)[None, :]),
        "ln1_g": 1.0 + small(ks[2], (DEPTH, D), 0.02),
        "ln1_b": small(ks[3], (DEPTH, D), 0.02),
        "ln2_g": 1.0 + small(ks[4], (DEPTH, D), 0.02),
        "ln2_b": small(ks[5], (DEPTH, D), 0.02),
        "da_w_in": nrm(ks[6], (n_a, D, da_width), D),
        "da_w_out": nrm(ks[7], (n_a, DA_HEADS * 2 * DA_HEAD_DIM, D), DA_HEADS * 2 * DA_HEAD_DIM, DEEPNORM_BETA),
        "da_lq1": small(ks[8], (n_a, DA_HEAD_DIM), 0.1),
        "da_lk1": small(ks[9], (n_a, DA_HEAD_DIM), 0.1),
        "da_lq2": small(ks[10], (n_a, DA_HEAD_DIM), 0.1),
        "da_lk2": small(ks[11], (n_a, DA_HEAD_DIM), 0.1),
        "da_subln_g": 1.0 + small(ks[12], (n_a, 2 * DA_HEAD_DIM), 0.02),
        "mb_w_in": nrm(ks[13], (n_b, D, 3 * mb_width), D),
        "mb_w_out": nrm(ks[14], (n_b, mb_width, D), mb_width, DEEPNORM_BETA),
        "w_router": nrm(ks[15], (DEPTH, D, N_EXPERTS), D),
        "router_bias": small(ks[16], (DEPTH, N_EXPERTS), 0.01),
        "w_gate": nrm(ks[17], (DEPTH, N_EXPERTS, D, D_EXPERT), D),
        "w_up": nrm(ks[18], (DEPTH, N_EXPERTS, D, D_EXPERT), D),
        "w_down": nrm(ks[19], (DEPTH, N_EXPERTS, D_EXPERT, D), D_EXPERT, DEEPNORM_BETA),
        "ws_gate": nrm(ks[20], (DEPTH, D, D_SHARED), D),
        "ws_up": nrm(ks[21], (DEPTH, D, D_SHARED), D),
        "ws_down": nrm(ks[22], (DEPTH, D_SHARED, D), D_SHARED, DEEPNORM_BETA),
    }


def reference(x, positions, ln1_g, ln1_b, ln2_g, ln2_b, da_w_in, da_w_out, da_lq1, da_lk1, da_lq2,
              da_lk2, da_subln_g, mb_w_in, mb_w_out, w_router, router_bias, w_gate, w_up, w_down,
              ws_gate, ws_up, ws_down):
    for i in range(DEPTH):
        m = i // N_MIXERS
        if i % N_MIXERS == 0:
            lambda_init = 0.8 - 0.6 * math.exp(-0.3 * i)
            h = diff_attention(x, positions, da_w_in[m], da_w_out[m], da_lq1[m], da_lk1[m],
                               da_lq2[m], da_lk2[m], da_subln_g[m], lambda_init)
        else:
            h = moba_attention(x, positions, mb_w_in[m], mb_w_out[m])
        x = layer_norm(DEEPNORM_ALPHA * x + h, ln1_g[i], ln1_b[i])
        f = moe(x, w_router[i], router_bias[i], w_gate[i], w_up[i], w_down[i],
                ws_gate[i], ws_up[i], ws_down[i])
        x = layer_norm(DEEPNORM_ALPHA * x + f, ln2_g[i], ln2_b[i])
    return x
```

```cpp
#include <hip/hip_runtime.h>
#include <cstdio>
#include <cstdint>

#define GAS __attribute__((address_space(1)))
#define LAS __attribute__((address_space(3)))
typedef unsigned short bf16_t;
typedef short bf16x8 __attribute__((ext_vector_type(8)));
typedef short s16x4 __attribute__((ext_vector_type(4)));
typedef float f32x2 __attribute__((ext_vector_type(2)));
typedef float f32x4 __attribute__((ext_vector_type(4)));
typedef float f32x16 __attribute__((ext_vector_type(16)));
typedef unsigned u32x2 __attribute__((ext_vector_type(2)));
typedef unsigned u32x4 __attribute__((ext_vector_type(4)));

constexpr int BATCH = 2, SEQ = 8192, DM = 2048, NTOK = BATCH * SEQ;
constexpr int NE = 64, NEX = 65  , DE = 512, NQKV = 6144, HD = 128, NSLAB = 16;
constexpr float LN_EPS = 1e-5f;
constexpr float ALPHA = 1.4142135623730951f;
constexpr float LAMBDA_INIT = 0.2f;
constexpr float ROUTED_SCALE = 2.5f;
constexpr int NWAVES = 8;
constexpr int MAXTILES = 640;

constexpr size_t MiB = 1u << 20;
constexpr size_t WS_CTL = 0, CTL_ZERO_BYTES = 1 * MiB;
constexpr size_t WS_TOKE = 2 * MiB;
constexpr size_t WS_TOKW = 3 * MiB;
constexpr size_t WS_LIST = 4 * MiB;
constexpr size_t WS_SEL = 8 * MiB;
constexpr size_t WS_KMEAN = 9 * MiB;
constexpr size_t WS_ROPE = 10 * MiB;
constexpr size_t WS_WRF = 12 * MiB;
constexpr size_t WS_WATT = 16 * MiB;
constexpr size_t WS_WGU = 80 * MiB;
constexpr size_t WS_WD = 600 * MiB;
constexpr size_t WS_XB = 860 * MiB;
constexpr size_t WS_C = 924 * MiB;
constexpr size_t WS_Q = WS_C, WS_K = WS_C + 64 * MiB, WS_V = WS_C + 128 * MiB;
constexpr size_t WS_O = WS_C + 192 * MiB;
constexpr size_t WS_AOUT = WS_C + 320 * MiB;
constexpr size_t WS_H = WS_C;
constexpr size_t WS_Y = WS_C + 160 * MiB;
constexpr size_t WS_QLIST = WS_C + 192 * MiB;
constexpr size_t WS_OP = WS_C + 384 * MiB;
constexpr size_t WS_ML = WS_C + 641 * MiB;
constexpr size_t WS_END = WS_C + 800 * MiB;
constexpr int CW_BAR = 4096;
constexpr int CW_CNT = 8192;
constexpr int CW_MCNT = 12288;
constexpr int CW_SQ = 13440;

constexpr int RING_BYTES = 131072;
constexpr int LDSCTL_OFF = RING_BYTES, MISC_OFF = LDSCTL_OFF + 320;
constexpr int LT_P = LDSCTL_OFF + 1024;
constexpr int LT_CNT = LDSCTL_OFF + 1536;
constexpr int LT_TILE = LDSCTL_OFF + 2048;
constexpr int LT_LCNT = LDSCTL_OFF + 5120;
constexpr int LT_LBASE = LDSCTL_OFF + 5632;
constexpr int LT_ENT = LDSCTL_OFF + 6144;
constexpr int LT_MC = 114688;
constexpr int LT_PB = 118784;
constexpr int LT_SC = 123904;
constexpr int LDS_BYTES = 147456;

#ifndef FP8_QKV0
#define FP8_QKV0 0
#endif
#ifndef FP8_QKV1
#define FP8_QKV1 1
#endif
#ifndef FP8_OUT0
#define FP8_OUT0 0
#endif
#ifndef FP8_OUT1
#define FP8_OUT1 1
#endif
#ifndef FP8_Y1
#define FP8_Y1 1
#endif
#ifndef FP8_MOE1
#define FP8_MOE1 1
#endif
constexpr float W8_SCALE = 64.f, W8_INV = 1.f / 64.f;
constexpr float AO8_SCALE = 16.f, AO8_INV = 1.f / 16.f;
constexpr float Y8_SCALE = 16.f, Y8_INV = 1.f / 16.f;
#define LDS_WAIT() asm volatile("s_waitcnt lgkmcnt(0)" ::: "memory")
#define VM_WAIT() asm volatile("s_waitcnt vmcnt(0)" ::: "memory")
#define SBAR() __builtin_amdgcn_sched_barrier(0)

__device__ __forceinline__ unsigned cvt_pk_bf16(float lo, float hi) { unsigned r; asm volatile("v_cvt_pk_bf16_f32 %0, %1, %2" : "=v"(r) : "v"(lo), "v"(hi)); return r; }
__device__ __forceinline__ unsigned pk4_fp8(float a, float b, float c, float d) { int p = __builtin_amdgcn_cvt_pk_fp8_f32(a, b, 0, false); p = __builtin_amdgcn_cvt_pk_fp8_f32(c, d, p, true); return (unsigned)p; }
__device__ __forceinline__ float bf_lo(unsigned u) { return __uint_as_float(u << 16); }
__device__ __forceinline__ float bf_hi(unsigned u) { return __uint_as_float(u & 0xffff0000u); }
template <int CTRL> __device__ __forceinline__ float dpp_mov(float v) { return __int_as_float(__builtin_amdgcn_update_dpp(0, __float_as_int(v), CTRL, 0xF, 0xF, true)); }
__device__ __forceinline__ float wave_sum(float v) {
    v += dpp_mov<0xB1>(v);
    v += dpp_mov<0x4E>(v);
    v += dpp_mov<0x141>(v);
    v += dpp_mov<0x140>(v);
    const float r0 = __int_as_float(__builtin_amdgcn_readlane(__float_as_int(v), 0)), r1 = __int_as_float(__builtin_amdgcn_readlane(__float_as_int(v), 16));
    const float r2 = __int_as_float(__builtin_amdgcn_readlane(__float_as_int(v), 32)), r3 = __int_as_float(__builtin_amdgcn_readlane(__float_as_int(v), 48));
    return (r0 + r1) + (r2 + r3);
}

#define XB_TMO      128
#define XB_XCNT(j)  (256  + 64 * (j))
#define XB_XSUB(j)  (1280 + 64 * (j))
#define XB_XGEN(j)  (2304 + 64 * (j))
#define XB_TOP      3328
#define XB_TOPGEN   3392
#define XCD_BAR_WORDS 3456
#define XB_SPIN_CAP (1u << 18)
__device__ __forceinline__ unsigned xb_ld(unsigned* p)              { return __hip_atomic_load(p, __ATOMIC_RELAXED, __HIP_MEMORY_SCOPE_AGENT); }
__device__ __forceinline__ unsigned xb_add(unsigned* p, unsigned v) { return __hip_atomic_fetch_add(p, v, __ATOMIC_RELAXED, __HIP_MEMORY_SCOPE_AGENT); }
__device__ __forceinline__ unsigned xb_xcc_id() { return (unsigned)__builtin_amdgcn_s_getreg((3 << 11) | 20) & 0xFu; }
#define XB_SPIN(cond, bar) do { unsigned _sp = 0; while (cond) { __builtin_amdgcn_s_sleep(1); \
    if ((++_sp & 255u) == 0u) { if (xb_ld(&(bar)[XB_TMO])) break; if (_sp > XB_SPIN_CAP) { atomicAdd(&(bar)[XB_TMO], 1u); break; } } } } while (0)
struct XcdBarrier { unsigned* bar; unsigned x; volatile LAS unsigned* st; };
__device__ __forceinline__ XcdBarrier xcd_barrier_post(unsigned* bar, volatile LAS unsigned* st) {
    XcdBarrier b; b.bar = bar; b.x = xb_xcc_id(); b.st = st;
    if (threadIdx.x == 0) (void)xb_add(&bar[XB_XCNT(b.x)], 1u);
    return b;
}
__device__ __forceinline__ void xcd_barrier_complete(unsigned* bar, unsigned x, unsigned& nloc, unsigned& nx) {
    const unsigned G = gridDim.x * gridDim.y * gridDim.z;
    unsigned sum, cnt, mine, sp = 0u;
    for (;;) {
        sum = 0u; cnt = 0u; mine = 0u;
#pragma unroll
        for (unsigned j = 0; j < 16; ++j) { const unsigned c = xb_ld(&bar[XB_XCNT(j)]); sum += c; cnt += (c > 0u) ? 1u : 0u; mine = (j == x) ? c : mine; }
        if (sum == G) break;
        __builtin_amdgcn_s_sleep(1);
        if ((++sp & 255u) == 0u) { if (xb_ld(&bar[XB_TMO])) break; if (sp > XB_SPIN_CAP) { atomicAdd(&bar[XB_TMO], 1u); break; } }
    }
    nloc = mine > 0u ? mine : 1u; nx = cnt > 0u ? cnt : 1u;
}
__device__ __forceinline__ void xcd_barrier(const XcdBarrier& b) {
    asm volatile("s_waitcnt vmcnt(0)" ::: "memory");
    __syncthreads();
    if (threadIdx.x == 0) {
        unsigned* bar = b.bar;
        __builtin_amdgcn_s_waitcnt(0);
        unsigned nloc = b.st[0], nx = b.st[1];
        if (nloc == 0u) { xcd_barrier_complete(bar, b.x, nloc, nx); b.st[0] = nloc; b.st[1] = nx; }
        const unsigned old = xb_add(&bar[XB_XSUB(b.x)], 1u);
        const unsigned gen = old / nloc;
        if (old + 1u == (gen + 1u) * nloc) {
            __builtin_amdgcn_fence(__ATOMIC_RELEASE, "agent");
            asm volatile("s_waitcnt vmcnt(0)" ::: "memory");
            const unsigned og = xb_add(&bar[XB_TOP], 1u);
            const unsigned tg = og / nx;
            if (og + 1u == (tg + 1u) * nx) xb_add(&bar[XB_TOPGEN], 1u);
            else XB_SPIN(xb_ld(&bar[XB_TOPGEN]) == tg, bar);
            __builtin_amdgcn_fence(__ATOMIC_ACQUIRE, "agent");
            xb_add(&bar[XB_XGEN(b.x)], 1u);
            asm volatile("s_waitcnt vmcnt(0)" ::: "memory");
        } else {
            XB_SPIN(xb_ld(&bar[XB_XGEN(b.x)]) == gen, bar);
            __builtin_amdgcn_fence(__ATOMIC_ACQUIRE, "agent");
            asm volatile("s_waitcnt vmcnt(0)" ::: "memory");
        }
    }
    __syncthreads();
}

namespace pg8 {
constexpr int BM = 256, BK = 64, HALF = 128, HTB = HALF * BK * 2, NXCD = 8, WGM = 8;
__device__ __forceinline__ int lds_byte(int r, int c) { const int st = (r >> 4) * 2 + (c >> 5), rr = r & 15, cc = c & 31, ob = rr * 64 + cc * 2; return st * 1024 + (ob ^ (((ob >> 9) & 1) << 5)); }
__device__ __forceinline__ void stage_rc(int b, int& R, int& C) { const int st = b / 1024, sb = b % 1024, swz = sb ^ (((sb >> 9) & 1) << 5); R = (st >> 1) * 16 + swz / 64; C = (st & 1) * 32 + (swz % 64) / 2; }
__device__ __forceinline__ int perm32(int rho) { const int n = rho >> 4, i = rho & 15; return 8 * (i >> 2) + 4 * n + (i & 3); }
struct Unit { int pm, pn, e, aux; };
__device__ __forceinline__ int xcd_remap(int L, int nwg) { const int q = nwg / NXCD, r = nwg % NXCD, xcd = L % NXCD, off = L / NXCD; return (xcd < r ? xcd * (q + 1) : r * (q + 1) + (xcd - r) * q) + off; }

struct SchedDense {
    const char* A; const char* Bt; int Kb, nM, nN, nwg, G, c;
    __device__ __forceinline__ void init(const void* A_, const void* Bt_, int M, int N, int Kb_, int G_, int c_) { A = (const char*)A_; Bt = (const char*)Bt_; Kb = Kb_; nM = M / BM; nN = N / BM; nwg = nM * nN; G = G_; c = c_; }
    __device__ __forceinline__ bool next(int i, Unit& u) const {
        const long L = (long)i * G + c; if (L >= nwg) return false;
        const int wgid = xcd_remap((int)L, nwg);
        const int nig = WGM * nN, gid = wgid / nig, fm = gid * WGM, gsz = (nM - fm) < WGM ? (nM - fm) : WGM;
        u.pm = fm + ((wgid % nig) % gsz); u.pn = (wgid % nig) / gsz; u.e = 0; u.aux = 0; return true;
    }
    __device__ __forceinline__ const char* a_base(const Unit&) const { return A; }
    __device__ __forceinline__ const char* b_base(const Unit& u) const { return Bt + (size_t)u.pn * BM * Kb; }
    __device__ __forceinline__ void a_off(const Unit& u, unsigned (&off)[2][2]) const {
        int tz = threadIdx.x; asm volatile("" : "+v"(tz));
#pragma unroll
        for (int i = 0; i < 2; ++i) { int R, C; stage_rc(tz * 16 + i * 8192, R, C);
#pragma unroll
            for (int h = 0; h < 2; ++h) off[h][i] = (unsigned)((u.pm * BM + h * HALF + R) * Kb + C * 2); }
    }
};
struct SchedMoe1 {
    const char* X; const char* W; const unsigned* list; const LAS int* P; const LAS int* cnt; const LAS int* tile_e; int U, G, c, Kb;
    __device__ __forceinline__ bool next(int i, Unit& u) const {
        const long L = (long)i * G + c; if (L >= U) return false;
        const int wgid = xcd_remap((int)L, U);
        u.pm = wgid >> 2; u.pn = wgid & 3; u.e = tile_e[u.pm]; u.aux = u.pm - P[u.e]; return true;
    }
    __device__ __forceinline__ const char* a_base(const Unit&) const { return X; }
    __device__ __forceinline__ const char* b_base(const Unit& u) const { return W + ((size_t)u.e * 1024 + (size_t)u.pn * 256) * Kb; }
    __device__ __forceinline__ void a_off(const Unit& u, unsigned (&off)[2][2]) const {
        const int n = cnt[u.e];
        int tz = threadIdx.x; asm volatile("" : "+v"(tz));
#pragma unroll
        for (int i = 0; i < 2; ++i) { int R, C; stage_rc(tz * 16 + i * 8192, R, C);
#pragma unroll
            for (int h = 0; h < 2; ++h) {
                const int r = u.aux * BM + h * HALF + R;
                unsigned tok;
                if (u.e == NE) tok = (unsigned)r;
                else tok = (r < n) ? list[(size_t)u.e * NTOK + r] : 0u;
                off[h][i] = tok * (unsigned)Kb + (unsigned)C * 2u;
            } }
    }
};
struct SchedMoe2 {
    const char* Hb; const char* W; const LAS int* tile_e; int U, G, c, Kb;
    __device__ __forceinline__ bool next(int i, Unit& u) const {
        const long L = (long)i * G + c; if (L >= U) return false;
        const int wgid = xcd_remap((int)L, U);
        u.pm = wgid >> 3; u.pn = wgid & 7; u.e = tile_e[u.pm]; u.aux = 0; return true;
    }
    __device__ __forceinline__ const char* a_base(const Unit&) const { return Hb; }
    __device__ __forceinline__ const char* b_base(const Unit& u) const { return W + ((size_t)u.e * DM + (size_t)u.pn * 256) * Kb; }
    __device__ __forceinline__ void a_off(const Unit& u, unsigned (&off)[2][2]) const {
        int tz = threadIdx.x; asm volatile("" : "+v"(tz));
#pragma unroll
        for (int i = 0; i < 2; ++i) { int R, C; stage_rc(tz * 16 + i * 8192, R, C);
#pragma unroll
            for (int h = 0; h < 2; ++h) off[h][i] = (unsigned)((u.pm * BM + h * HALF + R) * Kb + C * 2); }
    }
};

template <bool KM> struct EpiQKV {
    static constexpr bool PERM = true;
    bf16_t* QKV; const float* rope; float osc;
    __device__ __forceinline__ void operator()(const f32x4 (&acc)[2][2][4][2], const Unit& u, int wr, int wc, int fr, int fq) const {
        const int seg = u.pn >> 3, slab0 = (u.pn & 7) * 2;
        bf16_t* base = QKV + (size_t)seg * ((size_t)BATCH * NSLAB * SEQ * HD);
        const int row0 = u.pm * BM + wr * 64 + fr; const int b = (u.pm * BM) >> 13;
        const bool rot = (seg < 2) && (wc == 0);
        f32x4 cs0a = {0.f, 0.f, 0.f, 0.f}, cs0b = cs0a, cs1a = cs0a, cs1b = cs0a;
#pragma unroll
        for (int ai = 0; ai < 2; ++ai)
#pragma unroll
            for (int m = 0; m < 4; ++m) {
                const int row = row0 + ai * HALF + m * 16, s = row & (SEQ - 1);
                f32x4 cs = {1.f, 1.f, 1.f, 1.f}, sn = {0.f, 0.f, 0.f, 0.f};
                if (rot) { cs = *(const f32x4*)(rope + (size_t)row * 32 + 4 * fq); sn = *(const f32x4*)(rope + (size_t)row * 32 + 16 + 4 * fq); }
#pragma unroll
                for (int bj = 0; bj < 2; ++bj) {
                    f32x4 v0 = acc[ai][bj][m][0] * osc, v1 = acc[ai][bj][m][1] * osc;
                    if (rot) {
                        f32x4 w0, w1;
                        w0[0] = v0[0] * cs[0] - v0[1] * sn[0]; w0[1] = v0[1] * cs[0] + v0[0] * sn[0];
                        w0[2] = v0[2] * cs[1] - v0[3] * sn[1]; w0[3] = v0[3] * cs[1] + v0[2] * sn[1];
                        w1[0] = v1[0] * cs[2] - v1[1] * sn[2]; w1[1] = v1[1] * cs[2] + v1[0] * sn[2];
                        w1[2] = v1[2] * cs[3] - v1[3] * sn[3]; w1[3] = v1[3] * cs[3] + v1[2] * sn[3];
                        v0 = w0; v1 = w1;
                    }
                    u32x4 w; w.x = cvt_pk_bf16(v0[0], v0[1]); w.y = cvt_pk_bf16(v0[2], v0[3]); w.z = cvt_pk_bf16(v1[0], v1[1]); w.w = cvt_pk_bf16(v1[2], v1[3]);
                    *(u32x4*)(base + ((size_t)(b * NSLAB + slab0 + bj) * SEQ + s) * HD + wc * 32 + 8 * fq) = w;
                    if (KM && seg == 1) { const f32x4 ra = {bf_lo(w.x), bf_hi(w.x), bf_lo(w.y), bf_hi(w.y)}, rb = {bf_lo(w.z), bf_hi(w.z), bf_lo(w.w), bf_hi(w.w)};
                        if (bj == 0) { cs0a += ra; cs0b += rb; } else { cs1a += ra; cs1b += rb; } }
                }
            }
        if (KM && seg == 1) {
            bf16_t* km = (bf16_t*)((unsigned char*)QKV - WS_Q + WS_KMEAN);
            LAS float* kbuf = (LAS float*)(uintptr_t)(LDSCTL_OFF + 12288);
#define KM_RED(V, BJ, I0) do { _Pragma("unroll") for (int i = 0; i < 4; ++i) { float v = V[i]; v += dpp_mov<0xB1>(v); v += dpp_mov<0x4E>(v); v += dpp_mov<0x141>(v); v += dpp_mov<0x140>(v); \
                if (fr == 0) kbuf[((wr * 4 + wc) * 2 + (BJ)) * 32 + fq * 8 + (I0) + i] = v; } } while (0)
            KM_RED(cs0a, 0, 0); KM_RED(cs0b, 0, 4); KM_RED(cs1a, 1, 0); KM_RED(cs1b, 1, 4);
#undef KM_RED
            asm volatile("s_waitcnt lgkmcnt(0)" ::: "memory"); __builtin_amdgcn_s_barrier(); asm volatile("" ::: "memory");
            if (wr == 0) {
                const int l = fq * 16 + fr, bj = l >> 5, c32 = l & 31;
                const float mean = (kbuf[((0 * 4 + wc) * 2 + bj) * 32 + c32] + kbuf[((1 * 4 + wc) * 2 + bj) * 32 + c32]) * (1.f / 256.f);
                const unsigned hi = cvt_pk_bf16(mean, 0.f) & 0xffffu; const unsigned lo = cvt_pk_bf16(mean - bf_lo(hi), 0.f) & 0xffffu;
                const size_t ko = ((size_t)(b * NSLAB + slab0 + bj) * 64 + (u.pm & 31)) * HD + wc * 32 + c32;
                km[ko] = (bf16_t)hi; km[ko + 32 * HD] = (bf16_t)lo;
            }
        }
    }
};
struct EpiRes {
    static constexpr bool PERM = false;
    const float* xres; float* y; float osc;
    __device__ __forceinline__ void operator()(const f32x4 (&acc)[2][2][4][2], const Unit& u, int wr, int wc, int fr, int fq) const {
        const int row0 = u.pm * BM + wr * 64 + fr, col0 = u.pn * BM + wc * 32 + 4 * fq;
#pragma unroll
        for (int ai = 0; ai < 2; ++ai)
#pragma unroll
            for (int m = 0; m < 4; ++m) {
                const size_t ro = (size_t)(row0 + ai * HALF + m * 16) * DM + col0;
#pragma unroll
                for (int bj = 0; bj < 2; ++bj)
#pragma unroll
                    for (int n = 0; n < 2; ++n) { const f32x4 xr = *(const f32x4*)(xres + ro + bj * HALF + n * 16); *(f32x4*)(y + ro + bj * HALF + n * 16) = xr * ALPHA + acc[ai][bj][m][n] * osc; }
            }
    }
};
__device__ __forceinline__ float silu_mul(float g, float up) { return g * __builtin_amdgcn_rcpf(1.f + __builtin_amdgcn_exp2f(-1.4426950408889634f * g)) * up; }
template <bool OUT8> struct EpiSwiGLU {
    static constexpr bool PERM = true;
    bf16_t* H; float osc;
    __device__ __forceinline__ void operator()(const f32x4 (&acc)[2][2][4][2], const Unit& u, int wr, int wc, int fr, int fq) const {
        const int row0 = u.pm * BM + wr * 64 + fr, col0 = u.pn * 128 + wc * 32 + 8 * fq;
#pragma unroll
        for (int ai = 0; ai < 2; ++ai)
#pragma unroll
            for (int m = 0; m < 4; ++m) {
                const f32x4 g0 = acc[ai][0][m][0] * osc, g1 = acc[ai][0][m][1] * osc, u0 = acc[ai][1][m][0] * osc, u1 = acc[ai][1][m][1] * osc;
                if (OUT8) {
                    u32x2 w; w.x = pk4_fp8(silu_mul(g0[0], u0[0]), silu_mul(g0[1], u0[1]), silu_mul(g0[2], u0[2]), silu_mul(g0[3], u0[3]));
                    w.y = pk4_fp8(silu_mul(g1[0], u1[0]), silu_mul(g1[1], u1[1]), silu_mul(g1[2], u1[2]), silu_mul(g1[3], u1[3]));
                    *(u32x2*)((unsigned char*)H + (size_t)(row0 + ai * HALF + m * 16) * DE + col0) = w;
                } else {
                u32x4 w;
                w.x = cvt_pk_bf16(silu_mul(g0[0], u0[0]), silu_mul(g0[1], u0[1])); w.y = cvt_pk_bf16(silu_mul(g0[2], u0[2]), silu_mul(g0[3], u0[3]));
                w.z = cvt_pk_bf16(silu_mul(g1[0], u1[0]), silu_mul(g1[1], u1[1])); w.w = cvt_pk_bf16(silu_mul(g1[2], u1[2]), silu_mul(g1[3], u1[3]));
                *(u32x4*)(H + (size_t)(row0 + ai * HALF + m * 16) * DE + col0) = w;
                }
            }
    }
};
template <bool OUT8> struct EpiY {
    static constexpr bool PERM = true;
    bf16_t* Y; float osc;
    __device__ __forceinline__ void operator()(const f32x4 (&acc)[2][2][4][2], const Unit& u, int wr, int wc, int fr, int fq) const {
        const int row0 = u.pm * BM + wr * 64 + fr, col0 = u.pn * BM + wc * 32 + 8 * fq;
#pragma unroll
        for (int ai = 0; ai < 2; ++ai)
#pragma unroll
            for (int m = 0; m < 4; ++m) {
                bf16_t* rowp = Y + (size_t)(row0 + ai * HALF + m * 16) * DM + col0;
#pragma unroll
                for (int bj = 0; bj < 2; ++bj) { const f32x4 v0 = acc[ai][bj][m][0] * osc, v1 = acc[ai][bj][m][1] * osc;
                    if (OUT8) { u32x2 w; w.x = pk4_fp8(v0[0], v0[1], v0[2], v0[3]); w.y = pk4_fp8(v1[0], v1[1], v1[2], v1[3]);
                        *(u32x2*)((unsigned char*)Y + (size_t)(row0 + ai * HALF + m * 16) * DM + col0 + bj * HALF) = w; }
                    else { u32x4 w; w.x = cvt_pk_bf16(v0[0], v0[1]); w.y = cvt_pk_bf16(v0[2], v0[3]); w.z = cvt_pk_bf16(v1[0], v1[1]); w.w = cvt_pk_bf16(v1[2], v1[3]);
                        *(u32x4*)(rowp + bj * HALF) = w; } }
            }
    }
};

typedef int i32x4 __attribute__((ext_vector_type(4)));
typedef int i32x8 __attribute__((ext_vector_type(8)));
__device__ __forceinline__ i32x8 cat8(bf16x8 a, bf16x8 b) { const i32x4 x = __builtin_bit_cast(i32x4, a), y = __builtin_bit_cast(i32x4, b); return (i32x8){x[0], x[1], x[2], x[3], y[0], y[1], y[2], y[3]}; }
template <class Epi, class Sched, bool F8>
__device__ __forceinline__ void gemm_phase(LAS unsigned char* lds, const int K, const Sched& S, const Epi& E) {
    const int tid = threadIdx.x, wid = __builtin_amdgcn_readfirstlane(tid >> 6), lane = tid & 63, wr = wid >> 2, wc = wid & 3, fr = lane & 15, fq = lane >> 4;
    const int nt = K / 128;
    unsigned voffB[2];
#pragma unroll
    for (int i = 0; i < 2; ++i) { int R, C; stage_rc(tid * 16 + i * 8192, R, C); const int Rb = Epi::PERM ? ((R & ~31) + perm32(R & 31)) : R; voffB[i] = (unsigned)(Rb * K + C * 2); }
    const size_t kstep = (size_t)(BK * 2);
    const size_t hstep = (size_t)HALF * K;
    const unsigned ldsw = (unsigned)wid * 1024u;
    const int aoff = lds_byte(wr * 64 + fr, fq * 8), boff = lds_byte(wc * 32 + fr, fq * 8);
#define PG8_SA(b, h) (((b) * 2 + (h)) * HTB)
#define PG8_SB(b, h) ((4 + (b) * 2 + (h)) * HTB)
#define PG8_STAGE(bufoff, gbase, voff) do { _Pragma("unroll") for (int _i = 0; _i < 2; ++_i) \
        __builtin_amdgcn_global_load_lds((const unsigned*)((const char*)(gbase) + (voff)[_i]), (LAS unsigned*)(lds + (bufoff) + ldsw + _i * 8192), 16, 0, 0); } while (0)
#define PG8_LDA(dst, b, h) do { _Pragma("unroll") for (int m = 0; m < 4; ++m) _Pragma("unroll") for (int k = 0; k < 2; ++k) dst[m][k] = *(const LAS bf16x8*)(lds + PG8_SA(b, h) + aoff + m * 2048 + k * 1024); } while (0)
#define PG8_LDB(dst, b, h) do { _Pragma("unroll") for (int n = 0; n < 2; ++n) _Pragma("unroll") for (int k = 0; k < 2; ++k) dst[n][k] = *(const LAS bf16x8*)(lds + PG8_SB(b, h) + boff + n * 2048 + k * 1024); } while (0)
#define PG8_MMA(ai, bj, At, Bt) do { __builtin_amdgcn_s_setprio(1); _Pragma("unroll") for (int m = 0; m < 4; ++m) _Pragma("unroll") for (int n = 0; n < 2; ++n) { \
        if (F8) acc[ai][bj][m][n] = __builtin_amdgcn_mfma_scale_f32_16x16x128_f8f6f4(cat8(Bt[n][0], Bt[n][1]), cat8(At[m][0], At[m][1]), acc[ai][bj][m][n], 0, 0, 0, 0x7F7F7F7F, 0, 0x7F7F7F7F); \
        else { _Pragma("unroll") for (int k = 0; k < 2; ++k) acc[ai][bj][m][n] = __builtin_amdgcn_mfma_f32_16x16x32_bf16(Bt[n][k], At[m][k], acc[ai][bj][m][n], 0, 0, 0); } } \
        __builtin_amdgcn_s_setprio(0); } while (0)
#define PG8_WAIT_V(n) asm volatile("s_waitcnt vmcnt(" #n ")" ::: "memory")
#define PG8_WAIT_L(n) asm volatile("s_waitcnt lgkmcnt(" #n ")" ::: "memory")
#define PG8_BAR __builtin_amdgcn_s_barrier()
#define PG8_SCHED __builtin_amdgcn_sched_barrier(0)
    Unit cur, nxt; int ui = 0;
    if (!S.next(0, cur)) return;
    f32x4 acc[2][2][4][2];
#pragma unroll
    for (int a = 0; a < 2; ++a)
#pragma unroll
        for (int b = 0; b < 2; ++b)
#pragma unroll
            for (int m = 0; m < 4; ++m)
#pragma unroll
                for (int n = 0; n < 2; ++n) acc[a][b][m][n] = (f32x4){0.f, 0.f, 0.f, 0.f};
    bf16x8 At[4][2], B0[2][2], B1[2][2];
    unsigned cOff[2][2];
    const char* cA = S.a_base(cur); const char* cB = S.b_base(cur);
    S.a_off(cur, cOff);
    PG8_STAGE(PG8_SB(0, 0), cB, voffB); PG8_STAGE(PG8_SB(0, 1), cB + hstep, voffB); PG8_STAGE(PG8_SA(0, 0), cA, cOff[0]); PG8_STAGE(PG8_SA(0, 1), cA, cOff[1]);
    if (wr == 1) PG8_BAR;
    PG8_WAIT_V(2); PG8_BAR;
    PG8_STAGE(PG8_SB(1, 0), cB + kstep, voffB); PG8_STAGE(PG8_SA(1, 0), cA + kstep, cOff[0]); PG8_STAGE(PG8_SB(1, 1), cB + hstep + kstep, voffB);
    PG8_WAIT_V(6); PG8_BAR;
    for (;;) {
        const bool has_next = S.next(ui + 1, nxt);
        const char* nA = has_next ? S.a_base(nxt) : cA; const char* nB = has_next ? S.b_base(nxt) : cB;
#pragma unroll 1
        for (int t = 0; t < nt; t += 2) {
            const bool last = (t == nt - 2);
            const char* a1 = cA + (size_t)(t + 1) * kstep;
            const char* a2 = last ? nA : cA + (size_t)(t + 2) * kstep; const char* b2 = last ? nB : cB + (size_t)(t + 2) * kstep;
            const char* a3 = a2 + kstep; const char* b3 = b2 + kstep;
            PG8_LDB(B0, 0, 0); PG8_LDB(B1, 0, 1); PG8_SCHED; PG8_LDA(At, 0, 0); PG8_STAGE(PG8_SA(1, 1), a1, cOff[1]);
            if (last && has_next) S.a_off(nxt, cOff);
            PG8_WAIT_V(8); PG8_WAIT_L(0); PG8_BAR; PG8_MMA(0, 0, At, B0); PG8_MMA(0, 1, At, B1); PG8_BAR; PG8_SCHED;
            PG8_LDA(At, 0, 1); PG8_STAGE(PG8_SB(0, 0), b2, voffB); PG8_STAGE(PG8_SB(0, 1), b2 + hstep, voffB); PG8_STAGE(PG8_SA(0, 0), a2, cOff[0]);
            PG8_WAIT_V(8); PG8_WAIT_L(0); PG8_BAR; PG8_MMA(1, 0, At, B0); PG8_MMA(1, 1, At, B1); PG8_BAR; PG8_SCHED;
            PG8_LDB(B0, 1, 0); PG8_LDB(B1, 1, 1); PG8_SCHED; PG8_LDA(At, 1, 0); PG8_STAGE(PG8_SA(0, 1), a2, cOff[1]);
            PG8_WAIT_V(8); PG8_WAIT_L(0); PG8_BAR; PG8_MMA(0, 0, At, B0); PG8_MMA(0, 1, At, B1); PG8_BAR; PG8_SCHED;
            PG8_LDA(At, 1, 1); PG8_STAGE(PG8_SB(1, 0), b3, voffB); PG8_STAGE(PG8_SB(1, 1), b3 + hstep, voffB); PG8_STAGE(PG8_SA(1, 0), a3, cOff[0]);
            PG8_WAIT_V(8); PG8_WAIT_L(0); PG8_BAR; PG8_MMA(1, 0, At, B0); PG8_MMA(1, 1, At, B1); PG8_BAR; PG8_SCHED;
        }
        if (wr == 0) PG8_BAR;
        E(acc, cur, wr, wc, fr, fq);
        if (!has_next) break;
#pragma unroll
        for (int a = 0; a < 2; ++a)
#pragma unroll
            for (int b = 0; b < 2; ++b)
#pragma unroll
                for (int m = 0; m < 4; ++m)
#pragma unroll
                    for (int n = 0; n < 2; ++n) acc[a][b][m][n] = (f32x4){0.f, 0.f, 0.f, 0.f};
        cur = nxt; cA = nA; cB = nB; ++ui;
        if (wr == 1) PG8_BAR;
    }
    PG8_WAIT_V(0);
    PG8_BAR;
#undef PG8_SA
#undef PG8_SB
#undef PG8_STAGE
#undef PG8_LDA
#undef PG8_LDB
#undef PG8_MMA
#undef PG8_WAIT_V
#undef PG8_WAIT_L
#undef PG8_BAR
#undef PG8_SCHED
}
}

namespace att {
constexpr int D = 128, NW = 8, QBLK = 32, KVBLK = 64, QB = NW * QBLK;
constexpr float SCALE = 0.08838834764831845f;
constexpr float THR = 8.f;
constexpr int SHM_V = KVBLK * D * 2, SHM_K = KVBLK * D * 2;
constexpr int ATT_LDS = 2 * SHM_V + 2 * SHM_K + NW * 256 * 4;
#define KSWZ(row, colB) ((row) * 256 + ((colB) ^ (((row) & 7) << 4)))
__device__ __forceinline__ int v_st(int k, int c) { const int kk = (k & ~0xC) | ((k & 4) << 1) | ((k & 8) >> 1); return ((kk >> 3) * 4 + (c >> 5)) * 512 + ((kk & 7) * 32 + (c & 31)) * 2; }
__device__ __forceinline__ int v_rd_base(int lane) { return ((lane & 3) << 3) | (((lane >> 2) & 3) << 6) | (((lane >> 4) & 1) << 5) | (((lane >> 5) & 1) << 8); }
constexpr int v_rd_off(int d0, int ks, int half) { return d0 * 512 + ks * 4096 + half * 2048; }
__device__ __forceinline__ int crow(int r, int hi) { return (r & 3) + 8 * (r >> 2) + 4 * hi; }
__device__ __forceinline__ bf16x8 load8(const bf16_t* p) { return *reinterpret_cast<const bf16x8*>(p); }
__device__ __forceinline__ void mask_tile(f32x16& p0, f32x16& p1, int dq, unsigned W) {
    const float NEG = -__builtin_inff();
#pragma unroll
    for (int r = 0; r < 16; ++r) {
        const int c = (r & 3) + 8 * (r >> 2);
        if ((unsigned)(dq - c) >= W) p0[r] = NEG;
        if ((unsigned)(dq - c - 32) >= W) p1[r] = NEG;
    }
}
__device__ __forceinline__ void partialSM(f32x16& p0, f32x16& p1, float& m_reg, float& mn, float& alpha) {
    float pmax = p0[0];
#pragma unroll
    for (int r = 1; r < 16; ++r) pmax = fmaxf(pmax, p0[r]);
#pragma unroll
    for (int r = 0; r < 16; ++r) pmax = fmaxf(pmax, p1[r]);
    { auto rr = __builtin_amdgcn_permlane32_swap(__float_as_uint(pmax), __float_as_uint(pmax), false, false);
      pmax = fmaxf(__uint_as_float(rr[0]), __uint_as_float(rr[1])); }
    constexpr float C2 = 1.4426950408889634f * SCALE;
    if (__builtin_expect(__all((pmax - m_reg) * SCALE <= THR), 1)) { mn = m_reg; alpha = 1.f; }
    else { mn = fmaxf(m_reg, pmax); alpha = __builtin_amdgcn_exp2f((m_reg - mn) * C2); m_reg = mn; }
    const float mnL = -mn * C2;
#pragma unroll
    for (int r = 0; r < 16; ++r) p0[r] = fmaf(p0[r], C2, mnL);
#pragma unroll
    for (int r = 0; r < 16; ++r) p1[r] = fmaf(p1[r], C2, mnL);
#pragma unroll
    for (int r = 0; r < 16; ++r) p0[r] = __builtin_amdgcn_exp2f(p0[r]);
}
__device__ __forceinline__ void finishSM(f32x16& p0, f32x16& p1, float alpha, float& l_reg, bf16x8& pa0, bf16x8& pa1, bf16x8& pa2, bf16x8& pa3) {
#pragma unroll
    for (int r = 0; r < 16; ++r) p1[r] = __builtin_amdgcn_exp2f(p1[r]);
    float ps = 0;
#pragma unroll
    for (int r = 0; r < 16; ++r) ps += p0[r];
#pragma unroll
    for (int r = 0; r < 16; ++r) ps += p1[r];
    { auto rr = __builtin_amdgcn_permlane32_swap(__float_as_uint(ps), __float_as_uint(ps), false, false);
      ps = __uint_as_float(rr[0]) + __uint_as_float(rr[1]); }
    l_reg = l_reg * alpha + ps;
#define PK4(P, B_, OUT) do { unsigned a0 = cvt_pk_bf16(P[B_+0], P[B_+1]), a1 = cvt_pk_bf16(P[B_+2], P[B_+3]);                          \
        unsigned b0 = cvt_pk_bf16(P[B_+4], P[B_+5]), b1 = cvt_pk_bf16(P[B_+6], P[B_+7]);                                             \
        auto r0 = __builtin_amdgcn_permlane32_swap(a0, b0, false, false); auto r1 = __builtin_amdgcn_permlane32_swap(a1, b1, false, false); \
        u32x4 w = {r0[0], r1[0], r0[1], r1[1]}; OUT = *reinterpret_cast<bf16x8*>(&w); } while (0)
    PK4(p0, 0, pa0); PK4(p0, 8, pa1); PK4(p1, 0, pa2); PK4(p1, 8, pa3);
#undef PK4
}
template <int KB>
__device__ __forceinline__ void qkt(f32x16& p0, f32x16& p1, const char* K_lds, int r32, int hi, const bf16x8* qr) {
    p0 = f32x16{}; p1 = f32x16{};
    const char* kb[4];
#pragma unroll
    for (int dd = 0; dd < 4; ++dd) kb[dd] = K_lds + KB * SHM_K + KSWZ(r32, (dd * 16 + hi * 8) * 2);
#pragma unroll
    for (int d0 = 0; d0 < 8; ++d0) { const char* a = kb[d0 & 3] + (d0 >> 2) * 128;
        bf16x8 b0 = *reinterpret_cast<const bf16x8*>(a);
        bf16x8 b1 = *reinterpret_cast<const bf16x8*>(a + 32 * 256);
        p0 = __builtin_amdgcn_mfma_f32_32x32x16_bf16(b0, qr[d0], p0, 0, 0, 0);
        p1 = __builtin_amdgcn_mfma_f32_32x32x16_bf16(b1, qr[d0], p1, 0, 0, 0); }
}
template <int VB>
__device__ __forceinline__ void pv_tile(f32x16* o, int vb0, bf16x8 pa0, bf16x8 pa1, bf16x8 pa2, bf16x8 pa3) {
#define TRRD(dst, off) asm volatile("ds_read_b64_tr_b16 %0, %1 offset:%2" : "=&v"(dst) : "v"(vb0), "i"(off) : "memory")
#define PV_D0(d0) do { s16x4 l0, l1, l2, l3, h0, h1, h2, h3; constexpr int b_ = VB * SHM_V + v_rd_off(d0, 0, 0); \
        TRRD(l0, b_); TRRD(h0, b_ + 2048); TRRD(l1, b_ + 4096); TRRD(h1, b_ + 6144); TRRD(l2, b_ + 8192); TRRD(h2, b_ + 10240); TRRD(l3, b_ + 12288); TRRD(h3, b_ + 14336); \
        asm volatile("s_waitcnt lgkmcnt(0)" ::: "memory"); SBAR(); \
        o[d0] = __builtin_amdgcn_mfma_f32_32x32x16_bf16(pa0, (bf16x8){l0[0], l0[1], l0[2], l0[3], h0[0], h0[1], h0[2], h0[3]}, o[d0], 0, 0, 0);   \
        o[d0] = __builtin_amdgcn_mfma_f32_32x32x16_bf16(pa1, (bf16x8){l1[0], l1[1], l1[2], l1[3], h1[0], h1[1], h1[2], h1[3]}, o[d0], 0, 0, 0);   \
        o[d0] = __builtin_amdgcn_mfma_f32_32x32x16_bf16(pa2, (bf16x8){l2[0], l2[1], l2[2], l2[3], h2[0], h2[1], h2[2], h2[3]}, o[d0], 0, 0, 0);   \
        o[d0] = __builtin_amdgcn_mfma_f32_32x32x16_bf16(pa3, (bf16x8){l3[0], l3[1], l3[2], l3[3], h3[0], h3[1], h3[2], h3[3]}, o[d0], 0, 0, 0); } while (0)
    PV_D0(0); PV_D0(1); PV_D0(2); PV_D0(3);
#undef PV_D0
#undef TRRD
}
struct BlockRef { const bf16_t* Q; const bf16_t* K; const bf16_t* V; bf16_t* O; const unsigned* sel; const unsigned* list; float* ML; int P0, jlo, nvalid, nblk, hb; };
struct Seam { bf16x8 qr[8]; bf16x8 st_v0, st_v1, st_k0, st_k1; unsigned sel, qrow; };
#define ROW(p, k0, rr) ((p) + (size_t)((k0) + (rr)) * D + sc)
#define VMWN(n) asm volatile("s_waitcnt vmcnt(%0)" :: "i"(n) : "memory")
#define SLOAD_H(Kp, Vp, k0) do { S.st_v0 = load8(ROW(Vp, k0, sr)); S.st_v1 = load8(ROW(Vp, k0, 32 + sr));              \
                         S.st_k0 = load8(ROW(Kp, k0, sr)); S.st_k1 = load8(ROW(Kp, k0, 32 + sr)); } while (0)
#define SWRITE_HK(bf) do { *(bf16x8*)(K_lds + (bf) * SHM_K + kws) = S.st_k0; *(bf16x8*)(K_lds + (bf) * SHM_K + kws + 32 * 256) = S.st_k1; } while (0)
#define SWRITE_HV(bf) do { *(bf16x8*)(V_lds + (bf) * SHM_V + vst0) = S.st_v0; *(bf16x8*)(V_lds + (bf) * SHM_V + vst1) = S.st_v1; } while (0)
#define SWRITE_H(bf) do { SWRITE_HV(bf); SWRITE_HK(bf); } while (0)
template <bool SP>
__device__ __forceinline__ void attn_prime(const BlockRef& cur, char* lds, Seam& S) {
    int tid = threadIdx.x; asm volatile("" : "+v"(tid));
    const int wid = __builtin_amdgcn_readfirstlane(tid >> 6), lane = tid & 63, r32 = lane & 31, hi = lane >> 5;
    const int sr = tid >> 4, sc = (tid & 15) * 8, kws = KSWZ(sr, sc * 2); char* K_lds = lds + 2 * SHM_V;
    const int i = wid * QBLK + r32;
    unsigned q = (unsigned)i;
    if (SP) q = cur.list ? cur.list[i < cur.nvalid ? i : cur.nvalid - 1] : (unsigned)(cur.P0 + i);
    S.qrow = q; S.sel = SP ? cur.sel[q] : 0u;
#pragma unroll
    for (int d0 = 0; d0 < 8; ++d0) S.qr[d0] = load8(cur.Q + (size_t)q * D + d0 * 16 + hi * 8);
    SLOAD_H(cur.K, cur.V, SP ? cur.jlo * KVBLK : 0); VM_WAIT(); SWRITE_HK(0);
    __syncthreads();
}
template <bool SP>
__device__ __forceinline__ void attn_block(const BlockRef& cur, const BlockRef& nxt, const int ostride, char* lds, Seam& S) {
    int tid = threadIdx.x; asm volatile("" : "+v"(tid));
    const int wid = __builtin_amdgcn_readfirstlane(tid >> 6), lane = tid & 63, r32 = lane & 31, hi = lane >> 5;
    const int NT = SP ? 4 : cur.P0 / KVBLK + 4;
    const int jlo = SP ? cur.jlo : 0;
    const int qlo = cur.P0 + wid * QBLK, qm = qlo + r32 - 4 * hi;
    char* V_lds = lds; char* K_lds = lds + 2 * SHM_V;
    float* ws = (float*)(lds + 2 * SHM_V + 2 * SHM_K) + wid * 256; float* li_l = ws, * al_l = ws + 32;
    unsigned* rd = (unsigned*)(ws + 64); unsigned* nl = (unsigned*)(ws + 96);
    float m_reg = -1e30f, l_reg = 0; f32x16 o[4] = {};
    const int sr = tid >> 4, sc = (tid & 15) * 8, vst0 = v_st(sr, sc), vst1 = v_st(32 + sr, sc), kws = KSWZ(sr, sc * 2);
    const int vb0 = (int)(uintptr_t)V_lds + v_rd_base(lane);
    const bf16_t* Kh = cur.K; const bf16_t* Vh = cur.V;
    const bool causal = !SP || cur.list == nullptr;
#define RESC(a) do { if (__any((a) < 1.f)) { if (hi == 0) al_l[r32] = (a); asm volatile("s_waitcnt lgkmcnt(0)" ::: "memory");              \
                     for (int d_ = 0; d_ < 4; ++d_) for (int r = 0; r < 16; ++r) o[d_][r] *= al_l[crow(r, hi)]; } } while (0)
#define KBASE(t) ((jlo + (t)) * KVBLK)
#define MASKT(P0_, P1_, t) do { const int kb_ = KBASE(t); if (causal && kb_ + KVBLK - 1 > qlo) mask_tile(P0_, P1_, qm - kb_, 0x40000000u); } while (0)
    constexpr int NQL = 8;
#define SEAM_K0() do { VMWN(NQL); SWRITE_HK(0); SBAR(); } while (0)
    f32x16 pA0, pA1, pB0, pB1; float mnA, mnB, alA, alB; bf16x8 pa0, pa1, pa2, pa3;
    unsigned qn_tmp = 0u;
    if (SP) {
        if (hi == 0) { const bool valid = (cur.list == nullptr) || (wid * QBLK + r32 < cur.nvalid);
            const unsigned slot = cur.list ? (unsigned)__builtin_popcount(S.sel & ((1u << cur.nblk) - 1u)) : 3u;
            rd[r32] = valid ? (((unsigned)cur.hb + S.qrow) * 4u + slot) * 128u : (1u << 27); }
        if (nxt.list) { const int i = wid * QBLK + r32; qn_tmp = nxt.list[i < nxt.nvalid ? i : nxt.nvalid - 1]; }
    }
    SWRITE_HV(0); SBAR();
    if (NT > 1) { SLOAD_H(Kh, Vh, KBASE(1)); }
    SBAR(); qkt<0>(pA0, pA1, K_lds, r32, hi, S.qr);
    MASKT(pA0, pA1, 0); partialSM(pA0, pA1, m_reg, mnA, alA);
    if (NT > 1) { VM_WAIT(); SWRITE_H(1); }
    if (SP) nl[lane] = nxt.list ? qn_tmp : (unsigned)(nxt.P0 + wid * QBLK + r32);
    __syncthreads();
#define HALF_STEP(PX0, PX1, mnX, alX, PY0, PY1, alY, t, KB, VB, SB) do {                                                      \
        SBAR(); qkt<KB>(PX0, PX1, K_lds, r32, hi, S.qr);                                                                      \
        finishSM(PY0, PY1, alY, l_reg, pa0, pa1, pa2, pa3); SBAR();                                                           \
        if ((t) + 1 < NT) { SLOAD_H(Kh, Vh, KBASE((t) + 1)); SBAR(); }                                                        \
        pv_tile<VB>(o, vb0, pa0, pa1, pa2, pa3); MASKT(PX0, PX1, (t)); partialSM(PX0, PX1, m_reg, mnX, alX);                  \
        __syncthreads();                                                                                                      \
        if ((t) + 1 < NT) { VM_WAIT(); SWRITE_H(SB); }                                                                        \
        RESC(alX); __syncthreads(); } while (0)
    for (int t = 1; t + 1 < NT; t += 2) {
        HALF_STEP(pB0, pB1, mnB, alB, pA0, pA1, alA, t, 1, 0, 0);
        HALF_STEP(pA0, pA1, mnA, alA, pB0, pB1, alB, t + 1, 0, 1, 1);
    }
    const bool even = (NT & 1) == 0;
    if (even) { SBAR(); qkt<1>(pB0, pB1, K_lds, r32, hi, S.qr); SBAR(); }
    unsigned qn = (unsigned)(wid * QBLK + r32);
    if (SP) { qn = nl[lane]; S.qrow = qn; S.sel = nxt.sel[qn]; }
    SLOAD_H(nxt.K, nxt.V, SP ? nxt.jlo * KVBLK : 0); SBAR();
#pragma unroll
    for (int d0 = 0; d0 < 8; ++d0) S.qr[d0] = load8(nxt.Q + (size_t)qn * D + d0 * 16 + hi * 8);
    SBAR();
    finishSM(pA0, pA1, alA, l_reg, pa0, pa1, pa2, pa3); SBAR();
    pv_tile<0>(o, vb0, pa0, pa1, pa2, pa3);
    if (even) { MASKT(pB0, pB1, NT - 1); partialSM(pB0, pB1, m_reg, mnB, alB); __syncthreads(); RESC(alB);
        finishSM(pB0, pB1, alB, l_reg, pa0, pa1, pa2, pa3); SBAR(); pv_tile<1>(o, vb0, pa0, pa1, pa2, pa3); }
    SBAR(); SEAM_K0();
    if (hi == 0) li_l[r32] = l_reg; asm volatile("s_waitcnt lgkmcnt(0)" ::: "memory");
    float rli[16];
#pragma unroll
    for (int r = 0; r < 16; ++r) rli[r] = __builtin_amdgcn_rcpf(li_l[crow(r, hi)]);
    if (SP) {
        bf16_t* Ob = cur.O;
#pragma unroll
        for (int r = 0; r < 16; ++r) { const unsigned off = rd[crow(r, hi)];
#pragma unroll
            for (int d0 = 0; d0 < 4; ++d0) { const float v = o[d0][r] * rli[r];
                const float vn = __int_as_float(__builtin_amdgcn_mov_dpp(__float_as_int(v), 0xB1, 0xF, 0xF, true));
                if ((r32 & 1) == 0) *(unsigned*)(Ob + (size_t)off + d0 * 32 + r32) = cvt_pk_bf16(v, vn); } }
        if (hi == 0) { float* mlp = cur.ML + (size_t)(rd[r32] >> 7) * 2; f32x2 ml = {m_reg, l_reg}; *(f32x2*)mlp = ml; }
    } else {
        bf16_t* Ow = cur.O + (size_t)(wid * QBLK) * ostride;
#pragma unroll
        for (int r = 0; r < 16; ++r) { const int orow = crow(r, hi);
#pragma unroll
            for (int d0 = 0; d0 < 4; ++d0) { const float v = o[d0][r] * rli[r];
                const float vn = __int_as_float(__builtin_amdgcn_mov_dpp(__float_as_int(v), 0xB1, 0xF, 0xF, true));
                if ((r32 & 1) == 0) *(unsigned*)(Ow + (size_t)orow * ostride + d0 * 32 + r32) = cvt_pk_bf16(v, vn); } }
    }
    __syncthreads();
#undef RESC
#undef KBASE
#undef MASKT
#undef SEAM_K0
#undef HALF_STEP
}
#undef ROW
#undef VMWN
#undef SLOAD_H
#undef SWRITE_HK
#undef SWRITE_HV
#undef SWRITE_H
}

struct Args { const float* in[23]; float* out; unsigned char* ws; int ph_lo, ph_hi; };
typedef const __attribute__((address_space(4))) Args* KArgs;
__device__ __forceinline__ KArgs kargs() { KArgs p = (KArgs)__builtin_amdgcn_kernarg_segment_ptr(); asm volatile("" : "+s"(p)); return p; }
__device__ __forceinline__ int otid() { int t = threadIdx.x; asm volatile("" : "+v"(t)); return t; }
struct Geo { int G, bx, vcu, gw, NGW; };
__device__ __forceinline__ Geo geo() {
    Geo g; const int tid = otid(); const int wave = __builtin_amdgcn_readfirstlane(tid >> 6);
    g.G = gridDim.x; g.bx = blockIdx.x; g.vcu = (g.G % 8 == 0) ? (g.bx % 8) * (g.G / 8) + g.bx / 8 : g.bx; g.gw = g.vcu * NWAVES + wave; g.NGW = g.G * NWAVES; return g;
}
enum { I_X = 0, I_POS, I_LN1G, I_LN1B, I_LN2G, I_LN2B, I_DAWIN, I_DAWOUT, I_LQ1, I_LK1, I_LQ2, I_LK2, I_SUBLN, I_MBWIN, I_MBWOUT, I_WR, I_RB, I_WG, I_WU, I_WD, I_SG, I_SU, I_SD };

__device__ __forceinline__ int dst_row(int kind, int n) {
    if (kind == 1) { if (n < 4096) { int d = n & 127; const int h = n & ~127; if (d < 16) d = 2 * d; else if (d < 32) d = 2 * (d - 16) + 1; return h + d; } return n; }
    if (kind == 2) return ((n >> 7) << 8) + (n & 127);
    if (kind == 3) return ((n >> 7) << 8) + 128 + (n & 127);
    return n;
}
struct TrDesc { const float* W; unsigned char* WT; int K, N, k0, n0, kind, f8; };
constexpr int IT_IN = 32 * 192, IT_OUT = 32 * 64, IT_E = 512, IT_ATT = 2 * IT_IN + 2 * IT_OUT, IT_TOTAL = IT_ATT + 2 * NEX * 3 * IT_E;
__device__ __forceinline__ void tr_decode(KArgs a, int it, TrDesc& d) {
    unsigned char* ws = a->ws; int s;
    if (it < IT_ATT) {
        if (it < IT_IN) { d.W = a->in[I_DAWIN]; d.WT = ws + WS_WATT; d.K = DM; d.N = NQKV; d.kind = 1; d.f8 = FP8_QKV0; s = it; }
        else if (it < 2 * IT_IN) { d.W = a->in[I_MBWIN]; d.WT = ws + WS_WATT + 32 * MiB; d.K = DM; d.N = NQKV; d.kind = 1; d.f8 = FP8_QKV1; s = it - IT_IN; }
        else if (it < 2 * IT_IN + IT_OUT) { d.W = a->in[I_DAWOUT]; d.WT = ws + WS_WATT + 24 * MiB; d.K = DM; d.N = DM; d.kind = 0; d.f8 = FP8_OUT0; s = it - 2 * IT_IN; }
        else { d.W = a->in[I_MBWOUT]; d.WT = ws + WS_WATT + 56 * MiB; d.K = DM; d.N = DM; d.kind = 0; d.f8 = FP8_OUT1; s = it - 2 * IT_IN - IT_OUT; }
    } else {
        const int r = it - IT_ATT, le = r / (3 * IT_E), sub = r - le * (3 * IT_E), mtx = sub / IT_E; s = sub - mtx * IT_E;
        const int l = le / NEX, e = le - l * NEX;
        const size_t EW = (size_t)DM * DE;
        if (mtx < 2) {
            const float* src = (e < NE) ? a->in[mtx == 0 ? I_WG : I_WU] + ((size_t)l * NE + e) * EW : a->in[mtx == 0 ? I_SG : I_SU] + (size_t)l * EW;
            d.f8 = (l == 1) ? FP8_MOE1 : 0;
            d.W = src; d.WT = ws + WS_WGU + (size_t)l * NEX * (2 * EW) * 2 + (size_t)e * (2 * EW) * (d.f8 ? 1 : 2); d.K = DM; d.N = DE; d.kind = 2 + mtx;
        } else {
            const float* src = (e < NE) ? a->in[I_WD] + ((size_t)l * NE + e) * EW : a->in[I_SD] + (size_t)l * EW;
            d.f8 = (l == 1) ? FP8_MOE1 : 0;
            d.W = src; d.WT = ws + WS_WD + (size_t)l * NEX * EW * 2 + (size_t)e * EW * (d.f8 ? 1 : 2); d.K = DE; d.N = DM; d.kind = 0;
        }
    }
    const int nblk = d.N / 32; const int kb = s / nblk; d.k0 = kb * 64; d.n0 = (s - kb * nblk) * 32;
}
__device__ __forceinline__ void tr_load(const TrDesc& d, int lane, f32x4 (&v)[8]) {
    const int kk = lane >> 3, n4 = (lane & 7) * 4;
#pragma unroll
    for (int i = 0; i < 8; ++i) v[i] = *(const f32x4*)(d.W + (size_t)(d.k0 + kk + 8 * i) * d.N + d.n0 + n4);
}
__device__ __forceinline__ void tr_store(const TrDesc& d, int lane, const f32x4 (&v)[8], LAS float* scr) {
    const int kk = lane >> 3, n4 = (lane & 7) * 4, c = lane & 3;
#pragma unroll
    for (int hf = 0; hf < 2; ++hf) {
#pragma unroll
        for (int i = 0; i < 4; ++i)
#pragma unroll
            for (int q = 0; q < 4; ++q) scr[(kk + 8 * i) * 33 + n4 + q] = v[hf * 4 + i][q];
        LDS_WAIT();
#pragma unroll
        for (int j = 0; j < 2; ++j) { const int n = (lane >> 2) + 16 * j; const LAS float* s = scr + (8 * c) * 33 + n;
            const size_t eo = (size_t)dst_row(d.kind, d.n0 + n) * d.K + d.k0 + hf * 32 + 8 * c;
            if (d.f8) { u32x2 o; o.x = pk4_fp8(s[0 * 33] * W8_SCALE, s[1 * 33] * W8_SCALE, s[2 * 33] * W8_SCALE, s[3 * 33] * W8_SCALE); o.y = pk4_fp8(s[4 * 33] * W8_SCALE, s[5 * 33] * W8_SCALE, s[6 * 33] * W8_SCALE, s[7 * 33] * W8_SCALE);
                *(u32x2*)(d.WT + eo) = o; }
            else { u32x4 o; o.x = cvt_pk_bf16(s[0 * 33], s[1 * 33]); o.y = cvt_pk_bf16(s[2 * 33], s[3 * 33]); o.z = cvt_pk_bf16(s[4 * 33], s[5 * 33]); o.w = cvt_pk_bf16(s[6 * 33], s[7 * 33]);
                *(u32x4*)(d.WT + eo * 2) = o; } }
        LDS_WAIT();
    }
}
__device__ __forceinline__ void convert_items(KArgs a, LAS float* scr, int gw, int NGW, int lane, int it0, int it1) {
    TrDesc dA, dB, dC; f32x4 vA[8], vB[8], vC[8];
    int it = it0 + gw;
#define CV_LD(D, V, IT) do { if ((IT) < it1) { tr_decode(a, (IT), D); tr_load(D, lane, V); } } while (0)
    CV_LD(dA, vA, it); CV_LD(dB, vB, it + NGW); CV_LD(dC, vC, it + 2 * NGW);
    while (it < it1) {
        tr_store(dA, lane, vA, scr); CV_LD(dA, vA, it + 3 * NGW);
        if (it + NGW < it1) { tr_store(dB, lane, vB, scr); CV_LD(dB, vB, it + 4 * NGW); }
        if (it + 2 * NGW < it1) { tr_store(dC, lane, vC, scr); CV_LD(dC, vC, it + 5 * NGW); }
        it += 3 * NGW;
    }
#undef CV_LD
}
__device__ __forceinline__ void p0_prologue(KArgs a, LAS unsigned char* lds, int gw, int NGW, int wave, int lane) {
    LAS float* scr = (LAS float*)(lds + wave * 4224);
    convert_items(a, scr, gw, NGW, lane, 0, IT_IN);
    {
        const float* x = a->in[I_X]; bf16_t* xb = (bf16_t*)(a->ws + WS_XB);
        f32x4 vn[8];
        if (gw < NTOK) {
#pragma unroll
            for (int j = 0; j < 4; ++j) { vn[2 * j] = *(const f32x4*)(x + (size_t)gw * DM + 512 * j + 8 * lane); vn[2 * j + 1] = *(const f32x4*)(x + (size_t)gw * DM + 512 * j + 8 * lane + 4); } }
        for (int m = gw; m < NTOK; m += NGW) {
            f32x4 v[8];
#pragma unroll
            for (int j = 0; j < 8; ++j) v[j] = vn[j];
            if (m + NGW < NTOK) {
#pragma unroll
                for (int j = 0; j < 4; ++j) { vn[2 * j] = *(const f32x4*)(x + (size_t)(m + NGW) * DM + 512 * j + 8 * lane); vn[2 * j + 1] = *(const f32x4*)(x + (size_t)(m + NGW) * DM + 512 * j + 8 * lane + 4); } }
#pragma unroll
            for (int j = 0; j < 4; ++j) {
                if (FP8_QKV0) { u32x2 w; w.x = pk4_fp8(v[2 * j][0], v[2 * j][1], v[2 * j][2], v[2 * j][3]); w.y = pk4_fp8(v[2 * j + 1][0], v[2 * j + 1][1], v[2 * j + 1][2], v[2 * j + 1][3]);
                    *(u32x2*)((unsigned char*)xb + (size_t)m * DM + 512 * j + 8 * lane) = w; }
                else { u32x4 w; w.x = cvt_pk_bf16(v[2 * j][0], v[2 * j][1]); w.y = cvt_pk_bf16(v[2 * j][2], v[2 * j][3]); w.z = cvt_pk_bf16(v[2 * j + 1][0], v[2 * j + 1][1]); w.w = cvt_pk_bf16(v[2 * j + 1][2], v[2 * j + 1][3]);
                    *(u32x4*)(xb + (size_t)m * DM + 512 * j + 8 * lane) = w; } }
        }
    }
    {
        bf16_t* wf = (bf16_t*)(a->ws + WS_WRF);
        for (int idx = gw * 64 + lane; idx < 2 * 2 * 128 * 64; idx += NGW * 64) {
            const int ln = idx & 63, s = (idx >> 6) & 127, blk = (idx >> 13) & 1, l = idx >> 14;
            const int e = blk * 32 + (ln & 31), c = 16 * s + 8 * (ln >> 5);
            const float* w = a->in[I_WR] + ((size_t)l * DM + c) * NE + e;
            float v[8];
#pragma unroll
            for (int j = 0; j < 8; ++j) v[j] = w[(size_t)j * NE];
            u32x4 h, lo;
            h.x = cvt_pk_bf16(v[0], v[1]); h.y = cvt_pk_bf16(v[2], v[3]); h.z = cvt_pk_bf16(v[4], v[5]); h.w = cvt_pk_bf16(v[6], v[7]);
            lo.x = cvt_pk_bf16(v[0] - bf_lo(h.x), v[1] - bf_hi(h.x)); lo.y = cvt_pk_bf16(v[2] - bf_lo(h.y), v[3] - bf_hi(h.y));
            lo.z = cvt_pk_bf16(v[4] - bf_lo(h.z), v[5] - bf_hi(h.z)); lo.w = cvt_pk_bf16(v[6] - bf_lo(h.w), v[7] - bf_hi(h.w));
            const size_t fo = (((size_t)(l * 2 + 0) * 2 + blk) * 128 + s) * 64 + ln, fl = (((size_t)(l * 2 + 1) * 2 + blk) * 128 + s) * 64 + ln;
            *(u32x4*)(wf + fo * 8) = h; *(u32x4*)(wf + fl * 8) = lo;
        }
    }
    {
        const int* pos = (const int*)a->in[I_POS]; float* tab = (float*)(a->ws + WS_ROPE);
        for (int idx = gw * 64 + lane; idx < NTOK * 16; idx += NGW * 64) {
            const int t = idx >> 4, i = idx & 15;
            const float inv = powf(500000.f, -(float)(2 * i) / 32.f);
            const float ang = (float)pos[t] * inv;
            double rev = (double)ang * 0.15915494309189535; rev -= floor(rev);
            const float fr = (float)rev;
            tab[(size_t)t * 32 + i] = __builtin_amdgcn_cosf(fr); tab[(size_t)t * 32 + 16 + i] = __builtin_amdgcn_sinf(fr);
        }
    }
}

__device__ __forceinline__ void da_combine(KArgs a, int gw, int NGW, int lane) {
    float lam;
    {   const float* q1 = a->in[I_LQ1]; const float* k1 = a->in[I_LK1]; const float* q2 = a->in[I_LQ2]; const float* k2 = a->in[I_LK2];
        const float s1 = wave_sum(q1[lane] * k1[lane] + q1[lane + 64] * k1[lane + 64]);
        const float s2 = wave_sum(q2[lane] * k2[lane] + q2[lane + 64] * k2[lane + 64]);
        lam = expf(s1) - expf(s2) + LAMBDA_INIT; }
    const bf16_t* O = (const bf16_t*)(a->ws + WS_O); bf16_t* AO = (bf16_t*)(a->ws + WS_AOUT);
    const f32x4 g = *(const f32x4*)(a->in[I_SUBLN] + 4 * lane);
    for (int t = gw; t < NTOK; t += NGW) {
        const bf16_t* row = O + (size_t)t * 4096;
        u32x2 x1[8], x2[8];
#pragma unroll
        for (int h = 0; h < 8; ++h) { x1[h] = *(const u32x2*)(row + h * 512 + 4 * lane); x2[h] = *(const u32x2*)(row + h * 512 + 256 + 4 * lane); }
#pragma unroll
        for (int h = 0; h < 8; ++h) {
            f32x4 o;
            o[0] = bf_lo(x1[h].x) - lam * bf_lo(x2[h].x); o[1] = bf_hi(x1[h].x) - lam * bf_hi(x2[h].x);
            o[2] = bf_lo(x1[h].y) - lam * bf_lo(x2[h].y); o[3] = bf_hi(x1[h].y) - lam * bf_hi(x2[h].y);
            const float ss = wave_sum(o[0] * o[0] + o[1] * o[1] + o[2] * o[2] + o[3] * o[3]);
            const float sc = __builtin_amdgcn_rsqf(ss * (1.f / 256.f) + LN_EPS) * (1.f - LAMBDA_INIT);
            if (FP8_OUT0) { const float s8 = sc * AO8_SCALE; *(unsigned*)((unsigned char*)AO + (size_t)t * DM + h * 256 + 4 * lane) = pk4_fp8(o[0] * s8 * g[0], o[1] * s8 * g[1], o[2] * s8 * g[2], o[3] * s8 * g[3]); }
            else { u32x2 w; w.x = cvt_pk_bf16(o[0] * sc * g[0], o[1] * sc * g[1]); w.y = cvt_pk_bf16(o[2] * sc * g[2], o[3] * sc * g[3]);
                *(u32x2*)(AO + (size_t)t * DM + h * 256 + 4 * lane) = w; }
        }
    }
}

__device__ __forceinline__ void moba_kmean(KArgs a, int gw, int NGW, int lane) {
    const bf16_t* Kb = (const bf16_t*)(a->ws + WS_K); bf16_t* km = (bf16_t*)(a->ws + WS_KMEAN);
    for (int it = gw; it < BATCH * NSLAB * 32; it += NGW) {
        const int bh = it >> 5, n = it & 31;
        const bf16_t* p = Kb + ((size_t)bh * SEQ + (size_t)n * 256) * HD + 2 * lane;
        float s0 = 0.f, s1 = 0.f;
#pragma unroll 4
        for (int r = 0; r < 256; r += 8) {
            unsigned u[8];
#pragma unroll
            for (int q = 0; q < 8; ++q) u[q] = *(const unsigned*)(p + (size_t)(r + q) * HD);
#pragma unroll
            for (int q = 0; q < 8; ++q) { s0 += bf_lo(u[q]); s1 += bf_hi(u[q]); }
        }
        s0 *= (1.f / 256.f); s1 *= (1.f / 256.f);
        const unsigned hi = cvt_pk_bf16(s0, s1);
        const unsigned lo = cvt_pk_bf16(s0 - bf_lo(hi), s1 - bf_hi(hi));
        *(unsigned*)(km + ((size_t)bh * 64 + n) * HD + 2 * lane) = hi;
        *(unsigned*)(km + ((size_t)bh * 64 + 32 + n) * HD + 2 * lane) = lo;
    }
}
__device__ __forceinline__ void moba_gate(KArgs a, int gw, int NGW, int lane) {
    const bf16_t* Qb = (const bf16_t*)(a->ws + WS_Q); const bf16_t* km = (const bf16_t*)(a->ws + WS_KMEAN); unsigned* sel = (unsigned*)(a->ws + WS_SEL);
    unsigned* mcnt = (unsigned*)(a->ws + WS_CTL) + CW_MCNT; unsigned* qlist = (unsigned*)(a->ws + WS_QLIST);
    const int r32 = lane & 31, hi = lane >> 5;
    for (int it = gw; it < BATCH * NSLAB * (SEQ / 32); it += NGW) {
        const int bh = it >> 8, qg = it & 255, j = qg >> 3;
        const bf16_t* q = Qb + ((size_t)bh * SEQ + (size_t)qg * 32 + r32) * HD + hi * 8;
        const bf16_t* k = km + ((size_t)bh * 64 + r32) * HD + hi * 8;
        f32x16 p = {};
        bf16x8 qf[8], kh[8], kl[8];
#pragma unroll
        for (int d0 = 0; d0 < 8; ++d0) { qf[d0] = *(const bf16x8*)(q + d0 * 16); kh[d0] = *(const bf16x8*)(k + d0 * 16); kl[d0] = *(const bf16x8*)(k + 32 * HD + d0 * 16); }
        SBAR();
#pragma unroll
        for (int d0 = 0; d0 < 8; ++d0) {
            p = __builtin_amdgcn_mfma_f32_32x32x16_bf16(kh[d0], qf[d0], p, 0, 0, 0);
            p = __builtin_amdgcn_mfma_f32_32x32x16_bf16(kl[d0], qf[d0], p, 0, 0, 0);
        }
        float g[32];
#pragma unroll
        for (int r = 0; r < 16; ++r) {
            const float mine = p[r], other = __shfl_xor(mine, 32);
            const int qd = r >> 2, s = r & 3;
            g[8 * qd + s] = hi ? other : mine;
            g[8 * qd + 4 + s] = hi ? mine : other;
        }
        unsigned mask = 0u;
#pragma unroll
        for (int pass = 0; pass < 3; ++pass) {
            float best = -__builtin_inff(); int bi = -1;
#pragma unroll
            for (int n = 0; n < 32; ++n) { const bool ok = (n < j) && !((mask >> n) & 1u) && (g[n] > best); best = ok ? g[n] : best; bi = ok ? n : bi; }
            if (bi >= 0) mask |= 1u << bi;
        }
        if (hi == 0) sel[(size_t)bh * SEQ + (size_t)qg * 32 + r32] = mask;
        const bool rowlane = hi == 0;
        unsigned cntv = 0u;
        for (int n = 0; n < j; ++n) { const unsigned long long bb = __ballot(rowlane && ((mask >> n) & 1u)); if (lane == n) cntv = (unsigned)__popcll(bb); }
        unsigned basev = 0u;
        if (lane < j && cntv) basev = __hip_atomic_fetch_add(mcnt + bh * 32 + lane, cntv, __ATOMIC_RELAXED, __HIP_MEMORY_SCOPE_AGENT);
        for (int n = 0; n < j; ++n) { const unsigned long long bb = __ballot(rowlane && ((mask >> n) & 1u)); const unsigned base = (unsigned)__builtin_amdgcn_readlane((int)basev, n);
            if (rowlane && ((mask >> n) & 1u)) qlist[(size_t)(bh * 32 + n) * SEQ + base + (unsigned)__popcll(bb & ((1ull << lane) - 1ull))] = (unsigned)(qg * 32 + r32); }
    }
}

__device__ __forceinline__ void ln_router(KArgs a, int layer, LAS unsigned char* lds, int vcu, int G, int wave, int lane) {
    float* out = a->out; bf16_t* xb = (bf16_t*)(a->ws + WS_XB);
    const float* gam = a->in[I_LN1G] + layer * DM; const float* bet = a->in[I_LN1B] + layer * DM;
    const float rb = a->in[I_RB][layer * NE + lane];
    const bf16_t* wfh = (const bf16_t*)(a->ws + WS_WRF) + (size_t)(layer * 2 + 0) * 2 * 128 * 64 * 8;
    const bf16_t* wfl = (const bf16_t*)(a->ws + WS_WRF) + (size_t)(layer * 2 + 1) * 2 * 128 * 64 * 8;
    unsigned* gcount = (unsigned*)(a->ws + WS_CTL) + CW_CNT + layer * NE * 16;
    unsigned* list = (unsigned*)(a->ws + WS_LIST); unsigned* toke = (unsigned*)(a->ws + WS_TOKE); float* tokw = (float*)(a->ws + WS_TOKW);
    LAS unsigned char* xh = lds;
    LAS unsigned char* xl = lds + 65536;
    LAS float* part = (LAS float*)lds;
    LAS int* lcount = (LAS int*)(lds + LT_LCNT); LAS int* lbase = (LAS int*)(lds + LT_LBASE);
    LAS unsigned* ent = (LAS unsigned*)(lds + LT_ENT);
    const int t_beg = vcu * 64;
    if (threadIdx.x < 64) lcount[threadIdx.x] = 0;
    const int n32 = lane & 31, h5 = lane >> 5;
    f32x4 vn[8], gg[8], bb[8];
    {   const float* yr = out + (size_t)(t_beg + wave * 2) * DM;
#pragma unroll
        for (int j = 0; j < 8; ++j) vn[j] = *(const f32x4*)(yr + 256 * j + 4 * lane);
#pragma unroll
        for (int j = 0; j < 8; ++j) { gg[j] = *(const f32x4*)(gam + 256 * j + 4 * lane); bb[j] = *(const f32x4*)(bet + 256 * j + 4 * lane); } }
    __syncthreads();
#pragma unroll 1
    for (int it = 0; it < 4; ++it) {
#pragma unroll 1
        for (int k = 0; k < 2; ++k) {
            const int lt = 2 * wave + k, t = t_beg + 16 * it + lt; float* yr = out + (size_t)t * DM;
            f32x4 v[8]; float s = 0.f;
#pragma unroll
            for (int j = 0; j < 8; ++j) { v[j] = vn[j]; s += (v[j][0] + v[j][1]) + (v[j][2] + v[j][3]); }
            {
                const int tn = (k == 0) ? t + 1 : t + 15;
                if (k == 0 || it < 3) { const float* yn = out + (size_t)tn * DM;
#pragma unroll
                    for (int j = 0; j < 8; ++j) vn[j] = *(const f32x4*)(yn + 256 * j + 4 * lane); } }
            const float mean = wave_sum(s) * (1.f / DM); float s2 = 0.f;
#pragma unroll
            for (int j = 0; j < 8; ++j) { v[j] = v[j] - mean; s2 += (v[j][0] * v[j][0] + v[j][1] * v[j][1]) + (v[j][2] * v[j][2] + v[j][3] * v[j][3]); }
            const float rstd = __builtin_amdgcn_rsqf(wave_sum(s2) * (1.f / DM) + LN_EPS);
#pragma unroll
            for (int j = 0; j < 8; ++j) {
                const f32x4 xv = v[j] * rstd * gg[j] + bb[j];
                *(f32x4*)(yr + 256 * j + 4 * lane) = xv;
                u32x2 w; w.x = cvt_pk_bf16(xv[0], xv[1]); w.y = cvt_pk_bf16(xv[2], xv[3]);
                if (FP8_MOE1 && layer == 1) *(unsigned*)((unsigned char*)xb + (size_t)t * DM + 256 * j + 4 * lane) = pk4_fp8(xv[0], xv[1], xv[2], xv[3]);
                else *(u32x2*)(xb + (size_t)t * DM + 256 * j + 4 * lane) = w;
                u32x2 wl; wl.x = cvt_pk_bf16(xv[0] - bf_lo(w.x), xv[1] - bf_hi(w.x)); wl.y = cvt_pk_bf16(xv[2] - bf_lo(w.y), xv[3] - bf_hi(w.y));
                const int chunk = 32 * j + (lane >> 1), sw = lt * 4096 + ((chunk ^ lt) << 4) + 8 * (lane & 1);
                *(LAS u32x2*)(xh + sw) = w;
                *(LAS u32x2*)(xl + sw) = wl;
            }
        }
        __syncthreads();
        f32x16 acc0 = {}, acc1 = {};
        {
            const int row = n32 & 15;
            const bf16_t* wh0 = wfh + ((size_t)(0 * 128 + wave * 16) * 64 + lane) * 8; const bf16_t* wh1 = wfh + ((size_t)(1 * 128 + wave * 16) * 64 + lane) * 8;
            const bf16_t* wl0 = wfl + ((size_t)(0 * 128 + wave * 16) * 64 + lane) * 8; const bf16_t* wl1 = wfl + ((size_t)(1 * 128 + wave * 16) * 64 + lane) * 8;
#pragma unroll 1
            for (int sg = 0; sg < 16; sg += 4) {
                bf16x8 ah0[4], ah1[4], al0[4], al1[4];
#pragma unroll
                for (int u = 0; u < 4; ++u) { const int s = sg + u; ah0[u] = *(const bf16x8*)(wh0 + s * 512); ah1[u] = *(const bf16x8*)(wh1 + s * 512); al0[u] = *(const bf16x8*)(wl0 + s * 512); al1[u] = *(const bf16x8*)(wl1 + s * 512); }
                SBAR();
#pragma unroll
                for (int u = 0; u < 4; ++u) { const int s = sg + u;
                    const int off = row * 4096 + (((wave * 32 + 2 * s + h5) ^ row) << 4);
                    const bf16x8 bh = *(const LAS bf16x8*)(xh + off), bl = *(const LAS bf16x8*)(xl + off);
                    acc0 = __builtin_amdgcn_mfma_f32_32x32x16_bf16(ah0[u], bh, acc0, 0, 0, 0); acc1 = __builtin_amdgcn_mfma_f32_32x32x16_bf16(ah1[u], bh, acc1, 0, 0, 0);
                    acc0 = __builtin_amdgcn_mfma_f32_32x32x16_bf16(ah0[u], bl, acc0, 0, 0, 0); acc1 = __builtin_amdgcn_mfma_f32_32x32x16_bf16(ah1[u], bl, acc1, 0, 0, 0);
                    acc0 = __builtin_amdgcn_mfma_f32_32x32x16_bf16(al0[u], bh, acc0, 0, 0, 0); acc1 = __builtin_amdgcn_mfma_f32_32x32x16_bf16(al1[u], bh, acc1, 0, 0, 0); }
                SBAR();
            }
        }
        __syncthreads();
        if (n32 < 16) {
#pragma unroll
            for (int i = 0; i < 16; ++i) { const int e = (i & 3) + 8 * (i >> 2) + 4 * h5; part[(wave * 16 + n32) * 64 + e] = acc0[i]; part[(wave * 16 + n32) * 64 + 32 + e] = acc1[i]; }
        }
        __syncthreads();
#pragma unroll 1
        for (int k = 0; k < 2; ++k) {
            const int lt = 2 * wave + k, ti = 16 * it + lt;
            float logit = 0.f;
#pragma unroll
            for (int w = 0; w < 8; ++w) logit += part[(w * 16 + lt) * 64 + lane];
            const float sc = 1.f / (1.f + expf(-logit));
            const float bs = sc + rb;
            float m1 = bs;
            m1 = fmaxf(m1, dpp_mov<0xB1>(m1)); m1 = fmaxf(m1, dpp_mov<0x4E>(m1)); m1 = fmaxf(m1, dpp_mov<0x141>(m1));
            const unsigned long long eq = __ballot(bs == m1);
            const int gbase = lane & ~7;
            const int first = gbase + __builtin_ctz((unsigned)((eq >> gbase) & 0xffu));
            float m2 = (lane == first) ? -__builtin_inff() : bs;
            m2 = fmaxf(m2, dpp_mov<0xB1>(m2)); m2 = fmaxf(m2, dpp_mov<0x4E>(m2)); m2 = fmaxf(m2, dpp_mov<0x141>(m2));
            const float gs = m1 + m2; const int grp = lane >> 3;
            int grank = 0;
#pragma unroll
            for (int g2 = 0; g2 < 8; ++g2) { const float v = __int_as_float(__builtin_amdgcn_readlane(__float_as_int(gs), g2 * 8)); grank += (v > gs || (v == gs && g2 < grp)) ? 1 : 0; }
            const float masked = (grank < 4) ? bs : -__builtin_inff();
            int rank = 0;
#pragma unroll 8
            for (int e2 = 0; e2 < 64; ++e2) { const float v = __int_as_float(__builtin_amdgcn_readlane(__float_as_int(masked), e2)); rank += (v > masked || (v == masked && e2 < lane)) ? 1 : 0; }
            const bool selk = rank < 8;
            const float wsum = wave_sum(selk ? sc : 0.f);
            if (selk) {
                const int lp = __hip_atomic_fetch_add(lcount + lane, 1, __ATOMIC_RELAXED, __HIP_MEMORY_SCOPE_WORKGROUP);
                ent[(ti * 8 + rank) * 2] = ((unsigned)lane << 20) | (unsigned)lp;
                ((LAS float*)ent)[(ti * 8 + rank) * 2 + 1] = sc / wsum * ROUTED_SCALE;
            }
        }
        __syncthreads();
    }
    if (threadIdx.x < 64) { const int n = lcount[threadIdx.x]; lbase[threadIdx.x] = n > 0 ? (int)__hip_atomic_fetch_add(gcount + threadIdx.x * 16, (unsigned)n, __ATOMIC_RELAXED, __HIP_MEMORY_SCOPE_AGENT) : 0; }
    __syncthreads();
    for (int i = threadIdx.x; i < 64 * 8; i += NWAVES * 64) {
        const unsigned ep = ent[i * 2]; const float w = ((LAS float*)ent)[i * 2 + 1];
        const int e = ep >> 20, pos = lbase[e] + (int)(ep & 0xfffffu), t = t_beg + (i >> 3);
        list[(size_t)e * NTOK + pos] = (unsigned)t;
        toke[(size_t)t * 8 + (i & 7)] = ((unsigned)e << 20) | (unsigned)pos;
        tokw[(size_t)t * 8 + (i & 7)] = w;
    }
    __syncthreads();
}

__device__ __forceinline__ int moe_tables(KArgs a, int layer, LAS unsigned char* lds) {
    const unsigned* gcount = (const unsigned*)(a->ws + WS_CTL) + CW_CNT + layer * NE * 16;
    LAS int* P = (LAS int*)(lds + LT_P); LAS int* cnt = (LAS int*)(lds + LT_CNT); LAS int* tile_e = (LAS int*)(lds + LT_TILE);
    __syncthreads();
    if (threadIdx.x < NEX) cnt[threadIdx.x] = (threadIdx.x < NE) ? (int)__hip_atomic_load(gcount + threadIdx.x * 16, __ATOMIC_RELAXED, __HIP_MEMORY_SCOPE_AGENT) : NTOK;
    __syncthreads();
    if (threadIdx.x == 0) { int s = 0; for (int e = 0; e < NEX; ++e) { P[e] = s; s += (cnt[e] + 255) >> 8; } P[NEX] = s; }
    __syncthreads();
    if (threadIdx.x < NEX) { const int e = threadIdx.x; for (int t = P[e]; t < P[e + 1]; ++t) tile_e[t] = e; }
    __syncthreads();
    return P[NEX];
}

__device__ __forceinline__ void moe_combine(KArgs a, int layer, LAS unsigned char* lds, int gw, int NGW, int lane) {
    float* out = a->out; bf16_t* xb = (bf16_t*)(a->ws + WS_XB); const bf16_t* Y = (const bf16_t*)(a->ws + WS_Y);
    const unsigned* toke = (const unsigned*)(a->ws + WS_TOKE); const float* tokw = (const float*)(a->ws + WS_TOKW);
    const float* gam = a->in[I_LN2G] + layer * DM; const float* bet = a->in[I_LN2B] + layer * DM;
    const LAS int* P = (const LAS int*)(lds + LT_P);
    const int sh_base = P[NE] * 256;
    unsigned epn = 0u; float wn = 0.f;
    if (gw < NTOK && lane < 8) { epn = toke[(size_t)gw * 8 + lane]; wn = tokw[(size_t)gw * 8 + lane]; }
    for (int t = gw; t < NTOK; t += NGW) {
        const unsigned ep = epn; float w = wn;
        if (t + NGW < NTOK && lane < 8) { epn = toke[(size_t)(t + NGW) * 8 + lane]; wn = tokw[(size_t)(t + NGW) * 8 + lane]; }
        int slot = P[ep >> 20] * 256 + (int)(ep & 0xfffffu);
        if (lane == 8) { slot = sh_base + t; w = 1.f; }
        f32x4 acc[8]; u32x4 y[9][4]; float wk[9];
#pragma unroll
        for (int j = 0; j < 4; ++j) { acc[2 * j] = *(const f32x4*)(out + (size_t)t * DM + 512 * j + 8 * lane); acc[2 * j + 1] = *(const f32x4*)(out + (size_t)t * DM + 512 * j + 8 * lane + 4); }
        const bool y8 = FP8_Y1 && FP8_MOE1 && layer == 1;
#pragma unroll
        for (int q = 0; q < 9; ++q) { const int sl = __builtin_amdgcn_readlane(slot, q); wk[q] = __int_as_float(__builtin_amdgcn_readlane(__float_as_int(w), q)) * (y8 ? Y8_INV : 1.f);
#pragma unroll
            for (int j = 0; j < 4; ++j) {
                if (y8) { const u32x2 t2 = *(const u32x2*)((const unsigned char*)Y + (size_t)sl * DM + 512 * j + 8 * lane); y[q][j] = (u32x4){t2.x, t2.y, 0u, 0u}; }
                else y[q][j] = *(const u32x4*)(Y + (size_t)sl * DM + 512 * j + 8 * lane); } }
#pragma unroll
        for (int j = 0; j < 8; ++j) acc[j] = acc[j] * ALPHA;
#pragma unroll
        for (int q = 0; q < 9; ++q)
#pragma unroll
            for (int j = 0; j < 4; ++j) {
                if (y8) {
                    const f32x2 a0 = __builtin_amdgcn_cvt_pk_f32_fp8((int)y[q][j].x, false), a1 = __builtin_amdgcn_cvt_pk_f32_fp8((int)y[q][j].x, true);
                    const f32x2 b0 = __builtin_amdgcn_cvt_pk_f32_fp8((int)y[q][j].y, false), b1 = __builtin_amdgcn_cvt_pk_f32_fp8((int)y[q][j].y, true);
                    acc[2 * j][0] += wk[q] * a0[0]; acc[2 * j][1] += wk[q] * a0[1]; acc[2 * j][2] += wk[q] * a1[0]; acc[2 * j][3] += wk[q] * a1[1];
                    acc[2 * j + 1][0] += wk[q] * b0[0]; acc[2 * j + 1][1] += wk[q] * b0[1]; acc[2 * j + 1][2] += wk[q] * b1[0]; acc[2 * j + 1][3] += wk[q] * b1[1];
                } else {
                acc[2 * j][0] += wk[q] * bf_lo(y[q][j].x); acc[2 * j][1] += wk[q] * bf_hi(y[q][j].x); acc[2 * j][2] += wk[q] * bf_lo(y[q][j].y); acc[2 * j][3] += wk[q] * bf_hi(y[q][j].y);
                acc[2 * j + 1][0] += wk[q] * bf_lo(y[q][j].z); acc[2 * j + 1][1] += wk[q] * bf_hi(y[q][j].z); acc[2 * j + 1][2] += wk[q] * bf_lo(y[q][j].w); acc[2 * j + 1][3] += wk[q] * bf_hi(y[q][j].w);
                }
            }
        float s = 0.f;
#pragma unroll
        for (int j = 0; j < 8; ++j) s += (acc[j][0] + acc[j][1]) + (acc[j][2] + acc[j][3]);
        const float mean = wave_sum(s) * (1.f / DM); float s2 = 0.f;
#pragma unroll
        for (int j = 0; j < 8; ++j) { acc[j] = acc[j] - mean; s2 += (acc[j][0] * acc[j][0] + acc[j][1] * acc[j][1]) + (acc[j][2] * acc[j][2] + acc[j][3] * acc[j][3]); }
        const float rstd = __builtin_amdgcn_rsqf(wave_sum(s2) * (1.f / DM) + LN_EPS);
#pragma unroll
        for (int j = 0; j < 4; ++j) {
            const int c = 512 * j + 8 * lane;
            const f32x4 x0 = acc[2 * j] * rstd * *(const f32x4*)(gam + c) + *(const f32x4*)(bet + c);
            const f32x4 x1 = acc[2 * j + 1] * rstd * *(const f32x4*)(gam + c + 4) + *(const f32x4*)(bet + c + 4);
            *(f32x4*)(out + (size_t)t * DM + c) = x0; *(f32x4*)(out + (size_t)t * DM + c + 4) = x1;
            if (layer == 0) {
                if (FP8_QKV1) { u32x2 wv; wv.x = pk4_fp8(x0[0], x0[1], x0[2], x0[3]); wv.y = pk4_fp8(x1[0], x1[1], x1[2], x1[3]); *(u32x2*)((unsigned char*)xb + (size_t)t * DM + c) = wv; }
                else { u32x4 wv; wv.x = cvt_pk_bf16(x0[0], x0[1]); wv.y = cvt_pk_bf16(x0[2], x0[3]); wv.z = cvt_pk_bf16(x1[0], x1[1]); wv.w = cvt_pk_bf16(x1[2], x1[3]);
                    *(u32x4*)(xb + (size_t)t * DM + c) = wv; } }
        }
    }
}

__device__ __forceinline__ void attn_ref(KArgs a, int L, int pass, att::BlockRef& r) {
    const int xcd = L & 7, k = L >> 3, vh = xcd * 8 + (k >> 4), x = k & 15;
    const int qb = pass ? 31 - x : x;
    const bf16_t* Q = (const bf16_t*)(a->ws + WS_Q); const bf16_t* K = (const bf16_t*)(a->ws + WS_K); const bf16_t* V = (const bf16_t*)(a->ws + WS_V);
    r.P0 = qb * 256;
    const int half = vh & 1, bm = vh >> 1, b = bm >> 4, m = bm & 15;
    r.Q = Q + ((size_t)bm * SEQ + r.P0) * HD; r.K = K + (size_t)bm * SEQ * HD;
    r.V = V + (size_t)(b * NSLAB + (m >> 1) * 2 + half) * SEQ * HD;
    r.O = (bf16_t*)(a->ws + WS_O) + ((size_t)b * SEQ + r.P0) * 4096 + (m * 2 + half) * HD;
    r.sel = nullptr; r.list = nullptr; r.ML = nullptr; r.jlo = 0; r.nvalid = 256; r.nblk = 0; r.hb = 0;
}
__device__ __forceinline__ void attn_phase_da(KArgs a, char* lds, int G) {
    constexpr int total = 64 * 16;
    const int conv_slot = (int)(blockIdx.x & 3u);
    int L = blockIdx.x; if (L >= total) return;
    int pass = 0, item = 0; att::BlockRef cur, nxt; attn_ref(a, L, 0, cur);
    att::Seam S;
    att::attn_prime<false>(cur, lds, S);
    for (;;) {
        if (pass == 0) {
            if (conv_slot == item) {
                const int tid0 = otid(); const Geo cg = geo();
                convert_items(a, (LAS float*)((LAS unsigned char*)lds + att::ATT_LDS + __builtin_amdgcn_readfirstlane(tid0 >> 6) * 4224), cg.gw, cg.NGW, tid0 & 63, IT_IN, IT_TOTAL);
            }
            ++item;
        }
        const bool more_pass = pass == 0, more_item = L + G < total, last = !more_pass && !more_item;
        int passn = pass + 1, Ln = L;
        if (!more_pass) { passn = 0; Ln = more_item ? L + G : L; }
        if (last) nxt = cur; else attn_ref(a, Ln, passn, nxt);
        att::attn_block<false>(cur, nxt, 4096, lds, S);
        if (last) break;
        cur = nxt; pass = passn; L = Ln;
    }
}
__device__ __forceinline__ void moba_ref(KArgs a, LAS unsigned char* lds, int B, att::BlockRef& r) {
    const LAS int* PB = (const LAS int*)(lds + LT_PB); const LAS int* MC = (const LAS int*)(lds + LT_MC);
    int lo = 0, hi = 1024;
    while (hi - lo > 1) { const int mid = (lo + hi) >> 1; if (PB[mid] <= B) lo = mid; else hi = mid; }
    const int id = lo, bh = id >> 5, n = id & 31, c = B - PB[id];
    r.Q = (const bf16_t*)(a->ws + WS_Q) + (size_t)bh * SEQ * HD; r.K = (const bf16_t*)(a->ws + WS_K) + (size_t)bh * SEQ * HD; r.V = (const bf16_t*)(a->ws + WS_V) + (size_t)bh * SEQ * HD;
    r.O = (bf16_t*)(a->ws + WS_OP); r.ML = (float*)(a->ws + WS_ML); r.sel = (const unsigned*)(a->ws + WS_SEL) + (size_t)bh * SEQ;
    r.hb = bh * SEQ; r.jlo = 4 * n; r.nblk = n; r.P0 = n * 256;
    if (c == 0) { r.list = nullptr; r.nvalid = 256; }
    else { r.list = (const unsigned*)(a->ws + WS_QLIST) + (size_t)id * SEQ + (size_t)(c - 1) * 256; const int rem = MC[id] - (c - 1) * 256; r.nvalid = rem < 256 ? rem : 256; }
}
__device__ __forceinline__ void attn_phase_moba(KArgs a, LAS unsigned char* lds, char* lds_gen, int G) {
    LAS int* MC = (LAS int*)(lds + LT_MC); LAS int* PB = (LAS int*)(lds + LT_PB); LAS int* SC = (LAS int*)(lds + LT_SC);
    const unsigned* mcnt = (const unsigned*)(a->ws + WS_CTL) + CW_MCNT;
    const int t = threadIdx.x;
    __syncthreads();
    const int c0 = (int)__hip_atomic_load(mcnt + 2 * t, __ATOMIC_RELAXED, __HIP_MEMORY_SCOPE_AGENT), c1 = (int)__hip_atomic_load(mcnt + 2 * t + 1, __ATOMIC_RELAXED, __HIP_MEMORY_SCOPE_AGENT);
    MC[2 * t] = c0; MC[2 * t + 1] = c1;
    const int s0 = 1 + ((c0 + 255) >> 8), s1 = s0 + 1 + ((c1 + 255) >> 8);
    SC[t] = s1;
    __syncthreads();
    for (int off = 1; off < 512; off <<= 1) { const int v = SC[t] + (t >= off ? SC[t - off] : 0); __syncthreads(); SC[t] = v; __syncthreads(); }
    const int excl = t > 0 ? SC[t - 1] : 0;
    PB[2 * t] = excl; PB[2 * t + 1] = excl + s0; if (t == 511) PB[1024] = SC[511];
    __syncthreads();
    const int NB = PB[1024];
    int B = blockIdx.x; if (B >= NB) return;
    att::BlockRef cur, nxt; moba_ref(a, lds, B, cur);
    att::Seam S;
    att::attn_prime<true>(cur, lds_gen, S);
    for (;;) {
        const int Bn = B + G; const bool last = Bn >= NB;
        if (last) nxt = cur; else moba_ref(a, lds, Bn, nxt);
        att::attn_block<true>(cur, nxt, 0, lds_gen, S);
        if (last) break;
        cur = nxt; B = Bn;
    }
}
__device__ __forceinline__ void moba_kv_phase(KArgs a, LAS unsigned char* lds, char* lds_gen) {
    using namespace att;
    LAS int* PB = (LAS int*)(lds + LDSCTL_OFF + 1024); LAS int* MC = (LAS int*)(lds + LDSCTL_OFF + 5632); LAS int* SC = (LAS int*)lds;
    volatile LAS int* QW = (volatile LAS int*)(lds + LDSCTL_OFF + 14400);
    const unsigned* mcnt = (const unsigned*)(a->ws + WS_CTL) + CW_MCNT; unsigned* sq = (unsigned*)(a->ws + WS_CTL) + CW_SQ;
    int tid = threadIdx.x; asm volatile("" : "+v"(tid));
    const int wid = __builtin_amdgcn_readfirstlane(tid >> 6), lane = tid & 63, r32 = lane & 31, hi = lane >> 5;
    __syncthreads();
    {   const int c0 = (int)__hip_atomic_load(mcnt + 2 * tid, __ATOMIC_RELAXED, __HIP_MEMORY_SCOPE_AGENT), c1 = (int)__hip_atomic_load(mcnt + 2 * tid + 1, __ATOMIC_RELAXED, __HIP_MEMORY_SCOPE_AGENT);
        MC[2 * tid] = c0; MC[2 * tid + 1] = c1;
        const int s0 = (8 + ((c0 + 31) >> 5) + 15) >> 4, s1 = s0 + ((8 + ((c1 + 31) >> 5) + 15) >> 4);
        SC[tid] = s1;
        __syncthreads();
        for (int off = 1; off < 512; off <<= 1) { const int v = SC[tid] + (tid >= off ? SC[tid - off] : 0); __syncthreads(); SC[tid] = v; __syncthreads(); }
        const int excl = tid > 0 ? SC[tid - 1] : 0;
        PB[2 * tid] = excl; PB[2 * tid + 1] = excl + s0; if (tid == 511) PB[1024] = SC[511];
        __syncthreads(); }
    const int NP = PB[1024];
    char* V_lds = lds_gen; char* K_lds = lds_gen + 65536;
    float* ws = (float*)(lds_gen + LDSCTL_OFF + 10240) + wid * 128; float* li_l = ws, * al_l = ws + 32; unsigned* rd = (unsigned*)(ws + 64);
    const int vb0 = (int)(uintptr_t)V_lds + v_rd_base(lane);
    const int sr = tid >> 4, sc = (tid & 15) * 8;
    const bf16_t* Qb = (const bf16_t*)(a->ws + WS_Q); const bf16_t* Kb = (const bf16_t*)(a->ws + WS_K); const bf16_t* Vb = (const bf16_t*)(a->ws + WS_V);
    const unsigned* selb = (const unsigned*)(a->ws + WS_SEL); const unsigned* qlb = (const unsigned*)(a->ws + WS_QLIST);
    bf16_t* OPb = (bf16_t*)(a->ws + WS_OP); float* MLb = (float*)(a->ws + WS_ML);
    for (;;) {
        if (tid == 0) *QW = (int)__hip_atomic_fetch_add(sq, 1u, __ATOMIC_RELAXED, __HIP_MEMORY_SCOPE_AGENT);
        __syncthreads();
        const int I = *QW;
        if (I >= NP) break;
        int lo = 0, hb = 1024;
        while (hb - lo > 1) { const int mid = (lo + hb) >> 1; if (PB[mid] <= I) lo = mid; else hb = mid; }
        const int id = lo, bh = id >> 5, n = id & 31, part = I - PB[id], cnt = MC[id];
        {
            const bf16_t* Kh = Kb + ((size_t)bh * SEQ + (size_t)n * 256) * HD; const bf16_t* Vh = Vb + ((size_t)bh * SEQ + (size_t)n * 256) * HD;
            bf16x8 kv[8], vv[8];
#pragma unroll
            for (int i = 0; i < 8; ++i) { kv[i] = load8(Kh + (size_t)(sr + 32 * i) * HD + sc); vv[i] = load8(Vh + (size_t)(sr + 32 * i) * HD + sc); }
#pragma unroll
            for (int i = 0; i < 8; ++i) { const int tl = i >> 1, row = sr + 32 * (i & 1);
                *(bf16x8*)(K_lds + tl * SHM_K + KSWZ(row, sc * 2)) = kv[i]; *(bf16x8*)(V_lds + tl * SHM_V + v_st(row, sc)) = vv[i]; }
        }
        __syncthreads();
        const int nch = 8 + ((cnt + 31) >> 5), c_beg = 16 * part, c_end = (c_beg + 16 < nch) ? c_beg + 16 : nch;
#pragma unroll 1
        for (int cg = c_beg + wid; cg < c_end; cg += 8) {
            const bool own = cg < 8;
            const int li0 = (cg - 8) * 32 + r32;
            unsigned q; if (own) q = (unsigned)(n * 256 + cg * 32 + r32); else q = qlb[(size_t)id * SEQ + (li0 < cnt ? li0 : cnt - 1)];
            const bool valid = own || (li0 < cnt);
            unsigned slot = 3u; if (!own) slot = (unsigned)__builtin_popcount(selb[(size_t)bh * SEQ + q] & ((1u << n) - 1u));
            bf16x8 qr[8];
#pragma unroll
            for (int d0 = 0; d0 < 8; ++d0) qr[d0] = load8(Qb + ((size_t)bh * SEQ + q) * HD + d0 * 16 + hi * 8);
            if (hi == 0) rd[r32] = valid ? (((unsigned)(bh * SEQ) + q) * 4u + slot) * 128u : (1u << 27);
            const int NTu = own ? ((cg * 32 + 31) >> 6) + 1 : 4;
            const int qlo = n * 256 + cg * 32, qm = qlo + r32 - 4 * hi;
            float m_reg = -1e30f, l_reg = 0.f; f32x16 o[4] = {};
#define KV_STEP(T) do { if ((T) < NTu) { f32x16 p0, p1; float mn, al; bf16x8 pa0, pa1, pa2, pa3;                                        \
                qkt<T>(p0, p1, K_lds, r32, hi, qr);                                                                                       \
                if (own) { const int kb_ = n * 256 + (T) * KVBLK; if (kb_ + KVBLK - 1 > qlo) mask_tile(p0, p1, qm - kb_, 0x40000000u); }   \
                partialSM(p0, p1, m_reg, mn, al);                                                                                        \
                if (__any(al < 1.f)) { if (hi == 0) al_l[r32] = al; asm volatile("s_waitcnt lgkmcnt(0)" ::: "memory");                     \
                    for (int d_ = 0; d_ < 4; ++d_) for (int r = 0; r < 16; ++r) o[d_][r] *= al_l[crow(r, hi)]; }                           \
                finishSM(p0, p1, al, l_reg, pa0, pa1, pa2, pa3); SBAR();                                                                  \
                pv_tile<T>(o, vb0, pa0, pa1, pa2, pa3); } } while (0)
            KV_STEP(0); KV_STEP(1); KV_STEP(2); KV_STEP(3);
#undef KV_STEP
            if (hi == 0) li_l[r32] = l_reg; asm volatile("s_waitcnt lgkmcnt(0)" ::: "memory");
            float rli[16];
#pragma unroll
            for (int r = 0; r < 16; ++r) rli[r] = __builtin_amdgcn_rcpf(li_l[crow(r, hi)]);
#pragma unroll
            for (int r = 0; r < 16; ++r) { const unsigned off = rd[crow(r, hi)];
#pragma unroll
                for (int d0 = 0; d0 < 4; ++d0) { const float v = o[d0][r] * rli[r];
                    const float vn = __int_as_float(__builtin_amdgcn_mov_dpp(__float_as_int(v), 0xB1, 0xF, 0xF, true));
                    if ((r32 & 1) == 0) *(unsigned*)(OPb + (size_t)off + d0 * 32 + r32) = cvt_pk_bf16(v, vn); } }
            if (hi == 0) { float* mlp = MLb + (size_t)(rd[r32] >> 7) * 2; f32x2 ml = {m_reg, l_reg}; *(f32x2*)mlp = ml; }
        }
    }
}
__device__ __forceinline__ void moba_merge(KArgs a, int gw, int NGW, int lane) {
    const bf16_t* OP = (const bf16_t*)(a->ws + WS_OP); const float* ML = (const float*)(a->ws + WS_ML); const unsigned* sel = (const unsigned*)(a->ws + WS_SEL);
    bf16_t* AO = (bf16_t*)(a->ws + WS_AOUT);
    constexpr float C2 = 1.4426950408889634f * att::SCALE;
    const int h = lane >> 2, part = lane & 3;
    for (int t = gw; t < NTOK; t += NGW) {
        const int b = t >> 13, s = t & (SEQ - 1), bh = b * NSLAB + h;
        const size_t base = ((size_t)bh * SEQ + s) * 4;
        const int nsel = __builtin_popcount(sel[(size_t)bh * SEQ + s]);
        f32x2 ml[4]; u32x4 ov[4][4];
#pragma unroll
        for (int k = 0; k < 4; ++k) { ml[k] = *(const f32x2*)(ML + (base + k) * 2);
#pragma unroll
            for (int j = 0; j < 4; ++j) ov[k][j] = *(const u32x4*)(OP + (base + k) * 128 + part * 32 + j * 8); }
        float M = ml[3][0];
#pragma unroll
        for (int k = 0; k < 3; ++k) M = (k < nsel) ? fmaxf(M, ml[k][0]) : M;
        float w[4], W = 0.f;
#pragma unroll
        for (int k = 0; k < 4; ++k) { const bool valid = (k == 3) || (k < nsel); w[k] = valid ? ml[k][1] * __builtin_amdgcn_exp2f((ml[k][0] - M) * C2) : 0.f; W += w[k]; }
        const float rW = 1.f / W;
        float acc[32];
#pragma unroll
        for (int i = 0; i < 32; ++i) acc[i] = 0.f;
#pragma unroll
        for (int k = 0; k < 4; ++k) { const bool valid = (k == 3) || (k < nsel); const float wk = w[k] * rW;
#pragma unroll
            for (int j = 0; j < 4; ++j) { const u32x4 u = ov[k][j];
                acc[8 * j + 0] += valid ? wk * bf_lo(u.x) : 0.f; acc[8 * j + 1] += valid ? wk * bf_hi(u.x) : 0.f; acc[8 * j + 2] += valid ? wk * bf_lo(u.y) : 0.f; acc[8 * j + 3] += valid ? wk * bf_hi(u.y) : 0.f;
                acc[8 * j + 4] += valid ? wk * bf_lo(u.z) : 0.f; acc[8 * j + 5] += valid ? wk * bf_hi(u.z) : 0.f; acc[8 * j + 6] += valid ? wk * bf_lo(u.w) : 0.f; acc[8 * j + 7] += valid ? wk * bf_hi(u.w) : 0.f; } }
#pragma unroll
        for (int j = 0; j < 4; ++j) {
            if (FP8_OUT1) { u32x2 o; o.x = pk4_fp8(acc[8 * j] * AO8_SCALE, acc[8 * j + 1] * AO8_SCALE, acc[8 * j + 2] * AO8_SCALE, acc[8 * j + 3] * AO8_SCALE); o.y = pk4_fp8(acc[8 * j + 4] * AO8_SCALE, acc[8 * j + 5] * AO8_SCALE, acc[8 * j + 6] * AO8_SCALE, acc[8 * j + 7] * AO8_SCALE);
                *(u32x2*)((unsigned char*)AO + (size_t)t * DM + h * HD + part * 32 + j * 8) = o; }
            else { u32x4 o; o.x = cvt_pk_bf16(acc[8 * j], acc[8 * j + 1]); o.y = cvt_pk_bf16(acc[8 * j + 2], acc[8 * j + 3]); o.z = cvt_pk_bf16(acc[8 * j + 4], acc[8 * j + 5]); o.w = cvt_pk_bf16(acc[8 * j + 6], acc[8 * j + 7]);
                *(u32x4*)(AO + (size_t)t * DM + h * HD + part * 32 + j * 8) = o; } }
    }
}

#ifndef PHMASK
#define PHMASK 0x7ffff
#endif
#define IN(k) (((PHMASK >> (k)) & 1) && lo <= (k) && (k) < hi)
#define SEAM(k) do { if (IN(k) && IN((k) + 1)) xcd_barrier(bar); } while (0)
template <int LAYER>
__device__ __forceinline__ void layer_program(LAS unsigned char* lds, unsigned char* lds_gen, const XcdBarrier& bar, const int lo, const int hi) {
    constexpr int pb = LAYER == 0 ? 1 : 9;
    constexpr int po = LAYER == 0 ? 4 : 14;
    if (IN(pb)) {
        KArgs ka = kargs(); unsigned char* ws = ka->ws;
        constexpr bool F8 = LAYER == 0 ? (bool)FP8_QKV0 : (bool)FP8_QKV1; constexpr int Kb = F8 ? DM : DM * 2;
        pg8::SchedDense S; S.init(ws + WS_XB, ws + WS_WATT + (LAYER == 0 ? 0 : 32 * MiB), NTOK, NQKV, Kb, gridDim.x, blockIdx.x);
        constexpr bool KM = LAYER == 1;
        pg8::EpiQKV<KM> E{(bf16_t*)(ws + WS_Q), (const float*)(ws + WS_ROPE), F8 ? W8_INV : 1.f};
        pg8::gemm_phase<pg8::EpiQKV<KM>, pg8::SchedDense, F8>(lds, Kb, S, E);
    }
    SEAM(pb);
    if (LAYER == 0) {
        if (IN(2)) { KArgs ka = kargs();
            if (__builtin_amdgcn_readfirstlane(threadIdx.x) >= 256) __builtin_amdgcn_s_setprio(1);
            attn_phase_da(ka, (char*)lds_gen, gridDim.x);
            __builtin_amdgcn_s_setprio(0); }
        SEAM(2);
        if (IN(3)) { KArgs ka = kargs(); const Geo g = geo(); da_combine(ka, g.gw, g.NGW, otid() & 63); }
        SEAM(3);
    } else {
        if (IN(11)) { KArgs ka = kargs(); const Geo g = geo(); moba_gate(ka, g.gw, g.NGW, otid() & 63); }
        SEAM(11);
        if (IN(12)) { KArgs ka = kargs();
            if (__builtin_amdgcn_readfirstlane(threadIdx.x) >= 256) __builtin_amdgcn_s_setprio(1);
            moba_kv_phase(ka, lds, (char*)lds_gen);
            __builtin_amdgcn_s_setprio(0); }
        SEAM(12);
        if (IN(13)) { KArgs ka = kargs(); const Geo g = geo(); moba_merge(ka, g.gw, g.NGW, otid() & 63); }
        SEAM(13);
    }
    if (IN(po)) {
        KArgs ka = kargs(); unsigned char* ws = ka->ws;
        constexpr bool F8 = LAYER == 0 ? (bool)FP8_OUT0 : (bool)FP8_OUT1; constexpr int Kb = F8 ? DM : DM * 2;
        pg8::SchedDense S; S.init(ws + WS_AOUT, ws + WS_WATT + (LAYER == 0 ? 24 * MiB : 56 * MiB), NTOK, DM, Kb, gridDim.x, blockIdx.x);
        pg8::EpiRes E{LAYER == 0 ? ka->in[I_X] : ka->out, ka->out, F8 ? W8_INV * AO8_INV : 1.f};
        pg8::gemm_phase<pg8::EpiRes, pg8::SchedDense, F8>(lds, Kb, S, E);
    }
    SEAM(po);
    if (IN(po + 1)) { KArgs ka = kargs(); const Geo g = geo(); const int tid = otid(); ln_router(ka, LAYER, lds, g.vcu, g.G, __builtin_amdgcn_readfirstlane(tid >> 6), tid & 63); }
    SEAM(po + 1);
    if (IN(po + 2)) {
        KArgs ka = kargs(); unsigned char* ws = ka->ws;
        const int ntt = moe_tables(ka, LAYER, lds);
        constexpr bool F8 = FP8_MOE1 && LAYER == 1; constexpr int Kb = F8 ? DM : DM * 2;
        pg8::SchedMoe1 S{(const char*)(ws + WS_XB), (const char*)(ws + WS_WGU) + (size_t)LAYER * NEX * 1024 * DM * 2, (const unsigned*)(ws + WS_LIST),
                         (const LAS int*)(lds + LT_P), (const LAS int*)(lds + LT_CNT), (const LAS int*)(lds + LT_TILE), ntt * 4, (int)gridDim.x, (int)blockIdx.x, Kb};
        pg8::EpiSwiGLU<F8> E{(bf16_t*)(ws + WS_H), F8 ? W8_INV : 1.f};
        pg8::gemm_phase<pg8::EpiSwiGLU<F8>, pg8::SchedMoe1, F8>(lds, Kb, S, E);
    }
    SEAM(po + 2);
    if (IN(po + 3)) {
        KArgs ka = kargs(); unsigned char* ws = ka->ws;
        const int ntt = moe_tables(ka, LAYER, lds);
        constexpr bool F8 = FP8_MOE1 && LAYER == 1; constexpr int Kb = F8 ? DE : DE * 2;
        pg8::SchedMoe2 S{(const char*)(ws + WS_H), (const char*)(ws + WS_WD) + (size_t)LAYER * NEX * DM * DE * 2, (const LAS int*)(lds + LT_TILE), ntt * 8, (int)gridDim.x, (int)blockIdx.x, Kb};
        constexpr bool Y8 = F8 && FP8_Y1;
        pg8::EpiY<Y8> E{(bf16_t*)(ws + WS_Y), (F8 ? W8_INV : 1.f) * (Y8 ? Y8_SCALE : 1.f)};
        pg8::gemm_phase<pg8::EpiY<Y8>, pg8::SchedMoe2, F8>(lds, Kb, S, E);
    }
    SEAM(po + 3);
    if (IN(po + 4)) { KArgs ka = kargs(); const Geo g = geo(); (void)moe_tables(ka, LAYER, lds); moe_combine(ka, LAYER, lds, g.gw, g.NGW, otid() & 63); }
    if (LAYER == 0) SEAM(8);
}
__global__ void __launch_bounds__(NWAVES * 64, 2) fwd_kernel(Args args) {
    extern __shared__ __attribute__((aligned(16))) unsigned char lds_raw[];
    LAS unsigned char* lds = (LAS unsigned char*)lds_raw;
    volatile LAS unsigned* MISC = (volatile LAS unsigned*)(lds + MISC_OFF);
    for (int u = threadIdx.x; u < (LDS_BYTES - LDSCTL_OFF) / 4; u += NWAVES * 64) ((LAS unsigned*)(lds + LDSCTL_OFF))[u] = 0u;
    __syncthreads();
    XcdBarrier bar = xcd_barrier_post((unsigned*)(args.ws + WS_CTL) + CW_BAR, MISC + 8);
    const int lo = args.ph_lo, hi = args.ph_hi;
    if (IN(0)) { KArgs ka = kargs(); const Geo g = geo(); const int tid = otid(); p0_prologue(ka, lds, g.gw, g.NGW, __builtin_amdgcn_readfirstlane(tid >> 6), tid & 63); }
    SEAM(0);
    layer_program<0>(lds, lds_raw, bar, lo, hi);
    layer_program<1>(lds, lds_raw, bar, lo, hi);
}
#undef IN
#undef SEAM

extern "C" void kernel_launch(void* const* d_in, const int* in_sizes, int n_in, void* d_out, int out_size, void* d_ws, size_t ws_size, hipStream_t stream) {
    static int grid = 0;
    if (grid == 0) {
        if (n_in != 23 || out_size != NTOK * DM || ws_size < WS_END) { fprintf(stderr, "kernel_launch: unexpected shapes (n_in %d, out %d, ws %zu; need ws >= %zu)\n", n_in, out_size, ws_size, (size_t)WS_END); grid = -1; return; }
        int dev = 0, cus = 0, per_cu = 0;
        if (hipGetDevice(&dev) != hipSuccess || hipDeviceGetAttribute(&cus, hipDeviceAttributeMultiprocessorCount, dev) != hipSuccess) { grid = -1; return; }
        if (hipFuncSetAttribute((const void*)fwd_kernel, hipFuncAttributeMaxDynamicSharedMemorySize, LDS_BYTES) != hipSuccess) { fprintf(stderr, "kernel_launch: hipFuncSetAttribute failed\n"); grid = -1; return; }
        if (hipOccupancyMaxActiveBlocksPerMultiprocessor(&per_cu, (const void*)fwd_kernel, NWAVES * 64, LDS_BYTES) != hipSuccess || per_cu < 1) fprintf(stderr, "kernel_launch: occupancy query reports %d\n", per_cu);
        (void)hipGetLastError();
        grid = 256;
    }
    if (grid < 0) return;
    if (hipMemsetAsync((char*)d_ws + WS_CTL, 0, CTL_ZERO_BYTES, stream) != hipSuccess) return;
    Args a{};
    for (int i = 0; i < 23; ++i) a.in[i] = (const float*)d_in[i];
    a.out = (float*)d_out; a.ws = (unsigned char*)d_ws;
#ifndef MK_SPLIT
    a.ph_lo = 0; a.ph_hi = 19;
    hipLaunchKernelGGL(fwd_kernel, dim3(grid), dim3(NWAVES * 64), LDS_BYTES, stream, a);
#else
    for (int p = 0; p < 19; ++p) { a.ph_lo = p; a.ph_hi = p + 1; hipLaunchKernelGGL(fwd_kernel, dim3(grid), dim3(NWAVES * 64), LDS_BYTES, stream, a); }
#endif
}
```

```cpp
#include <hip/hip_runtime.h>
#include <cstdio>
#include <cstdint>

#define GAS __attribute__((address_space(1)))
#define LAS __attribute__((address_space(3)))
typedef unsigned short bf16_t;
typedef short bf16x8 __attribute__((ext_vector_type(8)));
typedef short s16x4 __attribute__((ext_vector_type(4)));
typedef float f32x2 __attribute__((ext_vector_type(2)));
typedef float f32x4 __attribute__((ext_vector_type(4)));
typedef float f32x16 __attribute__((ext_vector_type(16)));
typedef unsigned u32x2 __attribute__((ext_vector_type(2)));
typedef unsigned u32x4 __attribute__((ext_vector_type(4)));

constexpr int BATCH = 2, SEQ = 8192, DM = 2048, NTOK = BATCH * SEQ;
constexpr int NE = 64, NEX = 65  , DE = 512, NQKV = 6144, HD = 128, NSLAB = 16;
constexpr float LN_EPS = 1e-5f;
constexpr float ALPHA = 1.4142135623730951f;
constexpr float LAMBDA_INIT = 0.2f;
constexpr float ROUTED_SCALE = 2.5f;
constexpr int NWAVES = 8;
constexpr int MAXTILES = 640;

constexpr size_t MiB = 1u << 20;
constexpr size_t WS_CTL = 0, CTL_ZERO_BYTES = 1 * MiB;
constexpr size_t WS_TOKE = 2 * MiB;
constexpr size_t WS_TOKW = 3 * MiB;
constexpr size_t WS_LIST = 4 * MiB;
constexpr size_t WS_SEL = 8 * MiB;
constexpr size_t WS_KMEAN = 9 * MiB;
constexpr size_t WS_ROPE = 10 * MiB;
constexpr size_t WS_WRF = 12 * MiB;
constexpr size_t WS_WATT = 16 * MiB;
constexpr size_t WS_WGU = 80 * MiB;
constexpr size_t WS_WD = 600 * MiB;
constexpr size_t WS_XB = 860 * MiB;
constexpr size_t WS_C = 924 * MiB;
constexpr size_t WS_Q = WS_C, WS_K = WS_C + 64 * MiB, WS_V = WS_C + 128 * MiB;
constexpr size_t WS_O = WS_C + 192 * MiB;
constexpr size_t WS_AOUT = WS_C + 320 * MiB;
constexpr size_t WS_H = WS_C;
constexpr size_t WS_Y = WS_C + 160 * MiB;
constexpr size_t WS_QLIST = WS_C + 192 * MiB;
constexpr size_t WS_OP = WS_C + 384 * MiB;
constexpr size_t WS_ML = WS_C + 641 * MiB;
constexpr size_t WS_END = WS_C + 800 * MiB;
constexpr int CW_BAR = 4096;
constexpr int CW_CNT = 8192;
constexpr int CW_MCNT = 12288;
constexpr int CW_SQ = 13440;

constexpr int RING_BYTES = 131072;
constexpr int LDSCTL_OFF = RING_BYTES, MISC_OFF = LDSCTL_OFF + 320;
constexpr int LT_P = LDSCTL_OFF + 1024;
constexpr int LT_CNT = LDSCTL_OFF + 1536;
constexpr int LT_TILE = LDSCTL_OFF + 2048;
constexpr int LT_LCNT = LDSCTL_OFF + 5120;
constexpr int LT_LBASE = LDSCTL_OFF + 5632;
constexpr int LT_ENT = LDSCTL_OFF + 6144;
constexpr int LT_MC = 114688;
constexpr int LT_PB = 118784;
constexpr int LT_SC = 123904;
constexpr int LDS_BYTES = 147456;

#ifndef FP8_QKV0
#define FP8_QKV0 0
#endif
#ifndef FP8_QKV1
#define FP8_QKV1 1
#endif
#ifndef FP8_OUT0
#define FP8_OUT0 0
#endif
#ifndef FP8_OUT1
#define FP8_OUT1 1
#endif
#ifndef FP8_Y1
#define FP8_Y1 1
#endif
#ifndef FP8_MOE1
#define FP8_MOE1 1
#endif
constexpr float W8_SCALE = 64.f, W8_INV = 1.f / 64.f;
constexpr float AO8_SCALE = 16.f, AO8_INV = 1.f / 16.f;
constexpr float Y8_SCALE = 16.f, Y8_INV = 1.f / 16.f;
#define LDS_WAIT() asm volatile("s_waitcnt lgkmcnt(0)" ::: "memory")
#define VM_WAIT() asm volatile("s_waitcnt vmcnt(0)" ::: "memory")
#define SBAR() __builtin_amdgcn_sched_barrier(0)

__device__ __forceinline__ unsigned cvt_pk_bf16(float lo, float hi) { unsigned r; asm volatile("v_cvt_pk_bf16_f32 %0, %1, %2" : "=v"(r) : "v"(lo), "v"(hi)); return r; }
__device__ __forceinline__ unsigned pk4_fp8(float a, float b, float c, float d) { int p = __builtin_amdgcn_cvt_pk_fp8_f32(a, b, 0, false); p = __builtin_amdgcn_cvt_pk_fp8_f32(c, d, p, true); return (unsigned)p; }
__device__ __forceinline__ float bf_lo(unsigned u) { return __uint_as_float(u << 16); }
__device__ __forceinline__ float bf_hi(unsigned u) { return __uint_as_float(u & 0xffff0000u); }
template <int CTRL> __device__ __forceinline__ float dpp_mov(float v) { return __int_as_float(__builtin_amdgcn_update_dpp(0, __float_as_int(v), CTRL, 0xF, 0xF, true)); }
__device__ __forceinline__ float wave_sum(float v) {
    v += dpp_mov<0xB1>(v);
    v += dpp_mov<0x4E>(v);
    v += dpp_mov<0x141>(v);
    v += dpp_mov<0x140>(v);
    const float r0 = __int_as_float(__builtin_amdgcn_readlane(__float_as_int(v), 0)), r1 = __int_as_float(__builtin_amdgcn_readlane(__float_as_int(v), 16));
    const float r2 = __int_as_float(__builtin_amdgcn_readlane(__float_as_int(v), 32)), r3 = __int_as_float(__builtin_amdgcn_readlane(__float_as_int(v), 48));
    return (r0 + r1) + (r2 + r3);
}

#define XB_TMO      128
#define XB_XCNT(j)  (256  + 64 * (j))
#define XB_XSUB(j)  (1280 + 64 * (j))
#define XB_XGEN(j)  (2304 + 64 * (j))
#define XB_TOP      3328
#define XB_TOPGEN   3392
#define XCD_BAR_WORDS 3456
#define XB_SPIN_CAP (1u << 18)
__device__ __forceinline__ unsigned xb_ld(unsigned* p)              { return __hip_atomic_load(p, __ATOMIC_RELAXED, __HIP_MEMORY_SCOPE_AGENT); }
__device__ __forceinline__ unsigned xb_add(unsigned* p, unsigned v) { return __hip_atomic_fetch_add(p, v, __ATOMIC_RELAXED, __HIP_MEMORY_SCOPE_AGENT); }
__device__ __forceinline__ unsigned xb_xcc_id() { return (unsigned)__builtin_amdgcn_s_getreg((3 << 11) | 20) & 0xFu; }
#define XB_SPIN(cond, bar) do { unsigned _sp = 0; while (cond) { __builtin_amdgcn_s_sleep(1); \
    if ((++_sp & 255u) == 0u) { if (xb_ld(&(bar)[XB_TMO])) break; if (_sp > XB_SPIN_CAP) { atomicAdd(&(bar)[XB_TMO], 1u); break; } } } } while (0)
struct XcdBarrier { unsigned* bar; unsigned x; volatile LAS unsigned* st; };
__device__ __forceinline__ XcdBarrier xcd_barrier_post(unsigned* bar, volatile LAS unsigned* st) {
    XcdBarrier b; b.bar = bar; b.x = xb_xcc_id(); b.st = st;
    if (threadIdx.x == 0) (void)xb_add(&bar[XB_XCNT(b.x)], 1u);
    return b;
}
__device__ __forceinline__ void xcd_barrier_complete(unsigned* bar, unsigned x, unsigned& nloc, unsigned& nx) {
    const unsigned G = gridDim.x * gridDim.y * gridDim.z;
    unsigned sum, cnt, mine, sp = 0u;
    for (;;) {
        sum = 0u; cnt = 0u; mine = 0u;
#pragma unroll
        for (unsigned j = 0; j < 16; ++j) { const unsigned c = xb_ld(&bar[XB_XCNT(j)]); sum += c; cnt += (c > 0u) ? 1u : 0u; mine = (j == x) ? c : mine; }
        if (sum == G) break;
        __builtin_amdgcn_s_sleep(1);
        if ((++sp & 255u) == 0u) { if (xb_ld(&bar[XB_TMO])) break; if (sp > XB_SPIN_CAP) { atomicAdd(&bar[XB_TMO], 1u); break; } }
    }
    nloc = mine > 0u ? mine : 1u; nx = cnt > 0u ? cnt : 1u;
}
__device__ __forceinline__ void xcd_barrier(const XcdBarrier& b) {
    asm volatile("s_waitcnt vmcnt(0)" ::: "memory");
    __syncthreads();
    if (threadIdx.x == 0) {
        unsigned* bar = b.bar;
        __builtin_amdgcn_s_waitcnt(0);
        unsigned nloc = b.st[0], nx = b.st[1];
        if (nloc == 0u) { xcd_barrier_complete(bar, b.x, nloc, nx); b.st[0] = nloc; b.st[1] = nx; }
        const unsigned old = xb_add(&bar[XB_XSUB(b.x)], 1u);
        const unsigned gen = old / nloc;
        if (old + 1u == (gen + 1u) * nloc) {
            __builtin_amdgcn_fence(__ATOMIC_RELEASE, "agent");
            asm volatile("s_waitcnt vmcnt(0)" ::: "memory");
            const unsigned og = xb_add(&bar[XB_TOP], 1u);
            const unsigned tg = og / nx;
            if (og + 1u == (tg + 1u) * nx) xb_add(&bar[XB_TOPGEN], 1u);
            else XB_SPIN(xb_ld(&bar[XB_TOPGEN]) == tg, bar);
            __builtin_amdgcn_fence(__ATOMIC_ACQUIRE, "agent");
            xb_add(&bar[XB_XGEN(b.x)], 1u);
            asm volatile("s_waitcnt vmcnt(0)" ::: "memory");
        } else {
            XB_SPIN(xb_ld(&bar[XB_XGEN(b.x)]) == gen, bar);
            __builtin_amdgcn_fence(__ATOMIC_ACQUIRE, "agent");
            asm volatile("s_waitcnt vmcnt(0)" ::: "memory");
        }
    }
    __syncthreads();
}

namespace pg8 {
constexpr int BM = 256, BK = 64, HALF = 128, HTB = HALF * BK * 2, NXCD = 8, WGM = 8;
__device__ __forceinline__ int lds_byte(int r, int c) { const int st = (r >> 4) * 2 + (c >> 5), rr = r & 15, cc = c & 31, ob = rr * 64 + cc * 2; return st * 1024 + (ob ^ (((ob >> 9) & 1) << 5)); }
__device__ __forceinline__ void stage_rc(int b, int& R, int& C) { const int st = b / 1024, sb = b % 1024, swz = sb ^ (((sb >> 9) & 1) << 5); R = (st >> 1) * 16 + swz / 64; C = (st & 1) * 32 + (swz % 64) / 2; }
__device__ __forceinline__ int perm32(int rho) { const int n = rho >> 4, i = rho & 15; return 8 * (i >> 2) + 4 * n + (i & 3); }
struct Unit { int pm, pn, e, aux; };
__device__ __forceinline__ int xcd_remap(int L, int nwg) { const int q = nwg / NXCD, r = nwg % NXCD, xcd = L % NXCD, off = L / NXCD; return (xcd < r ? xcd * (q + 1) : r * (q + 1) + (xcd - r) * q) + off; }

struct SchedDense {
    const char* A; const char* Bt; int Kb, nM, nN, nwg, G, c;
    __device__ __forceinline__ void init(const void* A_, const void* Bt_, int M, int N, int Kb_, int G_, int c_) { A = (const char*)A_; Bt = (const char*)Bt_; Kb = Kb_; nM = M / BM; nN = N / BM; nwg = nM * nN; G = G_; c = c_; }
    __device__ __forceinline__ bool next(int i, Unit& u) const {
        const long L = (long)i * G + c; if (L >= nwg) return false;
        const int wgid = xcd_remap((int)L, nwg);
        const int nig = WGM * nN, gid = wgid / nig, fm = gid * WGM, gsz = (nM - fm) < WGM ? (nM - fm) : WGM;
        u.pm = fm + ((wgid % nig) % gsz); u.pn = (wgid % nig) / gsz; u.e = 0; u.aux = 0; return true;
    }
    __device__ __forceinline__ const char* a_base(const Unit&) const { return A; }
    __device__ __forceinline__ const char* b_base(const Unit& u) const { return Bt + (size_t)u.pn * BM * Kb; }
    __device__ __forceinline__ void a_off(const Unit& u, unsigned (&off)[2][2]) const {
        int tz = threadIdx.x; asm volatile("" : "+v"(tz));
#pragma unroll
        for (int i = 0; i < 2; ++i) { int R, C; stage_rc(tz * 16 + i * 8192, R, C);
#pragma unroll
            for (int h = 0; h < 2; ++h) off[h][i] = (unsigned)((u.pm * BM + h * HALF + R) * Kb + C * 2); }
    }
};
struct SchedMoe1 {
    const char* X; const char* W; const unsigned* list; const LAS int* P; const LAS int* cnt; const LAS int* tile_e; int U, G, c, Kb;
    __device__ __forceinline__ bool next(int i, Unit& u) const {
        const long L = (long)i * G + c; if (L >= U) return false;
        const int wgid = xcd_remap((int)L, U);
        u.pm = wgid >> 2; u.pn = wgid & 3; u.e = tile_e[u.pm]; u.aux = u.pm - P[u.e]; return true;
    }
    __device__ __forceinline__ const char* a_base(const Unit&) const { return X; }
    __device__ __forceinline__ const char* b_base(const Unit& u) const { return W + ((size_t)u.e * 1024 + (size_t)u.pn * 256) * Kb; }
    __device__ __forceinline__ void a_off(const Unit& u, unsigned (&off)[2][2]) const {
        const int n = cnt[u.e];
        int tz = threadIdx.x; asm volatile("" : "+v"(tz));
#pragma unroll
        for (int i = 0; i < 2; ++i) { int R, C; stage_rc(tz * 16 + i * 8192, R, C);
#pragma unroll
            for (int h = 0; h < 2; ++h) {
                const int r = u.aux * BM + h * HALF + R;
                unsigned tok;
                if (u.e == NE) tok = (unsigned)r;
                else tok = (r < n) ? list[(size_t)u.e * NTOK + r] : 0u;
                off[h][i] = tok * (unsigned)Kb + (unsigned)C * 2u;
            } }
    }
};
struct SchedMoe2 {
    const char* Hb; const char* W; const LAS int* tile_e; int U, G, c, Kb;
    __device__ __forceinline__ bool next(int i, Unit& u) const {
        const long L = (long)i * G + c; if (L >= U) return false;
        const int wgid = xcd_remap((int)L, U);
        u.pm = wgid >> 3; u.pn = wgid & 7; u.e = tile_e[u.pm]; u.aux = 0; return true;
    }
    __device__ __forceinline__ const char* a_base(const Unit&) const { return Hb; }
    __device__ __forceinline__ const char* b_base(const Unit& u) const { return W + ((size_t)u.e * DM + (size_t)u.pn * 256) * Kb; }
    __device__ __forceinline__ void a_off(const Unit& u, unsigned (&off)[2][2]) const {
        int tz = threadIdx.x; asm volatile("" : "+v"(tz));
#pragma unroll
        for (int i = 0; i < 2; ++i) { int R, C; stage_rc(tz * 16 + i * 8192, R, C);
#pragma unroll
            for (int h = 0; h < 2; ++h) off[h][i] = (unsigned)((u.pm * BM + h * HALF + R) * Kb + C * 2); }
    }
};

template <bool KM> struct EpiQKV {
    static constexpr bool PERM = true;
    bf16_t* QKV; const float* rope; float osc;
    __device__ __forceinline__ void operator()(const f32x4 (&acc)[2][2][4][2], const Unit& u, int wr, int wc, int fr, int fq) const {
        const int seg = u.pn >> 3, slab0 = (u.pn & 7) * 2;
        bf16_t* base = QKV + (size_t)seg * ((size_t)BATCH * NSLAB * SEQ * HD);
        const int row0 = u.pm * BM + wr * 64 + fr; const int b = (u.pm * BM) >> 13;
        const bool rot = (seg < 2) && (wc == 0);
        f32x4 cs0a = {0.f, 0.f, 0.f, 0.f}, cs0b = cs0a, cs1a = cs0a, cs1b = cs0a;
#pragma unroll
        for (int ai = 0; ai < 2; ++ai)
#pragma unroll
            for (int m = 0; m < 4; ++m) {
                const int row = row0 + ai * HALF + m * 16, s = row & (SEQ - 1);
                f32x4 cs = {1.f, 1.f, 1.f, 1.f}, sn = {0.f, 0.f, 0.f, 0.f};
                if (rot) { cs = *(const f32x4*)(rope + (size_t)row * 32 + 4 * fq); sn = *(const f32x4*)(rope + (size_t)row * 32 + 16 + 4 * fq); }
#pragma unroll
                for (int bj = 0; bj < 2; ++bj) {
                    f32x4 v0 = acc[ai][bj][m][0] * osc, v1 = acc[ai][bj][m][1] * osc;
                    if (rot) {
                        f32x4 w0, w1;
                        w0[0] = v0[0] * cs[0] - v0[1] * sn[0]; w0[1] = v0[1] * cs[0] + v0[0] * sn[0];
                        w0[2] = v0[2] * cs[1] - v0[3] * sn[1]; w0[3] = v0[3] * cs[1] + v0[2] * sn[1];
                        w1[0] = v1[0] * cs[2] - v1[1] * sn[2]; w1[1] = v1[1] * cs[2] + v1[0] * sn[2];
                        w1[2] = v1[2] * cs[3] - v1[3] * sn[3]; w1[3] = v1[3] * cs[3] + v1[2] * sn[3];
                        v0 = w0; v1 = w1;
                    }
                    u32x4 w; w.x = cvt_pk_bf16(v0[0], v0[1]); w.y = cvt_pk_bf16(v0[2], v0[3]); w.z = cvt_pk_bf16(v1[0], v1[1]); w.w = cvt_pk_bf16(v1[2], v1[3]);
                    *(u32x4*)(base + ((size_t)(b * NSLAB + slab0 + bj) * SEQ + s) * HD + wc * 32 + 8 * fq) = w;
                    if (KM && seg == 1) { const f32x4 ra = {bf_lo(w.x), bf_hi(w.x), bf_lo(w.y), bf_hi(w.y)}, rb = {bf_lo(w.z), bf_hi(w.z), bf_lo(w.w), bf_hi(w.w)};
                        if (bj == 0) { cs0a += ra; cs0b += rb; } else { cs1a += ra; cs1b += rb; } }
                }
            }
        if (KM && seg == 1) {
            bf16_t* km = (bf16_t*)((unsigned char*)QKV - WS_Q + WS_KMEAN);
            LAS float* kbuf = (LAS float*)(uintptr_t)(LDSCTL_OFF + 12288);
#define KM_RED(V, BJ, I0) do { _Pragma("unroll") for (int i = 0; i < 4; ++i) { float v = V[i]; v += dpp_mov<0xB1>(v); v += dpp_mov<0x4E>(v); v += dpp_mov<0x141>(v); v += dpp_mov<0x140>(v); \
                if (fr == 0) kbuf[((wr * 4 + wc) * 2 + (BJ)) * 32 + fq * 8 + (I0) + i] = v; } } while (0)
            KM_RED(cs0a, 0, 0); KM_RED(cs0b, 0, 4); KM_RED(cs1a, 1, 0); KM_RED(cs1b, 1, 4);
#undef KM_RED
            asm volatile("s_waitcnt lgkmcnt(0)" ::: "memory"); __builtin_amdgcn_s_barrier(); asm volatile("" ::: "memory");
            if (wr == 0) {
                const int l = fq * 16 + fr, bj = l >> 5, c32 = l & 31;
                const float mean = (kbuf[((0 * 4 + wc) * 2 + bj) * 32 + c32] + kbuf[((1 * 4 + wc) * 2 + bj) * 32 + c32]) * (1.f / 256.f);
                const unsigned hi = cvt_pk_bf16(mean, 0.f) & 0xffffu; const unsigned lo = cvt_pk_bf16(mean - bf_lo(hi), 0.f) & 0xffffu;
                const size_t ko = ((size_t)(b * NSLAB + slab0 + bj) * 64 + (u.pm & 31)) * HD + wc * 32 + c32;
                km[ko] = (bf16_t)hi; km[ko + 32 * HD] = (bf16_t)lo;
            }
        }
    }
};
struct EpiRes {
    static constexpr bool PERM = false;
    const float* xres; float* y; float osc;
    __device__ __forceinline__ void operator()(const f32x4 (&acc)[2][2][4][2], const Unit& u, int wr, int wc, int fr, int fq) const {
        const int row0 = u.pm * BM + wr * 64 + fr, col0 = u.pn * BM + wc * 32 + 4 * fq;
#pragma unroll
        for (int ai = 0; ai < 2; ++ai)
#pragma unroll
            for (int m = 0; m < 4; ++m) {
                const size_t ro = (size_t)(row0 + ai * HALF + m * 16) * DM + col0;
#pragma unroll
                for (int bj = 0; bj < 2; ++bj)
#pragma unroll
                    for (int n = 0; n < 2; ++n) { const f32x4 xr = *(const f32x4*)(xres + ro + bj * HALF + n * 16); *(f32x4*)(y + ro + bj * HALF + n * 16) = xr * ALPHA + acc[ai][bj][m][n] * osc; }
            }
    }
};
__device__ __forceinline__ float silu_mul(float g, float up) { return g * __builtin_amdgcn_rcpf(1.f + __builtin_amdgcn_exp2f(-1.4426950408889634f * g)) * up; }
template <bool OUT8> struct EpiSwiGLU {
    static constexpr bool PERM = true;
    bf16_t* H; float osc;
    __device__ __forceinline__ void operator()(const f32x4 (&acc)[2][2][4][2], const Unit& u, int wr, int wc, int fr, int fq) const {
        const int row0 = u.pm * BM + wr * 64 + fr, col0 = u.pn * 128 + wc * 32 + 8 * fq;
#pragma unroll
        for (int ai = 0; ai < 2; ++ai)
#pragma unroll
            for (int m = 0; m < 4; ++m) {
                const f32x4 g0 = acc[ai][0][m][0] * osc, g1 = acc[ai][0][m][1] * osc, u0 = acc[ai][1][m][0] * osc, u1 = acc[ai][1][m][1] * osc;
                if (OUT8) {
                    u32x2 w; w.x = pk4_fp8(silu_mul(g0[0], u0[0]), silu_mul(g0[1], u0[1]), silu_mul(g0[2], u0[2]), silu_mul(g0[3], u0[3]));
                    w.y = pk4_fp8(silu_mul(g1[0], u1[0]), silu_mul(g1[1], u1[1]), silu_mul(g1[2], u1[2]), silu_mul(g1[3], u1[3]));
                    *(u32x2*)((unsigned char*)H + (size_t)(row0 + ai * HALF + m * 16) * DE + col0) = w;
                } else {
                u32x4 w;
                w.x = cvt_pk_bf16(silu_mul(g0[0], u0[0]), silu_mul(g0[1], u0[1])); w.y = cvt_pk_bf16(silu_mul(g0[2], u0[2]), silu_mul(g0[3], u0[3]));
                w.z = cvt_pk_bf16(silu_mul(g1[0], u1[0]), silu_mul(g1[1], u1[1])); w.w = cvt_pk_bf16(silu_mul(g1[2], u1[2]), silu_mul(g1[3], u1[3]));
                *(u32x4*)(H + (size_t)(row0 + ai * HALF + m * 16) * DE + col0) = w;
                }
            }
    }
};
template <bool OUT8> struct EpiY {
    static constexpr bool PERM = true;
    bf16_t* Y; float osc;
    __device__ __forceinline__ void operator()(const f32x4 (&acc)[2][2][4][2], const Unit& u, int wr, int wc, int fr, int fq) const {
        const int row0 = u.pm * BM + wr * 64 + fr, col0 = u.pn * BM + wc * 32 + 8 * fq;
#pragma unroll
        for (int ai = 0; ai < 2; ++ai)
#pragma unroll
            for (int m = 0; m < 4; ++m) {
                bf16_t* rowp = Y + (size_t)(row0 + ai * HALF + m * 16) * DM + col0;
#pragma unroll
                for (int bj = 0; bj < 2; ++bj) { const f32x4 v0 = acc[ai][bj][m][0] * osc, v1 = acc[ai][bj][m][1] * osc;
                    if (OUT8) { u32x2 w; w.x = pk4_fp8(v0[0], v0[1], v0[2], v0[3]); w.y = pk4_fp8(v1[0], v1[1], v1[2], v1[3]);
                        *(u32x2*)((unsigned char*)Y + (size_t)(row0 + ai * HALF + m * 16) * DM + col0 + bj * HALF) = w; }
                    else { u32x4 w; w.x = cvt_pk_bf16(v0[0], v0[1]); w.y = cvt_pk_bf16(v0[2], v0[3]); w.z = cvt_pk_bf16(v1[0], v1[1]); w.w = cvt_pk_bf16(v1[2], v1[3]);
                        *(u32x4*)(rowp + bj * HALF) = w; } }
            }
    }
};

typedef int i32x4 __attribute__((ext_vector_type(4)));
typedef int i32x8 __attribute__((ext_vector_type(8)));
__device__ __forceinline__ i32x8 cat8(bf16x8 a, bf16x8 b) { const i32x4 x = __builtin_bit_cast(i32x4, a), y = __builtin_bit_cast(i32x4, b); return (i32x8){x[0], x[1], x[2], x[3], y[0], y[1], y[2], y[3]}; }
template <class Epi, class Sched, bool F8>
__device__ __forceinline__ void gemm_phase(LAS unsigned char* lds, const int K, const Sched& S, const Epi& E) {
    const int tid = threadIdx.x, wid = __builtin_amdgcn_readfirstlane(tid >> 6), lane = tid & 63, wr = wid >> 2, wc = wid & 3, fr = lane & 15, fq = lane >> 4;
    const int nt = K / 128;
    unsigned voffB[2];
#pragma unroll
    for (int i = 0; i < 2; ++i) { int R, C; stage_rc(tid * 16 + i * 8192, R, C); const int Rb = Epi::PERM ? ((R & ~31) + perm32(R & 31)) : R; voffB[i] = (unsigned)(Rb * K + C * 2); }
    const size_t kstep = (size_t)(BK * 2);
    const size_t hstep = (size_t)HALF * K;
    const unsigned ldsw = (unsigned)wid * 1024u;
    const int aoff = lds_byte(wr * 64 + fr, fq * 8), boff = lds_byte(wc * 32 + fr, fq * 8);
#define PG8_SA(b, h) (((b) * 2 + (h)) * HTB)
#define PG8_SB(b, h) ((4 + (b) * 2 + (h)) * HTB)
#define PG8_STAGE(bufoff, gbase, voff) do { _Pragma("unroll") for (int _i = 0; _i < 2; ++_i) \
        __builtin_amdgcn_global_load_lds((const unsigned*)((const char*)(gbase) + (voff)[_i]), (LAS unsigned*)(lds + (bufoff) + ldsw + _i * 8192), 16, 0, 0); } while (0)
#define PG8_LDA(dst, b, h) do { _Pragma("unroll") for (int m = 0; m < 4; ++m) _Pragma("unroll") for (int k = 0; k < 2; ++k) dst[m][k] = *(const LAS bf16x8*)(lds + PG8_SA(b, h) + aoff + m * 2048 + k * 1024); } while (0)
#define PG8_LDB(dst, b, h) do { _Pragma("unroll") for (int n = 0; n < 2; ++n) _Pragma("unroll") for (int k = 0; k < 2; ++k) dst[n][k] = *(const LAS bf16x8*)(lds + PG8_SB(b, h) + boff + n * 2048 + k * 1024); } while (0)
#define PG8_MMA(ai, bj, At, Bt) do { __builtin_amdgcn_s_setprio(1); _Pragma("unroll") for (int m = 0; m < 4; ++m) _Pragma("unroll") for (int n = 0; n < 2; ++n) { \
        if (F8) acc[ai][bj][m][n] = __builtin_amdgcn_mfma_scale_f32_16x16x128_f8f6f4(cat8(Bt[n][0], Bt[n][1]), cat8(At[m][0], At[m][1]), acc[ai][bj][m][n], 0, 0, 0, 0x7F7F7F7F, 0, 0x7F7F7F7F); \
        else { _Pragma("unroll") for (int k = 0; k < 2; ++k) acc[ai][bj][m][n] = __builtin_amdgcn_mfma_f32_16x16x32_bf16(Bt[n][k], At[m][k], acc[ai][bj][m][n], 0, 0, 0); } } \
        __builtin_amdgcn_s_setprio(0); } while (0)
#define PG8_WAIT_V(n) asm volatile("s_waitcnt vmcnt(" #n ")" ::: "memory")
#define PG8_WAIT_L(n) asm volatile("s_waitcnt lgkmcnt(" #n ")" ::: "memory")
#define PG8_BAR __builtin_amdgcn_s_barrier()
#define PG8_SCHED __builtin_amdgcn_sched_barrier(0)
    Unit cur, nxt; int ui = 0;
    if (!S.next(0, cur)) return;
    f32x4 acc[2][2][4][2];
#pragma unroll
    for (int a = 0; a < 2; ++a)
#pragma unroll
        for (int b = 0; b < 2; ++b)
#pragma unroll
            for (int m = 0; m < 4; ++m)
#pragma unroll
                for (int n = 0; n < 2; ++n) acc[a][b][m][n] = (f32x4){0.f, 0.f, 0.f, 0.f};
    bf16x8 At[4][2], B0[2][2], B1[2][2];
    unsigned cOff[2][2];
    const char* cA = S.a_base(cur); const char* cB = S.b_base(cur);
    S.a_off(cur, cOff);
    PG8_STAGE(PG8_SB(0, 0), cB, voffB); PG8_STAGE(PG8_SB(0, 1), cB + hstep, voffB); PG8_STAGE(PG8_SA(0, 0), cA, cOff[0]); PG8_STAGE(PG8_SA(0, 1), cA, cOff[1]);
    if (wr == 1) PG8_BAR;
    PG8_WAIT_V(2); PG8_BAR;
    PG8_STAGE(PG8_SB(1, 0), cB + kstep, voffB); PG8_STAGE(PG8_SA(1, 0), cA + kstep, cOff[0]); PG8_STAGE(PG8_SB(1, 1), cB + hstep + kstep, voffB);
    PG8_WAIT_V(6); PG8_BAR;
    for (;;) {
        const bool has_next = S.next(ui + 1, nxt);
        const char* nA = has_next ? S.a_base(nxt) : cA; const char* nB = has_next ? S.b_base(nxt) : cB;
#pragma unroll 1
        for (int t = 0; t < nt; t += 2) {
            const bool last = (t == nt - 2);
            const char* a1 = cA + (size_t)(t + 1) * kstep;
            const char* a2 = last ? nA : cA + (size_t)(t + 2) * kstep; const char* b2 = last ? nB : cB + (size_t)(t + 2) * kstep;
            const char* a3 = a2 + kstep; const char* b3 = b2 + kstep;
            PG8_LDB(B0, 0, 0); PG8_LDB(B1, 0, 1); PG8_SCHED; PG8_LDA(At, 0, 0); PG8_STAGE(PG8_SA(1, 1), a1, cOff[1]);
            if (last && has_next) S.a_off(nxt, cOff);
            PG8_WAIT_V(8); PG8_WAIT_L(0); PG8_BAR; PG8_MMA(0, 0, At, B0); PG8_MMA(0, 1, At, B1); PG8_BAR; PG8_SCHED;
            PG8_LDA(At, 0, 1); PG8_STAGE(PG8_SB(0, 0), b2, voffB); PG8_STAGE(PG8_SB(0, 1), b2 + hstep, voffB); PG8_STAGE(PG8_SA(0, 0), a2, cOff[0]);
            PG8_WAIT_V(8); PG8_WAIT_L(0); PG8_BAR; PG8_MMA(1, 0, At, B0); PG8_MMA(1, 1, At, B1); PG8_BAR; PG8_SCHED;
            PG8_LDB(B0, 1, 0); PG8_LDB(B1, 1, 1); PG8_SCHED; PG8_LDA(At, 1, 0); PG8_STAGE(PG8_SA(0, 1), a2, cOff[1]);
            PG8_WAIT_V(8); PG8_WAIT_L(0); PG8_BAR; PG8_MMA(0, 0, At, B0); PG8_MMA(0, 1, At, B1); PG8_BAR; PG8_SCHED;
            PG8_LDA(At, 1, 1); PG8_STAGE(PG8_SB(1, 0), b3, voffB); PG8_STAGE(PG8_SB(1, 1), b3 + hstep, voffB); PG8_STAGE(PG8_SA(1, 0), a3, cOff[0]);
            PG8_WAIT_V(8); PG8_WAIT_L(0); PG8_BAR; PG8_MMA(1, 0, At, B0); PG8_MMA(1, 1, At, B1); PG8_BAR; PG8_SCHED;
        }
        if (wr == 0) PG8_BAR;
        E(acc, cur, wr, wc, fr, fq);
        if (!has_next) break;
#pragma unroll
        for (int a = 0; a < 2; ++a)
#pragma unroll
            for (int b = 0; b < 2; ++b)
#pragma unroll
                for (int m = 0; m < 4; ++m)
#pragma unroll
                    for (int n = 0; n < 2; ++n) acc[a][b][m][n] = (f32x4){0.f, 0.f, 0.f, 0.f};
        cur = nxt; cA = nA; cB = nB; ++ui;
        if (wr == 1) PG8_BAR;
    }
    PG8_WAIT_V(0);
    PG8_BAR;
#undef PG8_SA
#undef PG8_SB
#undef PG8_STAGE
#undef PG8_LDA
#undef PG8_LDB
#undef PG8_MMA
#undef PG8_WAIT_V
#undef PG8_WAIT_L
#undef PG8_BAR
#undef PG8_SCHED
}
}

namespace att {
constexpr int D = 128, NW = 8, QBLK = 32, KVBLK = 64, QB = NW * QBLK;
constexpr float SCALE = 0.08838834764831845f;
constexpr float THR = 8.f;
constexpr int SHM_V = KVBLK * D * 2, SHM_K = KVBLK * D * 2;
constexpr int ATT_LDS = 2 * SHM_V + 2 * SHM_K + NW * 256 * 4;
#define KSWZ(row, colB) ((row) * 256 + ((colB) ^ (((row) & 7) << 4)))
__device__ __forceinline__ int v_st(int k, int c) { const int kk = (k & ~0xC) | ((k & 4) << 1) | ((k & 8) >> 1); return ((kk >> 3) * 4 + (c >> 5)) * 512 + ((kk & 7) * 32 + (c & 31)) * 2; }
__device__ __forceinline__ int v_rd_base(int lane) { return ((lane & 3) << 3) | (((lane >> 2) & 3) << 6) | (((lane >> 4) & 1) << 5) | (((lane >> 5) & 1) << 8); }
constexpr int v_rd_off(int d0, int ks, int half) { return d0 * 512 + ks * 4096 + half * 2048; }
__device__ __forceinline__ int crow(int r, int hi) { return (r & 3) + 8 * (r >> 2) + 4 * hi; }
__device__ __forceinline__ bf16x8 load8(const bf16_t* p) { return *reinterpret_cast<const bf16x8*>(p); }
__device__ __forceinline__ void mask_tile(f32x16& p0, f32x16& p1, int dq, unsigned W) {
    const float NEG = -__builtin_inff();
#pragma unroll
    for (int r = 0; r < 16; ++r) {
        const int c = (r & 3) + 8 * (r >> 2);
        if ((unsigned)(dq - c) >= W) p0[r] = NEG;
        if ((unsigned)(dq - c - 32) >= W) p1[r] = NEG;
    }
}
__device__ __forceinline__ void partialSM(f32x16& p0, f32x16& p1, float& m_reg, float& mn, float& alpha) {
    float pmax = p0[0];
#pragma unroll
    for (int r = 1; r < 16; ++r) pmax = fmaxf(pmax, p0[r]);
#pragma unroll
    for (int r = 0; r < 16; ++r) pmax = fmaxf(pmax, p1[r]);
    { auto rr = __builtin_amdgcn_permlane32_swap(__float_as_uint(pmax), __float_as_uint(pmax), false, false);
      pmax = fmaxf(__uint_as_float(rr[0]), __uint_as_float(rr[1])); }
    constexpr float C2 = 1.4426950408889634f * SCALE;
    if (__builtin_expect(__all((pmax - m_reg) * SCALE <= THR), 1)) { mn = m_reg; alpha = 1.f; }
    else { mn = fmaxf(m_reg, pmax); alpha = __builtin_amdgcn_exp2f((m_reg - mn) * C2); m_reg = mn; }
    const float mnL = -mn * C2;
#pragma unroll
    for (int r = 0; r < 16; ++r) p0[r] = fmaf(p0[r], C2, mnL);
#pragma unroll
    for (int r = 0; r < 16; ++r) p1[r] = fmaf(p1[r], C2, mnL);
#pragma unroll
    for (int r = 0; r < 16; ++r) p0[r] = __builtin_amdgcn_exp2f(p0[r]);
}
__device__ __forceinline__ void finishSM(f32x16& p0, f32x16& p1, float alpha, float& l_reg, bf16x8& pa0, bf16x8& pa1, bf16x8& pa2, bf16x8& pa3) {
#pragma unroll
    for (int r = 0; r < 16; ++r) p1[r] = __builtin_amdgcn_exp2f(p1[r]);
    float ps = 0;
#pragma unroll
    for (int r = 0; r < 16; ++r) ps += p0[r];
#pragma unroll
    for (int r = 0; r < 16; ++r) ps += p1[r];
    { auto rr = __builtin_amdgcn_permlane32_swap(__float_as_uint(ps), __float_as_uint(ps), false, false);
      ps = __uint_as_float(rr[0]) + __uint_as_float(rr[1]); }
    l_reg = l_reg * alpha + ps;
#define PK4(P, B_, OUT) do { unsigned a0 = cvt_pk_bf16(P[B_+0], P[B_+1]), a1 = cvt_pk_bf16(P[B_+2], P[B_+3]);                          \
        unsigned b0 = cvt_pk_bf16(P[B_+4], P[B_+5]), b1 = cvt_pk_bf16(P[B_+6], P[B_+7]);                                             \
        auto r0 = __builtin_amdgcn_permlane32_swap(a0, b0, false, false); auto r1 = __builtin_amdgcn_permlane32_swap(a1, b1, false, false); \
        u32x4 w = {r0[0], r1[0], r0[1], r1[1]}; OUT = *reinterpret_cast<bf16x8*>(&w); } while (0)
    PK4(p0, 0, pa0); PK4(p0, 8, pa1); PK4(p1, 0, pa2); PK4(p1, 8, pa3);
#undef PK4
}
template <int KB>
__device__ __forceinline__ void qkt(f32x16& p0, f32x16& p1, const char* K_lds, int r32, int hi, const bf16x8* qr) {
    p0 = f32x16{}; p1 = f32x16{};
    const char* kb[4];
#pragma unroll
    for (int dd = 0; dd < 4; ++dd) kb[dd] = K_lds + KB * SHM_K + KSWZ(r32, (dd * 16 + hi * 8) * 2);
#pragma unroll
    for (int d0 = 0; d0 < 8; ++d0) { const char* a = kb[d0 & 3] + (d0 >> 2) * 128;
        bf16x8 b0 = *reinterpret_cast<const bf16x8*>(a);
        bf16x8 b1 = *reinterpret_cast<const bf16x8*>(a + 32 * 256);
        p0 = __builtin_amdgcn_mfma_f32_32x32x16_bf16(b0, qr[d0], p0, 0, 0, 0);
        p1 = __builtin_amdgcn_mfma_f32_32x32x16_bf16(b1, qr[d0], p1, 0, 0, 0); }
}
template <int VB>
__device__ __forceinline__ void pv_tile(f32x16* o, int vb0, bf16x8 pa0, bf16x8 pa1, bf16x8 pa2, bf16x8 pa3) {
#define TRRD(dst, off) asm volatile("ds_read_b64_tr_b16 %0, %1 offset:%2" : "=&v"(dst) : "v"(vb0), "i"(off) : "memory")
#define PV_D0(d0) do { s16x4 l0, l1, l2, l3, h0, h1, h2, h3; constexpr int b_ = VB * SHM_V + v_rd_off(d0, 0, 0); \
        TRRD(l0, b_); TRRD(h0, b_ + 2048); TRRD(l1, b_ + 4096); TRRD(h1, b_ + 6144); TRRD(l2, b_ + 8192); TRRD(h2, b_ + 10240); TRRD(l3, b_ + 12288); TRRD(h3, b_ + 14336); \
        asm volatile("s_waitcnt lgkmcnt(0)" ::: "memory"); SBAR(); \
        o[d0] = __builtin_amdgcn_mfma_f32_32x32x16_bf16(pa0, (bf16x8){l0[0], l0[1], l0[2], l0[3], h0[0], h0[1], h0[2], h0[3]}, o[d0], 0, 0, 0);   \
        o[d0] = __builtin_amdgcn_mfma_f32_32x32x16_bf16(pa1, (bf16x8){l1[0], l1[1], l1[2], l1[3], h1[0], h1[1], h1[2], h1[3]}, o[d0], 0, 0, 0);   \
        o[d0] = __builtin_amdgcn_mfma_f32_32x32x16_bf16(pa2, (bf16x8){l2[0], l2[1], l2[2], l2[3], h2[0], h2[1], h2[2], h2[3]}, o[d0], 0, 0, 0);   \
        o[d0] = __builtin_amdgcn_mfma_f32_32x32x16_bf16(pa3, (bf16x8){l3[0], l3[1], l3[2], l3[3], h3[0], h3[1], h3[2], h3[3]}, o[d0], 0, 0, 0); } while (0)
    PV_D0(0); PV_D0(1); PV_D0(2); PV_D0(3);
#undef PV_D0
#undef TRRD
}
struct BlockRef { const bf16_t* Q; const bf16_t* K; const bf16_t* V; bf16_t* O; const unsigned* sel; const unsigned* list; float* ML; int P0, jlo, nvalid, nblk, hb; };
struct Seam { bf16x8 qr[8]; bf16x8 st_v0, st_v1, st_k0, st_k1; unsigned sel, qrow; };
#define ROW(p, k0, rr) ((p) + (size_t)((k0) + (rr)) * D + sc)
#define VMWN(n) asm volatile("s_waitcnt vmcnt(%0)" :: "i"(n) : "memory")
#define SLOAD_H(Kp, Vp, k0) do { S.st_v0 = load8(ROW(Vp, k0, sr)); S.st_v1 = load8(ROW(Vp, k0, 32 + sr));              \
                         S.st_k0 = load8(ROW(Kp, k0, sr)); S.st_k1 = load8(ROW(Kp, k0, 32 + sr)); } while (0)
#define SWRITE_HK(bf) do { *(bf16x8*)(K_lds + (bf) * SHM_K + kws) = S.st_k0; *(bf16x8*)(K_lds + (bf) * SHM_K + kws + 32 * 256) = S.st_k1; } while (0)
#define SWRITE_HV(bf) do { *(bf16x8*)(V_lds + (bf) * SHM_V + vst0) = S.st_v0; *(bf16x8*)(V_lds + (bf) * SHM_V + vst1) = S.st_v1; } while (0)
#define SWRITE_H(bf) do { SWRITE_HV(bf); SWRITE_HK(bf); } while (0)
template <bool SP>
__device__ __forceinline__ void attn_prime(const BlockRef& cur, char* lds, Seam& S) {
    int tid = threadIdx.x; asm volatile("" : "+v"(tid));
    const int wid = __builtin_amdgcn_readfirstlane(tid >> 6), lane = tid & 63, r32 = lane & 31, hi = lane >> 5;
    const int sr = tid >> 4, sc = (tid & 15) * 8, kws = KSWZ(sr, sc * 2); char* K_lds = lds + 2 * SHM_V;
    const int i = wid * QBLK + r32;
    unsigned q = (unsigned)i;
    if (SP) q = cur.list ? cur.list[i < cur.nvalid ? i : cur.nvalid - 1] : (unsigned)(cur.P0 + i);
    S.qrow = q; S.sel = SP ? cur.sel[q] : 0u;
#pragma unroll
    for (int d0 = 0; d0 < 8; ++d0) S.qr[d0] = load8(cur.Q + (size_t)q * D + d0 * 16 + hi * 8);
    SLOAD_H(cur.K, cur.V, SP ? cur.jlo * KVBLK : 0); VM_WAIT(); SWRITE_HK(0);
    __syncthreads();
}
template <bool SP>
__device__ __forceinline__ void attn_block(const BlockRef& cur, const BlockRef& nxt, const int ostride, char* lds, Seam& S) {
    int tid = threadIdx.x; asm volatile("" : "+v"(tid));
    const int wid = __builtin_amdgcn_readfirstlane(tid >> 6), lane = tid & 63, r32 = lane & 31, hi = lane >> 5;
    const int NT = SP ? 4 : cur.P0 / KVBLK + 4;
    const int jlo = SP ? cur.jlo : 0;
    const int qlo = cur.P0 + wid * QBLK, qm = qlo + r32 - 4 * hi;
    char* V_lds = lds; char* K_lds = lds + 2 * SHM_V;
    float* ws = (float*)(lds + 2 * SHM_V + 2 * SHM_K) + wid * 256; float* li_l = ws, * al_l = ws + 32;
    unsigned* rd = (unsigned*)(ws + 64); unsigned* nl = (unsigned*)(ws + 96);
    float m_reg = -1e30f, l_reg = 0; f32x16 o[4] = {};
    const int sr = tid >> 4, sc = (tid & 15) * 8, vst0 = v_st(sr, sc), vst1 = v_st(32 + sr, sc), kws = KSWZ(sr, sc * 2);
    const int vb0 = (int)(uintptr_t)V_lds + v_rd_base(lane);
    const bf16_t* Kh = cur.K; const bf16_t* Vh = cur.V;
    const bool causal = !SP || cur.list == nullptr;
#define RESC(a) do { if (__any((a) < 1.f)) { if (hi == 0) al_l[r32] = (a); asm volatile("s_waitcnt lgkmcnt(0)" ::: "memory");              \
                     for (int d_ = 0; d_ < 4; ++d_) for (int r = 0; r < 16; ++r) o[d_][r] *= al_l[crow(r, hi)]; } } while (0)
#define KBASE(t) ((jlo + (t)) * KVBLK)
#define MASKT(P0_, P1_, t) do { const int kb_ = KBASE(t); if (causal && kb_ + KVBLK - 1 > qlo) mask_tile(P0_, P1_, qm - kb_, 0x40000000u); } while (0)
    constexpr int NQL = 8;
#define SEAM_K0() do { VMWN(NQL); SWRITE_HK(0); SBAR(); } while (0)
    f32x16 pA0, pA1, pB0, pB1; float mnA, mnB, alA, alB; bf16x8 pa0, pa1, pa2, pa3;
    unsigned qn_tmp = 0u;
    if (SP) {
        if (hi == 0) { const bool valid = (cur.list == nullptr) || (wid * QBLK + r32 < cur.nvalid);
            const unsigned slot = cur.list ? (unsigned)__builtin_popcount(S.sel & ((1u << cur.nblk) - 1u)) : 3u;
            rd[r32] = valid ? (((unsigned)cur.hb + S.qrow) * 4u + slot) * 128u : (1u << 27); }
        if (nxt.list) { const int i = wid * QBLK + r32; qn_tmp = nxt.list[i < nxt.nvalid ? i : nxt.nvalid - 1]; }
    }
    SWRITE_HV(0); SBAR();
    if (NT > 1) { SLOAD_H(Kh, Vh, KBASE(1)); }
    SBAR(); qkt<0>(pA0, pA1, K_lds, r32, hi, S.qr);
    MASKT(pA0, pA1, 0); partialSM(pA0, pA1, m_reg, mnA, alA);
    if (NT > 1) { VM_WAIT(); SWRITE_H(1); }
    if (SP) nl[lane] = nxt.list ? qn_tmp : (unsigned)(nxt.P0 + wid * QBLK + r32);
    __syncthreads();
#define HALF_STEP(PX0, PX1, mnX, alX, PY0, PY1, alY, t, KB, VB, SB) do {                                                      \
        SBAR(); qkt<KB>(PX0, PX1, K_lds, r32, hi, S.qr);                                                                      \
        finishSM(PY0, PY1, alY, l_reg, pa0, pa1, pa2, pa3); SBAR();                                                           \
        if ((t) + 1 < NT) { SLOAD_H(Kh, Vh, KBASE((t) + 1)); SBAR(); }                                                        \
        pv_tile<VB>(o, vb0, pa0, pa1, pa2, pa3); MASKT(PX0, PX1, (t)); partialSM(PX0, PX1, m_reg, mnX, alX);                  \
        __syncthreads();                                                                                                      \
        if ((t) + 1 < NT) { VM_WAIT(); SWRITE_H(SB); }                                                                        \
        RESC(alX); __syncthreads(); } while (0)
    for (int t = 1; t + 1 < NT; t += 2) {
        HALF_STEP(pB0, pB1, mnB, alB, pA0, pA1, alA, t, 1, 0, 0);
        HALF_STEP(pA0, pA1, mnA, alA, pB0, pB1, alB, t + 1, 0, 1, 1);
    }
    const bool even = (NT & 1) == 0;
    if (even) { SBAR(); qkt<1>(pB0, pB1, K_lds, r32, hi, S.qr); SBAR(); }
    unsigned qn = (unsigned)(wid * QBLK + r32);
    if (SP) { qn = nl[lane]; S.qrow = qn; S.sel = nxt.sel[qn]; }
    SLOAD_H(nxt.K, nxt.V, SP ? nxt.jlo * KVBLK : 0); SBAR();
#pragma unroll
    for (int d0 = 0; d0 < 8; ++d0) S.qr[d0] = load8(nxt.Q + (size_t)qn * D + d0 * 16 + hi * 8);
    SBAR();
    finishSM(pA0, pA1, alA, l_reg, pa0, pa1, pa2, pa3); SBAR();
    pv_tile<0>(o, vb0, pa0, pa1, pa2, pa3);
    if (even) { MASKT(pB0, pB1, NT - 1); partialSM(pB0, pB1, m_reg, mnB, alB); __syncthreads(); RESC(alB);
        finishSM(pB0, pB1, alB, l_reg, pa0, pa1, pa2, pa3); SBAR(); pv_tile<1>(o, vb0, pa0, pa1, pa2, pa3); }
    SBAR(); SEAM_K0();
    if (hi == 0) li_l[r32] = l_reg; asm volatile("s_waitcnt lgkmcnt(0)" ::: "memory");
    float rli[16];
#pragma unroll
    for (int r = 0; r < 16; ++r) rli[r] = __builtin_amdgcn_rcpf(li_l[crow(r, hi)]);
    if (SP) {
        bf16_t* Ob = cur.O;
#pragma unroll
        for (int r = 0; r < 16; ++r) { const unsigned off = rd[crow(r, hi)];
#pragma unroll
            for (int d0 = 0; d0 < 4; ++d0) { const float v = o[d0][r] * rli[r];
                const float vn = __int_as_float(__builtin_amdgcn_mov_dpp(__float_as_int(v), 0xB1, 0xF, 0xF, true));
                if ((r32 & 1) == 0) *(unsigned*)(Ob + (size_t)off + d0 * 32 + r32) = cvt_pk_bf16(v, vn); } }
        if (hi == 0) { float* mlp = cur.ML + (size_t)(rd[r32] >> 7) * 2; f32x2 ml = {m_reg, l_reg}; *(f32x2*)mlp = ml; }
    } else {
        bf16_t* Ow = cur.O + (size_t)(wid * QBLK) * ostride;
#pragma unroll
        for (int r = 0; r < 16; ++r) { const int orow = crow(r, hi);
#pragma unroll
            for (int d0 = 0; d0 < 4; ++d0) { const float v = o[d0][r] * rli[r];
                const float vn = __int_as_float(__builtin_amdgcn_mov_dpp(__float_as_int(v), 0xB1, 0xF, 0xF, true));
                if ((r32 & 1) == 0) *(unsigned*)(Ow + (size_t)orow * ostride + d0 * 32 + r32) = cvt_pk_bf16(v, vn); } }
    }
    __syncthreads();
#undef RESC
#undef KBASE
#undef MASKT
#undef SEAM_K0
#undef HALF_STEP
}
#undef ROW
#undef VMWN
#undef SLOAD_H
#undef SWRITE_HK
#undef SWRITE_HV
#undef SWRITE_H
}

struct Args { const float* in[23]; float* out; unsigned char* ws; int ph_lo, ph_hi; };
typedef const __attribute__((address_space(4))) Args* KArgs;
__device__ __forceinline__ KArgs kargs() { KArgs p = (KArgs)__builtin_amdgcn_kernarg_segment_ptr(); asm volatile("" : "+s"(p)); return p; }
__device__ __forceinline__ int otid() { int t = threadIdx.x; asm volatile("" : "+v"(t)); return t; }
struct Geo { int G, bx, vcu, gw, NGW; };
__device__ __forceinline__ Geo geo() {
    Geo g; const int tid = otid(); const int wave = __builtin_amdgcn_readfirstlane(tid >> 6);
    g.G = gridDim.x; g.bx = blockIdx.x; g.vcu = (g.G % 8 == 0) ? (g.bx % 8) * (g.G / 8) + g.bx / 8 : g.bx; g.gw = g.vcu * NWAVES + wave; g.NGW = g.G * NWAVES; return g;
}
enum { I_X = 0, I_POS, I_LN1G, I_LN1B, I_LN2G, I_LN2B, I_DAWIN, I_DAWOUT, I_LQ1, I_LK1, I_LQ2, I_LK2, I_SUBLN, I_MBWIN, I_MBWOUT, I_WR, I_RB, I_WG, I_WU, I_WD, I_SG, I_SU, I_SD };

__device__ __forceinline__ int dst_row(int kind, int n) {
    if (kind == 1) { if (n < 4096) { int d = n & 127; const int h = n & ~127; if (d < 16) d = 2 * d; else if (d < 32) d = 2 * (d - 16) + 1; return h + d; } return n; }
    if (kind == 2) return ((n >> 7) << 8) + (n & 127);
    if (kind == 3) return ((n >> 7) << 8) + 128 + (n & 127);
    return n;
}
struct TrDesc { const float* W; unsigned char* WT; int K, N, k0, n0, kind, f8; };
constexpr int IT_IN = 32 * 192, IT_OUT = 32 * 64, IT_E = 512, IT_ATT = 2 * IT_IN + 2 * IT_OUT, IT_TOTAL = IT_ATT + 2 * NEX * 3 * IT_E;
__device__ __forceinline__ void tr_decode(KArgs a, int it, TrDesc& d) {
    unsigned char* ws = a->ws; int s;
    if (it < IT_ATT) {
        if (it < IT_IN) { d.W = a->in[I_DAWIN]; d.WT = ws + WS_WATT; d.K = DM; d.N = NQKV; d.kind = 1; d.f8 = FP8_QKV0; s = it; }
        else if (it < 2 * IT_IN) { d.W = a->in[I_MBWIN]; d.WT = ws + WS_WATT + 32 * MiB; d.K = DM; d.N = NQKV; d.kind = 1; d.f8 = FP8_QKV1; s = it - IT_IN; }
        else if (it < 2 * IT_IN + IT_OUT) { d.W = a->in[I_DAWOUT]; d.WT = ws + WS_WATT + 24 * MiB; d.K = DM; d.N = DM; d.kind = 0; d.f8 = FP8_OUT0; s = it - 2 * IT_IN; }
        else { d.W = a->in[I_MBWOUT]; d.WT = ws + WS_WATT + 56 * MiB; d.K = DM; d.N = DM; d.kind = 0; d.f8 = FP8_OUT1; s = it - 2 * IT_IN - IT_OUT; }
    } else {
        const int r = it - IT_ATT, le = r / (3 * IT_E), sub = r - le * (3 * IT_E), mtx = sub / IT_E; s = sub - mtx * IT_E;
        const int l = le / NEX, e = le - l * NEX;
        const size_t EW = (size_t)DM * DE;
        if (mtx < 2) {
            const float* src = (e < NE) ? a->in[mtx == 0 ? I_WG : I_WU] + ((size_t)l * NE + e) * EW : a->in[mtx == 0 ? I_SG : I_SU] + (size_t)l * EW;
            d.f8 = (l == 1) ? FP8_MOE1 : 0;
            d.W = src; d.WT = ws + WS_WGU + (size_t)l * NEX * (2 * EW) * 2 + (size_t)e * (2 * EW) * (d.f8 ? 1 : 2); d.K = DM; d.N = DE; d.kind = 2 + mtx;
        } else {
            const float* src = (e < NE) ? a->in[I_WD] + ((size_t)l * NE + e) * EW : a->in[I_SD] + (size_t)l * EW;
            d.f8 = (l == 1) ? FP8_MOE1 : 0;
            d.W = src; d.WT = ws + WS_WD + (size_t)l * NEX * EW * 2 + (size_t)e * EW * (d.f8 ? 1 : 2); d.K = DE; d.N = DM; d.kind = 0;
        }
    }
    const int nblk = d.N / 32; const int kb = s / nblk; d.k0 = kb * 64; d.n0 = (s - kb * nblk) * 32;
}
__device__ __forceinline__ void tr_load(const TrDesc& d, int lane, f32x4 (&v)[8]) {
    const int kk = lane >> 3, n4 = (lane & 7) * 4;
#pragma unroll
    for (int i = 0; i < 8; ++i) v[i] = *(const f32x4*)(d.W + (size_t)(d.k0 + kk + 8 * i) * d.N + d.n0 + n4);
}
__device__ __forceinline__ void tr_store(const TrDesc& d, int lane, const f32x4 (&v)[8], LAS float* scr) {
    const int kk = lane >> 3, n4 = (lane & 7) * 4, c = lane & 3;
#pragma unroll
    for (int hf = 0; hf < 2; ++hf) {
#pragma unroll
        for (int i = 0; i < 4; ++i)
#pragma unroll
            for (int q = 0; q < 4; ++q) scr[(kk + 8 * i) * 33 + n4 + q] = v[hf * 4 + i][q];
        LDS_WAIT();
#pragma unroll
        for (int j = 0; j < 2; ++j) { const int n = (lane >> 2) + 16 * j; const LAS float* s = scr + (8 * c) * 33 + n;
            const size_t eo = (size_t)dst_row(d.kind, d.n0 + n) * d.K + d.k0 + hf * 32 + 8 * c;
            if (d.f8) { u32x2 o; o.x = pk4_fp8(s[0 * 33] * W8_SCALE, s[1 * 33] * W8_SCALE, s[2 * 33] * W8_SCALE, s[3 * 33] * W8_SCALE); o.y = pk4_fp8(s[4 * 33] * W8_SCALE, s[5 * 33] * W8_SCALE, s[6 * 33] * W8_SCALE, s[7 * 33] * W8_SCALE);
                *(u32x2*)(d.WT + eo) = o; }
            else { u32x4 o; o.x = cvt_pk_bf16(s[0 * 33], s[1 * 33]); o.y = cvt_pk_bf16(s[2 * 33], s[3 * 33]); o.z = cvt_pk_bf16(s[4 * 33], s[5 * 33]); o.w = cvt_pk_bf16(s[6 * 33], s[7 * 33]);
                *(u32x4*)(d.WT + eo * 2) = o; } }
        LDS_WAIT();
    }
}
__device__ __forceinline__ void convert_items(KArgs a, LAS float* scr, int gw, int NGW, int lane, int it0, int it1) {
    TrDesc dA, dB, dC; f32x4 vA[8], vB[8], vC[8];
    int it = it0 + gw;
#define CV_LD(D, V, IT) do { if ((IT) < it1) { tr_decode(a, (IT), D); tr_load(D, lane, V); } } while (0)
    CV_LD(dA, vA, it); CV_LD(dB, vB, it + NGW); CV_LD(dC, vC, it + 2 * NGW);
    while (it < it1) {
        tr_store(dA, lane, vA, scr); CV_LD(dA, vA, it + 3 * NGW);
        if (it + NGW < it1) { tr_store(dB, lane, vB, scr); CV_LD(dB, vB, it + 4 * NGW); }
        if (it + 2 * NGW < it1) { tr_store(dC, lane, vC, scr); CV_LD(dC, vC, it + 5 * NGW); }
        it += 3 * NGW;
    }
#undef CV_LD
}
__device__ __forceinline__ void p0_prologue(KArgs a, LAS unsigned char* lds, int gw, int NGW, int wave, int lane) {
    LAS float* scr = (LAS float*)(lds + wave * 4224);
    convert_items(a, scr, gw, NGW, lane, 0, IT_IN);
    {
        const float* x = a->in[I_X]; bf16_t* xb = (bf16_t*)(a->ws + WS_XB);
        f32x4 vn[8];
        if (gw < NTOK) {
#pragma unroll
            for (int j = 0; j < 4; ++j) { vn[2 * j] = *(const f32x4*)(x + (size_t)gw * DM + 512 * j + 8 * lane); vn[2 * j + 1] = *(const f32x4*)(x + (size_t)gw * DM + 512 * j + 8 * lane + 4); } }
        for (int m = gw; m < NTOK; m += NGW) {
            f32x4 v[8];
#pragma unroll
            for (int j = 0; j < 8; ++j) v[j] = vn[j];
            if (m + NGW < NTOK) {
#pragma unroll
                for (int j = 0; j < 4; ++j) { vn[2 * j] = *(const f32x4*)(x + (size_t)(m + NGW) * DM + 512 * j + 8 * lane); vn[2 * j + 1] = *(const f32x4*)(x + (size_t)(m + NGW) * DM + 512 * j + 8 * lane + 4); } }
#pragma unroll
            for (int j = 0; j < 4; ++j) {
                if (FP8_QKV0) { u32x2 w; w.x = pk4_fp8(v[2 * j][0], v[2 * j][1], v[2 * j][2], v[2 * j][3]); w.y = pk4_fp8(v[2 * j + 1][0], v[2 * j + 1][1], v[2 * j + 1][2], v[2 * j + 1][3]);
                    *(u32x2*)((unsigned char*)xb + (size_t)m * DM + 512 * j + 8 * lane) = w; }
                else { u32x4 w; w.x = cvt_pk_bf16(v[2 * j][0], v[2 * j][1]); w.y = cvt_pk_bf16(v[2 * j][2], v[2 * j][3]); w.z = cvt_pk_bf16(v[2 * j + 1][0], v[2 * j + 1][1]); w.w = cvt_pk_bf16(v[2 * j + 1][2], v[2 * j + 1][3]);
                    *(u32x4*)(xb + (size_t)m * DM + 512 * j + 8 * lane) = w; } }
        }
    }
    {
        bf16_t* wf = (bf16_t*)(a->ws + WS_WRF);
        for (int idx = gw * 64 + lane; idx < 2 * 2 * 128 * 64; idx += NGW * 64) {
            const int ln = idx & 63, s = (idx >> 6) & 127, blk = (idx >> 13) & 1, l = idx >> 14;
            const int e = blk * 32 + (ln & 31), c = 16 * s + 8 * (ln >> 5);
            const float* w = a->in[I_WR] + ((size_t)l * DM + c) * NE + e;
            float v[8];
#pragma unroll
            for (int j = 0; j < 8; ++j) v[j] = w[(size_t)j * NE];
            u32x4 h, lo;
            h.x = cvt_pk_bf16(v[0], v[1]); h.y = cvt_pk_bf16(v[2], v[3]); h.z = cvt_pk_bf16(v[4], v[5]); h.w = cvt_pk_bf16(v[6], v[7]);
            lo.x = cvt_pk_bf16(v[0] - bf_lo(h.x), v[1] - bf_hi(h.x)); lo.y = cvt_pk_bf16(v[2] - bf_lo(h.y), v[3] - bf_hi(h.y));
            lo.z = cvt_pk_bf16(v[4] - bf_lo(h.z), v[5] - bf_hi(h.z)); lo.w = cvt_pk_bf16(v[6] - bf_lo(h.w), v[7] - bf_hi(h.w));
            const size_t fo = (((size_t)(l * 2 + 0) * 2 + blk) * 128 + s) * 64 + ln, fl = (((size_t)(l * 2 + 1) * 2 + blk) * 128 + s) * 64 + ln;
            *(u32x4*)(wf + fo * 8) = h; *(u32x4*)(wf + fl * 8) = lo;
        }
    }
    {
        const int* pos = (const int*)a->in[I_POS]; float* tab = (float*)(a->ws + WS_ROPE);
        for (int idx = gw * 64 + lane; idx < NTOK * 16; idx += NGW * 64) {
            const int t = idx >> 4, i = idx & 15;
            const float inv = powf(500000.f, -(float)(2 * i) / 32.f);
            const float ang = (float)pos[t] * inv;
            double rev = (double)ang * 0.15915494309189535; rev -= floor(rev);
            const float fr = (float)rev;
            tab[(size_t)t * 32 + i] = __builtin_amdgcn_cosf(fr); tab[(size_t)t * 32 + 16 + i] = __builtin_amdgcn_sinf(fr);
        }
    }
}

__device__ __forceinline__ void da_combine(KArgs a, int gw, int NGW, int lane) {
    float lam;
    {   const float* q1 = a->in[I_LQ1]; const float* k1 = a->in[I_LK1]; const float* q2 = a->in[I_LQ2]; const float* k2 = a->in[I_LK2];
        const float s1 = wave_sum(q1[lane] * k1[lane] + q1[lane + 64] * k1[lane + 64]);
        const float s2 = wave_sum(q2[lane] * k2[lane] + q2[lane + 64] * k2[lane + 64]);
        lam = expf(s1) - expf(s2) + LAMBDA_INIT; }
    const bf16_t* O = (const bf16_t*)(a->ws + WS_O); bf16_t* AO = (bf16_t*)(a->ws + WS_AOUT);
    const f32x4 g = *(const f32x4*)(a->in[I_SUBLN] + 4 * lane);
    for (int t = gw; t < NTOK; t += NGW) {
        const bf16_t* row = O + (size_t)t * 4096;
        u32x2 x1[8], x2[8];
#pragma unroll
        for (int h = 0; h < 8; ++h) { x1[h] = *(const u32x2*)(row + h * 512 + 4 * lane); x2[h] = *(const u32x2*)(row + h * 512 + 256 + 4 * lane); }
#pragma unroll
        for (int h = 0; h < 8; ++h) {
            f32x4 o;
            o[0] = bf_lo(x1[h].x) - lam * bf_lo(x2[h].x); o[1] = bf_hi(x1[h].x) - lam * bf_hi(x2[h].x);
            o[2] = bf_lo(x1[h].y) - lam * bf_lo(x2[h].y); o[3] = bf_hi(x1[h].y) - lam * bf_hi(x2[h].y);
            const float ss = wave_sum(o[0] * o[0] + o[1] * o[1] + o[2] * o[2] + o[3] * o[3]);
            const float sc = __builtin_amdgcn_rsqf(ss * (1.f / 256.f) + LN_EPS) * (1.f - LAMBDA_INIT);
            if (FP8_OUT0) { const float s8 = sc * AO8_SCALE; *(unsigned*)((unsigned char*)AO + (size_t)t * DM + h * 256 + 4 * lane) = pk4_fp8(o[0] * s8 * g[0], o[1] * s8 * g[1], o[2] * s8 * g[2], o[3] * s8 * g[3]); }
            else { u32x2 w; w.x = cvt_pk_bf16(o[0] * sc * g[0], o[1] * sc * g[1]); w.y = cvt_pk_bf16(o[2] * sc * g[2], o[3] * sc * g[3]);
                *(u32x2*)(AO + (size_t)t * DM + h * 256 + 4 * lane) = w; }
        }
    }
}

__device__ __forceinline__ void moba_kmean(KArgs a, int gw, int NGW, int lane) {
    const bf16_t* Kb = (const bf16_t*)(a->ws + WS_K); bf16_t* km = (bf16_t*)(a->ws + WS_KMEAN);
    for (int it = gw; it < BATCH * NSLAB * 32; it += NGW) {
        const int bh = it >> 5, n = it & 31;
        const bf16_t* p = Kb + ((size_t)bh * SEQ + (size_t)n * 256) * HD + 2 * lane;
        float s0 = 0.f, s1 = 0.f;
#pragma unroll 4
        for (int r = 0; r < 256; r += 8) {
            unsigned u[8];
#pragma unroll
            for (int q = 0; q < 8; ++q) u[q] = *(const unsigned*)(p + (size_t)(r + q) * HD);
#pragma unroll
            for (int q = 0; q < 8; ++q) { s0 += bf_lo(u[q]); s1 += bf_hi(u[q]); }
        }
        s0 *= (1.f / 256.f); s1 *= (1.f / 256.f);
        const unsigned hi = cvt_pk_bf16(s0, s1);
        const unsigned lo = cvt_pk_bf16(s0 - bf_lo(hi), s1 - bf_hi(hi));
        *(unsigned*)(km + ((size_t)bh * 64 + n) * HD + 2 * lane) = hi;
        *(unsigned*)(km + ((size_t)bh * 64 + 32 + n) * HD + 2 * lane) = lo;
    }
}
__device__ __forceinline__ void moba_gate(KArgs a, int gw, int NGW, int lane) {
    const bf16_t* Qb = (const bf16_t*)(a->ws + WS_Q); const bf16_t* km = (const bf16_t*)(a->ws + WS_KMEAN); unsigned* sel = (unsigned*)(a->ws + WS_SEL);
    unsigned* mcnt = (unsigned*)(a->ws + WS_CTL) + CW_MCNT; unsigned* qlist = (unsigned*)(a->ws + WS_QLIST);
    const int r32 = lane & 31, hi = lane >> 5;
    for (int it = gw; it < BATCH * NSLAB * (SEQ / 32); it += NGW) {
        const int bh = it >> 8, qg = it & 255, j = qg >> 3;
        const bf16_t* q = Qb + ((size_t)bh * SEQ + (size_t)qg * 32 + r32) * HD + hi * 8;
        const bf16_t* k = km + ((size_t)bh * 64 + r32) * HD + hi * 8;
        f32x16 p = {};
        bf16x8 qf[8], kh[8], kl[8];
#pragma unroll
        for (int d0 = 0; d0 < 8; ++d0) { qf[d0] = *(const bf16x8*)(q + d0 * 16); kh[d0] = *(const bf16x8*)(k + d0 * 16); kl[d0] = *(const bf16x8*)(k + 32 * HD + d0 * 16); }
        SBAR();
#pragma unroll
        for (int d0 = 0; d0 < 8; ++d0) {
            p = __builtin_amdgcn_mfma_f32_32x32x16_bf16(kh[d0], qf[d0], p, 0, 0, 0);
            p = __builtin_amdgcn_mfma_f32_32x32x16_bf16(kl[d0], qf[d0], p, 0, 0, 0);
        }
        float g[32];
#pragma unroll
        for (int r = 0; r < 16; ++r) {
            const float mine = p[r], other = __shfl_xor(mine, 32);
            const int qd = r >> 2, s = r & 3;
            g[8 * qd + s] = hi ? other : mine;
            g[8 * qd + 4 + s] = hi ? mine : other;
        }
        unsigned mask = 0u;
#pragma unroll
        for (int pass = 0; pass < 3; ++pass) {
            float best = -__builtin_inff(); int bi = -1;
#pragma unroll
            for (int n = 0; n < 32; ++n) { const bool ok = (n < j) && !((mask >> n) & 1u) && (g[n] > best); best = ok ? g[n] : best; bi = ok ? n : bi; }
            if (bi >= 0) mask |= 1u << bi;
        }
        if (hi == 0) sel[(size_t)bh * SEQ + (size_t)qg * 32 + r32] = mask;
        const bool rowlane = hi == 0;
        unsigned cntv = 0u;
        for (int n = 0; n < j; ++n) { const unsigned long long bb = __ballot(rowlane && ((mask >> n) & 1u)); if (lane == n) cntv = (unsigned)__popcll(bb); }
        unsigned basev = 0u;
        if (lane < j && cntv) basev = __hip_atomic_fetch_add(mcnt + bh * 32 + lane, cntv, __ATOMIC_RELAXED, __HIP_MEMORY_SCOPE_AGENT);
        for (int n = 0; n < j; ++n) { const unsigned long long bb = __ballot(rowlane && ((mask >> n) & 1u)); const unsigned base = (unsigned)__builtin_amdgcn_readlane((int)basev, n);
            if (rowlane && ((mask >> n) & 1u)) qlist[(size_t)(bh * 32 + n) * SEQ + base + (unsigned)__popcll(bb & ((1ull << lane) - 1ull))] = (unsigned)(qg * 32 + r32); }
    }
}

__device__ __forceinline__ void ln_router(KArgs a, int layer, LAS unsigned char* lds, int vcu, int G, int wave, int lane) {
    float* out = a->out; bf16_t* xb = (bf16_t*)(a->ws + WS_XB);
    const float* gam = a->in[I_LN1G] + layer * DM; const float* bet = a->in[I_LN1B] + layer * DM;
    const float rb = a->in[I_RB][layer * NE + lane];
    const bf16_t* wfh = (const bf16_t*)(a->ws + WS_WRF) + (size_t)(layer * 2 + 0) * 2 * 128 * 64 * 8;
    const bf16_t* wfl = (const bf16_t*)(a->ws + WS_WRF) + (size_t)(layer * 2 + 1) * 2 * 128 * 64 * 8;
    unsigned* gcount = (unsigned*)(a->ws + WS_CTL) + CW_CNT + layer * NE * 16;
    unsigned* list = (unsigned*)(a->ws + WS_LIST); unsigned* toke = (unsigned*)(a->ws + WS_TOKE); float* tokw = (float*)(a->ws + WS_TOKW);
    LAS unsigned char* xh = lds;
    LAS unsigned char* xl = lds + 65536;
    LAS float* part = (LAS float*)lds;
    LAS int* lcount = (LAS int*)(lds + LT_LCNT); LAS int* lbase = (LAS int*)(lds + LT_LBASE);
    LAS unsigned* ent = (LAS unsigned*)(lds + LT_ENT);
    const int t_beg = vcu * 64;
    if (threadIdx.x < 64) lcount[threadIdx.x] = 0;
    const int n32 = lane & 31, h5 = lane >> 5;
    f32x4 vn[8], gg[8], bb[8];
    {   const float* yr = out + (size_t)(t_beg + wave * 2) * DM;
#pragma unroll
        for (int j = 0; j < 8; ++j) vn[j] = *(const f32x4*)(yr + 256 * j + 4 * lane);
#pragma unroll
        for (int j = 0; j < 8; ++j) { gg[j] = *(const f32x4*)(gam + 256 * j + 4 * lane); bb[j] = *(const f32x4*)(bet + 256 * j + 4 * lane); } }
    __syncthreads();
#pragma unroll 1
    for (int it = 0; it < 4; ++it) {
#pragma unroll 1
        for (int k = 0; k < 2; ++k) {
            const int lt = 2 * wave + k, t = t_beg + 16 * it + lt; float* yr = out + (size_t)t * DM;
            f32x4 v[8]; float s = 0.f;
#pragma unroll
            for (int j = 0; j < 8; ++j) { v[j] = vn[j]; s += (v[j][0] + v[j][1]) + (v[j][2] + v[j][3]); }
            {
                const int tn = (k == 0) ? t + 1 : t + 15;
                if (k == 0 || it < 3) { const float* yn = out + (size_t)tn * DM;
#pragma unroll
                    for (int j = 0; j < 8; ++j) vn[j] = *(const f32x4*)(yn + 256 * j + 4 * lane); } }
            const float mean = wave_sum(s) * (1.f / DM); float s2 = 0.f;
#pragma unroll
            for (int j = 0; j < 8; ++j) { v[j] = v[j] - mean; s2 += (v[j][0] * v[j][0] + v[j][1] * v[j][1]) + (v[j][2] * v[j][2] + v[j][3] * v[j][3]); }
            const float rstd = __builtin_amdgcn_rsqf(wave_sum(s2) * (1.f / DM) + LN_EPS);
#pragma unroll
            for (int j = 0; j < 8; ++j) {
                const f32x4 xv = v[j] * rstd * gg[j] + bb[j];
                *(f32x4*)(yr + 256 * j + 4 * lane) = xv;
                u32x2 w; w.x = cvt_pk_bf16(xv[0], xv[1]); w.y = cvt_pk_bf16(xv[2], xv[3]);
                if (FP8_MOE1 && layer == 1) *(unsigned*)((unsigned char*)xb + (size_t)t * DM + 256 * j + 4 * lane) = pk4_fp8(xv[0], xv[1], xv[2], xv[3]);
                else *(u32x2*)(xb + (size_t)t * DM + 256 * j + 4 * lane) = w;
                u32x2 wl; wl.x = cvt_pk_bf16(xv[0] - bf_lo(w.x), xv[1] - bf_hi(w.x)); wl.y = cvt_pk_bf16(xv[2] - bf_lo(w.y), xv[3] - bf_hi(w.y));
                const int chunk = 32 * j + (lane >> 1), sw = lt * 4096 + ((chunk ^ lt) << 4) + 8 * (lane & 1);
                *(LAS u32x2*)(xh + sw) = w;
                *(LAS u32x2*)(xl + sw) = wl;
            }
        }
        __syncthreads();
        f32x16 acc0 = {}, acc1 = {};
        {
            const int row = n32 & 15;
            const bf16_t* wh0 = wfh + ((size_t)(0 * 128 + wave * 16) * 64 + lane) * 8; const bf16_t* wh1 = wfh + ((size_t)(1 * 128 + wave * 16) * 64 + lane) * 8;
            const bf16_t* wl0 = wfl + ((size_t)(0 * 128 + wave * 16) * 64 + lane) * 8; const bf16_t* wl1 = wfl + ((size_t)(1 * 128 + wave * 16) * 64 + lane) * 8;
#pragma unroll 1
            for (int sg = 0; sg < 16; sg += 4) {
                bf16x8 ah0[4], ah1[4], al0[4], al1[4];
#pragma unroll
                for (int u = 0; u < 4; ++u) { const int s = sg + u; ah0[u] = *(const bf16x8*)(wh0 + s * 512); ah1[u] = *(const bf16x8*)(wh1 + s * 512); al0[u] = *(const bf16x8*)(wl0 + s * 512); al1[u] = *(const bf16x8*)(wl1 + s * 512); }
                SBAR();
#pragma unroll
                for (int u = 0; u < 4; ++u) { const int s = sg + u;
                    const int off = row * 4096 + (((wave * 32 + 2 * s + h5) ^ row) << 4);
                    const bf16x8 bh = *(const LAS bf16x8*)(xh + off), bl = *(const LAS bf16x8*)(xl + off);
                    acc0 = __builtin_amdgcn_mfma_f32_32x32x16_bf16(ah0[u], bh, acc0, 0, 0, 0); acc1 = __builtin_amdgcn_mfma_f32_32x32x16_bf16(ah1[u], bh, acc1, 0, 0, 0);
                    acc0 = __builtin_amdgcn_mfma_f32_32x32x16_bf16(ah0[u], bl, acc0, 0, 0, 0); acc1 = __builtin_amdgcn_mfma_f32_32x32x16_bf16(ah1[u], bl, acc1, 0, 0, 0);
                    acc0 = __builtin_amdgcn_mfma_f32_32x32x16_bf16(al0[u], bh, acc0, 0, 0, 0); acc1 = __builtin_amdgcn_mfma_f32_32x32x16_bf16(al1[u], bh, acc1, 0, 0, 0); }
                SBAR();
            }
        }
        __syncthreads();
        if (n32 < 16) {
#pragma unroll
            for (int i = 0; i < 16; ++i) { const int e = (i & 3) + 8 * (i >> 2) + 4 * h5; part[(wave * 16 + n32) * 64 + e] = acc0[i]; part[(wave * 16 + n32) * 64 + 32 + e] = acc1[i]; }
        }
        __syncthreads();
#pragma unroll 1
        for (int k = 0; k < 2; ++k) {
            const int lt = 2 * wave + k, ti = 16 * it + lt;
            float logit = 0.f;
#pragma unroll
            for (int w = 0; w < 8; ++w) logit += part[(w * 16 + lt) * 64 + lane];
            const float sc = 1.f / (1.f + expf(-logit));
            const float bs = sc + rb;
            float m1 = bs;
            m1 = fmaxf(m1, dpp_mov<0xB1>(m1)); m1 = fmaxf(m1, dpp_mov<0x4E>(m1)); m1 = fmaxf(m1, dpp_mov<0x141>(m1));
            const unsigned long long eq = __ballot(bs == m1);
            const int gbase = lane & ~7;
            const int first = gbase + __builtin_ctz((unsigned)((eq >> gbase) & 0xffu));
            float m2 = (lane == first) ? -__builtin_inff() : bs;
            m2 = fmaxf(m2, dpp_mov<0xB1>(m2)); m2 = fmaxf(m2, dpp_mov<0x4E>(m2)); m2 = fmaxf(m2, dpp_mov<0x141>(m2));
            const float gs = m1 + m2; const int grp = lane >> 3;
            int grank = 0;
#pragma unroll
            for (int g2 = 0; g2 < 8; ++g2) { const float v = __int_as_float(__builtin_amdgcn_readlane(__float_as_int(gs), g2 * 8)); grank += (v > gs || (v == gs && g2 < grp)) ? 1 : 0; }
            const float masked = (grank < 4) ? bs : -__builtin_inff();
            int rank = 0;
#pragma unroll 8
            for (int e2 = 0; e2 < 64; ++e2) { const float v = __int_as_float(__builtin_amdgcn_readlane(__float_as_int(masked), e2)); rank += (v > masked || (v == masked && e2 < lane)) ? 1 : 0; }
            const bool selk = rank < 8;
            const float wsum = wave_sum(selk ? sc : 0.f);
            if (selk) {
                const int lp = __hip_atomic_fetch_add(lcount + lane, 1, __ATOMIC_RELAXED, __HIP_MEMORY_SCOPE_WORKGROUP);
                ent[(ti * 8 + rank) * 2] = ((unsigned)lane << 20) | (unsigned)lp;
                ((LAS float*)ent)[(ti * 8 + rank) * 2 + 1] = sc / wsum * ROUTED_SCALE;
            }
        }
        __syncthreads();
    }
    if (threadIdx.x < 64) { const int n = lcount[threadIdx.x]; lbase[threadIdx.x] = n > 0 ? (int)__hip_atomic_fetch_add(gcount + threadIdx.x * 16, (unsigned)n, __ATOMIC_RELAXED, __HIP_MEMORY_SCOPE_AGENT) : 0; }
    __syncthreads();
    for (int i = threadIdx.x; i < 64 * 8; i += NWAVES * 64) {
        const unsigned ep = ent[i * 2]; const float w = ((LAS float*)ent)[i * 2 + 1];
        const int e = ep >> 20, pos = lbase[e] + (int)(ep & 0xfffffu), t = t_beg + (i >> 3);
        list[(size_t)e * NTOK + pos] = (unsigned)t;
        toke[(size_t)t * 8 + (i & 7)] = ((unsigned)e << 20) | (unsigned)pos;
        tokw[(size_t)t * 8 + (i & 7)] = w;
    }
    __syncthreads();
}

__device__ __forceinline__ int moe_tables(KArgs a, int layer, LAS unsigned char* lds) {
    const unsigned* gcount = (const unsigned*)(a->ws + WS_CTL) + CW_CNT + layer * NE * 16;
    LAS int* P = (LAS int*)(lds + LT_P); LAS int* cnt = (LAS int*)(lds + LT_CNT); LAS int* tile_e = (LAS int*)(lds + LT_TILE);
    __syncthreads();
    if (threadIdx.x < NEX) cnt[threadIdx.x] = (threadIdx.x < NE) ? (int)__hip_atomic_load(gcount + threadIdx.x * 16, __ATOMIC_RELAXED, __HIP_MEMORY_SCOPE_AGENT) : NTOK;
    __syncthreads();
    if (threadIdx.x == 0) { int s = 0; for (int e = 0; e < NEX; ++e) { P[e] = s; s += (cnt[e] + 255) >> 8; } P[NEX] = s; }
    __syncthreads();
    if (threadIdx.x < NEX) { const int e = threadIdx.x; for (int t = P[e]; t < P[e + 1]; ++t) tile_e[t] = e; }
    __syncthreads();
    return P[NEX];
}

__device__ __forceinline__ void moe_combine(KArgs a, int layer, LAS unsigned char* lds, int gw, int NGW, int lane) {
    float* out = a->out; bf16_t* xb = (bf16_t*)(a->ws + WS_XB); const bf16_t* Y = (const bf16_t*)(a->ws + WS_Y);
    const unsigned* toke = (const unsigned*)(a->ws + WS_TOKE); const float* tokw = (const float*)(a->ws + WS_TOKW);
    const float* gam = a->in[I_LN2G] + layer * DM; const float* bet = a->in[I_LN2B] + layer * DM;
    const LAS int* P = (const LAS int*)(lds + LT_P);
    const int sh_base = P[NE] * 256;
    unsigned epn = 0u; float wn = 0.f;
    if (gw < NTOK && lane < 8) { epn = toke[(size_t)gw * 8 + lane]; wn = tokw[(size_t)gw * 8 + lane]; }
    for (int t = gw; t < NTOK; t += NGW) {
        const unsigned ep = epn; float w = wn;
        if (t + NGW < NTOK && lane < 8) { epn = toke[(size_t)(t + NGW) * 8 + lane]; wn = tokw[(size_t)(t + NGW) * 8 + lane]; }
        int slot = P[ep >> 20] * 256 + (int)(ep & 0xfffffu);
        if (lane == 8) { slot = sh_base + t; w = 1.f; }
        f32x4 acc[8]; u32x4 y[9][4]; float wk[9];
#pragma unroll
        for (int j = 0; j < 4; ++j) { acc[2 * j] = *(const f32x4*)(out + (size_t)t * DM + 512 * j + 8 * lane); acc[2 * j + 1] = *(const f32x4*)(out + (size_t)t * DM + 512 * j + 8 * lane + 4); }
        const bool y8 = FP8_Y1 && FP8_MOE1 && layer == 1;
#pragma unroll
        for (int q = 0; q < 9; ++q) { const int sl = __builtin_amdgcn_readlane(slot, q); wk[q] = __int_as_float(__builtin_amdgcn_readlane(__float_as_int(w), q)) * (y8 ? Y8_INV : 1.f);
#pragma unroll
            for (int j = 0; j < 4; ++j) {
                if (y8) { const u32x2 t2 = *(const u32x2*)((const unsigned char*)Y + (size_t)sl * DM + 512 * j + 8 * lane); y[q][j] = (u32x4){t2.x, t2.y, 0u, 0u}; }
                else y[q][j] = *(const u32x4*)(Y + (size_t)sl * DM + 512 * j + 8 * lane); } }
#pragma unroll
        for (int j = 0; j < 8; ++j) acc[j] = acc[j] * ALPHA;
#pragma unroll
        for (int q = 0; q < 9; ++q)
#pragma unroll
            for (int j = 0; j < 4; ++j) {
                if (y8) {
                    const f32x2 a0 = __builtin_amdgcn_cvt_pk_f32_fp8((int)y[q][j].x, false), a1 = __builtin_amdgcn_cvt_pk_f32_fp8((int)y[q][j].x, true);
                    const f32x2 b0 = __builtin_amdgcn_cvt_pk_f32_fp8((int)y[q][j].y, false), b1 = __builtin_amdgcn_cvt_pk_f32_fp8((int)y[q][j].y, true);
                    acc[2 * j][0] += wk[q] * a0[0]; acc[2 * j][1] += wk[q] * a0[1]; acc[2 * j][2] += wk[q] * a1[0]; acc[2 * j][3] += wk[q] * a1[1];
                    acc[2 * j + 1][0] += wk[q] * b0[0]; acc[2 * j + 1][1] += wk[q] * b0[1]; acc[2 * j + 1][2] += wk[q] * b1[0]; acc[2 * j + 1][3] += wk[q] * b1[1];
                } else {
                acc[2 * j][0] += wk[q] * bf_lo(y[q][j].x); acc[2 * j][1] += wk[q] * bf_hi(y[q][j].x); acc[2 * j][2] += wk[q] * bf_lo(y[q][j].y); acc[2 * j][3] += wk[q] * bf_hi(y[q][j].y);
                acc[2 * j + 1][0] += wk[q] * bf_lo(y[q][j].z); acc[2 * j + 1][1] += wk[q] * bf_hi(y[q][j].z); acc[2 * j + 1][2] += wk[q] * bf_lo(y[q][j].w); acc[2 * j + 1][3] += wk[q] * bf_hi(y[q][j].w);
                }
            }
        float s = 0.f;
#pragma unroll
        for (int j = 0; j < 8; ++j) s += (acc[j][0] + acc[j][1]) + (acc[j][2] + acc[j][3]);
        const float mean = wave_sum(s) * (1.f / DM); float s2 = 0.f;
#pragma unroll
        for (int j = 0; j < 8; ++j) { acc[j] = acc[j] - mean; s2 += (acc[j][0] * acc[j][0] + acc[j][1] * acc[j][1]) + (acc[j][2] * acc[j][2] + acc[j][3] * acc[j][3]); }
        const float rstd = __builtin_amdgcn_rsqf(wave_sum(s2) * (1.f / DM) + LN_EPS);
#pragma unroll
        for (int j = 0; j < 4; ++j) {
            const int c = 512 * j + 8 * lane;
            const f32x4 x0 = acc[2 * j] * rstd * *(const f32x4*)(gam + c) + *(const f32x4*)(bet + c);
            const f32x4 x1 = acc[2 * j + 1] * rstd * *(const f32x4*)(gam + c + 4) + *(const f32x4*)(bet + c + 4);
            *(f32x4*)(out + (size_t)t * DM + c) = x0; *(f32x4*)(out + (size_t)t * DM + c + 4) = x1;
            if (layer == 0) {
                if (FP8_QKV1) { u32x2 wv; wv.x = pk4_fp8(x0[0], x0[1], x0[2], x0[3]); wv.y = pk4_fp8(x1[0], x1[1], x1[2], x1[3]); *(u32x2*)((unsigned char*)xb + (size_t)t * DM + c) = wv; }
                else { u32x4 wv; wv.x = cvt_pk_bf16(x0[0], x0[1]); wv.y = cvt_pk_bf16(x0[2], x0[3]); wv.z = cvt_pk_bf16(x1[0], x1[1]); wv.w = cvt_pk_bf16(x1[2], x1[3]);
                    *(u32x4*)(xb + (size_t)t * DM + c) = wv; } }
        }
    }
}

__device__ __forceinline__ void attn_ref(KArgs a, int L, int pass, att::BlockRef& r) {
    const int xcd = L & 7, k = L >> 3, vh = xcd * 8 + (k >> 4), x = k & 15;
    const int qb = pass ? 31 - x : x;
    const bf16_t* Q = (const bf16_t*)(a->ws + WS_Q); const bf16_t* K = (const bf16_t*)(a->ws + WS_K); const bf16_t* V = (const bf16_t*)(a->ws + WS_V);
    r.P0 = qb * 256;
    const int half = vh & 1, bm = vh >> 1, b = bm >> 4, m = bm & 15;
    r.Q = Q + ((size_t)bm * SEQ + r.P0) * HD; r.K = K + (size_t)bm * SEQ * HD;
    r.V = V + (size_t)(b * NSLAB + (m >> 1) * 2 + half) * SEQ * HD;
    r.O = (bf16_t*)(a->ws + WS_O) + ((size_t)b * SEQ + r.P0) * 4096 + (m * 2 + half) * HD;
    r.sel = nullptr; r.list = nullptr; r.ML = nullptr; r.jlo = 0; r.nvalid = 256; r.nblk = 0; r.hb = 0;
}
__device__ __forceinline__ void attn_phase_da(KArgs a, char* lds, int G) {
    constexpr int total = 64 * 16;
    const int conv_slot = (int)(blockIdx.x & 3u);
    int L = blockIdx.x; if (L >= total) return;
    int pass = 0, item = 0; att::BlockRef cur, nxt; attn_ref(a, L, 0, cur);
    att::Seam S;
    att::attn_prime<false>(cur, lds, S);
    for (;;) {
        if (pass == 0) {
            if (conv_slot == item) {
                const int tid0 = otid(); const Geo cg = geo();
                convert_items(a, (LAS float*)((LAS unsigned char*)lds + att::ATT_LDS + __builtin_amdgcn_readfirstlane(tid0 >> 6) * 4224), cg.gw, cg.NGW, tid0 & 63, IT_IN, IT_TOTAL);
            }
            ++item;
        }
        const bool more_pass = pass == 0, more_item = L + G < total, last = !more_pass && !more_item;
        int passn = pass + 1, Ln = L;
        if (!more_pass) { passn = 0; Ln = more_item ? L + G : L; }
        if (last) nxt = cur; else attn_ref(a, Ln, passn, nxt);
        att::attn_block<false>(cur, nxt, 4096, lds, S);
        if (last) break;
        cur = nxt; pass = passn; L = Ln;
    }
}
__device__ __forceinline__ void moba_ref(KArgs a, LAS unsigned char* lds, int B, att::BlockRef& r) {
    const LAS int* PB = (const LAS int*)(lds + LT_PB); const LAS int* MC = (const LAS int*)(lds + LT_MC);
    int lo = 0, hi = 1024;
    while (hi - lo > 1) { const int mid = (lo + hi) >> 1; if (PB[mid] <= B) lo = mid; else hi = mid; }
    const int id = lo, bh = id >> 5, n = id & 31, c = B - PB[id];
    r.Q = (const bf16_t*)(a->ws + WS_Q) + (size_t)bh * SEQ * HD; r.K = (const bf16_t*)(a->ws + WS_K) + (size_t)bh * SEQ * HD; r.V = (const bf16_t*)(a->ws + WS_V) + (size_t)bh * SEQ * HD;
    r.O = (bf16_t*)(a->ws + WS_OP); r.ML = (float*)(a->ws + WS_ML); r.sel = (const unsigned*)(a->ws + WS_SEL) + (size_t)bh * SEQ;
    r.hb = bh * SEQ; r.jlo = 4 * n; r.nblk = n; r.P0 = n * 256;
    if (c == 0) { r.list = nullptr; r.nvalid = 256; }
    else { r.list = (const unsigned*)(a->ws + WS_QLIST) + (size_t)id * SEQ + (size_t)(c - 1) * 256; const int rem = MC[id] - (c - 1) * 256; r.nvalid = rem < 256 ? rem : 256; }
}
__device__ __forceinline__ void attn_phase_moba(KArgs a, LAS unsigned char* lds, char* lds_gen, int G) {
    LAS int* MC = (LAS int*)(lds + LT_MC); LAS int* PB = (LAS int*)(lds + LT_PB); LAS int* SC = (LAS int*)(lds + LT_SC);
    const unsigned* mcnt = (const unsigned*)(a->ws + WS_CTL) + CW_MCNT;
    const int t = threadIdx.x;
    __syncthreads();
    const int c0 = (int)__hip_atomic_load(mcnt + 2 * t, __ATOMIC_RELAXED, __HIP_MEMORY_SCOPE_AGENT), c1 = (int)__hip_atomic_load(mcnt + 2 * t + 1, __ATOMIC_RELAXED, __HIP_MEMORY_SCOPE_AGENT);
    MC[2 * t] = c0; MC[2 * t + 1] = c1;
    const int s0 = 1 + ((c0 + 255) >> 8), s1 = s0 + 1 + ((c1 + 255) >> 8);
    SC[t] = s1;
    __syncthreads();
    for (int off = 1; off < 512; off <<= 1) { const int v = SC[t] + (t >= off ? SC[t - off] : 0); __syncthreads(); SC[t] = v; __syncthreads(); }
    const int excl = t > 0 ? SC[t - 1] : 0;
    PB[2 * t] = excl; PB[2 * t + 1] = excl + s0; if (t == 511) PB[1024] = SC[511];
    __syncthreads();
    const int NB = PB[1024];
    int B = blockIdx.x; if (B >= NB) return;
    att::BlockRef cur, nxt; moba_ref(a, lds, B, cur);
    att::Seam S;
    att::attn_prime<true>(cur, lds_gen, S);
    for (;;) {
        const int Bn = B + G; const bool last = Bn >= NB;
        if (last) nxt = cur; else moba_ref(a, lds, Bn, nxt);
        att::attn_block<true>(cur, nxt, 0, lds_gen, S);
        if (last) break;
        cur = nxt; B = Bn;
    }
}
__device__ __forceinline__ void moba_kv_phase(KArgs a, LAS unsigned char* lds, char* lds_gen) {
    using namespace att;
    LAS int* PB = (LAS int*)(lds + LDSCTL_OFF + 1024); LAS int* MC = (LAS int*)(lds + LDSCTL_OFF + 5632); LAS int* SC = (LAS int*)lds;
    volatile LAS int* QW = (volatile LAS int*)(lds + LDSCTL_OFF + 14400);
    const unsigned* mcnt = (const unsigned*)(a->ws + WS_CTL) + CW_MCNT; unsigned* sq = (unsigned*)(a->ws + WS_CTL) + CW_SQ;
    int tid = threadIdx.x; asm volatile("" : "+v"(tid));
    const int wid = __builtin_amdgcn_readfirstlane(tid >> 6), lane = tid & 63, r32 = lane & 31, hi = lane >> 5;
    __syncthreads();
    {   const int c0 = (int)__hip_atomic_load(mcnt + 2 * tid, __ATOMIC_RELAXED, __HIP_MEMORY_SCOPE_AGENT), c1 = (int)__hip_atomic_load(mcnt + 2 * tid + 1, __ATOMIC_RELAXED, __HIP_MEMORY_SCOPE_AGENT);
        MC[2 * tid] = c0; MC[2 * tid + 1] = c1;
        const int s0 = (8 + ((c0 + 31) >> 5) + 31) >> 5, s1 = s0 + ((8 + ((c1 + 31) >> 5) + 31) >> 5);
        SC[tid] = s1;
        __syncthreads();
        for (int off = 1; off < 512; off <<= 1) { const int v = SC[tid] + (tid >= off ? SC[tid - off] : 0); __syncthreads(); SC[tid] = v; __syncthreads(); }
        const int excl = tid > 0 ? SC[tid - 1] : 0;
        PB[2 * tid] = excl; PB[2 * tid + 1] = excl + s0; if (tid == 511) PB[1024] = SC[511];
        __syncthreads(); }
    const int NP = PB[1024];
    char* V_lds = lds_gen; char* K_lds = lds_gen + 65536;
    float* ws = (float*)(lds_gen + LDSCTL_OFF + 10240) + wid * 128; float* li_l = ws, * al_l = ws + 32; unsigned* rd = (unsigned*)(ws + 64);
    const int vb0 = (int)(uintptr_t)V_lds + v_rd_base(lane);
    const int sr = tid >> 4, sc = (tid & 15) * 8;
    const bf16_t* Qb = (const bf16_t*)(a->ws + WS_Q); const bf16_t* Kb = (const bf16_t*)(a->ws + WS_K); const bf16_t* Vb = (const bf16_t*)(a->ws + WS_V);
    const unsigned* selb = (const unsigned*)(a->ws + WS_SEL); const unsigned* qlb = (const unsigned*)(a->ws + WS_QLIST);
    bf16_t* OPb = (bf16_t*)(a->ws + WS_OP); float* MLb = (float*)(a->ws + WS_ML);
    for (;;) {
        if (tid == 0) *QW = (int)__hip_atomic_fetch_add(sq, 1u, __ATOMIC_RELAXED, __HIP_MEMORY_SCOPE_AGENT);
        __syncthreads();
        const int I = *QW;
        if (I >= NP) break;
        int lo = 0, hb = 1024;
        while (hb - lo > 1) { const int mid = (lo + hb) >> 1; if (PB[mid] <= I) lo = mid; else hb = mid; }
        const int id = lo, bh = id >> 5, n = id & 31, part = I - PB[id], cnt = MC[id];
        {
            const bf16_t* Kh = Kb + ((size_t)bh * SEQ + (size_t)n * 256) * HD; const bf16_t* Vh = Vb + ((size_t)bh * SEQ + (size_t)n * 256) * HD;
            bf16x8 kv[8], vv[8];
#pragma unroll
            for (int i = 0; i < 8; ++i) { kv[i] = load8(Kh + (size_t)(sr + 32 * i) * HD + sc); vv[i] = load8(Vh + (size_t)(sr + 32 * i) * HD + sc); }
#pragma unroll
            for (int i = 0; i < 8; ++i) { const int tl = i >> 1, row = sr + 32 * (i & 1);
                *(bf16x8*)(K_lds + tl * SHM_K + KSWZ(row, sc * 2)) = kv[i]; *(bf16x8*)(V_lds + tl * SHM_V + v_st(row, sc)) = vv[i]; }
        }
        __syncthreads();
        const int nch = 8 + ((cnt + 31) >> 5), c_beg = 32 * part, c_end = (c_beg + 32 < nch) ? c_beg + 32 : nch;
#pragma unroll 1
        for (int cg = c_beg + wid; cg < c_end; cg += 8) {
            const bool own = cg < 8;
            const int li0 = (cg - 8) * 32 + r32;
            unsigned q; if (own) q = (unsigned)(n * 256 + cg * 32 + r32); else q = qlb[(size_t)id * SEQ + (li0 < cnt ? li0 : cnt - 1)];
            const bool valid = own || (li0 < cnt);
            unsigned slot = 3u; if (!own) slot = (unsigned)__builtin_popcount(selb[(size_t)bh * SEQ + q] & ((1u << n) - 1u));
            bf16x8 qr[8];
#pragma unroll
            for (int d0 = 0; d0 < 8; ++d0) qr[d0] = load8(Qb + ((size_t)bh * SEQ + q) * HD + d0 * 16 + hi * 8);
            if (hi == 0) rd[r32] = valid ? (((unsigned)(bh * SEQ) + q) * 4u + slot) * 128u : (1u << 27);
            const int NTu = own ? ((cg * 32 + 31) >> 6) + 1 : 4;
            const int qlo = n * 256 + cg * 32, qm = qlo + r32 - 4 * hi;
            float m_reg = -1e30f, l_reg = 0.f; f32x16 o[4] = {};
#define KV_STEP(T) do { if ((T) < NTu) { f32x16 p0, p1; float mn, al; bf16x8 pa0, pa1, pa2, pa3;                                        \
                qkt<T>(p0, p1, K_lds, r32, hi, qr);                                                                                       \
                if (own) { const int kb_ = n * 256 + (T) * KVBLK; if (kb_ + KVBLK - 1 > qlo) mask_tile(p0, p1, qm - kb_, 0x40000000u); }   \
                partialSM(p0, p1, m_reg, mn, al);                                                                                        \
                if (__any(al < 1.f)) { if (hi == 0) al_l[r32] = al; asm volatile("s_waitcnt lgkmcnt(0)" ::: "memory");                     \
                    for (int d_ = 0; d_ < 4; ++d_) for (int r = 0; r < 16; ++r) o[d_][r] *= al_l[crow(r, hi)]; }                           \
                finishSM(p0, p1, al, l_reg, pa0, pa1, pa2, pa3); SBAR();                                                                  \
                pv_tile<T>(o, vb0, pa0, pa1, pa2, pa3); } } while (0)
            KV_STEP(0); KV_STEP(1); KV_STEP(2); KV_STEP(3);
#undef KV_STEP
            if (hi == 0) li_l[r32] = l_reg; asm volatile("s_waitcnt lgkmcnt(0)" ::: "memory");
            float rli[16];
#pragma unroll
            for (int r = 0; r < 16; ++r) rli[r] = __builtin_amdgcn_rcpf(li_l[crow(r, hi)]);
#pragma unroll
            for (int r = 0; r < 16; ++r) { const unsigned off = rd[crow(r, hi)];
#pragma unroll
                for (int d0 = 0; d0 < 4; ++d0) { const float v = o[d0][r] * rli[r];
                    const float vn = __int_as_float(__builtin_amdgcn_mov_dpp(__float_as_int(v), 0xB1, 0xF, 0xF, true));
                    if ((r32 & 1) == 0) *(unsigned*)(OPb + (size_t)off + d0 * 32 + r32) = cvt_pk_bf16(v, vn); } }
            if (hi == 0) { float* mlp = MLb + (size_t)(rd[r32] >> 7) * 2; f32x2 ml = {m_reg, l_reg}; *(f32x2*)mlp = ml; }
        }
    }
}
__device__ __forceinline__ void moba_merge(KArgs a, int gw, int NGW, int lane) {
    const bf16_t* OP = (const bf16_t*)(a->ws + WS_OP); const float* ML = (const float*)(a->ws + WS_ML); const unsigned* sel = (const unsigned*)(a->ws + WS_SEL);
    bf16_t* AO = (bf16_t*)(a->ws + WS_AOUT);
    constexpr float C2 = 1.4426950408889634f * att::SCALE;
    const int h = lane >> 2, part = lane & 3;
    for (int t = gw; t < NTOK; t += NGW) {
        const int b = t >> 13, s = t & (SEQ - 1), bh = b * NSLAB + h;
        const size_t base = ((size_t)bh * SEQ + s) * 4;
        const int nsel = __builtin_popcount(sel[(size_t)bh * SEQ + s]);
        f32x2 ml[4]; u32x4 ov[4][4];
#pragma unroll
        for (int k = 0; k < 4; ++k) { ml[k] = *(const f32x2*)(ML + (base + k) * 2);
#pragma unroll
            for (int j = 0; j < 4; ++j) ov[k][j] = *(const u32x4*)(OP + (base + k) * 128 + part * 32 + j * 8); }
        float M = ml[3][0];
#pragma unroll
        for (int k = 0; k < 3; ++k) M = (k < nsel) ? fmaxf(M, ml[k][0]) : M;
        float w[4], W = 0.f;
#pragma unroll
        for (int k = 0; k < 4; ++k) { const bool valid = (k == 3) || (k < nsel); w[k] = valid ? ml[k][1] * __builtin_amdgcn_exp2f((ml[k][0] - M) * C2) : 0.f; W += w[k]; }
        const float rW = 1.f / W;
        float acc[32];
#pragma unroll
        for (int i = 0; i < 32; ++i) acc[i] = 0.f;
#pragma unroll
        for (int k = 0; k < 4; ++k) { const bool valid = (k == 3) || (k < nsel); const float wk = w[k] * rW;
#pragma unroll
            for (int j = 0; j < 4; ++j) { const u32x4 u = ov[k][j];
                acc[8 * j + 0] += valid ? wk * bf_lo(u.x) : 0.f; acc[8 * j + 1] += valid ? wk * bf_hi(u.x) : 0.f; acc[8 * j + 2] += valid ? wk * bf_lo(u.y) : 0.f; acc[8 * j + 3] += valid ? wk * bf_hi(u.y) : 0.f;
                acc[8 * j + 4] += valid ? wk * bf_lo(u.z) : 0.f; acc[8 * j + 5] += valid ? wk * bf_hi(u.z) : 0.f; acc[8 * j + 6] += valid ? wk * bf_lo(u.w) : 0.f; acc[8 * j + 7] += valid ? wk * bf_hi(u.w) : 0.f; } }
#pragma unroll
        for (int j = 0; j < 4; ++j) {
            if (FP8_OUT1) { u32x2 o; o.x = pk4_fp8(acc[8 * j] * AO8_SCALE, acc[8 * j + 1] * AO8_SCALE, acc[8 * j + 2] * AO8_SCALE, acc[8 * j + 3] * AO8_SCALE); o.y = pk4_fp8(acc[8 * j + 4] * AO8_SCALE, acc[8 * j + 5] * AO8_SCALE, acc[8 * j + 6] * AO8_SCALE, acc[8 * j + 7] * AO8_SCALE);
                *(u32x2*)((unsigned char*)AO + (size_t)t * DM + h * HD + part * 32 + j * 8) = o; }
            else { u32x4 o; o.x = cvt_pk_bf16(acc[8 * j], acc[8 * j + 1]); o.y = cvt_pk_bf16(acc[8 * j + 2], acc[8 * j + 3]); o.z = cvt_pk_bf16(acc[8 * j + 4], acc[8 * j + 5]); o.w = cvt_pk_bf16(acc[8 * j + 6], acc[8 * j + 7]);
                *(u32x4*)(AO + (size_t)t * DM + h * HD + part * 32 + j * 8) = o; } }
    }
}

#ifndef PHMASK
#define PHMASK 0x7ffff
#endif
#define IN(k) (((PHMASK >> (k)) & 1) && lo <= (k) && (k) < hi)
#define SEAM(k) do { if (IN(k) && IN((k) + 1)) xcd_barrier(bar); } while (0)
template <int LAYER>
__device__ __forceinline__ void layer_program(LAS unsigned char* lds, unsigned char* lds_gen, const XcdBarrier& bar, const int lo, const int hi) {
    constexpr int pb = LAYER == 0 ? 1 : 9;
    constexpr int po = LAYER == 0 ? 4 : 14;
    if (IN(pb)) {
        KArgs ka = kargs(); unsigned char* ws = ka->ws;
        constexpr bool F8 = LAYER == 0 ? (bool)FP8_QKV0 : (bool)FP8_QKV1; constexpr int Kb = F8 ? DM : DM * 2;
        pg8::SchedDense S; S.init(ws + WS_XB, ws + WS_WATT + (LAYER == 0 ? 0 : 32 * MiB), NTOK, NQKV, Kb, gridDim.x, blockIdx.x);
        constexpr bool KM = LAYER == 1;
        pg8::EpiQKV<KM> E{(bf16_t*)(ws + WS_Q), (const float*)(ws + WS_ROPE), F8 ? W8_INV : 1.f};
        pg8::gemm_phase<pg8::EpiQKV<KM>, pg8::SchedDense, F8>(lds, Kb, S, E);
    }
    SEAM(pb);
    if (LAYER == 0) {
        if (IN(2)) { KArgs ka = kargs();
            if (__builtin_amdgcn_readfirstlane(threadIdx.x) >= 256) __builtin_amdgcn_s_setprio(1);
            attn_phase_da(ka, (char*)lds_gen, gridDim.x);
            __builtin_amdgcn_s_setprio(0); }
        SEAM(2);
        if (IN(3)) { KArgs ka = kargs(); const Geo g = geo(); da_combine(ka, g.gw, g.NGW, otid() & 63); }
        SEAM(3);
    } else {
        if (IN(11)) { KArgs ka = kargs(); const Geo g = geo(); moba_gate(ka, g.gw, g.NGW, otid() & 63); }
        SEAM(11);
        if (IN(12)) { KArgs ka = kargs();
            if (__builtin_amdgcn_readfirstlane(threadIdx.x) >= 256) __builtin_amdgcn_s_setprio(1);
            moba_kv_phase(ka, lds, (char*)lds_gen);
            __builtin_amdgcn_s_setprio(0); }
        SEAM(12);
        if (IN(13)) { KArgs ka = kargs(); const Geo g = geo(); moba_merge(ka, g.gw, g.NGW, otid() & 63); }
        SEAM(13);
    }
    if (IN(po)) {
        KArgs ka = kargs(); unsigned char* ws = ka->ws;
        constexpr bool F8 = LAYER == 0 ? (bool)FP8_OUT0 : (bool)FP8_OUT1; constexpr int Kb = F8 ? DM : DM * 2;
        pg8::SchedDense S; S.init(ws + WS_AOUT, ws + WS_WATT + (LAYER == 0 ? 24 * MiB : 56 * MiB), NTOK, DM, Kb, gridDim.x, blockIdx.x);
        pg8::EpiRes E{LAYER == 0 ? ka->in[I_X] : ka->out, ka->out, F8 ? W8_INV * AO8_INV : 1.f};
        pg8::gemm_phase<pg8::EpiRes, pg8::SchedDense, F8>(lds, Kb, S, E);
    }
    SEAM(po);
    if (IN(po + 1)) { KArgs ka = kargs(); const Geo g = geo(); const int tid = otid(); ln_router(ka, LAYER, lds, g.vcu, g.G, __builtin_amdgcn_readfirstlane(tid >> 6), tid & 63); }
    SEAM(po + 1);
    if (IN(po + 2)) {
        KArgs ka = kargs(); unsigned char* ws = ka->ws;
        const int ntt = moe_tables(ka, LAYER, lds);
        constexpr bool F8 = FP8_MOE1 && LAYER == 1; constexpr int Kb = F8 ? DM : DM * 2;
        pg8::SchedMoe1 S{(const char*)(ws + WS_XB), (const char*)(ws + WS_WGU) + (size_t)LAYER * NEX * 1024 * DM * 2, (const unsigned*)(ws + WS_LIST),
                         (const LAS int*)(lds + LT_P), (const LAS int*)(lds + LT_CNT), (const LAS int*)(lds + LT_TILE), ntt * 4, (int)gridDim.x, (int)blockIdx.x, Kb};
        pg8::EpiSwiGLU<F8> E{(bf16_t*)(ws + WS_H), F8 ? W8_INV : 1.f};
        pg8::gemm_phase<pg8::EpiSwiGLU<F8>, pg8::SchedMoe1, F8>(lds, Kb, S, E);
    }
    SEAM(po + 2);
    if (IN(po + 3)) {
        KArgs ka = kargs(); unsigned char* ws = ka->ws;
        const int ntt = moe_tables(ka, LAYER, lds);
        constexpr bool F8 = FP8_MOE1 && LAYER == 1; constexpr int Kb = F8 ? DE : DE * 2;
        pg8::SchedMoe2 S{(const char*)(ws + WS_H), (const char*)(ws + WS_WD) + (size_t)LAYER * NEX * DM * DE * 2, (const LAS int*)(lds + LT_TILE), ntt * 8, (int)gridDim.x, (int)blockIdx.x, Kb};
        constexpr bool Y8 = F8 && FP8_Y1;
        pg8::EpiY<Y8> E{(bf16_t*)(ws + WS_Y), (F8 ? W8_INV : 1.f) * (Y8 ? Y8_SCALE : 1.f)};
        pg8::gemm_phase<pg8::EpiY<Y8>, pg8::SchedMoe2, F8>(lds, Kb, S, E);
    }
    SEAM(po + 3);
    if (IN(po + 4)) { KArgs ka = kargs(); const Geo g = geo(); (void)moe_tables(ka, LAYER, lds); moe_combine(ka, LAYER, lds, g.gw, g.NGW, otid() & 63); }
    if (LAYER == 0) SEAM(8);
}
__global__ void __launch_bounds__(NWAVES * 64, 2) fwd_kernel(Args args) {
    extern __shared__ __attribute__((aligned(16))) unsigned char lds_raw[];
    LAS unsigned char* lds = (LAS unsigned char*)lds_raw;
    volatile LAS unsigned* MISC = (volatile LAS unsigned*)(lds + MISC_OFF);
    for (int u = threadIdx.x; u < (LDS_BYTES - LDSCTL_OFF) / 4; u += NWAVES * 64) ((LAS unsigned*)(lds + LDSCTL_OFF))[u] = 0u;
    __syncthreads();
    XcdBarrier bar = xcd_barrier_post((unsigned*)(args.ws + WS_CTL) + CW_BAR, MISC + 8);
    const int lo = args.ph_lo, hi = args.ph_hi;
    if (IN(0)) { KArgs ka = kargs(); const Geo g = geo(); const int tid = otid(); p0_prologue(ka, lds, g.gw, g.NGW, __builtin_amdgcn_readfirstlane(tid >> 6), tid & 63); }
    SEAM(0);
    layer_program<0>(lds, lds_raw, bar, lo, hi);
    layer_program<1>(lds, lds_raw, bar, lo, hi);
}
#undef IN
#undef SEAM

extern "C" void kernel_launch(void* const* d_in, const int* in_sizes, int n_in, void* d_out, int out_size, void* d_ws, size_t ws_size, hipStream_t stream) {
    static int grid = 0;
    if (grid == 0) {
        if (n_in != 23 || out_size != NTOK * DM || ws_size < WS_END) { fprintf(stderr, "kernel_launch: unexpected shapes (n_in %d, out %d, ws %zu; need ws >= %zu)\n", n_in, out_size, ws_size, (size_t)WS_END); grid = -1; return; }
        int dev = 0, cus = 0, per_cu = 0;
        if (hipGetDevice(&dev) != hipSuccess || hipDeviceGetAttribute(&cus, hipDeviceAttributeMultiprocessorCount, dev) != hipSuccess) { grid = -1; return; }
        if (hipFuncSetAttribute((const void*)fwd_kernel, hipFuncAttributeMaxDynamicSharedMemorySize, LDS_BYTES) != hipSuccess) { fprintf(stderr, "kernel_launch: hipFuncSetAttribute failed\n"); grid = -1; return; }
        if (hipOccupancyMaxActiveBlocksPerMultiprocessor(&per_cu, (const void*)fwd_kernel, NWAVES * 64, LDS_BYTES) != hipSuccess || per_cu < 1) fprintf(stderr, "kernel_launch: occupancy query reports %d\n", per_cu);
        (void)hipGetLastError();
        grid = 256;
    }
    if (grid < 0) return;
    if (hipMemsetAsync((char*)d_ws + WS_CTL, 0, CTL_ZERO_BYTES, stream) != hipSuccess) return;
    Args a{};
    for (int i = 0; i < 23; ++i) a.in[i] = (const float*)d_in[i];
    a.out = (float*)d_out; a.ws = (unsigned char*)d_ws;
#ifndef MK_SPLIT
    a.ph_lo = 0; a.ph_hi = 19;
    hipLaunchKernelGGL(fwd_kernel, dim3(grid), dim3(NWAVES * 64), LDS_BYTES, stream, a);
#else
    for (int p = 0; p < 19; ++p) { a.ph_lo = p; a.ph_hi = p + 1; hipLaunchKernelGGL(fwd_kernel, dim3(grid), dim3(NWAVES * 64), LDS_BYTES, stream, a); }
#endif
}
```

```cpp
#include <hip/hip_runtime.h>
#include <cstdio>
#include <cstdint>

#define GAS __attribute__((address_space(1)))
#define LAS __attribute__((address_space(3)))
typedef unsigned short bf16_t;
typedef short bf16x8 __attribute__((ext_vector_type(8)));
typedef short s16x4 __attribute__((ext_vector_type(4)));
typedef float f32x2 __attribute__((ext_vector_type(2)));
typedef float f32x4 __attribute__((ext_vector_type(4)));
typedef float f32x16 __attribute__((ext_vector_type(16)));
typedef unsigned u32x2 __attribute__((ext_vector_type(2)));
typedef unsigned u32x4 __attribute__((ext_vector_type(4)));

constexpr int BATCH = 2, SEQ = 8192, DM = 2048, NTOK = BATCH * SEQ;
constexpr int NE = 64, NEX = 65  , DE = 512, NQKV = 6144, HD = 128, NSLAB = 16;
constexpr float LN_EPS = 1e-5f;
constexpr float ALPHA = 1.4142135623730951f;
constexpr float LAMBDA_INIT = 0.2f;
constexpr float ROUTED_SCALE = 2.5f;
constexpr int NWAVES = 8;
constexpr int MAXTILES = 640;

constexpr size_t MiB = 1u << 20;
constexpr size_t WS_CTL = 0, CTL_ZERO_BYTES = 1 * MiB;
constexpr size_t WS_TOKE = 2 * MiB;
constexpr size_t WS_TOKW = 3 * MiB;
constexpr size_t WS_LIST = 4 * MiB;
constexpr size_t WS_SEL = 8 * MiB;
constexpr size_t WS_KMEAN = 9 * MiB;
constexpr size_t WS_ROPE = 10 * MiB;
constexpr size_t WS_WRF = 12 * MiB;
constexpr size_t WS_WATT = 16 * MiB;
constexpr size_t WS_WGU = 80 * MiB;
constexpr size_t WS_WD = 600 * MiB;
constexpr size_t WS_XB = 860 * MiB;
constexpr size_t WS_C = 924 * MiB;
constexpr size_t WS_Q = WS_C, WS_K = WS_C + 64 * MiB, WS_V = WS_C + 128 * MiB;
constexpr size_t WS_O = WS_C + 192 * MiB;
constexpr size_t WS_AOUT = WS_C + 320 * MiB;
constexpr size_t WS_H = WS_C;
constexpr size_t WS_Y = WS_C + 160 * MiB;
constexpr size_t WS_QLIST = WS_C + 192 * MiB;
constexpr size_t WS_OP = WS_C + 384 * MiB;
constexpr size_t WS_ML = WS_C + 641 * MiB;
constexpr size_t WS_END = WS_C + 800 * MiB;
constexpr int CW_BAR = 4096;
constexpr int CW_CNT = 8192;
constexpr int CW_MCNT = 12288;
constexpr int CW_SQ = 13440;

constexpr int RING_BYTES = 131072;
constexpr int LDSCTL_OFF = RING_BYTES, MISC_OFF = LDSCTL_OFF + 320;
constexpr int LT_P = LDSCTL_OFF + 1024;
constexpr int LT_CNT = LDSCTL_OFF + 1536;
constexpr int LT_TILE = LDSCTL_OFF + 2048;
constexpr int LT_LCNT = LDSCTL_OFF + 5120;
constexpr int LT_LBASE = LDSCTL_OFF + 5632;
constexpr int LT_ENT = LDSCTL_OFF + 6144;
constexpr int LT_MC = 114688;
constexpr int LT_PB = 118784;
constexpr int LT_SC = 123904;
constexpr int LDS_BYTES = 147456;

#ifndef FP8_QKV0
#define FP8_QKV0 0
#endif
#ifndef FP8_QKV1
#define FP8_QKV1 1
#endif
#ifndef FP8_OUT0
#define FP8_OUT0 0
#endif
#ifndef FP8_OUT1
#define FP8_OUT1 1
#endif
#ifndef FP8_Y1
#define FP8_Y1 1
#endif
#ifndef FP8_MOE1
#define FP8_MOE1 1
#endif
constexpr float W8_SCALE = 64.f, W8_INV = 1.f / 64.f;
constexpr float AO8_SCALE = 16.f, AO8_INV = 1.f / 16.f;
constexpr float Y8_SCALE = 16.f, Y8_INV = 1.f / 16.f;
#define LDS_WAIT() asm volatile("s_waitcnt lgkmcnt(0)" ::: "memory")
#define VM_WAIT() asm volatile("s_waitcnt vmcnt(0)" ::: "memory")
#define SBAR() __builtin_amdgcn_sched_barrier(0)

__device__ __forceinline__ unsigned cvt_pk_bf16(float lo, float hi) { unsigned r; asm volatile("v_cvt_pk_bf16_f32 %0, %1, %2" : "=v"(r) : "v"(lo), "v"(hi)); return r; }
__device__ __forceinline__ unsigned pk4_fp8(float a, float b, float c, float d) { int p = __builtin_amdgcn_cvt_pk_fp8_f32(a, b, 0, false); p = __builtin_amdgcn_cvt_pk_fp8_f32(c, d, p, true); return (unsigned)p; }
__device__ __forceinline__ float bf_lo(unsigned u) { return __uint_as_float(u << 16); }
__device__ __forceinline__ float bf_hi(unsigned u) { return __uint_as_float(u & 0xffff0000u); }
template <int CTRL> __device__ __forceinline__ float dpp_mov(float v) { return __int_as_float(__builtin_amdgcn_update_dpp(0, __float_as_int(v), CTRL, 0xF, 0xF, true)); }
__device__ __forceinline__ float wave_sum(float v) {
    v += dpp_mov<0xB1>(v);
    v += dpp_mov<0x4E>(v);
    v += dpp_mov<0x141>(v);
    v += dpp_mov<0x140>(v);
    const float r0 = __int_as_float(__builtin_amdgcn_readlane(__float_as_int(v), 0)), r1 = __int_as_float(__builtin_amdgcn_readlane(__float_as_int(v), 16));
    const float r2 = __int_as_float(__builtin_amdgcn_readlane(__float_as_int(v), 32)), r3 = __int_as_float(__builtin_amdgcn_readlane(__float_as_int(v), 48));
    return (r0 + r1) + (r2 + r3);
}

#define XB_TMO      128
#define XB_XCNT(j)  (256  + 64 * (j))
#define XB_XSUB(j)  (1280 + 64 * (j))
#define XB_XGEN(j)  (2304 + 64 * (j))
#define XB_TOP      3328
#define XB_TOPGEN   3392
#define XCD_BAR_WORDS 3456
#define XB_SPIN_CAP (1u << 18)
__device__ __forceinline__ unsigned xb_ld(unsigned* p)              { return __hip_atomic_load(p, __ATOMIC_RELAXED, __HIP_MEMORY_SCOPE_AGENT); }
__device__ __forceinline__ unsigned xb_add(unsigned* p, unsigned v) { return __hip_atomic_fetch_add(p, v, __ATOMIC_RELAXED, __HIP_MEMORY_SCOPE_AGENT); }
__device__ __forceinline__ unsigned xb_xcc_id() { return (unsigned)__builtin_amdgcn_s_getreg((3 << 11) | 20) & 0xFu; }
#define XB_SPIN(cond, bar) do { unsigned _sp = 0; while (cond) { __builtin_amdgcn_s_sleep(1); \
    if ((++_sp & 255u) == 0u) { if (xb_ld(&(bar)[XB_TMO])) break; if (_sp > XB_SPIN_CAP) { atomicAdd(&(bar)[XB_TMO], 1u); break; } } } } while (0)
struct XcdBarrier { unsigned* bar; unsigned x; volatile LAS unsigned* st; };
__device__ __forceinline__ XcdBarrier xcd_barrier_post(unsigned* bar, volatile LAS unsigned* st) {
    XcdBarrier b; b.bar = bar; b.x = xb_xcc_id(); b.st = st;
    if (threadIdx.x == 0) (void)xb_add(&bar[XB_XCNT(b.x)], 1u);
    return b;
}
__device__ __forceinline__ void xcd_barrier_complete(unsigned* bar, unsigned x, unsigned& nloc, unsigned& nx) {
    const unsigned G = gridDim.x * gridDim.y * gridDim.z;
    unsigned sum, cnt, mine, sp = 0u;
    for (;;) {
        sum = 0u; cnt = 0u; mine = 0u;
#pragma unroll
        for (unsigned j = 0; j < 16; ++j) { const unsigned c = xb_ld(&bar[XB_XCNT(j)]); sum += c; cnt += (c > 0u) ? 1u : 0u; mine = (j == x) ? c : mine; }
        if (sum == G) break;
        __builtin_amdgcn_s_sleep(1);
        if ((++sp & 255u) == 0u) { if (xb_ld(&bar[XB_TMO])) break; if (sp > XB_SPIN_CAP) { atomicAdd(&bar[XB_TMO], 1u); break; } }
    }
    nloc = mine > 0u ? mine : 1u; nx = cnt > 0u ? cnt : 1u;
}
__device__ __forceinline__ void xcd_barrier(const XcdBarrier& b) {
    asm volatile("s_waitcnt vmcnt(0)" ::: "memory");
    __syncthreads();
    if (threadIdx.x == 0) {
        unsigned* bar = b.bar;
        __builtin_amdgcn_s_waitcnt(0);
        unsigned nloc = b.st[0], nx = b.st[1];
        if (nloc == 0u) { xcd_barrier_complete(bar, b.x, nloc, nx); b.st[0] = nloc; b.st[1] = nx; }
        const unsigned old = xb_add(&bar[XB_XSUB(b.x)], 1u);
        const unsigned gen = old / nloc;
        if (old + 1u == (gen + 1u) * nloc) {
            __builtin_amdgcn_fence(__ATOMIC_RELEASE, "agent");
            asm volatile("s_waitcnt vmcnt(0)" ::: "memory");
            const unsigned og = xb_add(&bar[XB_TOP], 1u);
            const unsigned tg = og / nx;
            if (og + 1u == (tg + 1u) * nx) xb_add(&bar[XB_TOPGEN], 1u);
            else XB_SPIN(xb_ld(&bar[XB_TOPGEN]) == tg, bar);
            __builtin_amdgcn_fence(__ATOMIC_ACQUIRE, "agent");
            xb_add(&bar[XB_XGEN(b.x)], 1u);
            asm volatile("s_waitcnt vmcnt(0)" ::: "memory");
        } else {
            XB_SPIN(xb_ld(&bar[XB_XGEN(b.x)]) == gen, bar);
            __builtin_amdgcn_fence(__ATOMIC_ACQUIRE, "agent");
            asm volatile("s_waitcnt vmcnt(0)" ::: "memory");
        }
    }
    __syncthreads();
}

namespace pg8 {
constexpr int BM = 256, BK = 64, HALF = 128, HTB = HALF * BK * 2, NXCD = 8, WGM = 8;
__device__ __forceinline__ int lds_byte(int r, int c) { const int st = (r >> 4) * 2 + (c >> 5), rr = r & 15, cc = c & 31, ob = rr * 64 + cc * 2; return st * 1024 + (ob ^ (((ob >> 9) & 1) << 5)); }
__device__ __forceinline__ void stage_rc(int b, int& R, int& C) { const int st = b / 1024, sb = b % 1024, swz = sb ^ (((sb >> 9) & 1) << 5); R = (st >> 1) * 16 + swz / 64; C = (st & 1) * 32 + (swz % 64) / 2; }
__device__ __forceinline__ int perm32(int rho) { const int n = rho >> 4, i = rho & 15; return 8 * (i >> 2) + 4 * n + (i & 3); }
struct Unit { int pm, pn, e, aux; };
__device__ __forceinline__ int xcd_remap(int L, int nwg) { const int q = nwg / NXCD, r = nwg % NXCD, xcd = L % NXCD, off = L / NXCD; return (xcd < r ? xcd * (q + 1) : r * (q + 1) + (xcd - r) * q) + off; }

struct SchedDense {
    const char* A; const char* Bt; int Kb, nM, nN, nwg, G, c;
    __device__ __forceinline__ void init(const void* A_, const void* Bt_, int M, int N, int Kb_, int G_, int c_) { A = (const char*)A_; Bt = (const char*)Bt_; Kb = Kb_; nM = M / BM; nN = N / BM; nwg = nM * nN; G = G_; c = c_; }
    __device__ __forceinline__ bool next(int i, Unit& u) const {
        const long L = (long)i * G + c; if (L >= nwg) return false;
        const int wgid = xcd_remap((int)L, nwg);
        const int nig = WGM * nN, gid = wgid / nig, fm = gid * WGM, gsz = (nM - fm) < WGM ? (nM - fm) : WGM;
        u.pm = fm + ((wgid % nig) % gsz); u.pn = (wgid % nig) / gsz; u.e = 0; u.aux = 0; return true;
    }
    __device__ __forceinline__ const char* a_base(const Unit&) const { return A; }
    __device__ __forceinline__ const char* b_base(const Unit& u) const { return Bt + (size_t)u.pn * BM * Kb; }
    __device__ __forceinline__ void a_off(const Unit& u, unsigned (&off)[2][2]) const {
        int tz = threadIdx.x; asm volatile("" : "+v"(tz));
#pragma unroll
        for (int i = 0; i < 2; ++i) { int R, C; stage_rc(tz * 16 + i * 8192, R, C);
#pragma unroll
            for (int h = 0; h < 2; ++h) off[h][i] = (unsigned)((u.pm * BM + h * HALF + R) * Kb + C * 2); }
    }
};
struct SchedMoe1 {
    const char* X; const char* W; const unsigned* list; const LAS int* P; const LAS int* cnt; const LAS int* tile_e; int U, G, c, Kb;
    __device__ __forceinline__ bool next(int i, Unit& u) const {
        const long L = (long)i * G + c; if (L >= U) return false;
        const int wgid = xcd_remap((int)L, U);
        u.pm = wgid >> 2; u.pn = wgid & 3; u.e = tile_e[u.pm]; u.aux = u.pm - P[u.e]; return true;
    }
    __device__ __forceinline__ const char* a_base(const Unit&) const { return X; }
    __device__ __forceinline__ const char* b_base(const Unit& u) const { return W + ((size_t)u.e * 1024 + (size_t)u.pn * 256) * Kb; }
    __device__ __forceinline__ void a_off(const Unit& u, unsigned (&off)[2][2]) const {
        const int n = cnt[u.e];
        int tz = threadIdx.x; asm volatile("" : "+v"(tz));
#pragma unroll
        for (int i = 0; i < 2; ++i) { int R, C; stage_rc(tz * 16 + i * 8192, R, C);
#pragma unroll
            for (int h = 0; h < 2; ++h) {
                const int r = u.aux * BM + h * HALF + R;
                unsigned tok;
                if (u.e == NE) tok = (unsigned)r;
                else tok = (r < n) ? list[(size_t)u.e * NTOK + r] : 0u;
                off[h][i] = tok * (unsigned)Kb + (unsigned)C * 2u;
            } }
    }
};
struct SchedMoe2 {
    const char* Hb; const char* W; const LAS int* tile_e; int U, G, c, Kb;
    __device__ __forceinline__ bool next(int i, Unit& u) const {
        const long L = (long)i * G + c; if (L >= U) return false;
        const int wgid = xcd_remap((int)L, U);
        u.pm = wgid >> 3; u.pn = wgid & 7; u.e = tile_e[u.pm]; u.aux = 0; return true;
    }
    __device__ __forceinline__ const char* a_base(const Unit&) const { return Hb; }
    __device__ __forceinline__ const char* b_base(const Unit& u) const { return W + ((size_t)u.e * DM + (size_t)u.pn * 256) * Kb; }
    __device__ __forceinline__ void a_off(const Unit& u, unsigned (&off)[2][2]) const {
        int tz = threadIdx.x; asm volatile("" : "+v"(tz));
#pragma unroll
        for (int i = 0; i < 2; ++i) { int R, C; stage_rc(tz * 16 + i * 8192, R, C);
#pragma unroll
            for (int h = 0; h < 2; ++h) off[h][i] = (unsigned)((u.pm * BM + h * HALF + R) * Kb + C * 2); }
    }
};

template <bool KM> struct EpiQKV {
    static constexpr bool PERM = true;
    bf16_t* QKV; const float* rope; float osc;
    __device__ __forceinline__ void operator()(const f32x4 (&acc)[2][2][4][2], const Unit& u, int wr, int wc, int fr, int fq) const {
        const int seg = u.pn >> 3, slab0 = (u.pn & 7) * 2;
        bf16_t* base = QKV + (size_t)seg * ((size_t)BATCH * NSLAB * SEQ * HD);
        const int row0 = u.pm * BM + wr * 64 + fr; const int b = (u.pm * BM) >> 13;
        const bool rot = (seg < 2) && (wc == 0);
        f32x4 cs0a = {0.f, 0.f, 0.f, 0.f}, cs0b = cs0a, cs1a = cs0a, cs1b = cs0a;
#pragma unroll
        for (int ai = 0; ai < 2; ++ai)
#pragma unroll
            for (int m = 0; m < 4; ++m) {
                const int row = row0 + ai * HALF + m * 16, s = row & (SEQ - 1);
                f32x4 cs = {1.f, 1.f, 1.f, 1.f}, sn = {0.f, 0.f, 0.f, 0.f};
                if (rot) { cs = *(const f32x4*)(rope + (size_t)row * 32 + 4 * fq); sn = *(const f32x4*)(rope + (size_t)row * 32 + 16 + 4 * fq); }
#pragma unroll
                for (int bj = 0; bj < 2; ++bj) {
                    f32x4 v0 = acc[ai][bj][m][0] * osc, v1 = acc[ai][bj][m][1] * osc;
                    if (rot) {
                        f32x4 w0, w1;
                        w0[0] = v0[0] * cs[0] - v0[1] * sn[0]; w0[1] = v0[1] * cs[0] + v0[0] * sn[0];
                        w0[2] = v0[2] * cs[1] - v0[3] * sn[1]; w0[3] = v0[3] * cs[1] + v0[2] * sn[1];
                        w1[0] = v1[0] * cs[2] - v1[1] * sn[2]; w1[1] = v1[1] * cs[2] + v1[0] * sn[2];
                        w1[2] = v1[2] * cs[3] - v1[3] * sn[3]; w1[3] = v1[3] * cs[3] + v1[2] * sn[3];
                        v0 = w0; v1 = w1;
                    }
                    u32x4 w; w.x = cvt_pk_bf16(v0[0], v0[1]); w.y = cvt_pk_bf16(v0[2], v0[3]); w.z = cvt_pk_bf16(v1[0], v1[1]); w.w = cvt_pk_bf16(v1[2], v1[3]);
                    *(u32x4*)(base + ((size_t)(b * NSLAB + slab0 + bj) * SEQ + s) * HD + wc * 32 + 8 * fq) = w;
                    if (KM && seg == 1) { const f32x4 ra = {bf_lo(w.x), bf_hi(w.x), bf_lo(w.y), bf_hi(w.y)}, rb = {bf_lo(w.z), bf_hi(w.z), bf_lo(w.w), bf_hi(w.w)};
                        if (bj == 0) { cs0a += ra; cs0b += rb; } else { cs1a += ra; cs1b += rb; } }
                }
            }
        if (KM && seg == 1) {
            bf16_t* km = (bf16_t*)((unsigned char*)QKV - WS_Q + WS_KMEAN);
            LAS float* kbuf = (LAS float*)(uintptr_t)(LDSCTL_OFF + 12288);
#define KM_RED(V, BJ, I0) do { _Pragma("unroll") for (int i = 0; i < 4; ++i) { float v = V[i]; v += dpp_mov<0xB1>(v); v += dpp_mov<0x4E>(v); v += dpp_mov<0x141>(v); v += dpp_mov<0x140>(v); \
                if (fr == 0) kbuf[((wr * 4 + wc) * 2 + (BJ)) * 32 + fq * 8 + (I0) + i] = v; } } while (0)
            KM_RED(cs0a, 0, 0); KM_RED(cs0b, 0, 4); KM_RED(cs1a, 1, 0); KM_RED(cs1b, 1, 4);
#undef KM_RED
            asm volatile("s_waitcnt lgkmcnt(0)" ::: "memory"); __builtin_amdgcn_s_barrier(); asm volatile("" ::: "memory");
            if (wr == 0) {
                const int l = fq * 16 + fr, bj = l >> 5, c32 = l & 31;
                const float mean = (kbuf[((0 * 4 + wc) * 2 + bj) * 32 + c32] + kbuf[((1 * 4 + wc) * 2 + bj) * 32 + c32]) * (1.f / 256.f);
                const unsigned hi = cvt_pk_bf16(mean, 0.f) & 0xffffu; const unsigned lo = cvt_pk_bf16(mean - bf_lo(hi), 0.f) & 0xffffu;
                const size_t ko = ((size_t)(b * NSLAB + slab0 + bj) * 64 + (u.pm & 31)) * HD + wc * 32 + c32;
                km[ko] = (bf16_t)hi; km[ko + 32 * HD] = (bf16_t)lo;
            }
        }
    }
};
struct EpiRes {
    static constexpr bool PERM = false;
    const float* xres; float* y; float osc;
    __device__ __forceinline__ void operator()(const f32x4 (&acc)[2][2][4][2], const Unit& u, int wr, int wc, int fr, int fq) const {
        const int row0 = u.pm * BM + wr * 64 + fr, col0 = u.pn * BM + wc * 32 + 4 * fq;
#pragma unroll
        for (int ai = 0; ai < 2; ++ai)
#pragma unroll
            for (int m = 0; m < 4; ++m) {
                const size_t ro = (size_t)(row0 + ai * HALF + m * 16) * DM + col0;
#pragma unroll
                for (int bj = 0; bj < 2; ++bj)
#pragma unroll
                    for (int n = 0; n < 2; ++n) { const f32x4 xr = *(const f32x4*)(xres + ro + bj * HALF + n * 16); *(f32x4*)(y + ro + bj * HALF + n * 16) = xr * ALPHA + acc[ai][bj][m][n] * osc; }
            }
    }
};
__device__ __forceinline__ float silu_mul(float g, float up) { return g * __builtin_amdgcn_rcpf(1.f + __builtin_amdgcn_exp2f(-1.4426950408889634f * g)) * up; }
template <bool OUT8> struct EpiSwiGLU {
    static constexpr bool PERM = true;
    bf16_t* H; float osc;
    __device__ __forceinline__ void operator()(const f32x4 (&acc)[2][2][4][2], const Unit& u, int wr, int wc, int fr, int fq) const {
        const int row0 = u.pm * BM + wr * 64 + fr, col0 = u.pn * 128 + wc * 32 + 8 * fq;
#pragma unroll
        for (int ai = 0; ai < 2; ++ai)
#pragma unroll
            for (int m = 0; m < 4; ++m) {
                const f32x4 g0 = acc[ai][0][m][0] * osc, g1 = acc[ai][0][m][1] * osc, u0 = acc[ai][1][m][0] * osc, u1 = acc[ai][1][m][1] * osc;
                if (OUT8) {
                    u32x2 w; w.x = pk4_fp8(silu_mul(g0[0], u0[0]), silu_mul(g0[1], u0[1]), silu_mul(g0[2], u0[2]), silu_mul(g0[3], u0[3]));
                    w.y = pk4_fp8(silu_mul(g1[0], u1[0]), silu_mul(g1[1], u1[1]), silu_mul(g1[2], u1[2]), silu_mul(g1[3], u1[3]));
                    *(u32x2*)((unsigned char*)H + (size_t)(row0 + ai * HALF + m * 16) * DE + col0) = w;
                } else {
                u32x4 w;
                w.x = cvt_pk_bf16(silu_mul(g0[0], u0[0]), silu_mul(g0[1], u0[1])); w.y = cvt_pk_bf16(silu_mul(g0[2], u0[2]), silu_mul(g0[3], u0[3]));
                w.z = cvt_pk_bf16(silu_mul(g1[0], u1[0]), silu_mul(g1[1], u1[1])); w.w = cvt_pk_bf16(silu_mul(g1[2], u1[2]), silu_mul(g1[3], u1[3]));
                *(u32x4*)(H + (size_t)(row0 + ai * HALF + m * 16) * DE + col0) = w;
                }
            }
    }
};
template <bool OUT8> struct EpiY {
    static constexpr bool PERM = true;
    bf16_t* Y; float osc;
    __device__ __forceinline__ void operator()(const f32x4 (&acc)[2][2][4][2], const Unit& u, int wr, int wc, int fr, int fq) const {
        const int row0 = u.pm * BM + wr * 64 + fr, col0 = u.pn * BM + wc * 32 + 8 * fq;
#pragma unroll
        for (int ai = 0; ai < 2; ++ai)
#pragma unroll
            for (int m = 0; m < 4; ++m) {
                bf16_t* rowp = Y + (size_t)(row0 + ai * HALF + m * 16) * DM + col0;
#pragma unroll
                for (int bj = 0; bj < 2; ++bj) { const f32x4 v0 = acc[ai][bj][m][0] * osc, v1 = acc[ai][bj][m][1] * osc;
                    if (OUT8) { u32x2 w; w.x = pk4_fp8(v0[0], v0[1], v0[2], v0[3]); w.y = pk4_fp8(v1[0], v1[1], v1[2], v1[3]);
                        *(u32x2*)((unsigned char*)Y + (size_t)(row0 + ai * HALF + m * 16) * DM + col0 + bj * HALF) = w; }
                    else { u32x4 w; w.x = cvt_pk_bf16(v0[0], v0[1]); w.y = cvt_pk_bf16(v0[2], v0[3]); w.z = cvt_pk_bf16(v1[0], v1[1]); w.w = cvt_pk_bf16(v1[2], v1[3]);
                        *(u32x4*)(rowp + bj * HALF) = w; } }
            }
    }
};

typedef int i32x4 __attribute__((ext_vector_type(4)));
typedef int i32x8 __attribute__((ext_vector_type(8)));
__device__ __forceinline__ i32x8 cat8(bf16x8 a, bf16x8 b) { const i32x4 x = __builtin_bit_cast(i32x4, a), y = __builtin_bit_cast(i32x4, b); return (i32x8){x[0], x[1], x[2], x[3], y[0], y[1], y[2], y[3]}; }
template <class Epi, class Sched, bool F8>
__device__ __forceinline__ void gemm_phase(LAS unsigned char* lds, const int K, const Sched& S, const Epi& E) {
    const int tid = threadIdx.x, wid = __builtin_amdgcn_readfirstlane(tid >> 6), lane = tid & 63, wr = wid >> 2, wc = wid & 3, fr = lane & 15, fq = lane >> 4;
    const int nt = K / 128;
    unsigned voffB[2];
#pragma unroll
    for (int i = 0; i < 2; ++i) { int R, C; stage_rc(tid * 16 + i * 8192, R, C); const int Rb = Epi::PERM ? ((R & ~31) + perm32(R & 31)) : R; voffB[i] = (unsigned)(Rb * K + C * 2); }
    const size_t kstep = (size_t)(BK * 2);
    const size_t hstep = (size_t)HALF * K;
    const unsigned ldsw = (unsigned)wid * 1024u;
    const int aoff = lds_byte(wr * 64 + fr, fq * 8), boff = lds_byte(wc * 32 + fr, fq * 8);
#define PG8_SA(b, h) (((b) * 2 + (h)) * HTB)
#define PG8_SB(b, h) ((4 + (b) * 2 + (h)) * HTB)
#define PG8_STAGE(bufoff, gbase, voff) do { _Pragma("unroll") for (int _i = 0; _i < 2; ++_i) \
        __builtin_amdgcn_global_load_lds((const unsigned*)((const char*)(gbase) + (voff)[_i]), (LAS unsigned*)(lds + (bufoff) + ldsw + _i * 8192), 16, 0, 0); } while (0)
#define PG8_LDA(dst, b, h) do { _Pragma("unroll") for (int m = 0; m < 4; ++m) _Pragma("unroll") for (int k = 0; k < 2; ++k) dst[m][k] = *(const LAS bf16x8*)(lds + PG8_SA(b, h) + aoff + m * 2048 + k * 1024); } while (0)
#define PG8_LDB(dst, b, h) do { _Pragma("unroll") for (int n = 0; n < 2; ++n) _Pragma("unroll") for (int k = 0; k < 2; ++k) dst[n][k] = *(const LAS bf16x8*)(lds + PG8_SB(b, h) + boff + n * 2048 + k * 1024); } while (0)
#define PG8_MMA(ai, bj, At, Bt) do { __builtin_amdgcn_s_setprio(1); _Pragma("unroll") for (int m = 0; m < 4; ++m) _Pragma("unroll") for (int n = 0; n < 2; ++n) { \
        if (F8) acc[ai][bj][m][n] = __builtin_amdgcn_mfma_scale_f32_16x16x128_f8f6f4(cat8(Bt[n][0], Bt[n][1]), cat8(At[m][0], At[m][1]), acc[ai][bj][m][n], 0, 0, 0, 0x7F7F7F7F, 0, 0x7F7F7F7F); \
        else { _Pragma("unroll") for (int k = 0; k < 2; ++k) acc[ai][bj][m][n] = __builtin_amdgcn_mfma_f32_16x16x32_bf16(Bt[n][k], At[m][k], acc[ai][bj][m][n], 0, 0, 0); } } \
        __builtin_amdgcn_s_setprio(0); } while (0)
#define PG8_WAIT_V(n) asm volatile("s_waitcnt vmcnt(" #n ")" ::: "memory")
#define PG8_WAIT_L(n) asm volatile("s_waitcnt lgkmcnt(" #n ")" ::: "memory")
#define PG8_BAR __builtin_amdgcn_s_barrier()
#define PG8_SCHED __builtin_amdgcn_sched_barrier(0)
    Unit cur, nxt; int ui = 0;
    if (!S.next(0, cur)) return;
    f32x4 acc[2][2][4][2];
#pragma unroll
    for (int a = 0; a < 2; ++a)
#pragma unroll
        for (int b = 0; b < 2; ++b)
#pragma unroll
            for (int m = 0; m < 4; ++m)
#pragma unroll
                for (int n = 0; n < 2; ++n) acc[a][b][m][n] = (f32x4){0.f, 0.f, 0.f, 0.f};
    bf16x8 At[4][2], B0[2][2], B1[2][2];
    unsigned cOff[2][2];
    const char* cA = S.a_base(cur); const char* cB = S.b_base(cur);
    S.a_off(cur, cOff);
    PG8_STAGE(PG8_SB(0, 0), cB, voffB); PG8_STAGE(PG8_SB(0, 1), cB + hstep, voffB); PG8_STAGE(PG8_SA(0, 0), cA, cOff[0]); PG8_STAGE(PG8_SA(0, 1), cA, cOff[1]);
    if (wr == 1) PG8_BAR;
    PG8_WAIT_V(2); PG8_BAR;
    PG8_STAGE(PG8_SB(1, 0), cB + kstep, voffB); PG8_STAGE(PG8_SA(1, 0), cA + kstep, cOff[0]); PG8_STAGE(PG8_SB(1, 1), cB + hstep + kstep, voffB);
    PG8_WAIT_V(6); PG8_BAR;
    for (;;) {
        const bool has_next = S.next(ui + 1, nxt);
        const char* nA = has_next ? S.a_base(nxt) : cA; const char* nB = has_next ? S.b_base(nxt) : cB;
#pragma unroll 1
        for (int t = 0; t < nt; t += 2) {
            const bool last = (t == nt - 2);
            const char* a1 = cA + (size_t)(t + 1) * kstep;
            const char* a2 = last ? nA : cA + (size_t)(t + 2) * kstep; const char* b2 = last ? nB : cB + (size_t)(t + 2) * kstep;
            const char* a3 = a2 + kstep; const char* b3 = b2 + kstep;
            PG8_LDB(B0, 0, 0); PG8_LDB(B1, 0, 1); PG8_SCHED; PG8_LDA(At, 0, 0); PG8_STAGE(PG8_SA(1, 1), a1, cOff[1]);
            if (last && has_next) S.a_off(nxt, cOff);
            PG8_WAIT_V(8); PG8_WAIT_L(0); PG8_BAR; PG8_MMA(0, 0, At, B0); PG8_MMA(0, 1, At, B1); PG8_BAR; PG8_SCHED;
            PG8_LDA(At, 0, 1); PG8_STAGE(PG8_SB(0, 0), b2, voffB); PG8_STAGE(PG8_SB(0, 1), b2 + hstep, voffB); PG8_STAGE(PG8_SA(0, 0), a2, cOff[0]);
            PG8_WAIT_V(8); PG8_WAIT_L(0); PG8_BAR; PG8_MMA(1, 0, At, B0); PG8_MMA(1, 1, At, B1); PG8_BAR; PG8_SCHED;
            PG8_LDB(B0, 1, 0); PG8_LDB(B1, 1, 1); PG8_SCHED; PG8_LDA(At, 1, 0); PG8_STAGE(PG8_SA(0, 1), a2, cOff[1]);
            PG8_WAIT_V(8); PG8_WAIT_L(0); PG8_BAR; PG8_MMA(0, 0, At, B0); PG8_MMA(0, 1, At, B1); PG8_BAR; PG8_SCHED;
            PG8_LDA(At, 1, 1); PG8_STAGE(PG8_SB(1, 0), b3, voffB); PG8_STAGE(PG8_SB(1, 1), b3 + hstep, voffB); PG8_STAGE(PG8_SA(1, 0), a3, cOff[0]);
            PG8_WAIT_V(8); PG8_WAIT_L(0); PG8_BAR; PG8_MMA(1, 0, At, B0); PG8_MMA(1, 1, At, B1); PG8_BAR; PG8_SCHED;
        }
        if (wr == 0) PG8_BAR;
        E(acc, cur, wr, wc, fr, fq);
        if (!has_next) break;
#pragma unroll
        for (int a = 0; a < 2; ++a)
#pragma unroll
            for (int b = 0; b < 2; ++b)
#pragma unroll
                for (int m = 0; m < 4; ++m)
#pragma unroll
                    for (int n = 0; n < 2; ++n) acc[a][b][m][n] = (f32x4){0.f, 0.f, 0.f, 0.f};
        cur = nxt; cA = nA; cB = nB; ++ui;
        if (wr == 1) PG8_BAR;
    }
    PG8_WAIT_V(0);
    PG8_BAR;
#undef PG8_SA
#undef PG8_SB
#undef PG8_STAGE
#undef PG8_LDA
#undef PG8_LDB
#undef PG8_MMA
#undef PG8_WAIT_V
#undef PG8_WAIT_L
#undef PG8_BAR
#undef PG8_SCHED
}
}

namespace att {
constexpr int D = 128, NW = 8, QBLK = 32, KVBLK = 64, QB = NW * QBLK;
constexpr float SCALE = 0.08838834764831845f;
constexpr float THR = 8.f;
constexpr int SHM_V = KVBLK * D * 2, SHM_K = KVBLK * D * 2;
constexpr int ATT_LDS = 2 * SHM_V + 2 * SHM_K + NW * 256 * 4;
#define KSWZ(row, colB) ((row) * 256 + ((colB) ^ (((row) & 7) << 4)))
__device__ __forceinline__ int v_st(int k, int c) { const int kk = (k & ~0xC) | ((k & 4) << 1) | ((k & 8) >> 1); return ((kk >> 3) * 4 + (c >> 5)) * 512 + ((kk & 7) * 32 + (c & 31)) * 2; }
__device__ __forceinline__ int v_rd_base(int lane) { return ((lane & 3) << 3) | (((lane >> 2) & 3) << 6) | (((lane >> 4) & 1) << 5) | (((lane >> 5) & 1) << 8); }
constexpr int v_rd_off(int d0, int ks, int half) { return d0 * 512 + ks * 4096 + half * 2048; }
__device__ __forceinline__ int crow(int r, int hi) { return (r & 3) + 8 * (r >> 2) + 4 * hi; }
__device__ __forceinline__ bf16x8 load8(const bf16_t* p) { return *reinterpret_cast<const bf16x8*>(p); }
__device__ __forceinline__ void mask_tile(f32x16& p0, f32x16& p1, int dq, unsigned W) {
    const float NEG = -__builtin_inff();
#pragma unroll
    for (int r = 0; r < 16; ++r) {
        const int c = (r & 3) + 8 * (r >> 2);
        if ((unsigned)(dq - c) >= W) p0[r] = NEG;
        if ((unsigned)(dq - c - 32) >= W) p1[r] = NEG;
    }
}
__device__ __forceinline__ void partialSM(f32x16& p0, f32x16& p1, float& m_reg, float& mn, float& alpha) {
    float pmax = p0[0];
#pragma unroll
    for (int r = 1; r < 16; ++r) pmax = fmaxf(pmax, p0[r]);
#pragma unroll
    for (int r = 0; r < 16; ++r) pmax = fmaxf(pmax, p1[r]);
    { auto rr = __builtin_amdgcn_permlane32_swap(__float_as_uint(pmax), __float_as_uint(pmax), false, false);
      pmax = fmaxf(__uint_as_float(rr[0]), __uint_as_float(rr[1])); }
    constexpr float C2 = 1.4426950408889634f * SCALE;
    if (__builtin_expect(__all((pmax - m_reg) * SCALE <= THR), 1)) { mn = m_reg; alpha = 1.f; }
    else { mn = fmaxf(m_reg, pmax); alpha = __builtin_amdgcn_exp2f((m_reg - mn) * C2); m_reg = mn; }
    const float mnL = -mn * C2;
#pragma unroll
    for (int r = 0; r < 16; ++r) p0[r] = fmaf(p0[r], C2, mnL);
#pragma unroll
    for (int r = 0; r < 16; ++r) p1[r] = fmaf(p1[r], C2, mnL);
#pragma unroll
    for (int r = 0; r < 16; ++r) p0[r] = __builtin_amdgcn_exp2f(p0[r]);
}
__device__ __forceinline__ void finishSM(f32x16& p0, f32x16& p1, float alpha, float& l_reg, bf16x8& pa0, bf16x8& pa1, bf16x8& pa2, bf16x8& pa3) {
#pragma unroll
    for (int r = 0; r < 16; ++r) p1[r] = __builtin_amdgcn_exp2f(p1[r]);
    float ps = 0;
#pragma unroll
    for (int r = 0; r < 16; ++r) ps += p0[r];
#pragma unroll
    for (int r = 0; r < 16; ++r) ps += p1[r];
    { auto rr = __builtin_amdgcn_permlane32_swap(__float_as_uint(ps), __float_as_uint(ps), false, false);
      ps = __uint_as_float(rr[0]) + __uint_as_float(rr[1]); }
    l_reg = l_reg * alpha + ps;
#define PK4(P, B_, OUT) do { unsigned a0 = cvt_pk_bf16(P[B_+0], P[B_+1]), a1 = cvt_pk_bf16(P[B_+2], P[B_+3]);                          \
        unsigned b0 = cvt_pk_bf16(P[B_+4], P[B_+5]), b1 = cvt_pk_bf16(P[B_+6], P[B_+7]);                                             \
        auto r0 = __builtin_amdgcn_permlane32_swap(a0, b0, false, false); auto r1 = __builtin_amdgcn_permlane32_swap(a1, b1, false, false); \
        u32x4 w = {r0[0], r1[0], r0[1], r1[1]}; OUT = *reinterpret_cast<bf16x8*>(&w); } while (0)
    PK4(p0, 0, pa0); PK4(p0, 8, pa1); PK4(p1, 0, pa2); PK4(p1, 8, pa3);
#undef PK4
}
template <int KB>
__device__ __forceinline__ void qkt(f32x16& p0, f32x16& p1, const char* K_lds, int r32, int hi, const bf16x8* qr) {
    p0 = f32x16{}; p1 = f32x16{};
    const char* kb[4];
#pragma unroll
    for (int dd = 0; dd < 4; ++dd) kb[dd] = K_lds + KB * SHM_K + KSWZ(r32, (dd * 16 + hi * 8) * 2);
#pragma unroll
    for (int d0 = 0; d0 < 8; ++d0) { const char* a = kb[d0 & 3] + (d0 >> 2) * 128;
        bf16x8 b0 = *reinterpret_cast<const bf16x8*>(a);
        bf16x8 b1 = *reinterpret_cast<const bf16x8*>(a + 32 * 256);
        p0 = __builtin_amdgcn_mfma_f32_32x32x16_bf16(b0, qr[d0], p0, 0, 0, 0);
        p1 = __builtin_amdgcn_mfma_f32_32x32x16_bf16(b1, qr[d0], p1, 0, 0, 0); }
}
template <int VB>
__device__ __forceinline__ void pv_tile(f32x16* o, int vb0, bf16x8 pa0, bf16x8 pa1, bf16x8 pa2, bf16x8 pa3) {
#define TRRD(dst, off) asm volatile("ds_read_b64_tr_b16 %0, %1 offset:%2" : "=&v"(dst) : "v"(vb0), "i"(off) : "memory")
#define PV_D0(d0) do { s16x4 l0, l1, l2, l3, h0, h1, h2, h3; constexpr int b_ = VB * SHM_V + v_rd_off(d0, 0, 0); \
        TRRD(l0, b_); TRRD(h0, b_ + 2048); TRRD(l1, b_ + 4096); TRRD(h1, b_ + 6144); TRRD(l2, b_ + 8192); TRRD(h2, b_ + 10240); TRRD(l3, b_ + 12288); TRRD(h3, b_ + 14336); \
        asm volatile("s_waitcnt lgkmcnt(0)" ::: "memory"); SBAR(); \
        o[d0] = __builtin_amdgcn_mfma_f32_32x32x16_bf16(pa0, (bf16x8){l0[0], l0[1], l0[2], l0[3], h0[0], h0[1], h0[2], h0[3]}, o[d0], 0, 0, 0);   \
        o[d0] = __builtin_amdgcn_mfma_f32_32x32x16_bf16(pa1, (bf16x8){l1[0], l1[1], l1[2], l1[3], h1[0], h1[1], h1[2], h1[3]}, o[d0], 0, 0, 0);   \
        o[d0] = __builtin_amdgcn_mfma_f32_32x32x16_bf16(pa2, (bf16x8){l2[0], l2[1], l2[2], l2[3], h2[0], h2[1], h2[2], h2[3]}, o[d0], 0, 0, 0);   \
        o[d0] = __builtin_amdgcn_mfma_f32_32x32x16_bf16(pa3, (bf16x8){l3[0], l3[1], l3[2], l3[3], h3[0], h3[1], h3[2], h3[3]}, o[d0], 0, 0, 0); } while (0)
    PV_D0(0); PV_D0(1); PV_D0(2); PV_D0(3);
#undef PV_D0
#undef TRRD
}
struct BlockRef { const bf16_t* Q; const bf16_t* K; const bf16_t* V; bf16_t* O; const unsigned* sel; const unsigned* list; float* ML; int P0, jlo, nvalid, nblk, hb; };
struct Seam { bf16x8 qr[8]; bf16x8 st_v0, st_v1, st_k0, st_k1; unsigned sel, qrow; };
#define ROW(p, k0, rr) ((p) + (size_t)((k0) + (rr)) * D + sc)
#define VMWN(n) asm volatile("s_waitcnt vmcnt(%0)" :: "i"(n) : "memory")
#define SLOAD_H(Kp, Vp, k0) do { S.st_v0 = load8(ROW(Vp, k0, sr)); S.st_v1 = load8(ROW(Vp, k0, 32 + sr));              \
                         S.st_k0 = load8(ROW(Kp, k0, sr)); S.st_k1 = load8(ROW(Kp, k0, 32 + sr)); } while (0)
#define SWRITE_HK(bf) do { *(bf16x8*)(K_lds + (bf) * SHM_K + kws) = S.st_k0; *(bf16x8*)(K_lds + (bf) * SHM_K + kws + 32 * 256) = S.st_k1; } while (0)
#define SWRITE_HV(bf) do { *(bf16x8*)(V_lds + (bf) * SHM_V + vst0) = S.st_v0; *(bf16x8*)(V_lds + (bf) * SHM_V + vst1) = S.st_v1; } while (0)
#define SWRITE_H(bf) do { SWRITE_HV(bf); SWRITE_HK(bf); } while (0)
template <bool SP>
__device__ __forceinline__ void attn_prime(const BlockRef& cur, char* lds, Seam& S) {
    int tid = threadIdx.x; asm volatile("" : "+v"(tid));
    const int wid = __builtin_amdgcn_readfirstlane(tid >> 6), lane = tid & 63, r32 = lane & 31, hi = lane >> 5;
    const int sr = tid >> 4, sc = (tid & 15) * 8, kws = KSWZ(sr, sc * 2); char* K_lds = lds + 2 * SHM_V;
    const int i = wid * QBLK + r32;
    unsigned q = (unsigned)i;
    if (SP) q = cur.list ? cur.list[i < cur.nvalid ? i : cur.nvalid - 1] : (unsigned)(cur.P0 + i);
    S.qrow = q; S.sel = SP ? cur.sel[q] : 0u;
#pragma unroll
    for (int d0 = 0; d0 < 8; ++d0) S.qr[d0] = load8(cur.Q + (size_t)q * D + d0 * 16 + hi * 8);
    SLOAD_H(cur.K, cur.V, SP ? cur.jlo * KVBLK : 0); VM_WAIT(); SWRITE_HK(0);
    __syncthreads();
}
template <bool SP>
__device__ __forceinline__ void attn_block(const BlockRef& cur, const BlockRef& nxt, const int ostride, char* lds, Seam& S) {
    int tid = threadIdx.x; asm volatile("" : "+v"(tid));
    const int wid = __builtin_amdgcn_readfirstlane(tid >> 6), lane = tid & 63, r32 = lane & 31, hi = lane >> 5;
    const int NT = SP ? 4 : cur.P0 / KVBLK + 4;
    const int jlo = SP ? cur.jlo : 0;
    const int qlo = cur.P0 + wid * QBLK, qm = qlo + r32 - 4 * hi;
    char* V_lds = lds; char* K_lds = lds + 2 * SHM_V;
    float* ws = (float*)(lds + 2 * SHM_V + 2 * SHM_K) + wid * 256; float* li_l = ws, * al_l = ws + 32;
    unsigned* rd = (unsigned*)(ws + 64); unsigned* nl = (unsigned*)(ws + 96);
    float m_reg = -1e30f, l_reg = 0; f32x16 o[4] = {};
    const int sr = tid >> 4, sc = (tid & 15) * 8, vst0 = v_st(sr, sc), vst1 = v_st(32 + sr, sc), kws = KSWZ(sr, sc * 2);
    const int vb0 = (int)(uintptr_t)V_lds + v_rd_base(lane);
    const bf16_t* Kh = cur.K; const bf16_t* Vh = cur.V;
    const bool causal = !SP || cur.list == nullptr;
#define RESC(a) do { if (__any((a) < 1.f)) { if (hi == 0) al_l[r32] = (a); asm volatile("s_waitcnt lgkmcnt(0)" ::: "memory");              \
                     for (int d_ = 0; d_ < 4; ++d_) for (int r = 0; r < 16; ++r) o[d_][r] *= al_l[crow(r, hi)]; } } while (0)
#define KBASE(t) ((jlo + (t)) * KVBLK)
#define MASKT(P0_, P1_, t) do { const int kb_ = KBASE(t); if (causal && kb_ + KVBLK - 1 > qlo) mask_tile(P0_, P1_, qm - kb_, 0x40000000u); } while (0)
    constexpr int NQL = 8;
#define SEAM_K0() do { VMWN(NQL); SWRITE_HK(0); SBAR(); } while (0)
    f32x16 pA0, pA1, pB0, pB1; float mnA, mnB, alA, alB; bf16x8 pa0, pa1, pa2, pa3;
    unsigned qn_tmp = 0u;
    if (SP) {
        if (hi == 0) { const bool valid = (cur.list == nullptr) || (wid * QBLK + r32 < cur.nvalid);
            const unsigned slot = cur.list ? (unsigned)__builtin_popcount(S.sel & ((1u << cur.nblk) - 1u)) : 3u;
            rd[r32] = valid ? (((unsigned)cur.hb + S.qrow) * 4u + slot) * 128u : (1u << 27); }
        if (nxt.list) { const int i = wid * QBLK + r32; qn_tmp = nxt.list[i < nxt.nvalid ? i : nxt.nvalid - 1]; }
    }
    SWRITE_HV(0); SBAR();
    if (NT > 1) { SLOAD_H(Kh, Vh, KBASE(1)); }
    SBAR(); qkt<0>(pA0, pA1, K_lds, r32, hi, S.qr);
    MASKT(pA0, pA1, 0); partialSM(pA0, pA1, m_reg, mnA, alA);
    if (NT > 1) { VM_WAIT(); SWRITE_H(1); }
    if (SP) nl[lane] = nxt.list ? qn_tmp : (unsigned)(nxt.P0 + wid * QBLK + r32);
    __syncthreads();
#define HALF_STEP(PX0, PX1, mnX, alX, PY0, PY1, alY, t, KB, VB, SB) do {                                                      \
        SBAR(); qkt<KB>(PX0, PX1, K_lds, r32, hi, S.qr);                                                                      \
        finishSM(PY0, PY1, alY, l_reg, pa0, pa1, pa2, pa3); SBAR();                                                           \
        if ((t) + 1 < NT) { SLOAD_H(Kh, Vh, KBASE((t) + 1)); SBAR(); }                                                        \
        pv_tile<VB>(o, vb0, pa0, pa1, pa2, pa3); MASKT(PX0, PX1, (t)); partialSM(PX0, PX1, m_reg, mnX, alX);                  \
        __syncthreads();                                                                                                      \
        if ((t) + 1 < NT) { VM_WAIT(); SWRITE_H(SB); }                                                                        \
        RESC(alX); __syncthreads(); } while (0)
    for (int t = 1; t + 1 < NT; t += 2) {
        HALF_STEP(pB0, pB1, mnB, alB, pA0, pA1, alA, t, 1, 0, 0);
        HALF_STEP(pA0, pA1, mnA, alA, pB0, pB1, alB, t + 1, 0, 1, 1);
    }
    const bool even = (NT & 1) == 0;
    if (even) { SBAR(); qkt<1>(pB0, pB1, K_lds, r32, hi, S.qr); SBAR(); }
    unsigned qn = (unsigned)(wid * QBLK + r32);
    if (SP) { qn = nl[lane]; S.qrow = qn; S.sel = nxt.sel[qn]; }
    SLOAD_H(nxt.K, nxt.V, SP ? nxt.jlo * KVBLK : 0); SBAR();
#pragma unroll
    for (int d0 = 0; d0 < 8; ++d0) S.qr[d0] = load8(nxt.Q + (size_t)qn * D + d0 * 16 + hi * 8);
    SBAR();
    finishSM(pA0, pA1, alA, l_reg, pa0, pa1, pa2, pa3); SBAR();
    pv_tile<0>(o, vb0, pa0, pa1, pa2, pa3);
    if (even) { MASKT(pB0, pB1, NT - 1); partialSM(pB0, pB1, m_reg, mnB, alB); __syncthreads(); RESC(alB);
        finishSM(pB0, pB1, alB, l_reg, pa0, pa1, pa2, pa3); SBAR(); pv_tile<1>(o, vb0, pa0, pa1, pa2, pa3); }
    SBAR(); SEAM_K0();
    if (hi == 0) li_l[r32] = l_reg; asm volatile("s_waitcnt lgkmcnt(0)" ::: "memory");
    float rli[16];
#pragma unroll
    for (int r = 0; r < 16; ++r) rli[r] = __builtin_amdgcn_rcpf(li_l[crow(r, hi)]);
    if (SP) {
        bf16_t* Ob = cur.O;
#pragma unroll
        for (int r = 0; r < 16; ++r) { const unsigned off = rd[crow(r, hi)];
#pragma unroll
            for (int d0 = 0; d0 < 4; ++d0) { const float v = o[d0][r] * rli[r];
                const float vn = __int_as_float(__builtin_amdgcn_mov_dpp(__float_as_int(v), 0xB1, 0xF, 0xF, true));
                if ((r32 & 1) == 0) *(unsigned*)(Ob + (size_t)off + d0 * 32 + r32) = cvt_pk_bf16(v, vn); } }
        if (hi == 0) { float* mlp = cur.ML + (size_t)(rd[r32] >> 7) * 2; f32x2 ml = {m_reg, l_reg}; *(f32x2*)mlp = ml; }
    } else {
        bf16_t* Ow = cur.O + (size_t)(wid * QBLK) * ostride;
#pragma unroll
        for (int r = 0; r < 16; ++r) { const int orow = crow(r, hi);
#pragma unroll
            for (int d0 = 0; d0 < 4; ++d0) { const float v = o[d0][r] * rli[r];
                const float vn = __int_as_float(__builtin_amdgcn_mov_dpp(__float_as_int(v), 0xB1, 0xF, 0xF, true));
                if ((r32 & 1) == 0) *(unsigned*)(Ow + (size_t)orow * ostride + d0 * 32 + r32) = cvt_pk_bf16(v, vn); } }
    }
    __syncthreads();
#undef RESC
#undef KBASE
#undef MASKT
#undef SEAM_K0
#undef HALF_STEP
}
#undef ROW
#undef VMWN
#undef SLOAD_H
#undef SWRITE_HK
#undef SWRITE_HV
#undef SWRITE_H
}

struct Args { const float* in[23]; float* out; unsigned char* ws; int ph_lo, ph_hi; };
typedef const __attribute__((address_space(4))) Args* KArgs;
__device__ __forceinline__ KArgs kargs() { KArgs p = (KArgs)__builtin_amdgcn_kernarg_segment_ptr(); asm volatile("" : "+s"(p)); return p; }
__device__ __forceinline__ int otid() { int t = threadIdx.x; asm volatile("" : "+v"(t)); return t; }
struct Geo { int G, bx, vcu, gw, NGW; };
__device__ __forceinline__ Geo geo() {
    Geo g; const int tid = otid(); const int wave = __builtin_amdgcn_readfirstlane(tid >> 6);
    g.G = gridDim.x; g.bx = blockIdx.x; g.vcu = (g.G % 8 == 0) ? (g.bx % 8) * (g.G / 8) + g.bx / 8 : g.bx; g.gw = g.vcu * NWAVES + wave; g.NGW = g.G * NWAVES; return g;
}
enum { I_X = 0, I_POS, I_LN1G, I_LN1B, I_LN2G, I_LN2B, I_DAWIN, I_DAWOUT, I_LQ1, I_LK1, I_LQ2, I_LK2, I_SUBLN, I_MBWIN, I_MBWOUT, I_WR, I_RB, I_WG, I_WU, I_WD, I_SG, I_SU, I_SD };

__device__ __forceinline__ int dst_row(int kind, int n) {
    if (kind == 1) { if (n < 4096) { int d = n & 127; const int h = n & ~127; if (d < 16) d = 2 * d; else if (d < 32) d = 2 * (d - 16) + 1; return h + d; } return n; }
    if (kind == 2) return ((n >> 7) << 8) + (n & 127);
    if (kind == 3) return ((n >> 7) << 8) + 128 + (n & 127);
    return n;
}
struct TrDesc { const float* W; unsigned char* WT; int K, N, k0, n0, kind, f8; };
constexpr int IT_IN = 32 * 192, IT_OUT = 32 * 64, IT_E = 512, IT_ATT = 2 * IT_IN + 2 * IT_OUT, IT_TOTAL = IT_ATT + 2 * NEX * 3 * IT_E;
__device__ __forceinline__ void tr_decode(KArgs a, int it, TrDesc& d) {
    unsigned char* ws = a->ws; int s;
    if (it < IT_ATT) {
        if (it < IT_IN) { d.W = a->in[I_DAWIN]; d.WT = ws + WS_WATT; d.K = DM; d.N = NQKV; d.kind = 1; d.f8 = FP8_QKV0; s = it; }
        else if (it < 2 * IT_IN) { d.W = a->in[I_MBWIN]; d.WT = ws + WS_WATT + 32 * MiB; d.K = DM; d.N = NQKV; d.kind = 1; d.f8 = FP8_QKV1; s = it - IT_IN; }
        else if (it < 2 * IT_IN + IT_OUT) { d.W = a->in[I_DAWOUT]; d.WT = ws + WS_WATT + 24 * MiB; d.K = DM; d.N = DM; d.kind = 0; d.f8 = FP8_OUT0; s = it - 2 * IT_IN; }
        else { d.W = a->in[I_MBWOUT]; d.WT = ws + WS_WATT + 56 * MiB; d.K = DM; d.N = DM; d.kind = 0; d.f8 = FP8_OUT1; s = it - 2 * IT_IN - IT_OUT; }
    } else {
        const int r = it - IT_ATT, le = r / (3 * IT_E), sub = r - le * (3 * IT_E), mtx = sub / IT_E; s = sub - mtx * IT_E;
        const int l = le / NEX, e = le - l * NEX;
        const size_t EW = (size_t)DM * DE;
        if (mtx < 2) {
            const float* src = (e < NE) ? a->in[mtx == 0 ? I_WG : I_WU] + ((size_t)l * NE + e) * EW : a->in[mtx == 0 ? I_SG : I_SU] + (size_t)l * EW;
            d.f8 = (l == 1) ? FP8_MOE1 : 0;
            d.W = src; d.WT = ws + WS_WGU + (size_t)l * NEX * (2 * EW) * 2 + (size_t)e * (2 * EW) * (d.f8 ? 1 : 2); d.K = DM; d.N = DE; d.kind = 2 + mtx;
        } else {
            const float* src = (e < NE) ? a->in[I_WD] + ((size_t)l * NE + e) * EW : a->in[I_SD] + (size_t)l * EW;
            d.f8 = (l == 1) ? FP8_MOE1 : 0;
            d.W = src; d.WT = ws + WS_WD + (size_t)l * NEX * EW * 2 + (size_t)e * EW * (d.f8 ? 1 : 2); d.K = DE; d.N = DM; d.kind = 0;
        }
    }
    const int nblk = d.N / 32; const int kb = s / nblk; d.k0 = kb * 64; d.n0 = (s - kb * nblk) * 32;
}
__device__ __forceinline__ void tr_load(const TrDesc& d, int lane, f32x4 (&v)[8]) {
    const int kk = lane >> 3, n4 = (lane & 7) * 4;
#pragma unroll
    for (int i = 0; i < 8; ++i) v[i] = *(const f32x4*)(d.W + (size_t)(d.k0 + kk + 8 * i) * d.N + d.n0 + n4);
}
__device__ __forceinline__ void tr_store(const TrDesc& d, int lane, const f32x4 (&v)[8], LAS float* scr) {
    const int kk = lane >> 3, n4 = (lane & 7) * 4, c = lane & 3;
#pragma unroll
    for (int hf = 0; hf < 2; ++hf) {
#pragma unroll
        for (int i = 0; i < 4; ++i)
#pragma unroll
            for (int q = 0; q < 4; ++q) scr[(kk + 8 * i) * 33 + n4 + q] = v[hf * 4 + i][q];
        LDS_WAIT();
#pragma unroll
        for (int j = 0; j < 2; ++j) { const int n = (lane >> 2) + 16 * j; const LAS float* s = scr + (8 * c) * 33 + n;
            const size_t eo = (size_t)dst_row(d.kind, d.n0 + n) * d.K + d.k0 + hf * 32 + 8 * c;
            if (d.f8) { u32x2 o; o.x = pk4_fp8(s[0 * 33] * W8_SCALE, s[1 * 33] * W8_SCALE, s[2 * 33] * W8_SCALE, s[3 * 33] * W8_SCALE); o.y = pk4_fp8(s[4 * 33] * W8_SCALE, s[5 * 33] * W8_SCALE, s[6 * 33] * W8_SCALE, s[7 * 33] * W8_SCALE);
                *(u32x2*)(d.WT + eo) = o; }
            else { u32x4 o; o.x = cvt_pk_bf16(s[0 * 33], s[1 * 33]); o.y = cvt_pk_bf16(s[2 * 33], s[3 * 33]); o.z = cvt_pk_bf16(s[4 * 33], s[5 * 33]); o.w = cvt_pk_bf16(s[6 * 33], s[7 * 33]);
                *(u32x4*)(d.WT + eo * 2) = o; } }
        LDS_WAIT();
    }
}
__device__ __forceinline__ void convert_items(KArgs a, LAS float* scr, int gw, int NGW, int lane, int it0, int it1) {
    TrDesc dA, dB, dC; f32x4 vA[8], vB[8], vC[8];
    int it = it0 + gw;
#define CV_LD(D, V, IT) do { if ((IT) < it1) { tr_decode(a, (IT), D); tr_load(D, lane, V); } } while (0)
    CV_LD(dA, vA, it); CV_LD(dB, vB, it + NGW); CV_LD(dC, vC, it + 2 * NGW);
    while (it < it1) {
        tr_store(dA, lane, vA, scr); CV_LD(dA, vA, it + 3 * NGW);
        if (it + NGW < it1) { tr_store(dB, lane, vB, scr); CV_LD(dB, vB, it + 4 * NGW); }
        if (it + 2 * NGW < it1) { tr_store(dC, lane, vC, scr); CV_LD(dC, vC, it + 5 * NGW); }
        it += 3 * NGW;
    }
#undef CV_LD
}
__device__ __forceinline__ void p0_prologue(KArgs a, LAS unsigned char* lds, int gw, int NGW, int wave, int lane) {
    LAS float* scr = (LAS float*)(lds + wave * 4224);
    convert_items(a, scr, gw, NGW, lane, 0, IT_IN);
    {
        const float* x = a->in[I_X]; bf16_t* xb = (bf16_t*)(a->ws + WS_XB);
        f32x4 vn[8];
        if (gw < NTOK) {
#pragma unroll
            for (int j = 0; j < 4; ++j) { vn[2 * j] = *(const f32x4*)(x + (size_t)gw * DM + 512 * j + 8 * lane); vn[2 * j + 1] = *(const f32x4*)(x + (size_t)gw * DM + 512 * j + 8 * lane + 4); } }
        for (int m = gw; m < NTOK; m += NGW) {
            f32x4 v[8];
#pragma unroll
            for (int j = 0; j < 8; ++j) v[j] = vn[j];
            if (m + NGW < NTOK) {
#pragma unroll
                for (int j = 0; j < 4; ++j) { vn[2 * j] = *(const f32x4*)(x + (size_t)(m + NGW) * DM + 512 * j + 8 * lane); vn[2 * j + 1] = *(const f32x4*)(x + (size_t)(m + NGW) * DM + 512 * j + 8 * lane + 4); } }
#pragma unroll
            for (int j = 0; j < 4; ++j) {
                if (FP8_QKV0) { u32x2 w; w.x = pk4_fp8(v[2 * j][0], v[2 * j][1], v[2 * j][2], v[2 * j][3]); w.y = pk4_fp8(v[2 * j + 1][0], v[2 * j + 1][1], v[2 * j + 1][2], v[2 * j + 1][3]);
                    *(u32x2*)((unsigned char*)xb + (size_t)m * DM + 512 * j + 8 * lane) = w; }
                else { u32x4 w; w.x = cvt_pk_bf16(v[2 * j][0], v[2 * j][1]); w.y = cvt_pk_bf16(v[2 * j][2], v[2 * j][3]); w.z = cvt_pk_bf16(v[2 * j + 1][0], v[2 * j + 1][1]); w.w = cvt_pk_bf16(v[2 * j + 1][2], v[2 * j + 1][3]);
                    *(u32x4*)(xb + (size_t)m * DM + 512 * j + 8 * lane) = w; } }
        }
    }
    {
        bf16_t* wf = (bf16_t*)(a->ws + WS_WRF);
        for (int idx = gw * 64 + lane; idx < 2 * 2 * 128 * 64; idx += NGW * 64) {
            const int ln = idx & 63, s = (idx >> 6) & 127, blk = (idx >> 13) & 1, l = idx >> 14;
            const int e = blk * 32 + (ln & 31), c = 16 * s + 8 * (ln >> 5);
            const float* w = a->in[I_WR] + ((size_t)l * DM + c) * NE + e;
            float v[8];
#pragma unroll
            for (int j = 0; j < 8; ++j) v[j] = w[(size_t)j * NE];
            u32x4 h, lo;
            h.x = cvt_pk_bf16(v[0], v[1]); h.y = cvt_pk_bf16(v[2], v[3]); h.z = cvt_pk_bf16(v[4], v[5]); h.w = cvt_pk_bf16(v[6], v[7]);
            lo.x = cvt_pk_bf16(v[0] - bf_lo(h.x), v[1] - bf_hi(h.x)); lo.y = cvt_pk_bf16(v[2] - bf_lo(h.y), v[3] - bf_hi(h.y));
            lo.z = cvt_pk_bf16(v[4] - bf_lo(h.z), v[5] - bf_hi(h.z)); lo.w = cvt_pk_bf16(v[6] - bf_lo(h.w), v[7] - bf_hi(h.w));
            const size_t fo = (((size_t)(l * 2 + 0) * 2 + blk) * 128 + s) * 64 + ln, fl = (((size_t)(l * 2 + 1) * 2 + blk) * 128 + s) * 64 + ln;
            *(u32x4*)(wf + fo * 8) = h; *(u32x4*)(wf + fl * 8) = lo;
        }
    }
    {
        const int* pos = (const int*)a->in[I_POS]; float* tab = (float*)(a->ws + WS_ROPE);
        for (int idx = gw * 64 + lane; idx < NTOK * 16; idx += NGW * 64) {
            const int t = idx >> 4, i = idx & 15;
            const float inv = powf(500000.f, -(float)(2 * i) / 32.f);
            const float ang = (float)pos[t] * inv;
            double rev = (double)ang * 0.15915494309189535; rev -= floor(rev);
            const float fr = (float)rev;
            tab[(size_t)t * 32 + i] = __builtin_amdgcn_cosf(fr); tab[(size_t)t * 32 + 16 + i] = __builtin_amdgcn_sinf(fr);
        }
    }
}

__device__ __forceinline__ void da_combine(KArgs a, int gw, int NGW, int lane) {
    float lam;
    {   const float* q1 = a->in[I_LQ1]; const float* k1 = a->in[I_LK1]; const float* q2 = a->in[I_LQ2]; const float* k2 = a->in[I_LK2];
        const float s1 = wave_sum(q1[lane] * k1[lane] + q1[lane + 64] * k1[lane + 64]);
        const float s2 = wave_sum(q2[lane] * k2[lane] + q2[lane + 64] * k2[lane + 64]);
        lam = expf(s1) - expf(s2) + LAMBDA_INIT; }
    const bf16_t* O = (const bf16_t*)(a->ws + WS_O); bf16_t* AO = (bf16_t*)(a->ws + WS_AOUT);
    const f32x4 g = *(const f32x4*)(a->in[I_SUBLN] + 4 * lane);
    for (int t = gw; t < NTOK; t += NGW) {
        const bf16_t* row = O + (size_t)t * 4096;
        u32x2 x1[8], x2[8];
#pragma unroll
        for (int h = 0; h < 8; ++h) { x1[h] = *(const u32x2*)(row + h * 512 + 4 * lane); x2[h] = *(const u32x2*)(row + h * 512 + 256 + 4 * lane); }
#pragma unroll
        for (int h = 0; h < 8; ++h) {
            f32x4 o;
            o[0] = bf_lo(x1[h].x) - lam * bf_lo(x2[h].x); o[1] = bf_hi(x1[h].x) - lam * bf_hi(x2[h].x);
            o[2] = bf_lo(x1[h].y) - lam * bf_lo(x2[h].y); o[3] = bf_hi(x1[h].y) - lam * bf_hi(x2[h].y);
            const float ss = wave_sum(o[0] * o[0] + o[1] * o[1] + o[2] * o[2] + o[3] * o[3]);
            const float sc = __builtin_amdgcn_rsqf(ss * (1.f / 256.f) + LN_EPS) * (1.f - LAMBDA_INIT);
            if (FP8_OUT0) { const float s8 = sc * AO8_SCALE; *(unsigned*)((unsigned char*)AO + (size_t)t * DM + h * 256 + 4 * lane) = pk4_fp8(o[0] * s8 * g[0], o[1] * s8 * g[1], o[2] * s8 * g[2], o[3] * s8 * g[3]); }
            else { u32x2 w; w.x = cvt_pk_bf16(o[0] * sc * g[0], o[1] * sc * g[1]); w.y = cvt_pk_bf16(o[2] * sc * g[2], o[3] * sc * g[3]);
                *(u32x2*)(AO + (size_t)t * DM + h * 256 + 4 * lane) = w; }
        }
    }
}

__device__ __forceinline__ void moba_kmean(KArgs a, int gw, int NGW, int lane) {
    const bf16_t* Kb = (const bf16_t*)(a->ws + WS_K); bf16_t* km = (bf16_t*)(a->ws + WS_KMEAN);
    for (int it = gw; it < BATCH * NSLAB * 32; it += NGW) {
        const int bh = it >> 5, n = it & 31;
        const bf16_t* p = Kb + ((size_t)bh * SEQ + (size_t)n * 256) * HD + 2 * lane;
        float s0 = 0.f, s1 = 0.f;
#pragma unroll 4
        for (int r = 0; r < 256; r += 8) {
            unsigned u[8];
#pragma unroll
            for (int q = 0; q < 8; ++q) u[q] = *(const unsigned*)(p + (size_t)(r + q) * HD);
#pragma unroll
            for (int q = 0; q < 8; ++q) { s0 += bf_lo(u[q]); s1 += bf_hi(u[q]); }
        }
        s0 *= (1.f / 256.f); s1 *= (1.f / 256.f);
        const unsigned hi = cvt_pk_bf16(s0, s1);
        const unsigned lo = cvt_pk_bf16(s0 - bf_lo(hi), s1 - bf_hi(hi));
        *(unsigned*)(km + ((size_t)bh * 64 + n) * HD + 2 * lane) = hi;
        *(unsigned*)(km + ((size_t)bh * 64 + 32 + n) * HD + 2 * lane) = lo;
    }
}
__device__ __forceinline__ void moba_gate(KArgs a, int gw, int NGW, int lane) {
    const bf16_t* Qb = (const bf16_t*)(a->ws + WS_Q); const bf16_t* km = (const bf16_t*)(a->ws + WS_KMEAN); unsigned* sel = (unsigned*)(a->ws + WS_SEL);
    unsigned* mcnt = (unsigned*)(a->ws + WS_CTL) + CW_MCNT; unsigned* qlist = (unsigned*)(a->ws + WS_QLIST);
    const int r32 = lane & 31, hi = lane >> 5;
    for (int it = gw; it < BATCH * NSLAB * (SEQ / 32); it += NGW) {
        const int bh = it >> 8, qg = it & 255, j = qg >> 3;
        const bf16_t* q = Qb + ((size_t)bh * SEQ + (size_t)qg * 32 + r32) * HD + hi * 8;
        const bf16_t* k = km + ((size_t)bh * 64 + r32) * HD + hi * 8;
        f32x16 p = {};
        bf16x8 qf[8], kh[8], kl[8];
#pragma unroll
        for (int d0 = 0; d0 < 8; ++d0) { qf[d0] = *(const bf16x8*)(q + d0 * 16); kh[d0] = *(const bf16x8*)(k + d0 * 16); kl[d0] = *(const bf16x8*)(k + 32 * HD + d0 * 16); }
        SBAR();
#pragma unroll
        for (int d0 = 0; d0 < 8; ++d0) {
            p = __builtin_amdgcn_mfma_f32_32x32x16_bf16(kh[d0], qf[d0], p, 0, 0, 0);
            p = __builtin_amdgcn_mfma_f32_32x32x16_bf16(kl[d0], qf[d0], p, 0, 0, 0);
        }
        float g[32];
#pragma unroll
        for (int r = 0; r < 16; ++r) {
            const float mine = p[r], other = __shfl_xor(mine, 32);
            const int qd = r >> 2, s = r & 3;
            g[8 * qd + s] = hi ? other : mine;
            g[8 * qd + 4 + s] = hi ? mine : other;
        }
        unsigned mask = 0u;
#pragma unroll
        for (int pass = 0; pass < 3; ++pass) {
            float best = -__builtin_inff(); int bi = -1;
#pragma unroll
            for (int n = 0; n < 32; ++n) { const bool ok = (n < j) && !((mask >> n) & 1u) && (g[n] > best); best = ok ? g[n] : best; bi = ok ? n : bi; }
            if (bi >= 0) mask |= 1u << bi;
        }
        if (hi == 0) sel[(size_t)bh * SEQ + (size_t)qg * 32 + r32] = mask;
        const bool rowlane = hi == 0;
        unsigned cntv = 0u;
        for (int n = 0; n < j; ++n) { const unsigned long long bb = __ballot(rowlane && ((mask >> n) & 1u)); if (lane == n) cntv = (unsigned)__popcll(bb); }
        unsigned basev = 0u;
        if (lane < j && cntv) basev = __hip_atomic_fetch_add(mcnt + bh * 32 + lane, cntv, __ATOMIC_RELAXED, __HIP_MEMORY_SCOPE_AGENT);
        for (int n = 0; n < j; ++n) { const unsigned long long bb = __ballot(rowlane && ((mask >> n) & 1u)); const unsigned base = (unsigned)__builtin_amdgcn_readlane((int)basev, n);
            if (rowlane && ((mask >> n) & 1u)) qlist[(size_t)(bh * 32 + n) * SEQ + base + (unsigned)__popcll(bb & ((1ull << lane) - 1ull))] = (unsigned)(qg * 32 + r32); }
    }
}

__device__ __forceinline__ void ln_router(KArgs a, int layer, LAS unsigned char* lds, int vcu, int G, int wave, int lane) {
    float* out = a->out; bf16_t* xb = (bf16_t*)(a->ws + WS_XB);
    const float* gam = a->in[I_LN1G] + layer * DM; const float* bet = a->in[I_LN1B] + layer * DM;
    const float rb = a->in[I_RB][layer * NE + lane];
    const bf16_t* wfh = (const bf16_t*)(a->ws + WS_WRF) + (size_t)(layer * 2 + 0) * 2 * 128 * 64 * 8;
    const bf16_t* wfl = (const bf16_t*)(a->ws + WS_WRF) + (size_t)(layer * 2 + 1) * 2 * 128 * 64 * 8;
    unsigned* gcount = (unsigned*)(a->ws + WS_CTL) + CW_CNT + layer * NE * 16;
    unsigned* list = (unsigned*)(a->ws + WS_LIST); unsigned* toke = (unsigned*)(a->ws + WS_TOKE); float* tokw = (float*)(a->ws + WS_TOKW);
    LAS unsigned char* xh = lds;
    LAS unsigned char* xl = lds + 65536;
    LAS float* part = (LAS float*)lds;
    LAS int* lcount = (LAS int*)(lds + LT_LCNT); LAS int* lbase = (LAS int*)(lds + LT_LBASE);
    LAS unsigned* ent = (LAS unsigned*)(lds + LT_ENT);
    const int t_beg = vcu * 64;
    if (threadIdx.x < 64) lcount[threadIdx.x] = 0;
    const int n32 = lane & 31, h5 = lane >> 5;
    f32x4 vn[8], gg[8], bb[8];
    {   const float* yr = out + (size_t)(t_beg + wave * 2) * DM;
#pragma unroll
        for (int j = 0; j < 8; ++j) vn[j] = *(const f32x4*)(yr + 256 * j + 4 * lane);
#pragma unroll
        for (int j = 0; j < 8; ++j) { gg[j] = *(const f32x4*)(gam + 256 * j + 4 * lane); bb[j] = *(const f32x4*)(bet + 256 * j + 4 * lane); } }
    __syncthreads();
#pragma unroll 1
    for (int it = 0; it < 4; ++it) {
#pragma unroll 1
        for (int k = 0; k < 2; ++k) {
            const int lt = 2 * wave + k, t = t_beg + 16 * it + lt; float* yr = out + (size_t)t * DM;
            f32x4 v[8]; float s = 0.f;
#pragma unroll
            for (int j = 0; j < 8; ++j) { v[j] = vn[j]; s += (v[j][0] + v[j][1]) + (v[j][2] + v[j][3]); }
            {
                const int tn = (k == 0) ? t + 1 : t + 15;
                if (k == 0 || it < 3) { const float* yn = out + (size_t)tn * DM;
#pragma unroll
                    for (int j = 0; j < 8; ++j) vn[j] = *(const f32x4*)(yn + 256 * j + 4 * lane); } }
            const float mean = wave_sum(s) * (1.f / DM); float s2 = 0.f;
#pragma unroll
            for (int j = 0; j < 8; ++j) { v[j] = v[j] - mean; s2 += (v[j][0] * v[j][0] + v[j][1] * v[j][1]) + (v[j][2] * v[j][2] + v[j][3] * v[j][3]); }
            const float rstd = __builtin_amdgcn_rsqf(wave_sum(s2) * (1.f / DM) + LN_EPS);
#pragma unroll
            for (int j = 0; j < 8; ++j) {
                const f32x4 xv = v[j] * rstd * gg[j] + bb[j];
                *(f32x4*)(yr + 256 * j + 4 * lane) = xv;
                u32x2 w; w.x = cvt_pk_bf16(xv[0], xv[1]); w.y = cvt_pk_bf16(xv[2], xv[3]);
                if (FP8_MOE1 && layer == 1) *(unsigned*)((unsigned char*)xb + (size_t)t * DM + 256 * j + 4 * lane) = pk4_fp8(xv[0], xv[1], xv[2], xv[3]);
                else *(u32x2*)(xb + (size_t)t * DM + 256 * j + 4 * lane) = w;
                u32x2 wl; wl.x = cvt_pk_bf16(xv[0] - bf_lo(w.x), xv[1] - bf_hi(w.x)); wl.y = cvt_pk_bf16(xv[2] - bf_lo(w.y), xv[3] - bf_hi(w.y));
                const int chunk = 32 * j + (lane >> 1), sw = lt * 4096 + ((chunk ^ lt) << 4) + 8 * (lane & 1);
                *(LAS u32x2*)(xh + sw) = w;
                *(LAS u32x2*)(xl + sw) = wl;
            }
        }
        __syncthreads();
        f32x16 acc0 = {}, acc1 = {};
        {
            const int row = n32 & 15;
            const bf16_t* wh0 = wfh + ((size_t)(0 * 128 + wave * 16) * 64 + lane) * 8; const bf16_t* wh1 = wfh + ((size_t)(1 * 128 + wave * 16) * 64 + lane) * 8;
            const bf16_t* wl0 = wfl + ((size_t)(0 * 128 + wave * 16) * 64 + lane) * 8; const bf16_t* wl1 = wfl + ((size_t)(1 * 128 + wave * 16) * 64 + lane) * 8;
#pragma unroll 1
            for (int sg = 0; sg < 16; sg += 4) {
                bf16x8 ah0[4], ah1[4], al0[4], al1[4];
#pragma unroll
                for (int u = 0; u < 4; ++u) { const int s = sg + u; ah0[u] = *(const bf16x8*)(wh0 + s * 512); ah1[u] = *(const bf16x8*)(wh1 + s * 512); al0[u] = *(const bf16x8*)(wl0 + s * 512); al1[u] = *(const bf16x8*)(wl1 + s * 512); }
                SBAR();
#pragma unroll
                for (int u = 0; u < 4; ++u) { const int s = sg + u;
                    const int off = row * 4096 + (((wave * 32 + 2 * s + h5) ^ row) << 4);
                    const bf16x8 bh = *(const LAS bf16x8*)(xh + off), bl = *(const LAS bf16x8*)(xl + off);
                    acc0 = __builtin_amdgcn_mfma_f32_32x32x16_bf16(ah0[u], bh, acc0, 0, 0, 0); acc1 = __builtin_amdgcn_mfma_f32_32x32x16_bf16(ah1[u], bh, acc1, 0, 0, 0);
                    acc0 = __builtin_amdgcn_mfma_f32_32x32x16_bf16(ah0[u], bl, acc0, 0, 0, 0); acc1 = __builtin_amdgcn_mfma_f32_32x32x16_bf16(ah1[u], bl, acc1, 0, 0, 0);
                    acc0 = __builtin_amdgcn_mfma_f32_32x32x16_bf16(al0[u], bh, acc0, 0, 0, 0); acc1 = __builtin_amdgcn_mfma_f32_32x32x16_bf16(al1[u], bh, acc1, 0, 0, 0); }
                SBAR();
            }
        }
        __syncthreads();
        if (n32 < 16) {
#pragma unroll
            for (int i = 0; i < 16; ++i) { const int e = (i & 3) + 8 * (i >> 2) + 4 * h5; part[(wave * 16 + n32) * 64 + e] = acc0[i]; part[(wave * 16 + n32) * 64 + 32 + e] = acc1[i]; }
        }
        __syncthreads();
#pragma unroll 1
        for (int k = 0; k < 2; ++k) {
            const int lt = 2 * wave + k, ti = 16 * it + lt;
            float logit = 0.f;
#pragma unroll
            for (int w = 0; w < 8; ++w) logit += part[(w * 16 + lt) * 64 + lane];
            const float sc = 1.f / (1.f + expf(-logit));
            const float bs = sc + rb;
            float m1 = bs;
            m1 = fmaxf(m1, dpp_mov<0xB1>(m1)); m1 = fmaxf(m1, dpp_mov<0x4E>(m1)); m1 = fmaxf(m1, dpp_mov<0x141>(m1));
            const unsigned long long eq = __ballot(bs == m1);
            const int gbase = lane & ~7;
            const int first = gbase + __builtin_ctz((unsigned)((eq >> gbase) & 0xffu));
            float m2 = (lane == first) ? -__builtin_inff() : bs;
            m2 = fmaxf(m2, dpp_mov<0xB1>(m2)); m2 = fmaxf(m2, dpp_mov<0x4E>(m2)); m2 = fmaxf(m2, dpp_mov<0x141>(m2));
            const float gs = m1 + m2; const int grp = lane >> 3;
            int grank = 0;
#pragma unroll
            for (int g2 = 0; g2 < 8; ++g2) { const float v = __int_as_float(__builtin_amdgcn_readlane(__float_as_int(gs), g2 * 8)); grank += (v > gs || (v == gs && g2 < grp)) ? 1 : 0; }
            const float masked = (grank < 4) ? bs : -__builtin_inff();
            int rank = 0;
#pragma unroll 8
            for (int e2 = 0; e2 < 64; ++e2) { const float v = __int_as_float(__builtin_amdgcn_readlane(__float_as_int(masked), e2)); rank += (v > masked || (v == masked && e2 < lane)) ? 1 : 0; }
            const bool selk = rank < 8;
            const float wsum = wave_sum(selk ? sc : 0.f);
            if (selk) {
                const int lp = __hip_atomic_fetch_add(lcount + lane, 1, __ATOMIC_RELAXED, __HIP_MEMORY_SCOPE_WORKGROUP);
                ent[(ti * 8 + rank) * 2] = ((unsigned)lane << 20) | (unsigned)lp;
                ((LAS float*)ent)[(ti * 8 + rank) * 2 + 1] = sc / wsum * ROUTED_SCALE;
            }
        }
        __syncthreads();
    }
    if (threadIdx.x < 64) { const int n = lcount[threadIdx.x]; lbase[threadIdx.x] = n > 0 ? (int)__hip_atomic_fetch_add(gcount + threadIdx.x * 16, (unsigned)n, __ATOMIC_RELAXED, __HIP_MEMORY_SCOPE_AGENT) : 0; }
    __syncthreads();
    for (int i = threadIdx.x; i < 64 * 8; i += NWAVES * 64) {
        const unsigned ep = ent[i * 2]; const float w = ((LAS float*)ent)[i * 2 + 1];
        const int e = ep >> 20, pos = lbase[e] + (int)(ep & 0xfffffu), t = t_beg + (i >> 3);
        list[(size_t)e * NTOK + pos] = (unsigned)t;
        toke[(size_t)t * 8 + (i & 7)] = ((unsigned)e << 20) | (unsigned)pos;
        tokw[(size_t)t * 8 + (i & 7)] = w;
    }
    __syncthreads();
}

__device__ __forceinline__ int moe_tables(KArgs a, int layer, LAS unsigned char* lds) {
    const unsigned* gcount = (const unsigned*)(a->ws + WS_CTL) + CW_CNT + layer * NE * 16;
    LAS int* P = (LAS int*)(lds + LT_P); LAS int* cnt = (LAS int*)(lds + LT_CNT); LAS int* tile_e = (LAS int*)(lds + LT_TILE);
    __syncthreads();
    if (threadIdx.x < NEX) cnt[threadIdx.x] = (threadIdx.x < NE) ? (int)__hip_atomic_load(gcount + threadIdx.x * 16, __ATOMIC_RELAXED, __HIP_MEMORY_SCOPE_AGENT) : NTOK;
    __syncthreads();
    if (threadIdx.x == 0) { int s = 0; for (int e = 0; e < NEX; ++e) { P[e] = s; s += (cnt[e] + 255) >> 8; } P[NEX] = s; }
    __syncthreads();
    if (threadIdx.x < NEX) { const int e = threadIdx.x; for (int t = P[e]; t < P[e + 1]; ++t) tile_e[t] = e; }
    __syncthreads();
    return P[NEX];
}

__device__ __forceinline__ void moe_combine(KArgs a, int layer, LAS unsigned char* lds, int gw, int NGW, int lane) {
    float* out = a->out; bf16_t* xb = (bf16_t*)(a->ws + WS_XB); const bf16_t* Y = (const bf16_t*)(a->ws + WS_Y);
    const unsigned* toke = (const unsigned*)(a->ws + WS_TOKE); const float* tokw = (const float*)(a->ws + WS_TOKW);
    const float* gam = a->in[I_LN2G] + layer * DM; const float* bet = a->in[I_LN2B] + layer * DM;
    const LAS int* P = (const LAS int*)(lds + LT_P);
    const int sh_base = P[NE] * 256;
    unsigned epn = 0u; float wn = 0.f;
    if (gw < NTOK && lane < 8) { epn = toke[(size_t)gw * 8 + lane]; wn = tokw[(size_t)gw * 8 + lane]; }
    for (int t = gw; t < NTOK; t += NGW) {
        const unsigned ep = epn; float w = wn;
        if (t + NGW < NTOK && lane < 8) { epn = toke[(size_t)(t + NGW) * 8 + lane]; wn = tokw[(size_t)(t + NGW) * 8 + lane]; }
        int slot = P[ep >> 20] * 256 + (int)(ep & 0xfffffu);
        if (lane == 8) { slot = sh_base + t; w = 1.f; }
        f32x4 acc[8]; u32x4 y[9][4]; float wk[9];
#pragma unroll
        for (int j = 0; j < 4; ++j) { acc[2 * j] = *(const f32x4*)(out + (size_t)t * DM + 512 * j + 8 * lane); acc[2 * j + 1] = *(const f32x4*)(out + (size_t)t * DM + 512 * j + 8 * lane + 4); }
        const bool y8 = FP8_Y1 && FP8_MOE1 && layer == 1;
#pragma unroll
        for (int q = 0; q < 9; ++q) { const int sl = __builtin_amdgcn_readlane(slot, q); wk[q] = __int_as_float(__builtin_amdgcn_readlane(__float_as_int(w), q)) * (y8 ? Y8_INV : 1.f);
#pragma unroll
            for (int j = 0; j < 4; ++j) {
                if (y8) { const u32x2 t2 = __builtin_nontemporal_load((const u32x2*)((const unsigned char*)Y + (size_t)sl * DM + 512 * j + 8 * lane)); y[q][j] = (u32x4){t2.x, t2.y, 0u, 0u}; }
                else y[q][j] = __builtin_nontemporal_load((const u32x4*)(Y + (size_t)sl * DM + 512 * j + 8 * lane)); } }
#pragma unroll
        for (int j = 0; j < 8; ++j) acc[j] = acc[j] * ALPHA;
#pragma unroll
        for (int q = 0; q < 9; ++q)
#pragma unroll
            for (int j = 0; j < 4; ++j) {
                if (y8) {
                    const f32x2 a0 = __builtin_amdgcn_cvt_pk_f32_fp8((int)y[q][j].x, false), a1 = __builtin_amdgcn_cvt_pk_f32_fp8((int)y[q][j].x, true);
                    const f32x2 b0 = __builtin_amdgcn_cvt_pk_f32_fp8((int)y[q][j].y, false), b1 = __builtin_amdgcn_cvt_pk_f32_fp8((int)y[q][j].y, true);
                    acc[2 * j][0] += wk[q] * a0[0]; acc[2 * j][1] += wk[q] * a0[1]; acc[2 * j][2] += wk[q] * a1[0]; acc[2 * j][3] += wk[q] * a1[1];
                    acc[2 * j + 1][0] += wk[q] * b0[0]; acc[2 * j + 1][1] += wk[q] * b0[1]; acc[2 * j + 1][2] += wk[q] * b1[0]; acc[2 * j + 1][3] += wk[q] * b1[1];
                } else {
                acc[2 * j][0] += wk[q] * bf_lo(y[q][j].x); acc[2 * j][1] += wk[q] * bf_hi(y[q][j].x); acc[2 * j][2] += wk[q] * bf_lo(y[q][j].y); acc[2 * j][3] += wk[q] * bf_hi(y[q][j].y);
                acc[2 * j + 1][0] += wk[q] * bf_lo(y[q][j].z); acc[2 * j + 1][1] += wk[q] * bf_hi(y[q][j].z); acc[2 * j + 1][2] += wk[q] * bf_lo(y[q][j].w); acc[2 * j + 1][3] += wk[q] * bf_hi(y[q][j].w);
                }
            }
        float s = 0.f;
#pragma unroll
        for (int j = 0; j < 8; ++j) s += (acc[j][0] + acc[j][1]) + (acc[j][2] + acc[j][3]);
        const float mean = wave_sum(s) * (1.f / DM); float s2 = 0.f;
#pragma unroll
        for (int j = 0; j < 8; ++j) { acc[j] = acc[j] - mean; s2 += (acc[j][0] * acc[j][0] + acc[j][1] * acc[j][1]) + (acc[j][2] * acc[j][2] + acc[j][3] * acc[j][3]); }
        const float rstd = __builtin_amdgcn_rsqf(wave_sum(s2) * (1.f / DM) + LN_EPS);
#pragma unroll
        for (int j = 0; j < 4; ++j) {
            const int c = 512 * j + 8 * lane;
            const f32x4 x0 = acc[2 * j] * rstd * *(const f32x4*)(gam + c) + *(const f32x4*)(bet + c);
            const f32x4 x1 = acc[2 * j + 1] * rstd * *(const f32x4*)(gam + c + 4) + *(const f32x4*)(bet + c + 4);
            *(f32x4*)(out + (size_t)t * DM + c) = x0; *(f32x4*)(out + (size_t)t * DM + c + 4) = x1;
            if (layer == 0) {
                if (FP8_QKV1) { u32x2 wv; wv.x = pk4_fp8(x0[0], x0[1], x0[2], x0[3]); wv.y = pk4_fp8(x1[0], x1[1], x1[2], x1[3]); *(u32x2*)((unsigned char*)xb + (size_t)t * DM + c) = wv; }
                else { u32x4 wv; wv.x = cvt_pk_bf16(x0[0], x0[1]); wv.y = cvt_pk_bf16(x0[2], x0[3]); wv.z = cvt_pk_bf16(x1[0], x1[1]); wv.w = cvt_pk_bf16(x1[2], x1[3]);
                    *(u32x4*)(xb + (size_t)t * DM + c) = wv; } }
        }
    }
}

__device__ __forceinline__ void attn_ref(KArgs a, int L, int pass, att::BlockRef& r) {
    const int xcd = L & 7, k = L >> 3, vh = xcd * 8 + (k >> 4), x = k & 15;
    const int qb = pass ? 31 - x : x;
    const bf16_t* Q = (const bf16_t*)(a->ws + WS_Q); const bf16_t* K = (const bf16_t*)(a->ws + WS_K); const bf16_t* V = (const bf16_t*)(a->ws + WS_V);
    r.P0 = qb * 256;
    const int half = vh & 1, bm = vh >> 1, b = bm >> 4, m = bm & 15;
    r.Q = Q + ((size_t)bm * SEQ + r.P0) * HD; r.K = K + (size_t)bm * SEQ * HD;
    r.V = V + (size_t)(b * NSLAB + (m >> 1) * 2 + half) * SEQ * HD;
    r.O = (bf16_t*)(a->ws + WS_O) + ((size_t)b * SEQ + r.P0) * 4096 + (m * 2 + half) * HD;
    r.sel = nullptr; r.list = nullptr; r.ML = nullptr; r.jlo = 0; r.nvalid = 256; r.nblk = 0; r.hb = 0;
}
__device__ __forceinline__ void attn_phase_da(KArgs a, char* lds, int G) {
    constexpr int total = 64 * 16;
    const int conv_slot = (int)(blockIdx.x & 3u);
    int L = blockIdx.x; if (L >= total) return;
    int pass = 0, item = 0; att::BlockRef cur, nxt; attn_ref(a, L, 0, cur);
    att::Seam S;
    att::attn_prime<false>(cur, lds, S);
    for (;;) {
        if (pass == 0) {
            if (conv_slot == item) {
                const int tid0 = otid(); const Geo cg = geo();
                convert_items(a, (LAS float*)((LAS unsigned char*)lds + att::ATT_LDS + __builtin_amdgcn_readfirstlane(tid0 >> 6) * 4224), cg.gw, cg.NGW, tid0 & 63, IT_IN, IT_TOTAL);
            }
            ++item;
        }
        const bool more_pass = pass == 0, more_item = L + G < total, last = !more_pass && !more_item;
        int passn = pass + 1, Ln = L;
        if (!more_pass) { passn = 0; Ln = more_item ? L + G : L; }
        if (last) nxt = cur; else attn_ref(a, Ln, passn, nxt);
        att::attn_block<false>(cur, nxt, 4096, lds, S);
        if (last) break;
        cur = nxt; pass = passn; L = Ln;
    }
}
__device__ __forceinline__ void moba_ref(KArgs a, LAS unsigned char* lds, int B, att::BlockRef& r) {
    const LAS int* PB = (const LAS int*)(lds + LT_PB); const LAS int* MC = (const LAS int*)(lds + LT_MC);
    int lo = 0, hi = 1024;
    while (hi - lo > 1) { const int mid = (lo + hi) >> 1; if (PB[mid] <= B) lo = mid; else hi = mid; }
    const int id = lo, bh = id >> 5, n = id & 31, c = B - PB[id];
    r.Q = (const bf16_t*)(a->ws + WS_Q) + (size_t)bh * SEQ * HD; r.K = (const bf16_t*)(a->ws + WS_K) + (size_t)bh * SEQ * HD; r.V = (const bf16_t*)(a->ws + WS_V) + (size_t)bh * SEQ * HD;
    r.O = (bf16_t*)(a->ws + WS_OP); r.ML = (float*)(a->ws + WS_ML); r.sel = (const unsigned*)(a->ws + WS_SEL) + (size_t)bh * SEQ;
    r.hb = bh * SEQ; r.jlo = 4 * n; r.nblk = n; r.P0 = n * 256;
    if (c == 0) { r.list = nullptr; r.nvalid = 256; }
    else { r.list = (const unsigned*)(a->ws + WS_QLIST) + (size_t)id * SEQ + (size_t)(c - 1) * 256; const int rem = MC[id] - (c - 1) * 256; r.nvalid = rem < 256 ? rem : 256; }
}
__device__ __forceinline__ void attn_phase_moba(KArgs a, LAS unsigned char* lds, char* lds_gen, int G) {
    LAS int* MC = (LAS int*)(lds + LT_MC); LAS int* PB = (LAS int*)(lds + LT_PB); LAS int* SC = (LAS int*)(lds + LT_SC);
    const unsigned* mcnt = (const unsigned*)(a->ws + WS_CTL) + CW_MCNT;
    const int t = threadIdx.x;
    __syncthreads();
    const int c0 = (int)__hip_atomic_load(mcnt + 2 * t, __ATOMIC_RELAXED, __HIP_MEMORY_SCOPE_AGENT), c1 = (int)__hip_atomic_load(mcnt + 2 * t + 1, __ATOMIC_RELAXED, __HIP_MEMORY_SCOPE_AGENT);
    MC[2 * t] = c0; MC[2 * t + 1] = c1;
    const int s0 = 1 + ((c0 + 255) >> 8), s1 = s0 + 1 + ((c1 + 255) >> 8);
    SC[t] = s1;
    __syncthreads();
    for (int off = 1; off < 512; off <<= 1) { const int v = SC[t] + (t >= off ? SC[t - off] : 0); __syncthreads(); SC[t] = v; __syncthreads(); }
    const int excl = t > 0 ? SC[t - 1] : 0;
    PB[2 * t] = excl; PB[2 * t + 1] = excl + s0; if (t == 511) PB[1024] = SC[511];
    __syncthreads();
    const int NB = PB[1024];
    int B = blockIdx.x; if (B >= NB) return;
    att::BlockRef cur, nxt; moba_ref(a, lds, B, cur);
    att::Seam S;
    att::attn_prime<true>(cur, lds_gen, S);
    for (;;) {
        const int Bn = B + G; const bool last = Bn >= NB;
        if (last) nxt = cur; else moba_ref(a, lds, Bn, nxt);
        att::attn_block<true>(cur, nxt, 0, lds_gen, S);
        if (last) break;
        cur = nxt; B = Bn;
    }
}
__device__ __forceinline__ void moba_kv_phase(KArgs a, LAS unsigned char* lds, char* lds_gen) {
    using namespace att;
    LAS int* PB = (LAS int*)(lds + LDSCTL_OFF + 1024); LAS int* MC = (LAS int*)(lds + LDSCTL_OFF + 5632); LAS int* SC = (LAS int*)lds;
    volatile LAS int* QW = (volatile LAS int*)(lds + LDSCTL_OFF + 14400);
    const unsigned* mcnt = (const unsigned*)(a->ws + WS_CTL) + CW_MCNT; unsigned* sq = (unsigned*)(a->ws + WS_CTL) + CW_SQ;
    int tid = threadIdx.x; asm volatile("" : "+v"(tid));
    const int wid = __builtin_amdgcn_readfirstlane(tid >> 6), lane = tid & 63, r32 = lane & 31, hi = lane >> 5;
    __syncthreads();
    {   const int c0 = (int)__hip_atomic_load(mcnt + 2 * tid, __ATOMIC_RELAXED, __HIP_MEMORY_SCOPE_AGENT), c1 = (int)__hip_atomic_load(mcnt + 2 * tid + 1, __ATOMIC_RELAXED, __HIP_MEMORY_SCOPE_AGENT);
        MC[2 * tid] = c0; MC[2 * tid + 1] = c1;
        const int s0 = (8 + ((c0 + 31) >> 5) + 31) >> 5, s1 = s0 + ((8 + ((c1 + 31) >> 5) + 31) >> 5);
        SC[tid] = s1;
        __syncthreads();
        for (int off = 1; off < 512; off <<= 1) { const int v = SC[tid] + (tid >= off ? SC[tid - off] : 0); __syncthreads(); SC[tid] = v; __syncthreads(); }
        const int excl = tid > 0 ? SC[tid - 1] : 0;
        PB[2 * tid] = excl; PB[2 * tid + 1] = excl + s0; if (tid == 511) PB[1024] = SC[511];
        __syncthreads(); }
    const int NP = PB[1024];
    char* V_lds = lds_gen; char* K_lds = lds_gen + 65536;
    float* ws = (float*)(lds_gen + LDSCTL_OFF + 10240) + wid * 128; float* li_l = ws, * al_l = ws + 32; unsigned* rd = (unsigned*)(ws + 64);
    const int vb0 = (int)(uintptr_t)V_lds + v_rd_base(lane);
    const int sr = tid >> 4, sc = (tid & 15) * 8;
    const bf16_t* Qb = (const bf16_t*)(a->ws + WS_Q); const bf16_t* Kb = (const bf16_t*)(a->ws + WS_K); const bf16_t* Vb = (const bf16_t*)(a->ws + WS_V);
    const unsigned* selb = (const unsigned*)(a->ws + WS_SEL); const unsigned* qlb = (const unsigned*)(a->ws + WS_QLIST);
    bf16_t* OPb = (bf16_t*)(a->ws + WS_OP); float* MLb = (float*)(a->ws + WS_ML);
    for (;;) {
        if (tid == 0) *QW = (int)__hip_atomic_fetch_add(sq, 1u, __ATOMIC_RELAXED, __HIP_MEMORY_SCOPE_AGENT);
        __syncthreads();
        const int I = *QW;
        if (I >= NP) break;
        int lo = 0, hb = 1024;
        while (hb - lo > 1) { const int mid = (lo + hb) >> 1; if (PB[mid] <= I) lo = mid; else hb = mid; }
        const int id = lo, bh = id >> 5, n = id & 31, part = I - PB[id], cnt = MC[id];
        {
            const bf16_t* Kh = Kb + ((size_t)bh * SEQ + (size_t)n * 256) * HD; const bf16_t* Vh = Vb + ((size_t)bh * SEQ + (size_t)n * 256) * HD;
            bf16x8 kv[8], vv[8];
#pragma unroll
            for (int i = 0; i < 8; ++i) { kv[i] = load8(Kh + (size_t)(sr + 32 * i) * HD + sc); vv[i] = load8(Vh + (size_t)(sr + 32 * i) * HD + sc); }
#pragma unroll
            for (int i = 0; i < 8; ++i) { const int tl = i >> 1, row = sr + 32 * (i & 1);
                *(bf16x8*)(K_lds + tl * SHM_K + KSWZ(row, sc * 2)) = kv[i]; *(bf16x8*)(V_lds + tl * SHM_V + v_st(row, sc)) = vv[i]; }
        }
        __syncthreads();
        const int nch = 8 + ((cnt + 31) >> 5), c_beg = 32 * part, c_end = (c_beg + 32 < nch) ? c_beg + 32 : nch;
#pragma unroll 1
        for (int cg = c_beg + wid; cg < c_end; cg += 8) {
            const bool own = cg < 8;
            const int li0 = (cg - 8) * 32 + r32;
            unsigned q; if (own) q = (unsigned)(n * 256 + cg * 32 + r32); else q = qlb[(size_t)id * SEQ + (li0 < cnt ? li0 : cnt - 1)];
            const bool valid = own || (li0 < cnt);
            unsigned slot = 3u; if (!own) slot = (unsigned)__builtin_popcount(selb[(size_t)bh * SEQ + q] & ((1u << n) - 1u));
            bf16x8 qr[8];
#pragma unroll
            for (int d0 = 0; d0 < 8; ++d0) qr[d0] = load8(Qb + ((size_t)bh * SEQ + q) * HD + d0 * 16 + hi * 8);
            if (hi == 0) rd[r32] = valid ? (((unsigned)(bh * SEQ) + q) * 4u + slot) * 128u : (1u << 27);
            const int NTu = own ? ((cg * 32 + 31) >> 6) + 1 : 4;
            const int qlo = n * 256 + cg * 32, qm = qlo + r32 - 4 * hi;
            float m_reg = -1e30f, l_reg = 0.f; f32x16 o[4] = {};
#define KV_STEP(T) do { if ((T) < NTu) { f32x16 p0, p1; float mn, al; bf16x8 pa0, pa1, pa2, pa3;                                        \
                qkt<T>(p0, p1, K_lds, r32, hi, qr);                                                                                       \
                if (own) { const int kb_ = n * 256 + (T) * KVBLK; if (kb_ + KVBLK - 1 > qlo) mask_tile(p0, p1, qm - kb_, 0x40000000u); }   \
                partialSM(p0, p1, m_reg, mn, al);                                                                                        \
                if (__any(al < 1.f)) { if (hi == 0) al_l[r32] = al; asm volatile("s_waitcnt lgkmcnt(0)" ::: "memory");                     \
                    for (int d_ = 0; d_ < 4; ++d_) for (int r = 0; r < 16; ++r) o[d_][r] *= al_l[crow(r, hi)]; }                           \
                finishSM(p0, p1, al, l_reg, pa0, pa1, pa2, pa3); SBAR();                                                                  \
                pv_tile<T>(o, vb0, pa0, pa1, pa2, pa3); } } while (0)
            KV_STEP(0); KV_STEP(1); KV_STEP(2); KV_STEP(3);
#undef KV_STEP
            if (hi == 0) li_l[r32] = l_reg; asm volatile("s_waitcnt lgkmcnt(0)" ::: "memory");
            float rli[16];
#pragma unroll
            for (int r = 0; r < 16; ++r) rli[r] = __builtin_amdgcn_rcpf(li_l[crow(r, hi)]);
#pragma unroll
            for (int r = 0; r < 16; ++r) { const unsigned off = rd[crow(r, hi)];
#pragma unroll
                for (int d0 = 0; d0 < 4; ++d0) { const float v = o[d0][r] * rli[r];
                    const float vn = __int_as_float(__builtin_amdgcn_mov_dpp(__float_as_int(v), 0xB1, 0xF, 0xF, true));
                    if ((r32 & 1) == 0) *(unsigned*)(OPb + (size_t)off + d0 * 32 + r32) = cvt_pk_bf16(v, vn); } }
            if (hi == 0) { float* mlp = MLb + (size_t)(rd[r32] >> 7) * 2; f32x2 ml = {m_reg, l_reg}; *(f32x2*)mlp = ml; }
        }
    }
}
__device__ __forceinline__ void moba_merge(KArgs a, int gw, int NGW, int lane) {
    const bf16_t* OP = (const bf16_t*)(a->ws + WS_OP); const float* ML = (const float*)(a->ws + WS_ML); const unsigned* sel = (const unsigned*)(a->ws + WS_SEL);
    bf16_t* AO = (bf16_t*)(a->ws + WS_AOUT);
    constexpr float C2 = 1.4426950408889634f * att::SCALE;
    const int h = lane >> 2, part = lane & 3;
    for (int t = gw; t < NTOK; t += NGW) {
        const int b = t >> 13, s = t & (SEQ - 1), bh = b * NSLAB + h;
        const size_t base = ((size_t)bh * SEQ + s) * 4;
        const int nsel = __builtin_popcount(sel[(size_t)bh * SEQ + s]);
        f32x2 ml[4]; u32x4 ov[4][4];
#pragma unroll
        for (int k = 0; k < 4; ++k) { ml[k] = *(const f32x2*)(ML + (base + k) * 2);
#pragma unroll
            for (int j = 0; j < 4; ++j) ov[k][j] = *(const u32x4*)(OP + (base + k) * 128 + part * 32 + j * 8); }
        float M = ml[3][0];
#pragma unroll
        for (int k = 0; k < 3; ++k) M = (k < nsel) ? fmaxf(M, ml[k][0]) : M;
        float w[4], W = 0.f;
#pragma unroll
        for (int k = 0; k < 4; ++k) { const bool valid = (k == 3) || (k < nsel); w[k] = valid ? ml[k][1] * __builtin_amdgcn_exp2f((ml[k][0] - M) * C2) : 0.f; W += w[k]; }
        const float rW = 1.f / W;
        float acc[32];
#pragma unroll
        for (int i = 0; i < 32; ++i) acc[i] = 0.f;
#pragma unroll
        for (int k = 0; k < 4; ++k) { const bool valid = (k == 3) || (k < nsel); const float wk = w[k] * rW;
#pragma unroll
            for (int j = 0; j < 4; ++j) { const u32x4 u = ov[k][j];
                acc[8 * j + 0] += valid ? wk * bf_lo(u.x) : 0.f; acc[8 * j + 1] += valid ? wk * bf_hi(u.x) : 0.f; acc[8 * j + 2] += valid ? wk * bf_lo(u.y) : 0.f; acc[8 * j + 3] += valid ? wk * bf_hi(u.y) : 0.f;
                acc[8 * j + 4] += valid ? wk * bf_lo(u.z) : 0.f; acc[8 * j + 5] += valid ? wk * bf_hi(u.z) : 0.f; acc[8 * j + 6] += valid ? wk * bf_lo(u.w) : 0.f; acc[8 * j + 7] += valid ? wk * bf_hi(u.w) : 0.f; } }
#pragma unroll
        for (int j = 0; j < 4; ++j) {
            if (FP8_OUT1) { u32x2 o; o.x = pk4_fp8(acc[8 * j] * AO8_SCALE, acc[8 * j + 1] * AO8_SCALE, acc[8 * j + 2] * AO8_SCALE, acc[8 * j + 3] * AO8_SCALE); o.y = pk4_fp8(acc[8 * j + 4] * AO8_SCALE, acc[8 * j + 5] * AO8_SCALE, acc[8 * j + 6] * AO8_SCALE, acc[8 * j + 7] * AO8_SCALE);
                *(u32x2*)((unsigned char*)AO + (size_t)t * DM + h * HD + part * 32 + j * 8) = o; }
            else { u32x4 o; o.x = cvt_pk_bf16(acc[8 * j], acc[8 * j + 1]); o.y = cvt_pk_bf16(acc[8 * j + 2], acc[8 * j + 3]); o.z = cvt_pk_bf16(acc[8 * j + 4], acc[8 * j + 5]); o.w = cvt_pk_bf16(acc[8 * j + 6], acc[8 * j + 7]);
                *(u32x4*)(AO + (size_t)t * DM + h * HD + part * 32 + j * 8) = o; } }
    }
}

#ifndef PHMASK
#define PHMASK 0x7ffff
#endif
#define IN(k) (((PHMASK >> (k)) & 1) && lo <= (k) && (k) < hi)
#define SEAM(k) do { if (IN(k) && IN((k) + 1)) xcd_barrier(bar); } while (0)
template <int LAYER>
__device__ __forceinline__ void layer_program(LAS unsigned char* lds, unsigned char* lds_gen, const XcdBarrier& bar, const int lo, const int hi) {
    constexpr int pb = LAYER == 0 ? 1 : 9;
    constexpr int po = LAYER == 0 ? 4 : 14;
    if (IN(pb)) {
        KArgs ka = kargs(); unsigned char* ws = ka->ws;
        constexpr bool F8 = LAYER == 0 ? (bool)FP8_QKV0 : (bool)FP8_QKV1; constexpr int Kb = F8 ? DM : DM * 2;
        pg8::SchedDense S; S.init(ws + WS_XB, ws + WS_WATT + (LAYER == 0 ? 0 : 32 * MiB), NTOK, NQKV, Kb, gridDim.x, blockIdx.x);
        constexpr bool KM = LAYER == 1;
        pg8::EpiQKV<KM> E{(bf16_t*)(ws + WS_Q), (const float*)(ws + WS_ROPE), F8 ? W8_INV : 1.f};
        pg8::gemm_phase<pg8::EpiQKV<KM>, pg8::SchedDense, F8>(lds, Kb, S, E);
    }
    SEAM(pb);
    if (LAYER == 0) {
        if (IN(2)) { KArgs ka = kargs();
            if (__builtin_amdgcn_readfirstlane(threadIdx.x) >= 256) __builtin_amdgcn_s_setprio(1);
            attn_phase_da(ka, (char*)lds_gen, gridDim.x);
            __builtin_amdgcn_s_setprio(0); }
        SEAM(2);
        if (IN(3)) { KArgs ka = kargs(); const Geo g = geo(); da_combine(ka, g.gw, g.NGW, otid() & 63); }
        SEAM(3);
    } else {
        if (IN(11)) { KArgs ka = kargs(); const Geo g = geo(); moba_gate(ka, g.gw, g.NGW, otid() & 63); }
        SEAM(11);
        if (IN(12)) { KArgs ka = kargs();
            if (__builtin_amdgcn_readfirstlane(threadIdx.x) >= 256) __builtin_amdgcn_s_setprio(1);
            moba_kv_phase(ka, lds, (char*)lds_gen);
            __builtin_amdgcn_s_setprio(0); }
        SEAM(12);
        if (IN(13)) { KArgs ka = kargs(); const Geo g = geo(); moba_merge(ka, g.gw, g.NGW, otid() & 63); }
        SEAM(13);
    }
    if (IN(po)) {
        KArgs ka = kargs(); unsigned char* ws = ka->ws;
        constexpr bool F8 = LAYER == 0 ? (bool)FP8_OUT0 : (bool)FP8_OUT1; constexpr int Kb = F8 ? DM : DM * 2;
        pg8::SchedDense S; S.init(ws + WS_AOUT, ws + WS_WATT + (LAYER == 0 ? 24 * MiB : 56 * MiB), NTOK, DM, Kb, gridDim.x, blockIdx.x);
        pg8::EpiRes E{LAYER == 0 ? ka->in[I_X] : ka->out, ka->out, F8 ? W8_INV * AO8_INV : 1.f};
        pg8::gemm_phase<pg8::EpiRes, pg8::SchedDense, F8>(lds, Kb, S, E);
    }
    SEAM(po);
    if (IN(po + 1)) { KArgs ka = kargs(); const Geo g = geo(); const int tid = otid(); ln_router(ka, LAYER, lds, g.vcu, g.G, __builtin_amdgcn_readfirstlane(tid >> 6), tid & 63); }
    SEAM(po + 1);
    if (IN(po + 2)) {
        KArgs ka = kargs(); unsigned char* ws = ka->ws;
        const int ntt = moe_tables(ka, LAYER, lds);
        constexpr bool F8 = FP8_MOE1 && LAYER == 1; constexpr int Kb = F8 ? DM : DM * 2;
        pg8::SchedMoe1 S{(const char*)(ws + WS_XB), (const char*)(ws + WS_WGU) + (size_t)LAYER * NEX * 1024 * DM * 2, (const unsigned*)(ws + WS_LIST),
                         (const LAS int*)(lds + LT_P), (const LAS int*)(lds + LT_CNT), (const LAS int*)(lds + LT_TILE), ntt * 4, (int)gridDim.x, (int)blockIdx.x, Kb};
        pg8::EpiSwiGLU<F8> E{(bf16_t*)(ws + WS_H), F8 ? W8_INV : 1.f};
        pg8::gemm_phase<pg8::EpiSwiGLU<F8>, pg8::SchedMoe1, F8>(lds, Kb, S, E);
    }
    SEAM(po + 2);
    if (IN(po + 3)) {
        KArgs ka = kargs(); unsigned char* ws = ka->ws;
        const int ntt = moe_tables(ka, LAYER, lds);
        constexpr bool F8 = FP8_MOE1 && LAYER == 1; constexpr int Kb = F8 ? DE : DE * 2;
        pg8::SchedMoe2 S{(const char*)(ws + WS_H), (const char*)(ws + WS_WD) + (size_t)LAYER * NEX * DM * DE * 2, (const LAS int*)(lds + LT_TILE), ntt * 8, (int)gridDim.x, (int)blockIdx.x, Kb};
        constexpr bool Y8 = F8 && FP8_Y1;
        pg8::EpiY<Y8> E{(bf16_t*)(ws + WS_Y), (F8 ? W8_INV : 1.f) * (Y8 ? Y8_SCALE : 1.f)};
        pg8::gemm_phase<pg8::EpiY<Y8>, pg8::SchedMoe2, F8>(lds, Kb, S, E);
    }
    SEAM(po + 3);
    if (IN(po + 4)) { KArgs ka = kargs(); const Geo g = geo(); (void)moe_tables(ka, LAYER, lds); moe_combine(ka, LAYER, lds, g.gw, g.NGW, otid() & 63); }
    if (LAYER == 0) SEAM(8);
}
__global__ void __launch_bounds__(NWAVES * 64, 2) fwd_kernel(Args args) {
    extern __shared__ __attribute__((aligned(16))) unsigned char lds_raw[];
    LAS unsigned char* lds = (LAS unsigned char*)lds_raw;
    volatile LAS unsigned* MISC = (volatile LAS unsigned*)(lds + MISC_OFF);
    for (int u = threadIdx.x; u < (LDS_BYTES - LDSCTL_OFF) / 4; u += NWAVES * 64) ((LAS unsigned*)(lds + LDSCTL_OFF))[u] = 0u;
    __syncthreads();
    XcdBarrier bar = xcd_barrier_post((unsigned*)(args.ws + WS_CTL) + CW_BAR, MISC + 8);
    const int lo = args.ph_lo, hi = args.ph_hi;
    if (IN(0)) { KArgs ka = kargs(); const Geo g = geo(); const int tid = otid(); p0_prologue(ka, lds, g.gw, g.NGW, __builtin_amdgcn_readfirstlane(tid >> 6), tid & 63); }
    SEAM(0);
    layer_program<0>(lds, lds_raw, bar, lo, hi);
    layer_program<1>(lds, lds_raw, bar, lo, hi);
}
#undef IN
#undef SEAM

extern "C" void kernel_launch(void* const* d_in, const int* in_sizes, int n_in, void* d_out, int out_size, void* d_ws, size_t ws_size, hipStream_t stream) {
    static int grid = 0;
    if (grid == 0) {
        if (n_in != 23 || out_size != NTOK * DM || ws_size < WS_END) { fprintf(stderr, "kernel_launch: unexpected shapes (n_in %d, out %d, ws %zu; need ws >= %zu)\n", n_in, out_size, ws_size, (size_t)WS_END); grid = -1; return; }
        int dev = 0, cus = 0, per_cu = 0;
        if (hipGetDevice(&dev) != hipSuccess || hipDeviceGetAttribute(&cus, hipDeviceAttributeMultiprocessorCount, dev) != hipSuccess) { grid = -1; return; }
        if (hipFuncSetAttribute((const void*)fwd_kernel, hipFuncAttributeMaxDynamicSharedMemorySize, LDS_BYTES) != hipSuccess) { fprintf(stderr, "kernel_launch: hipFuncSetAttribute failed\n"); grid = -1; return; }
        if (hipOccupancyMaxActiveBlocksPerMultiprocessor(&per_cu, (const void*)fwd_kernel, NWAVES * 64, LDS_BYTES) != hipSuccess || per_cu < 1) fprintf(stderr, "kernel_launch: occupancy query reports %d\n", per_cu);
        (void)hipGetLastError();
        grid = 256;
    }
    if (grid < 0) return;
    if (hipMemsetAsync((char*)d_ws + WS_CTL, 0, CTL_ZERO_BYTES, stream) != hipSuccess) return;
    Args a{};
    for (int i = 0; i < 23; ++i) a.in[i] = (const float*)d_in[i];
    a.out = (float*)d_out; a.ws = (unsigned char*)d_ws;
#ifndef MK_SPLIT
    a.ph_lo = 0; a.ph_hi = 19;
    hipLaunchKernelGGL(fwd_kernel, dim3(grid), dim3(NWAVES * 64), LDS_BYTES, stream, a);
#else
    for (int p = 0; p < 19; ++p) { a.ph_lo = p; a.ph_hi = p + 1; hipLaunchKernelGGL(fwd_kernel, dim3(grid), dim3(NWAVES * 64), LDS_BYTES, stream, a); }
#endif
}
```

```cpp
#include <hip/hip_runtime.h>
#include <cstdio>
#include <cstdint>

#define GAS __attribute__((address_space(1)))
#define LAS __attribute__((address_space(3)))
typedef unsigned short bf16_t;
typedef short bf16x8 __attribute__((ext_vector_type(8)));
typedef short s16x4 __attribute__((ext_vector_type(4)));
typedef float f32x2 __attribute__((ext_vector_type(2)));
typedef float f32x4 __attribute__((ext_vector_type(4)));
typedef float f32x16 __attribute__((ext_vector_type(16)));
typedef unsigned u32x2 __attribute__((ext_vector_type(2)));
typedef unsigned u32x4 __attribute__((ext_vector_type(4)));

constexpr int BATCH = 2, SEQ = 8192, DM = 2048, NTOK = BATCH * SEQ;
constexpr int NE = 64, NEX = 65  , DE = 512, NQKV = 6144, HD = 128, NSLAB = 16;
constexpr float LN_EPS = 1e-5f;
constexpr float ALPHA = 1.4142135623730951f;
constexpr float LAMBDA_INIT = 0.2f;
constexpr float ROUTED_SCALE = 2.5f;
constexpr int NWAVES = 8;
constexpr int MAXTILES = 640;

constexpr size_t MiB = 1u << 20;
constexpr size_t WS_CTL = 0, CTL_ZERO_BYTES = 1 * MiB;
constexpr size_t WS_TOKE = 2 * MiB;
constexpr size_t WS_TOKW = 3 * MiB;
constexpr size_t WS_LIST = 4 * MiB;
constexpr size_t WS_SEL = 8 * MiB;
constexpr size_t WS_KMEAN = 9 * MiB;
constexpr size_t WS_ROPE = 10 * MiB;
constexpr size_t WS_WRF = 12 * MiB;
constexpr size_t WS_WATT = 16 * MiB;
constexpr size_t WS_WGU = 80 * MiB;
constexpr size_t WS_WD = 600 * MiB;
constexpr size_t WS_XB = 860 * MiB;
constexpr size_t WS_C = 924 * MiB;
constexpr size_t WS_Q = WS_C, WS_K = WS_C + 64 * MiB, WS_V = WS_C + 128 * MiB;
constexpr size_t WS_O = WS_C + 192 * MiB;
constexpr size_t WS_AOUT = WS_C + 320 * MiB;
constexpr size_t WS_H = WS_C;
constexpr size_t WS_Y = WS_C + 160 * MiB;
constexpr size_t WS_QLIST = WS_C + 192 * MiB;
constexpr size_t WS_OP = WS_C + 384 * MiB;
constexpr size_t WS_ML = WS_C + 641 * MiB;
constexpr size_t WS_END = WS_C + 800 * MiB;
constexpr int CW_BAR = 4096;
constexpr int CW_CNT = 8192;
constexpr int CW_MCNT = 12288;
constexpr int CW_SQ = 13440;

constexpr int RING_BYTES = 131072;
constexpr int LDSCTL_OFF = RING_BYTES, MISC_OFF = LDSCTL_OFF + 320;
constexpr int LT_P = LDSCTL_OFF + 1024;
constexpr int LT_CNT = LDSCTL_OFF + 1536;
constexpr int LT_TILE = LDSCTL_OFF + 2048;
constexpr int LT_LCNT = LDSCTL_OFF + 5120;
constexpr int LT_LBASE = LDSCTL_OFF + 5632;
constexpr int LT_ENT = LDSCTL_OFF + 6144;
constexpr int LT_MC = 114688;
constexpr int LT_PB = 118784;
constexpr int LT_SC = 123904;
constexpr int LDS_BYTES = 147456;

#ifndef FP8_QKV0
#define FP8_QKV0 0
#endif
#ifndef FP8_QKV1
#define FP8_QKV1 1
#endif
#ifndef FP8_OUT0
#define FP8_OUT0 0
#endif
#ifndef FP8_OUT1
#define FP8_OUT1 1
#endif
#ifndef FP8_Y1
#define FP8_Y1 1
#endif
#ifndef FP8_MOE1
#define FP8_MOE1 1
#endif
#ifndef FP8_MOE0
#define FP8_MOE0 1
#endif
#ifndef FP8_Y0
#define FP8_Y0 0
#endif
#define MOE_F8(l) ((l) == 0 ? (bool)FP8_MOE0 : (bool)FP8_MOE1)
#define MOE_Y8(l) ((l) == 0 ? (bool)(FP8_MOE0 && FP8_Y0) : (bool)(FP8_MOE1 && FP8_Y1))
constexpr float W8_SCALE = 64.f, W8_INV = 1.f / 64.f;
constexpr float AO8_SCALE = 16.f, AO8_INV = 1.f / 16.f;
constexpr float Y8_SCALE = 16.f, Y8_INV = 1.f / 16.f;
#define LDS_WAIT() asm volatile("s_waitcnt lgkmcnt(0)" ::: "memory")
#define VM_WAIT() asm volatile("s_waitcnt vmcnt(0)" ::: "memory")
#define SBAR() __builtin_amdgcn_sched_barrier(0)

__device__ __forceinline__ unsigned cvt_pk_bf16(float lo, float hi) { unsigned r; asm volatile("v_cvt_pk_bf16_f32 %0, %1, %2" : "=v"(r) : "v"(lo), "v"(hi)); return r; }
__device__ __forceinline__ unsigned pk4_fp8(float a, float b, float c, float d) { int p = __builtin_amdgcn_cvt_pk_fp8_f32(a, b, 0, false); p = __builtin_amdgcn_cvt_pk_fp8_f32(c, d, p, true); return (unsigned)p; }
__device__ __forceinline__ float bf_lo(unsigned u) { return __uint_as_float(u << 16); }
__device__ __forceinline__ float bf_hi(unsigned u) { return __uint_as_float(u & 0xffff0000u); }
template <int CTRL> __device__ __forceinline__ float dpp_mov(float v) { return __int_as_float(__builtin_amdgcn_update_dpp(0, __float_as_int(v), CTRL, 0xF, 0xF, true)); }
__device__ __forceinline__ float wave_sum(float v) {
    v += dpp_mov<0xB1>(v);
    v += dpp_mov<0x4E>(v);
    v += dpp_mov<0x141>(v);
    v += dpp_mov<0x140>(v);
    const float r0 = __int_as_float(__builtin_amdgcn_readlane(__float_as_int(v), 0)), r1 = __int_as_float(__builtin_amdgcn_readlane(__float_as_int(v), 16));
    const float r2 = __int_as_float(__builtin_amdgcn_readlane(__float_as_int(v), 32)), r3 = __int_as_float(__builtin_amdgcn_readlane(__float_as_int(v), 48));
    return (r0 + r1) + (r2 + r3);
}

#define XB_TMO      128
#define XB_XCNT(j)  (256  + 64 * (j))
#define XB_XSUB(j)  (1280 + 64 * (j))
#define XB_XGEN(j)  (2304 + 64 * (j))
#define XB_TOP      3328
#define XB_TOPGEN   3392
#define XCD_BAR_WORDS 3456
#define XB_SPIN_CAP (1u << 18)
__device__ __forceinline__ unsigned xb_ld(unsigned* p)              { return __hip_atomic_load(p, __ATOMIC_RELAXED, __HIP_MEMORY_SCOPE_AGENT); }
__device__ __forceinline__ unsigned xb_add(unsigned* p, unsigned v) { return __hip_atomic_fetch_add(p, v, __ATOMIC_RELAXED, __HIP_MEMORY_SCOPE_AGENT); }
__device__ __forceinline__ unsigned xb_xcc_id() { return (unsigned)__builtin_amdgcn_s_getreg((3 << 11) | 20) & 0xFu; }
#define XB_SPIN(cond, bar) do { unsigned _sp = 0; while (cond) { __builtin_amdgcn_s_sleep(1); \
    if ((++_sp & 255u) == 0u) { if (xb_ld(&(bar)[XB_TMO])) break; if (_sp > XB_SPIN_CAP) { atomicAdd(&(bar)[XB_TMO], 1u); break; } } } } while (0)
struct XcdBarrier { unsigned* bar; unsigned x; volatile LAS unsigned* st; };
__device__ __forceinline__ XcdBarrier xcd_barrier_post(unsigned* bar, volatile LAS unsigned* st) {
    XcdBarrier b; b.bar = bar; b.x = xb_xcc_id(); b.st = st;
    if (threadIdx.x == 0) (void)xb_add(&bar[XB_XCNT(b.x)], 1u);
    return b;
}
__device__ __forceinline__ void xcd_barrier_complete(unsigned* bar, unsigned x, unsigned& nloc, unsigned& nx) {
    const unsigned G = gridDim.x * gridDim.y * gridDim.z;
    unsigned sum, cnt, mine, sp = 0u;
    for (;;) {
        sum = 0u; cnt = 0u; mine = 0u;
#pragma unroll
        for (unsigned j = 0; j < 16; ++j) { const unsigned c = xb_ld(&bar[XB_XCNT(j)]); sum += c; cnt += (c > 0u) ? 1u : 0u; mine = (j == x) ? c : mine; }
        if (sum == G) break;
        __builtin_amdgcn_s_sleep(1);
        if ((++sp & 255u) == 0u) { if (xb_ld(&bar[XB_TMO])) break; if (sp > XB_SPIN_CAP) { atomicAdd(&bar[XB_TMO], 1u); break; } }
    }
    nloc = mine > 0u ? mine : 1u; nx = cnt > 0u ? cnt : 1u;
}
__device__ __forceinline__ void xcd_barrier(const XcdBarrier& b) {
    asm volatile("s_waitcnt vmcnt(0)" ::: "memory");
    __syncthreads();
    if (threadIdx.x == 0) {
        unsigned* bar = b.bar;
        __builtin_amdgcn_s_waitcnt(0);
        unsigned nloc = b.st[0], nx = b.st[1];
        if (nloc == 0u) { xcd_barrier_complete(bar, b.x, nloc, nx); b.st[0] = nloc; b.st[1] = nx; }
        const unsigned old = xb_add(&bar[XB_XSUB(b.x)], 1u);
        const unsigned gen = old / nloc;
        if (old + 1u == (gen + 1u) * nloc) {
            __builtin_amdgcn_fence(__ATOMIC_RELEASE, "agent");
            asm volatile("s_waitcnt vmcnt(0)" ::: "memory");
            const unsigned og = xb_add(&bar[XB_TOP], 1u);
            const unsigned tg = og / nx;
            if (og + 1u == (tg + 1u) * nx) xb_add(&bar[XB_TOPGEN], 1u);
            else XB_SPIN(xb_ld(&bar[XB_TOPGEN]) == tg, bar);
            __builtin_amdgcn_fence(__ATOMIC_ACQUIRE, "agent");
            xb_add(&bar[XB_XGEN(b.x)], 1u);
            asm volatile("s_waitcnt vmcnt(0)" ::: "memory");
        } else {
            XB_SPIN(xb_ld(&bar[XB_XGEN(b.x)]) == gen, bar);
            __builtin_amdgcn_fence(__ATOMIC_ACQUIRE, "agent");
            asm volatile("s_waitcnt vmcnt(0)" ::: "memory");
        }
    }
    __syncthreads();
}

namespace pg8 {
constexpr int BM = 256, BK = 64, HALF = 128, HTB = HALF * BK * 2, NXCD = 8, WGM = 8;
__device__ __forceinline__ int lds_byte(int r, int c) { const int st = (r >> 4) * 2 + (c >> 5), rr = r & 15, cc = c & 31, ob = rr * 64 + cc * 2; return st * 1024 + (ob ^ (((ob >> 9) & 1) << 5)); }
__device__ __forceinline__ void stage_rc(int b, int& R, int& C) { const int st = b / 1024, sb = b % 1024, swz = sb ^ (((sb >> 9) & 1) << 5); R = (st >> 1) * 16 + swz / 64; C = (st & 1) * 32 + (swz % 64) / 2; }
__device__ __forceinline__ int perm32(int rho) { const int n = rho >> 4, i = rho & 15; return 8 * (i >> 2) + 4 * n + (i & 3); }
struct Unit { int pm, pn, e, aux; };
__device__ __forceinline__ int xcd_remap(int L, int nwg) { const int q = nwg / NXCD, r = nwg % NXCD, xcd = L % NXCD, off = L / NXCD; return (xcd < r ? xcd * (q + 1) : r * (q + 1) + (xcd - r) * q) + off; }

struct SchedDense {
    const char* A; const char* Bt; int Kb, nM, nN, nwg, G, c;
    __device__ __forceinline__ void init(const void* A_, const void* Bt_, int M, int N, int Kb_, int G_, int c_) { A = (const char*)A_; Bt = (const char*)Bt_; Kb = Kb_; nM = M / BM; nN = N / BM; nwg = nM * nN; G = G_; c = c_; }
    __device__ __forceinline__ bool next(int i, Unit& u) const {
        const long L = (long)i * G + c; if (L >= nwg) return false;
        const int wgid = xcd_remap((int)L, nwg);
        const int nig = WGM * nN, gid = wgid / nig, fm = gid * WGM, gsz = (nM - fm) < WGM ? (nM - fm) : WGM;
        u.pm = fm + ((wgid % nig) % gsz); u.pn = (wgid % nig) / gsz; u.e = 0; u.aux = 0; return true;
    }
    __device__ __forceinline__ const char* a_base(const Unit&) const { return A; }
    __device__ __forceinline__ const char* b_base(const Unit& u) const { return Bt + (size_t)u.pn * BM * Kb; }
    __device__ __forceinline__ void a_off(const Unit& u, unsigned (&off)[2][2]) const {
        int tz = threadIdx.x; asm volatile("" : "+v"(tz));
#pragma unroll
        for (int i = 0; i < 2; ++i) { int R, C; stage_rc(tz * 16 + i * 8192, R, C);
#pragma unroll
            for (int h = 0; h < 2; ++h) off[h][i] = (unsigned)((u.pm * BM + h * HALF + R) * Kb + C * 2); }
    }
};
struct SchedMoe1 {
    const char* X; const char* W; const unsigned* list; const LAS int* P; const LAS int* cnt; const LAS int* tile_e; int U, G, c, Kb;
    __device__ __forceinline__ bool next(int i, Unit& u) const {
        const long L = (long)i * G + c; if (L >= U) return false;
        const int wgid = xcd_remap((int)L, U);
        u.pm = wgid >> 2; u.pn = wgid & 3; u.e = tile_e[u.pm]; u.aux = u.pm - P[u.e]; return true;
    }
    __device__ __forceinline__ const char* a_base(const Unit&) const { return X; }
    __device__ __forceinline__ const char* b_base(const Unit& u) const { return W + ((size_t)u.e * 1024 + (size_t)u.pn * 256) * Kb; }
    __device__ __forceinline__ void a_off(const Unit& u, unsigned (&off)[2][2]) const {
        const int n = cnt[u.e];
        int tz = threadIdx.x; asm volatile("" : "+v"(tz));
#pragma unroll
        for (int i = 0; i < 2; ++i) { int R, C; stage_rc(tz * 16 + i * 8192, R, C);
#pragma unroll
            for (int h = 0; h < 2; ++h) {
                const int r = u.aux * BM + h * HALF + R;
                unsigned tok;
                if (u.e == NE) tok = (unsigned)r;
                else tok = (r < n) ? list[(size_t)u.e * NTOK + r] : 0u;
                off[h][i] = tok * (unsigned)Kb + (unsigned)C * 2u;
            } }
    }
};
struct SchedMoe2 {
    const char* Hb; const char* W; const LAS int* tile_e; int U, G, c, Kb;
    __device__ __forceinline__ bool next(int i, Unit& u) const {
        const long L = (long)i * G + c; if (L >= U) return false;
        const int wgid = xcd_remap((int)L, U);
        u.pm = wgid >> 3; u.pn = wgid & 7; u.e = tile_e[u.pm]; u.aux = 0; return true;
    }
    __device__ __forceinline__ const char* a_base(const Unit&) const { return Hb; }
    __device__ __forceinline__ const char* b_base(const Unit& u) const { return W + ((size_t)u.e * DM + (size_t)u.pn * 256) * Kb; }
    __device__ __forceinline__ void a_off(const Unit& u, unsigned (&off)[2][2]) const {
        int tz = threadIdx.x; asm volatile("" : "+v"(tz));
#pragma unroll
        for (int i = 0; i < 2; ++i) { int R, C; stage_rc(tz * 16 + i * 8192, R, C);
#pragma unroll
            for (int h = 0; h < 2; ++h) off[h][i] = (unsigned)((u.pm * BM + h * HALF + R) * Kb + C * 2); }
    }
};

template <bool KM> struct EpiQKV {
    static constexpr bool PERM = true;
    bf16_t* QKV; const float* rope; float osc;
    __device__ __forceinline__ void operator()(const f32x4 (&acc)[2][2][4][2], const Unit& u, int wr, int wc, int fr, int fq) const {
        const int seg = u.pn >> 3, slab0 = (u.pn & 7) * 2;
        bf16_t* base = QKV + (size_t)seg * ((size_t)BATCH * NSLAB * SEQ * HD);
        const int row0 = u.pm * BM + wr * 64 + fr; const int b = (u.pm * BM) >> 13;
        const bool rot = (seg < 2) && (wc == 0);
        f32x4 cs0a = {0.f, 0.f, 0.f, 0.f}, cs0b = cs0a, cs1a = cs0a, cs1b = cs0a;
#pragma unroll
        for (int ai = 0; ai < 2; ++ai)
#pragma unroll
            for (int m = 0; m < 4; ++m) {
                const int row = row0 + ai * HALF + m * 16, s = row & (SEQ - 1);
                f32x4 cs = {1.f, 1.f, 1.f, 1.f}, sn = {0.f, 0.f, 0.f, 0.f};
                if (rot) { cs = *(const f32x4*)(rope + (size_t)row * 32 + 4 * fq); sn = *(const f32x4*)(rope + (size_t)row * 32 + 16 + 4 * fq); }
#pragma unroll
                for (int bj = 0; bj < 2; ++bj) {
                    f32x4 v0 = acc[ai][bj][m][0] * osc, v1 = acc[ai][bj][m][1] * osc;
                    if (rot) {
                        f32x4 w0, w1;
                        w0[0] = v0[0] * cs[0] - v0[1] * sn[0]; w0[1] = v0[1] * cs[0] + v0[0] * sn[0];
                        w0[2] = v0[2] * cs[1] - v0[3] * sn[1]; w0[3] = v0[3] * cs[1] + v0[2] * sn[1];
                        w1[0] = v1[0] * cs[2] - v1[1] * sn[2]; w1[1] = v1[1] * cs[2] + v1[0] * sn[2];
                        w1[2] = v1[2] * cs[3] - v1[3] * sn[3]; w1[3] = v1[3] * cs[3] + v1[2] * sn[3];
                        v0 = w0; v1 = w1;
                    }
                    u32x4 w; w.x = cvt_pk_bf16(v0[0], v0[1]); w.y = cvt_pk_bf16(v0[2], v0[3]); w.z = cvt_pk_bf16(v1[0], v1[1]); w.w = cvt_pk_bf16(v1[2], v1[3]);
                    *(u32x4*)(base + ((size_t)(b * NSLAB + slab0 + bj) * SEQ + s) * HD + wc * 32 + 8 * fq) = w;
                    if (KM && seg == 1) { const f32x4 ra = {bf_lo(w.x), bf_hi(w.x), bf_lo(w.y), bf_hi(w.y)}, rb = {bf_lo(w.z), bf_hi(w.z), bf_lo(w.w), bf_hi(w.w)};
                        if (bj == 0) { cs0a += ra; cs0b += rb; } else { cs1a += ra; cs1b += rb; } }
                }
            }
        if (KM && seg == 1) {
            bf16_t* km = (bf16_t*)((unsigned char*)QKV - WS_Q + WS_KMEAN);
            LAS float* kbuf = (LAS float*)(uintptr_t)(LDSCTL_OFF + 12288);
#define KM_RED(V, BJ, I0) do { _Pragma("unroll") for (int i = 0; i < 4; ++i) { float v = V[i]; v += dpp_mov<0xB1>(v); v += dpp_mov<0x4E>(v); v += dpp_mov<0x141>(v); v += dpp_mov<0x140>(v); \
                if (fr == 0) kbuf[((wr * 4 + wc) * 2 + (BJ)) * 32 + fq * 8 + (I0) + i] = v; } } while (0)
            KM_RED(cs0a, 0, 0); KM_RED(cs0b, 0, 4); KM_RED(cs1a, 1, 0); KM_RED(cs1b, 1, 4);
#undef KM_RED
            asm volatile("s_waitcnt lgkmcnt(0)" ::: "memory"); __builtin_amdgcn_s_barrier(); asm volatile("" ::: "memory");
            if (wr == 0) {
                const int l = fq * 16 + fr, bj = l >> 5, c32 = l & 31;
                const float mean = (kbuf[((0 * 4 + wc) * 2 + bj) * 32 + c32] + kbuf[((1 * 4 + wc) * 2 + bj) * 32 + c32]) * (1.f / 256.f);
                const unsigned hi = cvt_pk_bf16(mean, 0.f) & 0xffffu; const unsigned lo = cvt_pk_bf16(mean - bf_lo(hi), 0.f) & 0xffffu;
                const size_t ko = ((size_t)(b * NSLAB + slab0 + bj) * 64 + (u.pm & 31)) * HD + wc * 32 + c32;
                km[ko] = (bf16_t)hi; km[ko + 32 * HD] = (bf16_t)lo;
            }
        }
    }
};
struct EpiRes {
    static constexpr bool PERM = false;
    const float* xres; float* y; float osc;
    __device__ __forceinline__ void operator()(const f32x4 (&acc)[2][2][4][2], const Unit& u, int wr, int wc, int fr, int fq) const {
        const int row0 = u.pm * BM + wr * 64 + fr, col0 = u.pn * BM + wc * 32 + 4 * fq;
#pragma unroll
        for (int ai = 0; ai < 2; ++ai)
#pragma unroll
            for (int m = 0; m < 4; ++m) {
                const size_t ro = (size_t)(row0 + ai * HALF + m * 16) * DM + col0;
#pragma unroll
                for (int bj = 0; bj < 2; ++bj)
#pragma unroll
                    for (int n = 0; n < 2; ++n) { const f32x4 xr = *(const f32x4*)(xres + ro + bj * HALF + n * 16); *(f32x4*)(y + ro + bj * HALF + n * 16) = xr * ALPHA + acc[ai][bj][m][n] * osc; }
            }
    }
};
__device__ __forceinline__ float silu_mul(float g, float up) { return g * __builtin_amdgcn_rcpf(1.f + __builtin_amdgcn_exp2f(-1.4426950408889634f * g)) * up; }
template <bool OUT8> struct EpiSwiGLU {
    static constexpr bool PERM = true;
    bf16_t* H; float osc;
    __device__ __forceinline__ void operator()(const f32x4 (&acc)[2][2][4][2], const Unit& u, int wr, int wc, int fr, int fq) const {
        const int row0 = u.pm * BM + wr * 64 + fr, col0 = u.pn * 128 + wc * 32 + 8 * fq;
#pragma unroll
        for (int ai = 0; ai < 2; ++ai)
#pragma unroll
            for (int m = 0; m < 4; ++m) {
                const f32x4 g0 = acc[ai][0][m][0] * osc, g1 = acc[ai][0][m][1] * osc, u0 = acc[ai][1][m][0] * osc, u1 = acc[ai][1][m][1] * osc;
                if (OUT8) {
                    u32x2 w; w.x = pk4_fp8(silu_mul(g0[0], u0[0]), silu_mul(g0[1], u0[1]), silu_mul(g0[2], u0[2]), silu_mul(g0[3], u0[3]));
                    w.y = pk4_fp8(silu_mul(g1[0], u1[0]), silu_mul(g1[1], u1[1]), silu_mul(g1[2], u1[2]), silu_mul(g1[3], u1[3]));
                    *(u32x2*)((unsigned char*)H + (size_t)(row0 + ai * HALF + m * 16) * DE + col0) = w;
                } else {
                u32x4 w;
                w.x = cvt_pk_bf16(silu_mul(g0[0], u0[0]), silu_mul(g0[1], u0[1])); w.y = cvt_pk_bf16(silu_mul(g0[2], u0[2]), silu_mul(g0[3], u0[3]));
                w.z = cvt_pk_bf16(silu_mul(g1[0], u1[0]), silu_mul(g1[1], u1[1])); w.w = cvt_pk_bf16(silu_mul(g1[2], u1[2]), silu_mul(g1[3], u1[3]));
                *(u32x4*)(H + (size_t)(row0 + ai * HALF + m * 16) * DE + col0) = w;
                }
            }
    }
};
template <bool OUT8> struct EpiY {
    static constexpr bool PERM = true;
    bf16_t* Y; float osc;
    __device__ __forceinline__ void operator()(const f32x4 (&acc)[2][2][4][2], const Unit& u, int wr, int wc, int fr, int fq) const {
        const int row0 = u.pm * BM + wr * 64 + fr, col0 = u.pn * BM + wc * 32 + 8 * fq;
#pragma unroll
        for (int ai = 0; ai < 2; ++ai)
#pragma unroll
            for (int m = 0; m < 4; ++m) {
                bf16_t* rowp = Y + (size_t)(row0 + ai * HALF + m * 16) * DM + col0;
#pragma unroll
                for (int bj = 0; bj < 2; ++bj) { const f32x4 v0 = acc[ai][bj][m][0] * osc, v1 = acc[ai][bj][m][1] * osc;
                    if (OUT8) { u32x2 w; w.x = pk4_fp8(v0[0], v0[1], v0[2], v0[3]); w.y = pk4_fp8(v1[0], v1[1], v1[2], v1[3]);
                        *(u32x2*)((unsigned char*)Y + (size_t)(row0 + ai * HALF + m * 16) * DM + col0 + bj * HALF) = w; }
                    else { u32x4 w; w.x = cvt_pk_bf16(v0[0], v0[1]); w.y = cvt_pk_bf16(v0[2], v0[3]); w.z = cvt_pk_bf16(v1[0], v1[1]); w.w = cvt_pk_bf16(v1[2], v1[3]);
                        *(u32x4*)(rowp + bj * HALF) = w; } }
            }
    }
};

typedef int i32x4 __attribute__((ext_vector_type(4)));
typedef int i32x8 __attribute__((ext_vector_type(8)));
__device__ __forceinline__ i32x8 cat8(bf16x8 a, bf16x8 b) { const i32x4 x = __builtin_bit_cast(i32x4, a), y = __builtin_bit_cast(i32x4, b); return (i32x8){x[0], x[1], x[2], x[3], y[0], y[1], y[2], y[3]}; }
template <class Epi, class Sched, bool F8>
__device__ __forceinline__ void gemm_phase(LAS unsigned char* lds, const int K, const Sched& S, const Epi& E) {
    const int tid = threadIdx.x, wid = __builtin_amdgcn_readfirstlane(tid >> 6), lane = tid & 63, wr = wid >> 2, wc = wid & 3, fr = lane & 15, fq = lane >> 4;
    const int nt = K / 128;
    unsigned voffB[2];
#pragma unroll
    for (int i = 0; i < 2; ++i) { int R, C; stage_rc(tid * 16 + i * 8192, R, C); const int Rb = Epi::PERM ? ((R & ~31) + perm32(R & 31)) : R; voffB[i] = (unsigned)(Rb * K + C * 2); }
    const size_t kstep = (size_t)(BK * 2);
    const size_t hstep = (size_t)HALF * K;
    const unsigned ldsw = (unsigned)wid * 1024u;
    const int aoff = lds_byte(wr * 64 + fr, fq * 8), boff = lds_byte(wc * 32 + fr, fq * 8);
#define PG8_SA(b, h) (((b) * 2 + (h)) * HTB)
#define PG8_SB(b, h) ((4 + (b) * 2 + (h)) * HTB)
#define PG8_STAGE(bufoff, gbase, voff) do { _Pragma("unroll") for (int _i = 0; _i < 2; ++_i) \
        __builtin_amdgcn_global_load_lds((const unsigned*)((const char*)(gbase) + (voff)[_i]), (LAS unsigned*)(lds + (bufoff) + ldsw + _i * 8192), 16, 0, 0); } while (0)
#define PG8_LDA(dst, b, h) do { _Pragma("unroll") for (int m = 0; m < 4; ++m) _Pragma("unroll") for (int k = 0; k < 2; ++k) dst[m][k] = *(const LAS bf16x8*)(lds + PG8_SA(b, h) + aoff + m * 2048 + k * 1024); } while (0)
#define PG8_LDB(dst, b, h) do { _Pragma("unroll") for (int n = 0; n < 2; ++n) _Pragma("unroll") for (int k = 0; k < 2; ++k) dst[n][k] = *(const LAS bf16x8*)(lds + PG8_SB(b, h) + boff + n * 2048 + k * 1024); } while (0)
#define PG8_MMA(ai, bj, At, Bt) do { __builtin_amdgcn_s_setprio(1); _Pragma("unroll") for (int m = 0; m < 4; ++m) _Pragma("unroll") for (int n = 0; n < 2; ++n) { \
        if (F8) acc[ai][bj][m][n] = __builtin_amdgcn_mfma_scale_f32_16x16x128_f8f6f4(cat8(Bt[n][0], Bt[n][1]), cat8(At[m][0], At[m][1]), acc[ai][bj][m][n], 0, 0, 0, 0x7F7F7F7F, 0, 0x7F7F7F7F); \
        else { _Pragma("unroll") for (int k = 0; k < 2; ++k) acc[ai][bj][m][n] = __builtin_amdgcn_mfma_f32_16x16x32_bf16(Bt[n][k], At[m][k], acc[ai][bj][m][n], 0, 0, 0); } } \
        __builtin_amdgcn_s_setprio(0); } while (0)
#define PG8_WAIT_V(n) asm volatile("s_waitcnt vmcnt(" #n ")" ::: "memory")
#define PG8_WAIT_L(n) asm volatile("s_waitcnt lgkmcnt(" #n ")" ::: "memory")
#define PG8_BAR __builtin_amdgcn_s_barrier()
#define PG8_SCHED __builtin_amdgcn_sched_barrier(0)
    Unit cur, nxt; int ui = 0;
    if (!S.next(0, cur)) return;
    f32x4 acc[2][2][4][2];
#pragma unroll
    for (int a = 0; a < 2; ++a)
#pragma unroll
        for (int b = 0; b < 2; ++b)
#pragma unroll
            for (int m = 0; m < 4; ++m)
#pragma unroll
                for (int n = 0; n < 2; ++n) acc[a][b][m][n] = (f32x4){0.f, 0.f, 0.f, 0.f};
    bf16x8 At[4][2], B0[2][2], B1[2][2];
    unsigned cOff[2][2];
    const char* cA = S.a_base(cur); const char* cB = S.b_base(cur);
    S.a_off(cur, cOff);
    PG8_STAGE(PG8_SB(0, 0), cB, voffB); PG8_STAGE(PG8_SB(0, 1), cB + hstep, voffB); PG8_STAGE(PG8_SA(0, 0), cA, cOff[0]); PG8_STAGE(PG8_SA(0, 1), cA, cOff[1]);
    if (wr == 1) PG8_BAR;
    PG8_WAIT_V(2); PG8_BAR;
    PG8_STAGE(PG8_SB(1, 0), cB + kstep, voffB); PG8_STAGE(PG8_SA(1, 0), cA + kstep, cOff[0]); PG8_STAGE(PG8_SB(1, 1), cB + hstep + kstep, voffB);
    PG8_WAIT_V(6); PG8_BAR;
    for (;;) {
        const bool has_next = S.next(ui + 1, nxt);
        const char* nA = has_next ? S.a_base(nxt) : cA; const char* nB = has_next ? S.b_base(nxt) : cB;
#pragma unroll 1
        for (int t = 0; t < nt; t += 2) {
            const bool last = (t == nt - 2);
            const char* a1 = cA + (size_t)(t + 1) * kstep;
            const char* a2 = last ? nA : cA + (size_t)(t + 2) * kstep; const char* b2 = last ? nB : cB + (size_t)(t + 2) * kstep;
            const char* a3 = a2 + kstep; const char* b3 = b2 + kstep;
            PG8_LDB(B0, 0, 0); PG8_LDB(B1, 0, 1); PG8_SCHED; PG8_LDA(At, 0, 0); PG8_STAGE(PG8_SA(1, 1), a1, cOff[1]);
            if (last && has_next) S.a_off(nxt, cOff);
            PG8_WAIT_V(8); PG8_WAIT_L(0); PG8_BAR; PG8_MMA(0, 0, At, B0); PG8_MMA(0, 1, At, B1); PG8_BAR; PG8_SCHED;
            PG8_LDA(At, 0, 1); PG8_STAGE(PG8_SB(0, 0), b2, voffB); PG8_STAGE(PG8_SB(0, 1), b2 + hstep, voffB); PG8_STAGE(PG8_SA(0, 0), a2, cOff[0]);
            PG8_WAIT_V(8); PG8_WAIT_L(0); PG8_BAR; PG8_MMA(1, 0, At, B0); PG8_MMA(1, 1, At, B1); PG8_BAR; PG8_SCHED;
            PG8_LDB(B0, 1, 0); PG8_LDB(B1, 1, 1); PG8_SCHED; PG8_LDA(At, 1, 0); PG8_STAGE(PG8_SA(0, 1), a2, cOff[1]);
            PG8_WAIT_V(8); PG8_WAIT_L(0); PG8_BAR; PG8_MMA(0, 0, At, B0); PG8_MMA(0, 1, At, B1); PG8_BAR; PG8_SCHED;
            PG8_LDA(At, 1, 1); PG8_STAGE(PG8_SB(1, 0), b3, voffB); PG8_STAGE(PG8_SB(1, 1), b3 + hstep, voffB); PG8_STAGE(PG8_SA(1, 0), a3, cOff[0]);
            PG8_WAIT_V(8); PG8_WAIT_L(0); PG8_BAR; PG8_MMA(1, 0, At, B0); PG8_MMA(1, 1, At, B1); PG8_BAR; PG8_SCHED;
        }
        if (wr == 0) PG8_BAR;
        E(acc, cur, wr, wc, fr, fq);
        if (!has_next) break;
#pragma unroll
        for (int a = 0; a < 2; ++a)
#pragma unroll
            for (int b = 0; b < 2; ++b)
#pragma unroll
                for (int m = 0; m < 4; ++m)
#pragma unroll
                    for (int n = 0; n < 2; ++n) acc[a][b][m][n] = (f32x4){0.f, 0.f, 0.f, 0.f};
        cur = nxt; cA = nA; cB = nB; ++ui;
        if (wr == 1) PG8_BAR;
    }
    PG8_WAIT_V(0);
    PG8_BAR;
#undef PG8_SA
#undef PG8_SB
#undef PG8_STAGE
#undef PG8_LDA
#undef PG8_LDB
#undef PG8_MMA
#undef PG8_WAIT_V
#undef PG8_WAIT_L
#undef PG8_BAR
#undef PG8_SCHED
}
}

namespace att {
constexpr int D = 128, NW = 8, QBLK = 32, KVBLK = 64, QB = NW * QBLK;
constexpr float SCALE = 0.08838834764831845f;
constexpr float THR = 8.f;
constexpr int SHM_V = KVBLK * D * 2, SHM_K = KVBLK * D * 2;
constexpr int ATT_LDS = 2 * SHM_V + 2 * SHM_K + NW * 256 * 4;
#define KSWZ(row, colB) ((row) * 256 + ((colB) ^ (((row) & 7) << 4)))
__device__ __forceinline__ int v_st(int k, int c) { const int kk = (k & ~0xC) | ((k & 4) << 1) | ((k & 8) >> 1); return ((kk >> 3) * 4 + (c >> 5)) * 512 + ((kk & 7) * 32 + (c & 31)) * 2; }
__device__ __forceinline__ int v_rd_base(int lane) { return ((lane & 3) << 3) | (((lane >> 2) & 3) << 6) | (((lane >> 4) & 1) << 5) | (((lane >> 5) & 1) << 8); }
constexpr int v_rd_off(int d0, int ks, int half) { return d0 * 512 + ks * 4096 + half * 2048; }
__device__ __forceinline__ int crow(int r, int hi) { return (r & 3) + 8 * (r >> 2) + 4 * hi; }
__device__ __forceinline__ bf16x8 load8(const bf16_t* p) { return *reinterpret_cast<const bf16x8*>(p); }
__device__ __forceinline__ void mask_tile(f32x16& p0, f32x16& p1, int dq, unsigned W) {
    const float NEG = -__builtin_inff();
#pragma unroll
    for (int r = 0; r < 16; ++r) {
        const int c = (r & 3) + 8 * (r >> 2);
        if ((unsigned)(dq - c) >= W) p0[r] = NEG;
        if ((unsigned)(dq - c - 32) >= W) p1[r] = NEG;
    }
}
__device__ __forceinline__ void partialSM(f32x16& p0, f32x16& p1, float& m_reg, float& mn, float& alpha) {
    float pmax = p0[0];
#pragma unroll
    for (int r = 1; r < 16; ++r) pmax = fmaxf(pmax, p0[r]);
#pragma unroll
    for (int r = 0; r < 16; ++r) pmax = fmaxf(pmax, p1[r]);
    { auto rr = __builtin_amdgcn_permlane32_swap(__float_as_uint(pmax), __float_as_uint(pmax), false, false);
      pmax = fmaxf(__uint_as_float(rr[0]), __uint_as_float(rr[1])); }
    constexpr float C2 = 1.4426950408889634f * SCALE;
    if (__builtin_expect(__all((pmax - m_reg) * SCALE <= THR), 1)) { mn = m_reg; alpha = 1.f; }
    else { mn = fmaxf(m_reg, pmax); alpha = __builtin_amdgcn_exp2f((m_reg - mn) * C2); m_reg = mn; }
    const float mnL = -mn * C2;
#pragma unroll
    for (int r = 0; r < 16; ++r) p0[r] = fmaf(p0[r], C2, mnL);
#pragma unroll
    for (int r = 0; r < 16; ++r) p1[r] = fmaf(p1[r], C2, mnL);
#pragma unroll
    for (int r = 0; r < 16; ++r) p0[r] = __builtin_amdgcn_exp2f(p0[r]);
}
__device__ __forceinline__ void finishSM(f32x16& p0, f32x16& p1, float alpha, float& l_reg, bf16x8& pa0, bf16x8& pa1, bf16x8& pa2, bf16x8& pa3) {
#pragma unroll
    for (int r = 0; r < 16; ++r) p1[r] = __builtin_amdgcn_exp2f(p1[r]);
    float ps = 0;
#pragma unroll
    for (int r = 0; r < 16; ++r) ps += p0[r];
#pragma unroll
    for (int r = 0; r < 16; ++r) ps += p1[r];
    { auto rr = __builtin_amdgcn_permlane32_swap(__float_as_uint(ps), __float_as_uint(ps), false, false);
      ps = __uint_as_float(rr[0]) + __uint_as_float(rr[1]); }
    l_reg = l_reg * alpha + ps;
#define PK4(P, B_, OUT) do { unsigned a0 = cvt_pk_bf16(P[B_+0], P[B_+1]), a1 = cvt_pk_bf16(P[B_+2], P[B_+3]);                          \
        unsigned b0 = cvt_pk_bf16(P[B_+4], P[B_+5]), b1 = cvt_pk_bf16(P[B_+6], P[B_+7]);                                             \
        auto r0 = __builtin_amdgcn_permlane32_swap(a0, b0, false, false); auto r1 = __builtin_amdgcn_permlane32_swap(a1, b1, false, false); \
        u32x4 w = {r0[0], r1[0], r0[1], r1[1]}; OUT = *reinterpret_cast<bf16x8*>(&w); } while (0)
    PK4(p0, 0, pa0); PK4(p0, 8, pa1); PK4(p1, 0, pa2); PK4(p1, 8, pa3);
#undef PK4
}
template <int KB>
__device__ __forceinline__ void qkt(f32x16& p0, f32x16& p1, const char* K_lds, int r32, int hi, const bf16x8* qr) {
    p0 = f32x16{}; p1 = f32x16{};
    const char* kb[4];
#pragma unroll
    for (int dd = 0; dd < 4; ++dd) kb[dd] = K_lds + KB * SHM_K + KSWZ(r32, (dd * 16 + hi * 8) * 2);
#pragma unroll
    for (int d0 = 0; d0 < 8; ++d0) { const char* a = kb[d0 & 3] + (d0 >> 2) * 128;
        bf16x8 b0 = *reinterpret_cast<const bf16x8*>(a);
        bf16x8 b1 = *reinterpret_cast<const bf16x8*>(a + 32 * 256);
        p0 = __builtin_amdgcn_mfma_f32_32x32x16_bf16(b0, qr[d0], p0, 0, 0, 0);
        p1 = __builtin_amdgcn_mfma_f32_32x32x16_bf16(b1, qr[d0], p1, 0, 0, 0); }
}
template <int VB>
__device__ __forceinline__ void pv_tile(f32x16* o, int vb0, bf16x8 pa0, bf16x8 pa1, bf16x8 pa2, bf16x8 pa3) {
#define TRRD(dst, off) asm volatile("ds_read_b64_tr_b16 %0, %1 offset:%2" : "=&v"(dst) : "v"(vb0), "i"(off) : "memory")
#define PV_D0(d0) do { s16x4 l0, l1, l2, l3, h0, h1, h2, h3; constexpr int b_ = VB * SHM_V + v_rd_off(d0, 0, 0); \
        TRRD(l0, b_); TRRD(h0, b_ + 2048); TRRD(l1, b_ + 4096); TRRD(h1, b_ + 6144); TRRD(l2, b_ + 8192); TRRD(h2, b_ + 10240); TRRD(l3, b_ + 12288); TRRD(h3, b_ + 14336); \
        asm volatile("s_waitcnt lgkmcnt(0)" ::: "memory"); SBAR(); \
        o[d0] = __builtin_amdgcn_mfma_f32_32x32x16_bf16(pa0, (bf16x8){l0[0], l0[1], l0[2], l0[3], h0[0], h0[1], h0[2], h0[3]}, o[d0], 0, 0, 0);   \
        o[d0] = __builtin_amdgcn_mfma_f32_32x32x16_bf16(pa1, (bf16x8){l1[0], l1[1], l1[2], l1[3], h1[0], h1[1], h1[2], h1[3]}, o[d0], 0, 0, 0);   \
        o[d0] = __builtin_amdgcn_mfma_f32_32x32x16_bf16(pa2, (bf16x8){l2[0], l2[1], l2[2], l2[3], h2[0], h2[1], h2[2], h2[3]}, o[d0], 0, 0, 0);   \
        o[d0] = __builtin_amdgcn_mfma_f32_32x32x16_bf16(pa3, (bf16x8){l3[0], l3[1], l3[2], l3[3], h3[0], h3[1], h3[2], h3[3]}, o[d0], 0, 0, 0); } while (0)
    PV_D0(0); PV_D0(1); PV_D0(2); PV_D0(3);
#undef PV_D0
#undef TRRD
}
struct BlockRef { const bf16_t* Q; const bf16_t* K; const bf16_t* V; bf16_t* O; const unsigned* sel; const unsigned* list; float* ML; int P0, jlo, nvalid, nblk, hb; };
struct Seam { bf16x8 qr[8]; bf16x8 st_v0, st_v1, st_k0, st_k1; unsigned sel, qrow; };
#define ROW(p, k0, rr) ((p) + (size_t)((k0) + (rr)) * D + sc)
#define VMWN(n) asm volatile("s_waitcnt vmcnt(%0)" :: "i"(n) : "memory")
#define SLOAD_H(Kp, Vp, k0) do { S.st_v0 = load8(ROW(Vp, k0, sr)); S.st_v1 = load8(ROW(Vp, k0, 32 + sr));              \
                         S.st_k0 = load8(ROW(Kp, k0, sr)); S.st_k1 = load8(ROW(Kp, k0, 32 + sr)); } while (0)
#define SWRITE_HK(bf) do { *(bf16x8*)(K_lds + (bf) * SHM_K + kws) = S.st_k0; *(bf16x8*)(K_lds + (bf) * SHM_K + kws + 32 * 256) = S.st_k1; } while (0)
#define SWRITE_HV(bf) do { *(bf16x8*)(V_lds + (bf) * SHM_V + vst0) = S.st_v0; *(bf16x8*)(V_lds + (bf) * SHM_V + vst1) = S.st_v1; } while (0)
#define SWRITE_H(bf) do { SWRITE_HV(bf); SWRITE_HK(bf); } while (0)
template <bool SP>
__device__ __forceinline__ void attn_prime(const BlockRef& cur, char* lds, Seam& S) {
    int tid = threadIdx.x; asm volatile("" : "+v"(tid));
    const int wid = __builtin_amdgcn_readfirstlane(tid >> 6), lane = tid & 63, r32 = lane & 31, hi = lane >> 5;
    const int sr = tid >> 4, sc = (tid & 15) * 8, kws = KSWZ(sr, sc * 2); char* K_lds = lds + 2 * SHM_V;
    const int i = wid * QBLK + r32;
    unsigned q = (unsigned)i;
    if (SP) q = cur.list ? cur.list[i < cur.nvalid ? i : cur.nvalid - 1] : (unsigned)(cur.P0 + i);
    S.qrow = q; S.sel = SP ? cur.sel[q] : 0u;
#pragma unroll
    for (int d0 = 0; d0 < 8; ++d0) S.qr[d0] = load8(cur.Q + (size_t)q * D + d0 * 16 + hi * 8);
    SLOAD_H(cur.K, cur.V, SP ? cur.jlo * KVBLK : 0); VM_WAIT(); SWRITE_HK(0);
    __syncthreads();
}
template <bool SP>
__device__ __forceinline__ void attn_block(const BlockRef& cur, const BlockRef& nxt, const int ostride, char* lds, Seam& S) {
    int tid = threadIdx.x; asm volatile("" : "+v"(tid));
    const int wid = __builtin_amdgcn_readfirstlane(tid >> 6), lane = tid & 63, r32 = lane & 31, hi = lane >> 5;
    const int NT = SP ? 4 : cur.P0 / KVBLK + 4;
    const int jlo = SP ? cur.jlo : 0;
    const int qlo = cur.P0 + wid * QBLK, qm = qlo + r32 - 4 * hi;
    char* V_lds = lds; char* K_lds = lds + 2 * SHM_V;
    float* ws = (float*)(lds + 2 * SHM_V + 2 * SHM_K) + wid * 256; float* li_l = ws, * al_l = ws + 32;
    unsigned* rd = (unsigned*)(ws + 64); unsigned* nl = (unsigned*)(ws + 96);
    float m_reg = -1e30f, l_reg = 0; f32x16 o[4] = {};
    const int sr = tid >> 4, sc = (tid & 15) * 8, vst0 = v_st(sr, sc), vst1 = v_st(32 + sr, sc), kws = KSWZ(sr, sc * 2);
    const int vb0 = (int)(uintptr_t)V_lds + v_rd_base(lane);
    const bf16_t* Kh = cur.K; const bf16_t* Vh = cur.V;
    const bool causal = !SP || cur.list == nullptr;
#define RESC(a) do { if (__any((a) < 1.f)) { if (hi == 0) al_l[r32] = (a); asm volatile("s_waitcnt lgkmcnt(0)" ::: "memory");              \
                     for (int d_ = 0; d_ < 4; ++d_) for (int r = 0; r < 16; ++r) o[d_][r] *= al_l[crow(r, hi)]; } } while (0)
#define KBASE(t) ((jlo + (t)) * KVBLK)
#define MASKT(P0_, P1_, t) do { const int kb_ = KBASE(t); if (causal && kb_ + KVBLK - 1 > qlo) mask_tile(P0_, P1_, qm - kb_, 0x40000000u); } while (0)
    constexpr int NQL = 8;
#define SEAM_K0() do { VMWN(NQL); SWRITE_HK(0); SBAR(); } while (0)
    f32x16 pA0, pA1, pB0, pB1; float mnA, mnB, alA, alB; bf16x8 pa0, pa1, pa2, pa3;
    unsigned qn_tmp = 0u;
    if (SP) {
        if (hi == 0) { const bool valid = (cur.list == nullptr) || (wid * QBLK + r32 < cur.nvalid);
            const unsigned slot = cur.list ? (unsigned)__builtin_popcount(S.sel & ((1u << cur.nblk) - 1u)) : 3u;
            rd[r32] = valid ? (((unsigned)cur.hb + S.qrow) * 4u + slot) * 128u : (1u << 27); }
        if (nxt.list) { const int i = wid * QBLK + r32; qn_tmp = nxt.list[i < nxt.nvalid ? i : nxt.nvalid - 1]; }
    }
    SWRITE_HV(0); SBAR();
    if (NT > 1) { SLOAD_H(Kh, Vh, KBASE(1)); }
    SBAR(); qkt<0>(pA0, pA1, K_lds, r32, hi, S.qr);
    MASKT(pA0, pA1, 0); partialSM(pA0, pA1, m_reg, mnA, alA);
    if (NT > 1) { VM_WAIT(); SWRITE_H(1); }
    if (SP) nl[lane] = nxt.list ? qn_tmp : (unsigned)(nxt.P0 + wid * QBLK + r32);
    __syncthreads();
#define HALF_STEP(PX0, PX1, mnX, alX, PY0, PY1, alY, t, KB, VB, SB) do {                                                      \
        SBAR(); qkt<KB>(PX0, PX1, K_lds, r32, hi, S.qr);                                                                      \
        finishSM(PY0, PY1, alY, l_reg, pa0, pa1, pa2, pa3); SBAR();                                                           \
        if ((t) + 1 < NT) { SLOAD_H(Kh, Vh, KBASE((t) + 1)); SBAR(); }                                                        \
        pv_tile<VB>(o, vb0, pa0, pa1, pa2, pa3); MASKT(PX0, PX1, (t)); partialSM(PX0, PX1, m_reg, mnX, alX);                  \
        __syncthreads();                                                                                                      \
        if ((t) + 1 < NT) { VM_WAIT(); SWRITE_H(SB); }                                                                        \
        RESC(alX); __syncthreads(); } while (0)
    for (int t = 1; t + 1 < NT; t += 2) {
        HALF_STEP(pB0, pB1, mnB, alB, pA0, pA1, alA, t, 1, 0, 0);
        HALF_STEP(pA0, pA1, mnA, alA, pB0, pB1, alB, t + 1, 0, 1, 1);
    }
    const bool even = (NT & 1) == 0;
    if (even) { SBAR(); qkt<1>(pB0, pB1, K_lds, r32, hi, S.qr); SBAR(); }
    unsigned qn = (unsigned)(wid * QBLK + r32);
    if (SP) { qn = nl[lane]; S.qrow = qn; S.sel = nxt.sel[qn]; }
    SLOAD_H(nxt.K, nxt.V, SP ? nxt.jlo * KVBLK : 0); SBAR();
#pragma unroll
    for (int d0 = 0; d0 < 8; ++d0) S.qr[d0] = load8(nxt.Q + (size_t)qn * D + d0 * 16 + hi * 8);
    SBAR();
    finishSM(pA0, pA1, alA, l_reg, pa0, pa1, pa2, pa3); SBAR();
    pv_tile<0>(o, vb0, pa0, pa1, pa2, pa3);
    if (even) { MASKT(pB0, pB1, NT - 1); partialSM(pB0, pB1, m_reg, mnB, alB); __syncthreads(); RESC(alB);
        finishSM(pB0, pB1, alB, l_reg, pa0, pa1, pa2, pa3); SBAR(); pv_tile<1>(o, vb0, pa0, pa1, pa2, pa3); }
    SBAR(); SEAM_K0();
    if (hi == 0) li_l[r32] = l_reg; asm volatile("s_waitcnt lgkmcnt(0)" ::: "memory");
    float rli[16];
#pragma unroll
    for (int r = 0; r < 16; ++r) rli[r] = __builtin_amdgcn_rcpf(li_l[crow(r, hi)]);
    if (SP) {
        bf16_t* Ob = cur.O;
#pragma unroll
        for (int r = 0; r < 16; ++r) { const unsigned off = rd[crow(r, hi)];
#pragma unroll
            for (int d0 = 0; d0 < 4; ++d0) { const float v = o[d0][r] * rli[r];
                const float vn = __int_as_float(__builtin_amdgcn_mov_dpp(__float_as_int(v), 0xB1, 0xF, 0xF, true));
                if ((r32 & 1) == 0) *(unsigned*)(Ob + (size_t)off + d0 * 32 + r32) = cvt_pk_bf16(v, vn); } }
        if (hi == 0) { float* mlp = cur.ML + (size_t)(rd[r32] >> 7) * 2; f32x2 ml = {m_reg, l_reg}; *(f32x2*)mlp = ml; }
    } else {
        bf16_t* Ow = cur.O + (size_t)(wid * QBLK) * ostride;
#pragma unroll
        for (int r = 0; r < 16; ++r) { const int orow = crow(r, hi);
#pragma unroll
            for (int d0 = 0; d0 < 4; ++d0) { const float v = o[d0][r] * rli[r];
                const float vn = __int_as_float(__builtin_amdgcn_mov_dpp(__float_as_int(v), 0xB1, 0xF, 0xF, true));
                if ((r32 & 1) == 0) *(unsigned*)(Ow + (size_t)orow * ostride + d0 * 32 + r32) = cvt_pk_bf16(v, vn); } }
    }
    __syncthreads();
#undef RESC
#undef KBASE
#undef MASKT
#undef SEAM_K0
#undef HALF_STEP
}
#undef ROW
#undef VMWN
#undef SLOAD_H
#undef SWRITE_HK
#undef SWRITE_HV
#undef SWRITE_H
}

struct Args { const float* in[23]; float* out; unsigned char* ws; int ph_lo, ph_hi; };
typedef const __attribute__((address_space(4))) Args* KArgs;
__device__ __forceinline__ KArgs kargs() { KArgs p = (KArgs)__builtin_amdgcn_kernarg_segment_ptr(); asm volatile("" : "+s"(p)); return p; }
__device__ __forceinline__ int otid() { int t = threadIdx.x; asm volatile("" : "+v"(t)); return t; }
struct Geo { int G, bx, vcu, gw, NGW; };
__device__ __forceinline__ Geo geo() {
    Geo g; const int tid = otid(); const int wave = __builtin_amdgcn_readfirstlane(tid >> 6);
    g.G = gridDim.x; g.bx = blockIdx.x; g.vcu = (g.G % 8 == 0) ? (g.bx % 8) * (g.G / 8) + g.bx / 8 : g.bx; g.gw = g.vcu * NWAVES + wave; g.NGW = g.G * NWAVES; return g;
}
enum { I_X = 0, I_POS, I_LN1G, I_LN1B, I_LN2G, I_LN2B, I_DAWIN, I_DAWOUT, I_LQ1, I_LK1, I_LQ2, I_LK2, I_SUBLN, I_MBWIN, I_MBWOUT, I_WR, I_RB, I_WG, I_WU, I_WD, I_SG, I_SU, I_SD };

__device__ __forceinline__ int dst_row(int kind, int n) {
    if (kind == 1) { if (n < 4096) { int d = n & 127; const int h = n & ~127; if (d < 16) d = 2 * d; else if (d < 32) d = 2 * (d - 16) + 1; return h + d; } return n; }
    if (kind == 2) return ((n >> 7) << 8) + (n & 127);
    if (kind == 3) return ((n >> 7) << 8) + 128 + (n & 127);
    return n;
}
struct TrDesc { const float* W; unsigned char* WT; int K, N, k0, n0, kind, f8; };
constexpr int IT_IN = 32 * 192, IT_OUT = 32 * 64, IT_E = 512, IT_ATT = 2 * IT_IN + 2 * IT_OUT, IT_TOTAL = IT_ATT + 2 * NEX * 3 * IT_E;
__device__ __forceinline__ void tr_decode(KArgs a, int it, TrDesc& d) {
    unsigned char* ws = a->ws; int s;
    if (it < IT_ATT) {
        if (it < IT_IN) { d.W = a->in[I_DAWIN]; d.WT = ws + WS_WATT; d.K = DM; d.N = NQKV; d.kind = 1; d.f8 = FP8_QKV0; s = it; }
        else if (it < 2 * IT_IN) { d.W = a->in[I_MBWIN]; d.WT = ws + WS_WATT + 32 * MiB; d.K = DM; d.N = NQKV; d.kind = 1; d.f8 = FP8_QKV1; s = it - IT_IN; }
        else if (it < 2 * IT_IN + IT_OUT) { d.W = a->in[I_DAWOUT]; d.WT = ws + WS_WATT + 24 * MiB; d.K = DM; d.N = DM; d.kind = 0; d.f8 = FP8_OUT0; s = it - 2 * IT_IN; }
        else { d.W = a->in[I_MBWOUT]; d.WT = ws + WS_WATT + 56 * MiB; d.K = DM; d.N = DM; d.kind = 0; d.f8 = FP8_OUT1; s = it - 2 * IT_IN - IT_OUT; }
    } else {
        const int r = it - IT_ATT, le = r / (3 * IT_E), sub = r - le * (3 * IT_E), mtx = sub / IT_E; s = sub - mtx * IT_E;
        const int l = le / NEX, e = le - l * NEX;
        const size_t EW = (size_t)DM * DE;
        if (mtx < 2) {
            const float* src = (e < NE) ? a->in[mtx == 0 ? I_WG : I_WU] + ((size_t)l * NE + e) * EW : a->in[mtx == 0 ? I_SG : I_SU] + (size_t)l * EW;
            d.f8 = MOE_F8(l);
            d.W = src; d.WT = ws + WS_WGU + (size_t)l * NEX * (2 * EW) * 2 + (size_t)e * (2 * EW) * (d.f8 ? 1 : 2); d.K = DM; d.N = DE; d.kind = 2 + mtx;
        } else {
            const float* src = (e < NE) ? a->in[I_WD] + ((size_t)l * NE + e) * EW : a->in[I_SD] + (size_t)l * EW;
            d.f8 = MOE_F8(l);
            d.W = src; d.WT = ws + WS_WD + (size_t)l * NEX * EW * 2 + (size_t)e * EW * (d.f8 ? 1 : 2); d.K = DE; d.N = DM; d.kind = 0;
        }
    }
    const int nblk = d.N / 32; const int kb = s / nblk; d.k0 = kb * 64; d.n0 = (s - kb * nblk) * 32;
}
__device__ __forceinline__ void tr_load(const TrDesc& d, int lane, f32x4 (&v)[8]) {
    const int kk = lane >> 3, n4 = (lane & 7) * 4;
#pragma unroll
    for (int i = 0; i < 8; ++i) v[i] = *(const f32x4*)(d.W + (size_t)(d.k0 + kk + 8 * i) * d.N + d.n0 + n4);
}
__device__ __forceinline__ void tr_store(const TrDesc& d, int lane, const f32x4 (&v)[8], LAS float* scr) {
    const int kk = lane >> 3, n4 = (lane & 7) * 4, c = lane & 3;
#pragma unroll
    for (int hf = 0; hf < 2; ++hf) {
#pragma unroll
        for (int i = 0; i < 4; ++i)
#pragma unroll
            for (int q = 0; q < 4; ++q) scr[(kk + 8 * i) * 33 + n4 + q] = v[hf * 4 + i][q];
        LDS_WAIT();
#pragma unroll
        for (int j = 0; j < 2; ++j) { const int n = (lane >> 2) + 16 * j; const LAS float* s = scr + (8 * c) * 33 + n;
            const size_t eo = (size_t)dst_row(d.kind, d.n0 + n) * d.K + d.k0 + hf * 32 + 8 * c;
            if (d.f8) { u32x2 o; o.x = pk4_fp8(s[0 * 33] * W8_SCALE, s[1 * 33] * W8_SCALE, s[2 * 33] * W8_SCALE, s[3 * 33] * W8_SCALE); o.y = pk4_fp8(s[4 * 33] * W8_SCALE, s[5 * 33] * W8_SCALE, s[6 * 33] * W8_SCALE, s[7 * 33] * W8_SCALE);
                *(u32x2*)(d.WT + eo) = o; }
            else { u32x4 o; o.x = cvt_pk_bf16(s[0 * 33], s[1 * 33]); o.y = cvt_pk_bf16(s[2 * 33], s[3 * 33]); o.z = cvt_pk_bf16(s[4 * 33], s[5 * 33]); o.w = cvt_pk_bf16(s[6 * 33], s[7 * 33]);
                *(u32x4*)(d.WT + eo * 2) = o; } }
        LDS_WAIT();
    }
}
__device__ __forceinline__ void convert_items(KArgs a, LAS float* scr, int gw, int NGW, int lane, int it0, int it1) {
    TrDesc dA, dB, dC; f32x4 vA[8], vB[8], vC[8];
    int it = it0 + gw;
#define CV_LD(D, V, IT) do { if ((IT) < it1) { tr_decode(a, (IT), D); tr_load(D, lane, V); } } while (0)
    CV_LD(dA, vA, it); CV_LD(dB, vB, it + NGW); CV_LD(dC, vC, it + 2 * NGW);
    while (it < it1) {
        tr_store(dA, lane, vA, scr); CV_LD(dA, vA, it + 3 * NGW);
        if (it + NGW < it1) { tr_store(dB, lane, vB, scr); CV_LD(dB, vB, it + 4 * NGW); }
        if (it + 2 * NGW < it1) { tr_store(dC, lane, vC, scr); CV_LD(dC, vC, it + 5 * NGW); }
        it += 3 * NGW;
    }
#undef CV_LD
}
__device__ __forceinline__ void p0_prologue(KArgs a, LAS unsigned char* lds, int gw, int NGW, int wave, int lane) {
    LAS float* scr = (LAS float*)(lds + wave * 4224);
    convert_items(a, scr, gw, NGW, lane, 0, IT_IN);
    {
        const float* x = a->in[I_X]; bf16_t* xb = (bf16_t*)(a->ws + WS_XB);
        f32x4 vn[8];
        if (gw < NTOK) {
#pragma unroll
            for (int j = 0; j < 4; ++j) { vn[2 * j] = *(const f32x4*)(x + (size_t)gw * DM + 512 * j + 8 * lane); vn[2 * j + 1] = *(const f32x4*)(x + (size_t)gw * DM + 512 * j + 8 * lane + 4); } }
        for (int m = gw; m < NTOK; m += NGW) {
            f32x4 v[8];
#pragma unroll
            for (int j = 0; j < 8; ++j) v[j] = vn[j];
            if (m + NGW < NTOK) {
#pragma unroll
                for (int j = 0; j < 4; ++j) { vn[2 * j] = *(const f32x4*)(x + (size_t)(m + NGW) * DM + 512 * j + 8 * lane); vn[2 * j + 1] = *(const f32x4*)(x + (size_t)(m + NGW) * DM + 512 * j + 8 * lane + 4); } }
#pragma unroll
            for (int j = 0; j < 4; ++j) {
                if (FP8_QKV0) { u32x2 w; w.x = pk4_fp8(v[2 * j][0], v[2 * j][1], v[2 * j][2], v[2 * j][3]); w.y = pk4_fp8(v[2 * j + 1][0], v[2 * j + 1][1], v[2 * j + 1][2], v[2 * j + 1][3]);
                    *(u32x2*)((unsigned char*)xb + (size_t)m * DM + 512 * j + 8 * lane) = w; }
                else { u32x4 w; w.x = cvt_pk_bf16(v[2 * j][0], v[2 * j][1]); w.y = cvt_pk_bf16(v[2 * j][2], v[2 * j][3]); w.z = cvt_pk_bf16(v[2 * j + 1][0], v[2 * j + 1][1]); w.w = cvt_pk_bf16(v[2 * j + 1][2], v[2 * j + 1][3]);
                    *(u32x4*)(xb + (size_t)m * DM + 512 * j + 8 * lane) = w; } }
        }
    }
    {
        bf16_t* wf = (bf16_t*)(a->ws + WS_WRF);
        for (int idx = gw * 64 + lane; idx < 2 * 2 * 128 * 64; idx += NGW * 64) {
            const int ln = idx & 63, s = (idx >> 6) & 127, blk = (idx >> 13) & 1, l = idx >> 14;
            const int e = blk * 32 + (ln & 31), c = 16 * s + 8 * (ln >> 5);
            const float* w = a->in[I_WR] + ((size_t)l * DM + c) * NE + e;
            float v[8];
#pragma unroll
            for (int j = 0; j < 8; ++j) v[j] = w[(size_t)j * NE];
            u32x4 h, lo;
            h.x = cvt_pk_bf16(v[0], v[1]); h.y = cvt_pk_bf16(v[2], v[3]); h.z = cvt_pk_bf16(v[4], v[5]); h.w = cvt_pk_bf16(v[6], v[7]);
            lo.x = cvt_pk_bf16(v[0] - bf_lo(h.x), v[1] - bf_hi(h.x)); lo.y = cvt_pk_bf16(v[2] - bf_lo(h.y), v[3] - bf_hi(h.y));
            lo.z = cvt_pk_bf16(v[4] - bf_lo(h.z), v[5] - bf_hi(h.z)); lo.w = cvt_pk_bf16(v[6] - bf_lo(h.w), v[7] - bf_hi(h.w));
            const size_t fo = (((size_t)(l * 2 + 0) * 2 + blk) * 128 + s) * 64 + ln, fl = (((size_t)(l * 2 + 1) * 2 + blk) * 128 + s) * 64 + ln;
            *(u32x4*)(wf + fo * 8) = h; *(u32x4*)(wf + fl * 8) = lo;
        }
    }
    {
        const int* pos = (const int*)a->in[I_POS]; float* tab = (float*)(a->ws + WS_ROPE);
        for (int idx = gw * 64 + lane; idx < NTOK * 16; idx += NGW * 64) {
            const int t = idx >> 4, i = idx & 15;
            const float inv = powf(500000.f, -(float)(2 * i) / 32.f);
            const float ang = (float)pos[t] * inv;
            double rev = (double)ang * 0.15915494309189535; rev -= floor(rev);
            const float fr = (float)rev;
            tab[(size_t)t * 32 + i] = __builtin_amdgcn_cosf(fr); tab[(size_t)t * 32 + 16 + i] = __builtin_amdgcn_sinf(fr);
        }
    }
}

__device__ __forceinline__ void da_combine(KArgs a, int gw, int NGW, int lane) {
    float lam;
    {   const float* q1 = a->in[I_LQ1]; const float* k1 = a->in[I_LK1]; const float* q2 = a->in[I_LQ2]; const float* k2 = a->in[I_LK2];
        const float s1 = wave_sum(q1[lane] * k1[lane] + q1[lane + 64] * k1[lane + 64]);
        const float s2 = wave_sum(q2[lane] * k2[lane] + q2[lane + 64] * k2[lane + 64]);
        lam = expf(s1) - expf(s2) + LAMBDA_INIT; }
    const bf16_t* O = (const bf16_t*)(a->ws + WS_O); bf16_t* AO = (bf16_t*)(a->ws + WS_AOUT);
    const f32x4 g = *(const f32x4*)(a->in[I_SUBLN] + 4 * lane);
    for (int t = gw; t < NTOK; t += NGW) {
        const bf16_t* row = O + (size_t)t * 4096;
        u32x2 x1[8], x2[8];
#pragma unroll
        for (int h = 0; h < 8; ++h) { x1[h] = *(const u32x2*)(row + h * 512 + 4 * lane); x2[h] = *(const u32x2*)(row + h * 512 + 256 + 4 * lane); }
#pragma unroll
        for (int h = 0; h < 8; ++h) {
            f32x4 o;
            o[0] = bf_lo(x1[h].x) - lam * bf_lo(x2[h].x); o[1] = bf_hi(x1[h].x) - lam * bf_hi(x2[h].x);
            o[2] = bf_lo(x1[h].y) - lam * bf_lo(x2[h].y); o[3] = bf_hi(x1[h].y) - lam * bf_hi(x2[h].y);
            const float ss = wave_sum(o[0] * o[0] + o[1] * o[1] + o[2] * o[2] + o[3] * o[3]);
            const float sc = __builtin_amdgcn_rsqf(ss * (1.f / 256.f) + LN_EPS) * (1.f - LAMBDA_INIT);
            if (FP8_OUT0) { const float s8 = sc * AO8_SCALE; *(unsigned*)((unsigned char*)AO + (size_t)t * DM + h * 256 + 4 * lane) = pk4_fp8(o[0] * s8 * g[0], o[1] * s8 * g[1], o[2] * s8 * g[2], o[3] * s8 * g[3]); }
            else { u32x2 w; w.x = cvt_pk_bf16(o[0] * sc * g[0], o[1] * sc * g[1]); w.y = cvt_pk_bf16(o[2] * sc * g[2], o[3] * sc * g[3]);
                *(u32x2*)(AO + (size_t)t * DM + h * 256 + 4 * lane) = w; }
        }
    }
}

__device__ __forceinline__ void moba_kmean(KArgs a, int gw, int NGW, int lane) {
    const bf16_t* Kb = (const bf16_t*)(a->ws + WS_K); bf16_t* km = (bf16_t*)(a->ws + WS_KMEAN);
    for (int it = gw; it < BATCH * NSLAB * 32; it += NGW) {
        const int bh = it >> 5, n = it & 31;
        const bf16_t* p = Kb + ((size_t)bh * SEQ + (size_t)n * 256) * HD + 2 * lane;
        float s0 = 0.f, s1 = 0.f;
#pragma unroll 4
        for (int r = 0; r < 256; r += 8) {
            unsigned u[8];
#pragma unroll
            for (int q = 0; q < 8; ++q) u[q] = *(const unsigned*)(p + (size_t)(r + q) * HD);
#pragma unroll
            for (int q = 0; q < 8; ++q) { s0 += bf_lo(u[q]); s1 += bf_hi(u[q]); }
        }
        s0 *= (1.f / 256.f); s1 *= (1.f / 256.f);
        const unsigned hi = cvt_pk_bf16(s0, s1);
        const unsigned lo = cvt_pk_bf16(s0 - bf_lo(hi), s1 - bf_hi(hi));
        *(unsigned*)(km + ((size_t)bh * 64 + n) * HD + 2 * lane) = hi;
        *(unsigned*)(km + ((size_t)bh * 64 + 32 + n) * HD + 2 * lane) = lo;
    }
}
__device__ __forceinline__ void moba_gate(KArgs a, int gw, int NGW, int lane) {
    const bf16_t* Qb = (const bf16_t*)(a->ws + WS_Q); const bf16_t* km = (const bf16_t*)(a->ws + WS_KMEAN); unsigned* sel = (unsigned*)(a->ws + WS_SEL);
    unsigned* mcnt = (unsigned*)(a->ws + WS_CTL) + CW_MCNT; unsigned* qlist = (unsigned*)(a->ws + WS_QLIST);
    const int r32 = lane & 31, hi = lane >> 5;
    for (int it = gw; it < BATCH * NSLAB * (SEQ / 32); it += NGW) {
        const int bh = it >> 8, qg = it & 255, j = qg >> 3;
        const bf16_t* q = Qb + ((size_t)bh * SEQ + (size_t)qg * 32 + r32) * HD + hi * 8;
        const bf16_t* k = km + ((size_t)bh * 64 + r32) * HD + hi * 8;
        f32x16 p = {};
        bf16x8 qf[8], kh[8], kl[8];
#pragma unroll
        for (int d0 = 0; d0 < 8; ++d0) { qf[d0] = *(const bf16x8*)(q + d0 * 16); kh[d0] = *(const bf16x8*)(k + d0 * 16); kl[d0] = *(const bf16x8*)(k + 32 * HD + d0 * 16); }
        SBAR();
#pragma unroll
        for (int d0 = 0; d0 < 8; ++d0) {
            p = __builtin_amdgcn_mfma_f32_32x32x16_bf16(kh[d0], qf[d0], p, 0, 0, 0);
            p = __builtin_amdgcn_mfma_f32_32x32x16_bf16(kl[d0], qf[d0], p, 0, 0, 0);
        }
        float g[32];
#pragma unroll
        for (int r = 0; r < 16; ++r) {
            const float mine = p[r], other = __shfl_xor(mine, 32);
            const int qd = r >> 2, s = r & 3;
            g[8 * qd + s] = hi ? other : mine;
            g[8 * qd + 4 + s] = hi ? mine : other;
        }
        unsigned mask = 0u;
#pragma unroll
        for (int pass = 0; pass < 3; ++pass) {
            float best = -__builtin_inff(); int bi = -1;
#pragma unroll
            for (int n = 0; n < 32; ++n) { const bool ok = (n < j) && !((mask >> n) & 1u) && (g[n] > best); best = ok ? g[n] : best; bi = ok ? n : bi; }
            if (bi >= 0) mask |= 1u << bi;
        }
        if (hi == 0) sel[(size_t)bh * SEQ + (size_t)qg * 32 + r32] = mask;
        const bool rowlane = hi == 0;
        unsigned cntv = 0u;
        for (int n = 0; n < j; ++n) { const unsigned long long bb = __ballot(rowlane && ((mask >> n) & 1u)); if (lane == n) cntv = (unsigned)__popcll(bb); }
        unsigned basev = 0u;
        if (lane < j && cntv) basev = __hip_atomic_fetch_add(mcnt + bh * 32 + lane, cntv, __ATOMIC_RELAXED, __HIP_MEMORY_SCOPE_AGENT);
        for (int n = 0; n < j; ++n) { const unsigned long long bb = __ballot(rowlane && ((mask >> n) & 1u)); const unsigned base = (unsigned)__builtin_amdgcn_readlane((int)basev, n);
            if (rowlane && ((mask >> n) & 1u)) qlist[(size_t)(bh * 32 + n) * SEQ + base + (unsigned)__popcll(bb & ((1ull << lane) - 1ull))] = (unsigned)(qg * 32 + r32); }
    }
}

__device__ __forceinline__ void ln_router(KArgs a, int layer, LAS unsigned char* lds, int vcu, int G, int wave, int lane) {
    float* out = a->out; bf16_t* xb = (bf16_t*)(a->ws + WS_XB);
    const float* gam = a->in[I_LN1G] + layer * DM; const float* bet = a->in[I_LN1B] + layer * DM;
    const float rb = a->in[I_RB][layer * NE + lane];
    const bf16_t* wfh = (const bf16_t*)(a->ws + WS_WRF) + (size_t)(layer * 2 + 0) * 2 * 128 * 64 * 8;
    const bf16_t* wfl = (const bf16_t*)(a->ws + WS_WRF) + (size_t)(layer * 2 + 1) * 2 * 128 * 64 * 8;
    unsigned* gcount = (unsigned*)(a->ws + WS_CTL) + CW_CNT + layer * NE * 16;
    unsigned* list = (unsigned*)(a->ws + WS_LIST); unsigned* toke = (unsigned*)(a->ws + WS_TOKE); float* tokw = (float*)(a->ws + WS_TOKW);
    LAS unsigned char* xh = lds;
    LAS unsigned char* xl = lds + 65536;
    LAS float* part = (LAS float*)lds;
    LAS int* lcount = (LAS int*)(lds + LT_LCNT); LAS int* lbase = (LAS int*)(lds + LT_LBASE);
    LAS unsigned* ent = (LAS unsigned*)(lds + LT_ENT);
    const int t_beg = vcu * 64;
    if (threadIdx.x < 64) lcount[threadIdx.x] = 0;
    const int n32 = lane & 31, h5 = lane >> 5;
    f32x4 vn[8], gg[8], bb[8];
    {   const float* yr = out + (size_t)(t_beg + wave * 2) * DM;
#pragma unroll
        for (int j = 0; j < 8; ++j) vn[j] = *(const f32x4*)(yr + 256 * j + 4 * lane);
#pragma unroll
        for (int j = 0; j < 8; ++j) { gg[j] = *(const f32x4*)(gam + 256 * j + 4 * lane); bb[j] = *(const f32x4*)(bet + 256 * j + 4 * lane); } }
    __syncthreads();
#pragma unroll 1
    for (int it = 0; it < 4; ++it) {
#pragma unroll 1
        for (int k = 0; k < 2; ++k) {
            const int lt = 2 * wave + k, t = t_beg + 16 * it + lt; float* yr = out + (size_t)t * DM;
            f32x4 v[8]; float s = 0.f;
#pragma unroll
            for (int j = 0; j < 8; ++j) { v[j] = vn[j]; s += (v[j][0] + v[j][1]) + (v[j][2] + v[j][3]); }
            {
                const int tn = (k == 0) ? t + 1 : t + 15;
                if (k == 0 || it < 3) { const float* yn = out + (size_t)tn * DM;
#pragma unroll
                    for (int j = 0; j < 8; ++j) vn[j] = *(const f32x4*)(yn + 256 * j + 4 * lane); } }
            const float mean = wave_sum(s) * (1.f / DM); float s2 = 0.f;
#pragma unroll
            for (int j = 0; j < 8; ++j) { v[j] = v[j] - mean; s2 += (v[j][0] * v[j][0] + v[j][1] * v[j][1]) + (v[j][2] * v[j][2] + v[j][3] * v[j][3]); }
            const float rstd = __builtin_amdgcn_rsqf(wave_sum(s2) * (1.f / DM) + LN_EPS);
#pragma unroll
            for (int j = 0; j < 8; ++j) {
                const f32x4 xv = v[j] * rstd * gg[j] + bb[j];
                *(f32x4*)(yr + 256 * j + 4 * lane) = xv;
                u32x2 w; w.x = cvt_pk_bf16(xv[0], xv[1]); w.y = cvt_pk_bf16(xv[2], xv[3]);
                if (MOE_F8(layer)) *(unsigned*)((unsigned char*)xb + (size_t)t * DM + 256 * j + 4 * lane) = pk4_fp8(xv[0], xv[1], xv[2], xv[3]);
                else *(u32x2*)(xb + (size_t)t * DM + 256 * j + 4 * lane) = w;
                u32x2 wl; wl.x = cvt_pk_bf16(xv[0] - bf_lo(w.x), xv[1] - bf_hi(w.x)); wl.y = cvt_pk_bf16(xv[2] - bf_lo(w.y), xv[3] - bf_hi(w.y));
                const int chunk = 32 * j + (lane >> 1), sw = lt * 4096 + ((chunk ^ lt) << 4) + 8 * (lane & 1);
                *(LAS u32x2*)(xh + sw) = w;
                *(LAS u32x2*)(xl + sw) = wl;
            }
        }
        __syncthreads();
        f32x16 acc0 = {}, acc1 = {};
        {
            const int row = n32 & 15;
            const bf16_t* wh0 = wfh + ((size_t)(0 * 128 + wave * 16) * 64 + lane) * 8; const bf16_t* wh1 = wfh + ((size_t)(1 * 128 + wave * 16) * 64 + lane) * 8;
            const bf16_t* wl0 = wfl + ((size_t)(0 * 128 + wave * 16) * 64 + lane) * 8; const bf16_t* wl1 = wfl + ((size_t)(1 * 128 + wave * 16) * 64 + lane) * 8;
#pragma unroll 1
            for (int sg = 0; sg < 16; sg += 4) {
                bf16x8 ah0[4], ah1[4], al0[4], al1[4];
#pragma unroll
                for (int u = 0; u < 4; ++u) { const int s = sg + u; ah0[u] = *(const bf16x8*)(wh0 + s * 512); ah1[u] = *(const bf16x8*)(wh1 + s * 512); al0[u] = *(const bf16x8*)(wl0 + s * 512); al1[u] = *(const bf16x8*)(wl1 + s * 512); }
                SBAR();
#pragma unroll
                for (int u = 0; u < 4; ++u) { const int s = sg + u;
                    const int off = row * 4096 + (((wave * 32 + 2 * s + h5) ^ row) << 4);
                    const bf16x8 bh = *(const LAS bf16x8*)(xh + off), bl = *(const LAS bf16x8*)(xl + off);
                    acc0 = __builtin_amdgcn_mfma_f32_32x32x16_bf16(ah0[u], bh, acc0, 0, 0, 0); acc1 = __builtin_amdgcn_mfma_f32_32x32x16_bf16(ah1[u], bh, acc1, 0, 0, 0);
                    acc0 = __builtin_amdgcn_mfma_f32_32x32x16_bf16(ah0[u], bl, acc0, 0, 0, 0); acc1 = __builtin_amdgcn_mfma_f32_32x32x16_bf16(ah1[u], bl, acc1, 0, 0, 0);
                    acc0 = __builtin_amdgcn_mfma_f32_32x32x16_bf16(al0[u], bh, acc0, 0, 0, 0); acc1 = __builtin_amdgcn_mfma_f32_32x32x16_bf16(al1[u], bh, acc1, 0, 0, 0); }
                SBAR();
            }
        }
        __syncthreads();
        if (n32 < 16) {
#pragma unroll
            for (int i = 0; i < 16; ++i) { const int e = (i & 3) + 8 * (i >> 2) + 4 * h5; part[(wave * 16 + n32) * 64 + e] = acc0[i]; part[(wave * 16 + n32) * 64 + 32 + e] = acc1[i]; }
        }
        __syncthreads();
#pragma unroll 1
        for (int k = 0; k < 2; ++k) {
            const int lt = 2 * wave + k, ti = 16 * it + lt;
            float logit = 0.f;
#pragma unroll
            for (int w = 0; w < 8; ++w) logit += part[(w * 16 + lt) * 64 + lane];
            const float sc = 1.f / (1.f + expf(-logit));
            const float bs = sc + rb;
            float m1 = bs;
            m1 = fmaxf(m1, dpp_mov<0xB1>(m1)); m1 = fmaxf(m1, dpp_mov<0x4E>(m1)); m1 = fmaxf(m1, dpp_mov<0x141>(m1));
            const unsigned long long eq = __ballot(bs == m1);
            const int gbase = lane & ~7;
            const int first = gbase + __builtin_ctz((unsigned)((eq >> gbase) & 0xffu));
            float m2 = (lane == first) ? -__builtin_inff() : bs;
            m2 = fmaxf(m2, dpp_mov<0xB1>(m2)); m2 = fmaxf(m2, dpp_mov<0x4E>(m2)); m2 = fmaxf(m2, dpp_mov<0x141>(m2));
            const float gs = m1 + m2; const int grp = lane >> 3;
            int grank = 0;
#pragma unroll
            for (int g2 = 0; g2 < 8; ++g2) { const float v = __int_as_float(__builtin_amdgcn_readlane(__float_as_int(gs), g2 * 8)); grank += (v > gs || (v == gs && g2 < grp)) ? 1 : 0; }
            const float masked = (grank < 4) ? bs : -__builtin_inff();
            int rank = 0;
#pragma unroll 8
            for (int e2 = 0; e2 < 64; ++e2) { const float v = __int_as_float(__builtin_amdgcn_readlane(__float_as_int(masked), e2)); rank += (v > masked || (v == masked && e2 < lane)) ? 1 : 0; }
            const bool selk = rank < 8;
            const float wsum = wave_sum(selk ? sc : 0.f);
            if (selk) {
                const int lp = __hip_atomic_fetch_add(lcount + lane, 1, __ATOMIC_RELAXED, __HIP_MEMORY_SCOPE_WORKGROUP);
                ent[(ti * 8 + rank) * 2] = ((unsigned)lane << 20) | (unsigned)lp;
                ((LAS float*)ent)[(ti * 8 + rank) * 2 + 1] = sc / wsum * ROUTED_SCALE;
            }
        }
        __syncthreads();
    }
    if (threadIdx.x < 64) { const int n = lcount[threadIdx.x]; lbase[threadIdx.x] = n > 0 ? (int)__hip_atomic_fetch_add(gcount + threadIdx.x * 16, (unsigned)n, __ATOMIC_RELAXED, __HIP_MEMORY_SCOPE_AGENT) : 0; }
    __syncthreads();
    for (int i = threadIdx.x; i < 64 * 8; i += NWAVES * 64) {
        const unsigned ep = ent[i * 2]; const float w = ((LAS float*)ent)[i * 2 + 1];
        const int e = ep >> 20, pos = lbase[e] + (int)(ep & 0xfffffu), t = t_beg + (i >> 3);
        list[(size_t)e * NTOK + pos] = (unsigned)t;
        toke[(size_t)t * 8 + (i & 7)] = ((unsigned)e << 20) | (unsigned)pos;
        tokw[(size_t)t * 8 + (i & 7)] = w;
    }
    __syncthreads();
}

__device__ __forceinline__ int moe_tables(KArgs a, int layer, LAS unsigned char* lds) {
    const unsigned* gcount = (const unsigned*)(a->ws + WS_CTL) + CW_CNT + layer * NE * 16;
    LAS int* P = (LAS int*)(lds + LT_P); LAS int* cnt = (LAS int*)(lds + LT_CNT); LAS int* tile_e = (LAS int*)(lds + LT_TILE);
    __syncthreads();
    if (threadIdx.x < NEX) cnt[threadIdx.x] = (threadIdx.x < NE) ? (int)__hip_atomic_load(gcount + threadIdx.x * 16, __ATOMIC_RELAXED, __HIP_MEMORY_SCOPE_AGENT) : NTOK;
    __syncthreads();
    if (threadIdx.x == 0) { int s = 0; for (int e = 0; e < NEX; ++e) { P[e] = s; s += (cnt[e] + 255) >> 8; } P[NEX] = s; }
    __syncthreads();
    if (threadIdx.x < NEX) { const int e = threadIdx.x; for (int t = P[e]; t < P[e + 1]; ++t) tile_e[t] = e; }
    __syncthreads();
    return P[NEX];
}

__device__ __forceinline__ void moe_combine(KArgs a, int layer, LAS unsigned char* lds, int gw, int NGW, int lane) {
    float* out = a->out; bf16_t* xb = (bf16_t*)(a->ws + WS_XB); const bf16_t* Y = (const bf16_t*)(a->ws + WS_Y);
    const unsigned* toke = (const unsigned*)(a->ws + WS_TOKE); const float* tokw = (const float*)(a->ws + WS_TOKW);
    const float* gam = a->in[I_LN2G] + layer * DM; const float* bet = a->in[I_LN2B] + layer * DM;
    const LAS int* P = (const LAS int*)(lds + LT_P);
    const int sh_base = P[NE] * 256;
    unsigned epn = 0u; float wn = 0.f;
    if (gw < NTOK && lane < 8) { epn = toke[(size_t)gw * 8 + lane]; wn = tokw[(size_t)gw * 8 + lane]; }
    for (int t = gw; t < NTOK; t += NGW) {
        const unsigned ep = epn; float w = wn;
        if (t + NGW < NTOK && lane < 8) { epn = toke[(size_t)(t + NGW) * 8 + lane]; wn = tokw[(size_t)(t + NGW) * 8 + lane]; }
        int slot = P[ep >> 20] * 256 + (int)(ep & 0xfffffu);
        if (lane == 8) { slot = sh_base + t; w = 1.f; }
        f32x4 acc[8]; u32x4 y[9][4]; float wk[9];
#pragma unroll
        for (int j = 0; j < 4; ++j) { acc[2 * j] = *(const f32x4*)(out + (size_t)t * DM + 512 * j + 8 * lane); acc[2 * j + 1] = *(const f32x4*)(out + (size_t)t * DM + 512 * j + 8 * lane + 4); }
        const bool y8 = MOE_Y8(layer);
#pragma unroll
        for (int q = 0; q < 9; ++q) { const int sl = __builtin_amdgcn_readlane(slot, q); wk[q] = __int_as_float(__builtin_amdgcn_readlane(__float_as_int(w), q)) * (y8 ? Y8_INV : 1.f);
#pragma unroll
            for (int j = 0; j < 4; ++j) {
                if (y8) { const u32x2 t2 = __builtin_nontemporal_load((const u32x2*)((const unsigned char*)Y + (size_t)sl * DM + 512 * j + 8 * lane)); y[q][j] = (u32x4){t2.x, t2.y, 0u, 0u}; }
                else y[q][j] = __builtin_nontemporal_load((const u32x4*)(Y + (size_t)sl * DM + 512 * j + 8 * lane)); } }
#pragma unroll
        for (int j = 0; j < 8; ++j) acc[j] = acc[j] * ALPHA;
#pragma unroll
        for (int q = 0; q < 9; ++q)
#pragma unroll
            for (int j = 0; j < 4; ++j) {
                if (y8) {
                    const f32x2 a0 = __builtin_amdgcn_cvt_pk_f32_fp8((int)y[q][j].x, false), a1 = __builtin_amdgcn_cvt_pk_f32_fp8((int)y[q][j].x, true);
                    const f32x2 b0 = __builtin_amdgcn_cvt_pk_f32_fp8((int)y[q][j].y, false), b1 = __builtin_amdgcn_cvt_pk_f32_fp8((int)y[q][j].y, true);
                    acc[2 * j][0] += wk[q] * a0[0]; acc[2 * j][1] += wk[q] * a0[1]; acc[2 * j][2] += wk[q] * a1[0]; acc[2 * j][3] += wk[q] * a1[1];
                    acc[2 * j + 1][0] += wk[q] * b0[0]; acc[2 * j + 1][1] += wk[q] * b0[1]; acc[2 * j + 1][2] += wk[q] * b1[0]; acc[2 * j + 1][3] += wk[q] * b1[1];
                } else {
                acc[2 * j][0] += wk[q] * bf_lo(y[q][j].x); acc[2 * j][1] += wk[q] * bf_hi(y[q][j].x); acc[2 * j][2] += wk[q] * bf_lo(y[q][j].y); acc[2 * j][3] += wk[q] * bf_hi(y[q][j].y);
                acc[2 * j + 1][0] += wk[q] * bf_lo(y[q][j].z); acc[2 * j + 1][1] += wk[q] * bf_hi(y[q][j].z); acc[2 * j + 1][2] += wk[q] * bf_lo(y[q][j].w); acc[2 * j + 1][3] += wk[q] * bf_hi(y[q][j].w);
                }
            }
        float s = 0.f;
#pragma unroll
        for (int j = 0; j < 8; ++j) s += (acc[j][0] + acc[j][1]) + (acc[j][2] + acc[j][3]);
        const float mean = wave_sum(s) * (1.f / DM); float s2 = 0.f;
#pragma unroll
        for (int j = 0; j < 8; ++j) { acc[j] = acc[j] - mean; s2 += (acc[j][0] * acc[j][0] + acc[j][1] * acc[j][1]) + (acc[j][2] * acc[j][2] + acc[j][3] * acc[j][3]); }
        const float rstd = __builtin_amdgcn_rsqf(wave_sum(s2) * (1.f / DM) + LN_EPS);
#pragma unroll
        for (int j = 0; j < 4; ++j) {
            const int c = 512 * j + 8 * lane;
            const f32x4 x0 = acc[2 * j] * rstd * *(const f32x4*)(gam + c) + *(const f32x4*)(bet + c);
            const f32x4 x1 = acc[2 * j + 1] * rstd * *(const f32x4*)(gam + c + 4) + *(const f32x4*)(bet + c + 4);
            *(f32x4*)(out + (size_t)t * DM + c) = x0; *(f32x4*)(out + (size_t)t * DM + c + 4) = x1;
            if (layer == 0) {
                if (FP8_QKV1) { u32x2 wv; wv.x = pk4_fp8(x0[0], x0[1], x0[2], x0[3]); wv.y = pk4_fp8(x1[0], x1[1], x1[2], x1[3]); *(u32x2*)((unsigned char*)xb + (size_t)t * DM + c) = wv; }
                else { u32x4 wv; wv.x = cvt_pk_bf16(x0[0], x0[1]); wv.y = cvt_pk_bf16(x0[2], x0[3]); wv.z = cvt_pk_bf16(x1[0], x1[1]); wv.w = cvt_pk_bf16(x1[2], x1[3]);
                    *(u32x4*)(xb + (size_t)t * DM + c) = wv; } }
        }
    }
}

__device__ __forceinline__ void attn_ref(KArgs a, int L, int pass, att::BlockRef& r) {
    const int xcd = L & 7, k = L >> 3, vh = xcd * 8 + (k >> 4), x = k & 15;
    const int qb = pass ? 31 - x : x;
    const bf16_t* Q = (const bf16_t*)(a->ws + WS_Q); const bf16_t* K = (const bf16_t*)(a->ws + WS_K); const bf16_t* V = (const bf16_t*)(a->ws + WS_V);
    r.P0 = qb * 256;
    const int half = vh & 1, bm = vh >> 1, b = bm >> 4, m = bm & 15;
    r.Q = Q + ((size_t)bm * SEQ + r.P0) * HD; r.K = K + (size_t)bm * SEQ * HD;
    r.V = V + (size_t)(b * NSLAB + (m >> 1) * 2 + half) * SEQ * HD;
    r.O = (bf16_t*)(a->ws + WS_O) + ((size_t)b * SEQ + r.P0) * 4096 + (m * 2 + half) * HD;
    r.sel = nullptr; r.list = nullptr; r.ML = nullptr; r.jlo = 0; r.nvalid = 256; r.nblk = 0; r.hb = 0;
}
__device__ __forceinline__ void attn_phase_da(KArgs a, char* lds, int G) {
    constexpr int total = 64 * 16;
    const int conv_slot = (int)(blockIdx.x & 3u);
    int L = blockIdx.x; if (L >= total) return;
    int pass = 0, item = 0; att::BlockRef cur, nxt; attn_ref(a, L, 0, cur);
    att::Seam S;
    att::attn_prime<false>(cur, lds, S);
    for (;;) {
        if (pass == 0) {
            if (conv_slot == item) {
                const int tid0 = otid(); const Geo cg = geo();
                convert_items(a, (LAS float*)((LAS unsigned char*)lds + att::ATT_LDS + __builtin_amdgcn_readfirstlane(tid0 >> 6) * 4224), cg.gw, cg.NGW, tid0 & 63, IT_IN, IT_TOTAL);
            }
            ++item;
        }
        const bool more_pass = pass == 0, more_item = L + G < total, last = !more_pass && !more_item;
        int passn = pass + 1, Ln = L;
        if (!more_pass) { passn = 0; Ln = more_item ? L + G : L; }
        if (last) nxt = cur; else attn_ref(a, Ln, passn, nxt);
        att::attn_block<false>(cur, nxt, 4096, lds, S);
        if (last) break;
        cur = nxt; pass = passn; L = Ln;
    }
}
__device__ __forceinline__ void moba_ref(KArgs a, LAS unsigned char* lds, int B, att::BlockRef& r) {
    const LAS int* PB = (const LAS int*)(lds + LT_PB); const LAS int* MC = (const LAS int*)(lds + LT_MC);
    int lo = 0, hi = 1024;
    while (hi - lo > 1) { const int mid = (lo + hi) >> 1; if (PB[mid] <= B) lo = mid; else hi = mid; }
    const int id = lo, bh = id >> 5, n = id & 31, c = B - PB[id];
    r.Q = (const bf16_t*)(a->ws + WS_Q) + (size_t)bh * SEQ * HD; r.K = (const bf16_t*)(a->ws + WS_K) + (size_t)bh * SEQ * HD; r.V = (const bf16_t*)(a->ws + WS_V) + (size_t)bh * SEQ * HD;
    r.O = (bf16_t*)(a->ws + WS_OP); r.ML = (float*)(a->ws + WS_ML); r.sel = (const unsigned*)(a->ws + WS_SEL) + (size_t)bh * SEQ;
    r.hb = bh * SEQ; r.jlo = 4 * n; r.nblk = n; r.P0 = n * 256;
    if (c == 0) { r.list = nullptr; r.nvalid = 256; }
    else { r.list = (const unsigned*)(a->ws + WS_QLIST) + (size_t)id * SEQ + (size_t)(c - 1) * 256; const int rem = MC[id] - (c - 1) * 256; r.nvalid = rem < 256 ? rem : 256; }
}
__device__ __forceinline__ void attn_phase_moba(KArgs a, LAS unsigned char* lds, char* lds_gen, int G) {
    LAS int* MC = (LAS int*)(lds + LT_MC); LAS int* PB = (LAS int*)(lds + LT_PB); LAS int* SC = (LAS int*)(lds + LT_SC);
    const unsigned* mcnt = (const unsigned*)(a->ws + WS_CTL) + CW_MCNT;
    const int t = threadIdx.x;
    __syncthreads();
    const int c0 = (int)__hip_atomic_load(mcnt + 2 * t, __ATOMIC_RELAXED, __HIP_MEMORY_SCOPE_AGENT), c1 = (int)__hip_atomic_load(mcnt + 2 * t + 1, __ATOMIC_RELAXED, __HIP_MEMORY_SCOPE_AGENT);
    MC[2 * t] = c0; MC[2 * t + 1] = c1;
    const int s0 = 1 + ((c0 + 255) >> 8), s1 = s0 + 1 + ((c1 + 255) >> 8);
    SC[t] = s1;
    __syncthreads();
    for (int off = 1; off < 512; off <<= 1) { const int v = SC[t] + (t >= off ? SC[t - off] : 0); __syncthreads(); SC[t] = v; __syncthreads(); }
    const int excl = t > 0 ? SC[t - 1] : 0;
    PB[2 * t] = excl; PB[2 * t + 1] = excl + s0; if (t == 511) PB[1024] = SC[511];
    __syncthreads();
    const int NB = PB[1024];
    int B = blockIdx.x; if (B >= NB) return;
    att::BlockRef cur, nxt; moba_ref(a, lds, B, cur);
    att::Seam S;
    att::attn_prime<true>(cur, lds_gen, S);
    for (;;) {
        const int Bn = B + G; const bool last = Bn >= NB;
        if (last) nxt = cur; else moba_ref(a, lds, Bn, nxt);
        att::attn_block<true>(cur, nxt, 0, lds_gen, S);
        if (last) break;
        cur = nxt; B = Bn;
    }
}
__device__ __forceinline__ void moba_kv_phase(KArgs a, LAS unsigned char* lds, char* lds_gen) {
    using namespace att;
    LAS int* PB = (LAS int*)(lds + LDSCTL_OFF + 1024); LAS int* MC = (LAS int*)(lds + LDSCTL_OFF + 5632); LAS int* SC = (LAS int*)lds;
    volatile LAS int* QW = (volatile LAS int*)(lds + LDSCTL_OFF + 14400);
    const unsigned* mcnt = (const unsigned*)(a->ws + WS_CTL) + CW_MCNT; unsigned* sq = (unsigned*)(a->ws + WS_CTL) + CW_SQ;
    int tid = threadIdx.x; asm volatile("" : "+v"(tid));
    const int wid = __builtin_amdgcn_readfirstlane(tid >> 6), lane = tid & 63, r32 = lane & 31, hi = lane >> 5;
    __syncthreads();
    {   const int c0 = (int)__hip_atomic_load(mcnt + 2 * tid, __ATOMIC_RELAXED, __HIP_MEMORY_SCOPE_AGENT), c1 = (int)__hip_atomic_load(mcnt + 2 * tid + 1, __ATOMIC_RELAXED, __HIP_MEMORY_SCOPE_AGENT);
        MC[2 * tid] = c0; MC[2 * tid + 1] = c1;
        const int s0 = (8 + ((c0 + 31) >> 5) + 31) >> 5, s1 = s0 + ((8 + ((c1 + 31) >> 5) + 31) >> 5);
        SC[tid] = s1;
        __syncthreads();
        for (int off = 1; off < 512; off <<= 1) { const int v = SC[tid] + (tid >= off ? SC[tid - off] : 0); __syncthreads(); SC[tid] = v; __syncthreads(); }
        const int excl = tid > 0 ? SC[tid - 1] : 0;
        PB[2 * tid] = excl; PB[2 * tid + 1] = excl + s0; if (tid == 511) PB[1024] = SC[511];
        __syncthreads(); }
    const int NP = PB[1024];
    char* V_lds = lds_gen; char* K_lds = lds_gen + 65536;
    float* ws = (float*)(lds_gen + LDSCTL_OFF + 10240) + wid * 128; float* li_l = ws, * al_l = ws + 32; unsigned* rd = (unsigned*)(ws + 64);
    const int vb0 = (int)(uintptr_t)V_lds + v_rd_base(lane);
    const int sr = tid >> 4, sc = (tid & 15) * 8;
    const bf16_t* Qb = (const bf16_t*)(a->ws + WS_Q); const bf16_t* Kb = (const bf16_t*)(a->ws + WS_K); const bf16_t* Vb = (const bf16_t*)(a->ws + WS_V);
    const unsigned* selb = (const unsigned*)(a->ws + WS_SEL); const unsigned* qlb = (const unsigned*)(a->ws + WS_QLIST);
    bf16_t* OPb = (bf16_t*)(a->ws + WS_OP); float* MLb = (float*)(a->ws + WS_ML);
    for (;;) {
        if (tid == 0) *QW = (int)__hip_atomic_fetch_add(sq, 1u, __ATOMIC_RELAXED, __HIP_MEMORY_SCOPE_AGENT);
        __syncthreads();
        const int I = *QW;
        if (I >= NP) break;
        int lo = 0, hb = 1024;
        while (hb - lo > 1) { const int mid = (lo + hb) >> 1; if (PB[mid] <= I) lo = mid; else hb = mid; }
        const int id = lo, bh = id >> 5, n = id & 31, part = I - PB[id], cnt = MC[id];
        {
            const bf16_t* Kh = Kb + ((size_t)bh * SEQ + (size_t)n * 256) * HD; const bf16_t* Vh = Vb + ((size_t)bh * SEQ + (size_t)n * 256) * HD;
            bf16x8 kv[8], vv[8];
#pragma unroll
            for (int i = 0; i < 8; ++i) { kv[i] = load8(Kh + (size_t)(sr + 32 * i) * HD + sc); vv[i] = load8(Vh + (size_t)(sr + 32 * i) * HD + sc); }
#pragma unroll
            for (int i = 0; i < 8; ++i) { const int tl = i >> 1, row = sr + 32 * (i & 1);
                *(bf16x8*)(K_lds + tl * SHM_K + KSWZ(row, sc * 2)) = kv[i]; *(bf16x8*)(V_lds + tl * SHM_V + v_st(row, sc)) = vv[i]; }
        }
        __syncthreads();
        const int nch = 8 + ((cnt + 31) >> 5), c_beg = 32 * part, c_end = (c_beg + 32 < nch) ? c_beg + 32 : nch;
#pragma unroll 1
        for (int cg = c_beg + wid; cg < c_end; cg += 8) {
            const bool own = cg < 8;
            const int li0 = (cg - 8) * 32 + r32;
            unsigned q; if (own) q = (unsigned)(n * 256 + cg * 32 + r32); else q = qlb[(size_t)id * SEQ + (li0 < cnt ? li0 : cnt - 1)];
            const bool valid = own || (li0 < cnt);
            unsigned slot = 3u; if (!own) slot = (unsigned)__builtin_popcount(selb[(size_t)bh * SEQ + q] & ((1u << n) - 1u));
            bf16x8 qr[8];
#pragma unroll
            for (int d0 = 0; d0 < 8; ++d0) qr[d0] = load8(Qb + ((size_t)bh * SEQ + q) * HD + d0 * 16 + hi * 8);
            if (hi == 0) rd[r32] = valid ? (((unsigned)(bh * SEQ) + q) * 4u + slot) * 128u : (1u << 27);
            const int NTu = own ? ((cg * 32 + 31) >> 6) + 1 : 4;
            const int qlo = n * 256 + cg * 32, qm = qlo + r32 - 4 * hi;
            float m_reg = -1e30f, l_reg = 0.f; f32x16 o[4] = {};
#define KV_STEP(T) do { if ((T) < NTu) { f32x16 p0, p1; float mn, al; bf16x8 pa0, pa1, pa2, pa3;                                        \
                qkt<T>(p0, p1, K_lds, r32, hi, qr);                                                                                       \
                if (own) { const int kb_ = n * 256 + (T) * KVBLK; if (kb_ + KVBLK - 1 > qlo) mask_tile(p0, p1, qm - kb_, 0x40000000u); }   \
                partialSM(p0, p1, m_reg, mn, al);                                                                                        \
                if (__any(al < 1.f)) { if (hi == 0) al_l[r32] = al; asm volatile("s_waitcnt lgkmcnt(0)" ::: "memory");                     \
                    for (int d_ = 0; d_ < 4; ++d_) for (int r = 0; r < 16; ++r) o[d_][r] *= al_l[crow(r, hi)]; }                           \
                finishSM(p0, p1, al, l_reg, pa0, pa1, pa2, pa3); SBAR();                                                                  \
                pv_tile<T>(o, vb0, pa0, pa1, pa2, pa3); } } while (0)
            KV_STEP(0); KV_STEP(1); KV_STEP(2); KV_STEP(3);
#undef KV_STEP
            if (hi == 0) li_l[r32] = l_reg; asm volatile("s_waitcnt lgkmcnt(0)" ::: "memory");
            float rli[16];
#pragma unroll
            for (int r = 0; r < 16; ++r) rli[r] = __builtin_amdgcn_rcpf(li_l[crow(r, hi)]);
#pragma unroll
            for (int r = 0; r < 16; ++r) { const unsigned off = rd[crow(r, hi)];
#pragma unroll
                for (int d0 = 0; d0 < 4; ++d0) { const float v = o[d0][r] * rli[r];
                    const float vn = __int_as_float(__builtin_amdgcn_mov_dpp(__float_as_int(v), 0xB1, 0xF, 0xF, true));
                    if ((r32 & 1) == 0) *(unsigned*)(OPb + (size_t)off + d0 * 32 + r32) = cvt_pk_bf16(v, vn); } }
            if (hi == 0) { float* mlp = MLb + (size_t)(rd[r32] >> 7) * 2; f32x2 ml = {m_reg, l_reg}; *(f32x2*)mlp = ml; }
        }
    }
}
__device__ __forceinline__ void moba_merge(KArgs a, int gw, int NGW, int lane) {
    const bf16_t* OP = (const bf16_t*)(a->ws + WS_OP); const float* ML = (const float*)(a->ws + WS_ML); const unsigned* sel = (const unsigned*)(a->ws + WS_SEL);
    bf16_t* AO = (bf16_t*)(a->ws + WS_AOUT);
    constexpr float C2 = 1.4426950408889634f * att::SCALE;
    const int h = lane >> 2, part = lane & 3;
    for (int t = gw; t < NTOK; t += NGW) {
        const int b = t >> 13, s = t & (SEQ - 1), bh = b * NSLAB + h;
        const size_t base = ((size_t)bh * SEQ + s) * 4;
        const int nsel = __builtin_popcount(sel[(size_t)bh * SEQ + s]);
        f32x2 ml[4]; u32x4 ov[4][4];
#pragma unroll
        for (int k = 0; k < 4; ++k) { ml[k] = *(const f32x2*)(ML + (base + k) * 2);
#pragma unroll
            for (int j = 0; j < 4; ++j) ov[k][j] = *(const u32x4*)(OP + (base + k) * 128 + part * 32 + j * 8); }
        float M = ml[3][0];
#pragma unroll
        for (int k = 0; k < 3; ++k) M = (k < nsel) ? fmaxf(M, ml[k][0]) : M;
        float w[4], W = 0.f;
#pragma unroll
        for (int k = 0; k < 4; ++k) { const bool valid = (k == 3) || (k < nsel); w[k] = valid ? ml[k][1] * __builtin_amdgcn_exp2f((ml[k][0] - M) * C2) : 0.f; W += w[k]; }
        const float rW = 1.f / W;
        float acc[32];
#pragma unroll
        for (int i = 0; i < 32; ++i) acc[i] = 0.f;
#pragma unroll
        for (int k = 0; k < 4; ++k) { const bool valid = (k == 3) || (k < nsel); const float wk = w[k] * rW;
#pragma unroll
            for (int j = 0; j < 4; ++j) { const u32x4 u = ov[k][j];
                acc[8 * j + 0] += valid ? wk * bf_lo(u.x) : 0.f; acc[8 * j + 1] += valid ? wk * bf_hi(u.x) : 0.f; acc[8 * j + 2] += valid ? wk * bf_lo(u.y) : 0.f; acc[8 * j + 3] += valid ? wk * bf_hi(u.y) : 0.f;
                acc[8 * j + 4] += valid ? wk * bf_lo(u.z) : 0.f; acc[8 * j + 5] += valid ? wk * bf_hi(u.z) : 0.f; acc[8 * j + 6] += valid ? wk * bf_lo(u.w) : 0.f; acc[8 * j + 7] += valid ? wk * bf_hi(u.w) : 0.f; } }
#pragma unroll
        for (int j = 0; j < 4; ++j) {
            if (FP8_OUT1) { u32x2 o; o.x = pk4_fp8(acc[8 * j] * AO8_SCALE, acc[8 * j + 1] * AO8_SCALE, acc[8 * j + 2] * AO8_SCALE, acc[8 * j + 3] * AO8_SCALE); o.y = pk4_fp8(acc[8 * j + 4] * AO8_SCALE, acc[8 * j + 5] * AO8_SCALE, acc[8 * j + 6] * AO8_SCALE, acc[8 * j + 7] * AO8_SCALE);
                *(u32x2*)((unsigned char*)AO + (size_t)t * DM + h * HD + part * 32 + j * 8) = o; }
            else { u32x4 o; o.x = cvt_pk_bf16(acc[8 * j], acc[8 * j + 1]); o.y = cvt_pk_bf16(acc[8 * j + 2], acc[8 * j + 3]); o.z = cvt_pk_bf16(acc[8 * j + 4], acc[8 * j + 5]); o.w = cvt_pk_bf16(acc[8 * j + 6], acc[8 * j + 7]);
                *(u32x4*)(AO + (size_t)t * DM + h * HD + part * 32 + j * 8) = o; } }
    }
}

#ifndef PHMASK
#define PHMASK 0x7ffff
#endif
#define IN(k) (((PHMASK >> (k)) & 1) && lo <= (k) && (k) < hi)
#define SEAM(k) do { if (IN(k) && IN((k) + 1)) xcd_barrier(bar); } while (0)
template <int LAYER>
__device__ __forceinline__ void layer_program(LAS unsigned char* lds, unsigned char* lds_gen, const XcdBarrier& bar, const int lo, const int hi) {
    constexpr int pb = LAYER == 0 ? 1 : 9;
    constexpr int po = LAYER == 0 ? 4 : 14;
    if (IN(pb)) {
        KArgs ka = kargs(); unsigned char* ws = ka->ws;
        constexpr bool F8 = LAYER == 0 ? (bool)FP8_QKV0 : (bool)FP8_QKV1; constexpr int Kb = F8 ? DM : DM * 2;
        pg8::SchedDense S; S.init(ws + WS_XB, ws + WS_WATT + (LAYER == 0 ? 0 : 32 * MiB), NTOK, NQKV, Kb, gridDim.x, blockIdx.x);
        constexpr bool KM = LAYER == 1;
        pg8::EpiQKV<KM> E{(bf16_t*)(ws + WS_Q), (const float*)(ws + WS_ROPE), F8 ? W8_INV : 1.f};
        pg8::gemm_phase<pg8::EpiQKV<KM>, pg8::SchedDense, F8>(lds, Kb, S, E);
    }
    SEAM(pb);
    if (LAYER == 0) {
        if (IN(2)) { KArgs ka = kargs();
            if (__builtin_amdgcn_readfirstlane(threadIdx.x) >= 256) __builtin_amdgcn_s_setprio(1);
            attn_phase_da(ka, (char*)lds_gen, gridDim.x);
            __builtin_amdgcn_s_setprio(0); }
        SEAM(2);
        if (IN(3)) { KArgs ka = kargs(); const Geo g = geo(); da_combine(ka, g.gw, g.NGW, otid() & 63); }
        SEAM(3);
    } else {
        if (IN(11)) { KArgs ka = kargs(); const Geo g = geo(); moba_gate(ka, g.gw, g.NGW, otid() & 63); }
        SEAM(11);
        if (IN(12)) { KArgs ka = kargs();
            if (__builtin_amdgcn_readfirstlane(threadIdx.x) >= 256) __builtin_amdgcn_s_setprio(1);
            moba_kv_phase(ka, lds, (char*)lds_gen);
            __builtin_amdgcn_s_setprio(0); }
        SEAM(12);
        if (IN(13)) { KArgs ka = kargs(); const Geo g = geo(); moba_merge(ka, g.gw, g.NGW, otid() & 63); }
        SEAM(13);
    }
    if (IN(po)) {
        KArgs ka = kargs(); unsigned char* ws = ka->ws;
        constexpr bool F8 = LAYER == 0 ? (bool)FP8_OUT0 : (bool)FP8_OUT1; constexpr int Kb = F8 ? DM : DM * 2;
        pg8::SchedDense S; S.init(ws + WS_AOUT, ws + WS_WATT + (LAYER == 0 ? 24 * MiB : 56 * MiB), NTOK, DM, Kb, gridDim.x, blockIdx.x);
        pg8::EpiRes E{LAYER == 0 ? ka->in[I_X] : ka->out, ka->out, F8 ? W8_INV * AO8_INV : 1.f};
        pg8::gemm_phase<pg8::EpiRes, pg8::SchedDense, F8>(lds, Kb, S, E);
    }
    SEAM(po);
    if (IN(po + 1)) { KArgs ka = kargs(); const Geo g = geo(); const int tid = otid(); ln_router(ka, LAYER, lds, g.vcu, g.G, __builtin_amdgcn_readfirstlane(tid >> 6), tid & 63); }
    SEAM(po + 1);
    if (IN(po + 2)) {
        KArgs ka = kargs(); unsigned char* ws = ka->ws;
        const int ntt = moe_tables(ka, LAYER, lds);
        constexpr bool F8 = MOE_F8(LAYER); constexpr int Kb = F8 ? DM : DM * 2;
        pg8::SchedMoe1 S{(const char*)(ws + WS_XB), (const char*)(ws + WS_WGU) + (size_t)LAYER * NEX * 1024 * DM * 2, (const unsigned*)(ws + WS_LIST),
                         (const LAS int*)(lds + LT_P), (const LAS int*)(lds + LT_CNT), (const LAS int*)(lds + LT_TILE), ntt * 4, (int)gridDim.x, (int)blockIdx.x, Kb};
        pg8::EpiSwiGLU<F8> E{(bf16_t*)(ws + WS_H), F8 ? W8_INV : 1.f};
        pg8::gemm_phase<pg8::EpiSwiGLU<F8>, pg8::SchedMoe1, F8>(lds, Kb, S, E);
    }
    SEAM(po + 2);
    if (IN(po + 3)) {
        KArgs ka = kargs(); unsigned char* ws = ka->ws;
        const int ntt = moe_tables(ka, LAYER, lds);
        constexpr bool F8 = MOE_F8(LAYER); constexpr int Kb = F8 ? DE : DE * 2;
        pg8::SchedMoe2 S{(const char*)(ws + WS_H), (const char*)(ws + WS_WD) + (size_t)LAYER * NEX * DM * DE * 2, (const LAS int*)(lds + LT_TILE), ntt * 8, (int)gridDim.x, (int)blockIdx.x, Kb};
        constexpr bool Y8 = MOE_Y8(LAYER);
        pg8::EpiY<Y8> E{(bf16_t*)(ws + WS_Y), (F8 ? W8_INV : 1.f) * (Y8 ? Y8_SCALE : 1.f)};
        pg8::gemm_phase<pg8::EpiY<Y8>, pg8::SchedMoe2, F8>(lds, Kb, S, E);
    }
    SEAM(po + 3);
    if (IN(po + 4)) { KArgs ka = kargs(); const Geo g = geo(); (void)moe_tables(ka, LAYER, lds); moe_combine(ka, LAYER, lds, g.gw, g.NGW, otid() & 63); }
    if (LAYER == 0) SEAM(8);
}
__global__ void __launch_bounds__(NWAVES * 64, 2) fwd_kernel(Args args) {
    extern __shared__ __attribute__((aligned(16))) unsigned char lds_raw[];
    LAS unsigned char* lds = (LAS unsigned char*)lds_raw;
    volatile LAS unsigned* MISC = (volatile LAS unsigned*)(lds + MISC_OFF);
    for (int u = threadIdx.x; u < (LDS_BYTES - LDSCTL_OFF) / 4; u += NWAVES * 64) ((LAS unsigned*)(lds + LDSCTL_OFF))[u] = 0u;
    __syncthreads();
    XcdBarrier bar = xcd_barrier_post((unsigned*)(args.ws + WS_CTL) + CW_BAR, MISC + 8);
    const int lo = args.ph_lo, hi = args.ph_hi;
    if (IN(0)) { KArgs ka = kargs(); const Geo g = geo(); const int tid = otid(); p0_prologue(ka, lds, g.gw, g.NGW, __builtin_amdgcn_readfirstlane(tid >> 6), tid & 63); }
    SEAM(0);
    layer_program<0>(lds, lds_raw, bar, lo, hi);
    layer_program<1>(lds, lds_raw, bar, lo, hi);
}
#undef IN
#undef SEAM

extern "C" void kernel_launch(void* const* d_in, const int* in_sizes, int n_in, void* d_out, int out_size, void* d_ws, size_t ws_size, hipStream_t stream) {
    static int grid = 0;
    if (grid == 0) {
        if (n_in != 23 || out_size != NTOK * DM || ws_size < WS_END) { fprintf(stderr, "kernel_launch: unexpected shapes (n_in %d, out %d, ws %zu; need ws >= %zu)\n", n_in, out_size, ws_size, (size_t)WS_END); grid = -1; return; }
        int dev = 0, cus = 0, per_cu = 0;
        if (hipGetDevice(&dev) != hipSuccess || hipDeviceGetAttribute(&cus, hipDeviceAttributeMultiprocessorCount, dev) != hipSuccess) { grid = -1; return; }
        if (hipFuncSetAttribute((const void*)fwd_kernel, hipFuncAttributeMaxDynamicSharedMemorySize, LDS_BYTES) != hipSuccess) { fprintf(stderr, "kernel_launch: hipFuncSetAttribute failed\n"); grid = -1; return; }
        if (hipOccupancyMaxActiveBlocksPerMultiprocessor(&per_cu, (const void*)fwd_kernel, NWAVES * 64, LDS_BYTES) != hipSuccess || per_cu < 1) fprintf(stderr, "kernel_launch: occupancy query reports %d\n", per_cu);
        (void)hipGetLastError();
        grid = 256;
    }
    if (grid < 0) return;
    if (hipMemsetAsync((char*)d_ws + WS_CTL, 0, CTL_ZERO_BYTES, stream) != hipSuccess) return;
    Args a{};
    for (int i = 0; i < 23; ++i) a.in[i] = (const float*)d_in[i];
    a.out = (float*)d_out; a.ws = (unsigned char*)d_ws;
#ifndef MK_SPLIT
    a.ph_lo = 0; a.ph_hi = 19;
    hipLaunchKernelGGL(fwd_kernel, dim3(grid), dim3(NWAVES * 64), LDS_BYTES, stream, a);
#else
    for (int p = 0; p < 19; ++p) { a.ph_lo = p; a.ph_hi = p + 1; hipLaunchKernelGGL(fwd_kernel, dim3(grid), dim3(NWAVES * 64), LDS_BYTES, stream, a); }
#endif
}
```

```cpp
#define FP8_Y0 1
#include <hip/hip_runtime.h>
#include <cstdio>
#include <cstdint>

#define GAS __attribute__((address_space(1)))
#define LAS __attribute__((address_space(3)))
typedef unsigned short bf16_t;
typedef short bf16x8 __attribute__((ext_vector_type(8)));
typedef short s16x4 __attribute__((ext_vector_type(4)));
typedef float f32x2 __attribute__((ext_vector_type(2)));
typedef float f32x4 __attribute__((ext_vector_type(4)));
typedef float f32x16 __attribute__((ext_vector_type(16)));
typedef unsigned u32x2 __attribute__((ext_vector_type(2)));
typedef unsigned u32x4 __attribute__((ext_vector_type(4)));

constexpr int BATCH = 2, SEQ = 8192, DM = 2048, NTOK = BATCH * SEQ;
constexpr int NE = 64, NEX = 65  , DE = 512, NQKV = 6144, HD = 128, NSLAB = 16;
constexpr float LN_EPS = 1e-5f;
constexpr float ALPHA = 1.4142135623730951f;
constexpr float LAMBDA_INIT = 0.2f;
constexpr float ROUTED_SCALE = 2.5f;
constexpr int NWAVES = 8;
constexpr int MAXTILES = 640;

constexpr size_t MiB = 1u << 20;
constexpr size_t WS_CTL = 0, CTL_ZERO_BYTES = 1 * MiB;
constexpr size_t WS_TOKE = 2 * MiB;
constexpr size_t WS_TOKW = 3 * MiB;
constexpr size_t WS_LIST = 4 * MiB;
constexpr size_t WS_SEL = 8 * MiB;
constexpr size_t WS_KMEAN = 9 * MiB;
constexpr size_t WS_ROPE = 10 * MiB;
constexpr size_t WS_WRF = 12 * MiB;
constexpr size_t WS_WATT = 16 * MiB;
constexpr size_t WS_WGU = 80 * MiB;
constexpr size_t WS_WD = 600 * MiB;
constexpr size_t WS_XB = 860 * MiB;
constexpr size_t WS_C = 924 * MiB;
constexpr size_t WS_Q = WS_C, WS_K = WS_C + 64 * MiB, WS_V = WS_C + 128 * MiB;
constexpr size_t WS_O = WS_C + 192 * MiB;
constexpr size_t WS_AOUT = WS_C + 320 * MiB;
constexpr size_t WS_H = WS_C;
constexpr size_t WS_Y = WS_C + 160 * MiB;
constexpr size_t WS_QLIST = WS_C + 192 * MiB;
constexpr size_t WS_OP = WS_C + 384 * MiB;
constexpr size_t WS_ML = WS_C + 641 * MiB;
constexpr size_t WS_END = WS_C + 800 * MiB;
constexpr int CW_BAR = 4096;
constexpr int CW_CNT = 8192;
constexpr int CW_MCNT = 12288;
constexpr int CW_SQ = 13440;

constexpr int RING_BYTES = 131072;
constexpr int LDSCTL_OFF = RING_BYTES, MISC_OFF = LDSCTL_OFF + 320;
constexpr int LT_P = LDSCTL_OFF + 1024;
constexpr int LT_CNT = LDSCTL_OFF + 1536;
constexpr int LT_TILE = LDSCTL_OFF + 2048;
constexpr int LT_LCNT = LDSCTL_OFF + 5120;
constexpr int LT_LBASE = LDSCTL_OFF + 5632;
constexpr int LT_ENT = LDSCTL_OFF + 6144;
constexpr int LT_MC = 114688;
constexpr int LT_PB = 118784;
constexpr int LT_SC = 123904;
constexpr int LDS_BYTES = 147456;

#ifndef FP8_QKV0
#define FP8_QKV0 0
#endif
#ifndef FP8_QKV1
#define FP8_QKV1 1
#endif
#ifndef FP8_OUT0
#define FP8_OUT0 0
#endif
#ifndef FP8_OUT1
#define FP8_OUT1 1
#endif
#ifndef FP8_Y1
#define FP8_Y1 1
#endif
#ifndef FP8_MOE1
#define FP8_MOE1 1
#endif
#ifndef FP8_MOE0
#define FP8_MOE0 1
#endif
#ifndef FP8_Y0
#define FP8_Y0 0
#endif
#define MOE_F8(l) ((l) == 0 ? (bool)FP8_MOE0 : (bool)FP8_MOE1)
#define MOE_Y8(l) ((l) == 0 ? (bool)(FP8_MOE0 && FP8_Y0) : (bool)(FP8_MOE1 && FP8_Y1))
constexpr float W8_SCALE = 64.f, W8_INV = 1.f / 64.f;
constexpr float AO8_SCALE = 16.f, AO8_INV = 1.f / 16.f;
constexpr float Y8_SCALE = 16.f, Y8_INV = 1.f / 16.f;
#define LDS_WAIT() asm volatile("s_waitcnt lgkmcnt(0)" ::: "memory")
#define VM_WAIT() asm volatile("s_waitcnt vmcnt(0)" ::: "memory")
#define SBAR() __builtin_amdgcn_sched_barrier(0)

__device__ __forceinline__ unsigned cvt_pk_bf16(float lo, float hi) { unsigned r; asm volatile("v_cvt_pk_bf16_f32 %0, %1, %2" : "=v"(r) : "v"(lo), "v"(hi)); return r; }
__device__ __forceinline__ unsigned pk4_fp8(float a, float b, float c, float d) { int p = __builtin_amdgcn_cvt_pk_fp8_f32(a, b, 0, false); p = __builtin_amdgcn_cvt_pk_fp8_f32(c, d, p, true); return (unsigned)p; }
__device__ __forceinline__ float bf_lo(unsigned u) { return __uint_as_float(u << 16); }
__device__ __forceinline__ float bf_hi(unsigned u) { return __uint_as_float(u & 0xffff0000u); }
template <int CTRL> __device__ __forceinline__ float dpp_mov(float v) { return __int_as_float(__builtin_amdgcn_update_dpp(0, __float_as_int(v), CTRL, 0xF, 0xF, true)); }
__device__ __forceinline__ float wave_sum(float v) {
    v += dpp_mov<0xB1>(v);
    v += dpp_mov<0x4E>(v);
    v += dpp_mov<0x141>(v);
    v += dpp_mov<0x140>(v);
    const float r0 = __int_as_float(__builtin_amdgcn_readlane(__float_as_int(v), 0)), r1 = __int_as_float(__builtin_amdgcn_readlane(__float_as_int(v), 16));
    const float r2 = __int_as_float(__builtin_amdgcn_readlane(__float_as_int(v), 32)), r3 = __int_as_float(__builtin_amdgcn_readlane(__float_as_int(v), 48));
    return (r0 + r1) + (r2 + r3);
}

#define XB_TMO      128
#define XB_XCNT(j)  (256  + 64 * (j))
#define XB_XSUB(j)  (1280 + 64 * (j))
#define XB_XGEN(j)  (2304 + 64 * (j))
#define XB_TOP      3328
#define XB_TOPGEN   3392
#define XCD_BAR_WORDS 3456
#define XB_SPIN_CAP (1u << 18)
__device__ __forceinline__ unsigned xb_ld(unsigned* p)              { return __hip_atomic_load(p, __ATOMIC_RELAXED, __HIP_MEMORY_SCOPE_AGENT); }
__device__ __forceinline__ unsigned xb_add(unsigned* p, unsigned v) { return __hip_atomic_fetch_add(p, v, __ATOMIC_RELAXED, __HIP_MEMORY_SCOPE_AGENT); }
__device__ __forceinline__ unsigned xb_xcc_id() { return (unsigned)__builtin_amdgcn_s_getreg((3 << 11) | 20) & 0xFu; }
#define XB_SPIN(cond, bar) do { unsigned _sp = 0; while (cond) { __builtin_amdgcn_s_sleep(1); \
    if ((++_sp & 255u) == 0u) { if (xb_ld(&(bar)[XB_TMO])) break; if (_sp > XB_SPIN_CAP) { atomicAdd(&(bar)[XB_TMO], 1u); break; } } } } while (0)
struct XcdBarrier { unsigned* bar; unsigned x; volatile LAS unsigned* st; };
__device__ __forceinline__ XcdBarrier xcd_barrier_post(unsigned* bar, volatile LAS unsigned* st) {
    XcdBarrier b; b.bar = bar; b.x = xb_xcc_id(); b.st = st;
    if (threadIdx.x == 0) (void)xb_add(&bar[XB_XCNT(b.x)], 1u);
    return b;
}
__device__ __forceinline__ void xcd_barrier_complete(unsigned* bar, unsigned x, unsigned& nloc, unsigned& nx) {
    const unsigned G = gridDim.x * gridDim.y * gridDim.z;
    unsigned sum, cnt, mine, sp = 0u;
    for (;;) {
        sum = 0u; cnt = 0u; mine = 0u;
#pragma unroll
        for (unsigned j = 0; j < 16; ++j) { const unsigned c = xb_ld(&bar[XB_XCNT(j)]); sum += c; cnt += (c > 0u) ? 1u : 0u; mine = (j == x) ? c : mine; }
        if (sum == G) break;
        __builtin_amdgcn_s_sleep(1);
        if ((++sp & 255u) == 0u) { if (xb_ld(&bar[XB_TMO])) break; if (sp > XB_SPIN_CAP) { atomicAdd(&bar[XB_TMO], 1u); break; } }
    }
    nloc = mine > 0u ? mine : 1u; nx = cnt > 0u ? cnt : 1u;
}
__device__ __forceinline__ void xcd_barrier(const XcdBarrier& b) {
    asm volatile("s_waitcnt vmcnt(0)" ::: "memory");
    __syncthreads();
    if (threadIdx.x == 0) {
        unsigned* bar = b.bar;
        __builtin_amdgcn_s_waitcnt(0);
        unsigned nloc = b.st[0], nx = b.st[1];
        if (nloc == 0u) { xcd_barrier_complete(bar, b.x, nloc, nx); b.st[0] = nloc; b.st[1] = nx; }
        const unsigned old = xb_add(&bar[XB_XSUB(b.x)], 1u);
        const unsigned gen = old / nloc;
        if (old + 1u == (gen + 1u) * nloc) {
            __builtin_amdgcn_fence(__ATOMIC_RELEASE, "agent");
            asm volatile("s_waitcnt vmcnt(0)" ::: "memory");
            const unsigned og = xb_add(&bar[XB_TOP], 1u);
            const unsigned tg = og / nx;
            if (og + 1u == (tg + 1u) * nx) xb_add(&bar[XB_TOPGEN], 1u);
            else XB_SPIN(xb_ld(&bar[XB_TOPGEN]) == tg, bar);
            __builtin_amdgcn_fence(__ATOMIC_ACQUIRE, "agent");
            xb_add(&bar[XB_XGEN(b.x)], 1u);
            asm volatile("s_waitcnt vmcnt(0)" ::: "memory");
        } else {
            XB_SPIN(xb_ld(&bar[XB_XGEN(b.x)]) == gen, bar);
            __builtin_amdgcn_fence(__ATOMIC_ACQUIRE, "agent");
            asm volatile("s_waitcnt vmcnt(0)" ::: "memory");
        }
    }
    __syncthreads();
}

namespace pg8 {
constexpr int BM = 256, BK = 64, HALF = 128, HTB = HALF * BK * 2, NXCD = 8, WGM = 8;
__device__ __forceinline__ int lds_byte(int r, int c) { const int st = (r >> 4) * 2 + (c >> 5), rr = r & 15, cc = c & 31, ob = rr * 64 + cc * 2; return st * 1024 + (ob ^ (((ob >> 9) & 1) << 5)); }
__device__ __forceinline__ void stage_rc(int b, int& R, int& C) { const int st = b / 1024, sb = b % 1024, swz = sb ^ (((sb >> 9) & 1) << 5); R = (st >> 1) * 16 + swz / 64; C = (st & 1) * 32 + (swz % 64) / 2; }
__device__ __forceinline__ int perm32(int rho) { const int n = rho >> 4, i = rho & 15; return 8 * (i >> 2) + 4 * n + (i & 3); }
struct Unit { int pm, pn, e, aux; };
__device__ __forceinline__ int xcd_remap(int L, int nwg) { const int q = nwg / NXCD, r = nwg % NXCD, xcd = L % NXCD, off = L / NXCD; return (xcd < r ? xcd * (q + 1) : r * (q + 1) + (xcd - r) * q) + off; }

struct SchedDense {
    const char* A; const char* Bt; int Kb, nM, nN, nwg, G, c;
    __device__ __forceinline__ void init(const void* A_, const void* Bt_, int M, int N, int Kb_, int G_, int c_) { A = (const char*)A_; Bt = (const char*)Bt_; Kb = Kb_; nM = M / BM; nN = N / BM; nwg = nM * nN; G = G_; c = c_; }
    __device__ __forceinline__ bool next(int i, Unit& u) const {
        const long L = (long)i * G + c; if (L >= nwg) return false;
        const int wgid = xcd_remap((int)L, nwg);
        const int nig = WGM * nN, gid = wgid / nig, fm = gid * WGM, gsz = (nM - fm) < WGM ? (nM - fm) : WGM;
        u.pm = fm + ((wgid % nig) % gsz); u.pn = (wgid % nig) / gsz; u.e = 0; u.aux = 0; return true;
    }
    __device__ __forceinline__ const char* a_base(const Unit&) const { return A; }
    __device__ __forceinline__ const char* b_base(const Unit& u) const { return Bt + (size_t)u.pn * BM * Kb; }
    __device__ __forceinline__ void a_off(const Unit& u, unsigned (&off)[2][2]) const {
        int tz = threadIdx.x; asm volatile("" : "+v"(tz));
#pragma unroll
        for (int i = 0; i < 2; ++i) { int R, C; stage_rc(tz * 16 + i * 8192, R, C);
#pragma unroll
            for (int h = 0; h < 2; ++h) off[h][i] = (unsigned)((u.pm * BM + h * HALF + R) * Kb + C * 2); }
    }
};
struct SchedMoe1 {
    const char* X; const char* W; const unsigned* list; const LAS int* P; const LAS int* cnt; const LAS int* tile_e; int U, G, c, Kb;
    __device__ __forceinline__ bool next(int i, Unit& u) const {
        const long L = (long)i * G + c; if (L >= U) return false;
        const int wgid = xcd_remap((int)L, U);
        u.pm = wgid >> 2; u.pn = wgid & 3; u.e = tile_e[u.pm]; u.aux = u.pm - P[u.e]; return true;
    }
    __device__ __forceinline__ const char* a_base(const Unit&) const { return X; }
    __device__ __forceinline__ const char* b_base(const Unit& u) const { return W + ((size_t)u.e * 1024 + (size_t)u.pn * 256) * Kb; }
    __device__ __forceinline__ void a_off(const Unit& u, unsigned (&off)[2][2]) const {
        const int n = cnt[u.e];
        int tz = threadIdx.x; asm volatile("" : "+v"(tz));
#pragma unroll
        for (int i = 0; i < 2; ++i) { int R, C; stage_rc(tz * 16 + i * 8192, R, C);
#pragma unroll
            for (int h = 0; h < 2; ++h) {
                const int r = u.aux * BM + h * HALF + R;
                unsigned tok;
                if (u.e == NE) tok = (unsigned)r;
                else tok = (r < n) ? list[(size_t)u.e * NTOK + r] : 0u;
                off[h][i] = tok * (unsigned)Kb + (unsigned)C * 2u;
            } }
    }
};
struct SchedMoe2 {
    const char* Hb; const char* W; const LAS int* tile_e; int U, G, c, Kb;
    __device__ __forceinline__ bool next(int i, Unit& u) const {
        const long L = (long)i * G + c; if (L >= U) return false;
        const int wgid = xcd_remap((int)L, U);
        u.pm = wgid >> 3; u.pn = wgid & 7; u.e = tile_e[u.pm]; u.aux = 0; return true;
    }
    __device__ __forceinline__ const char* a_base(const Unit&) const { return Hb; }
    __device__ __forceinline__ const char* b_base(const Unit& u) const { return W + ((size_t)u.e * DM + (size_t)u.pn * 256) * Kb; }
    __device__ __forceinline__ void a_off(const Unit& u, unsigned (&off)[2][2]) const {
        int tz = threadIdx.x; asm volatile("" : "+v"(tz));
#pragma unroll
        for (int i = 0; i < 2; ++i) { int R, C; stage_rc(tz * 16 + i * 8192, R, C);
#pragma unroll
            for (int h = 0; h < 2; ++h) off[h][i] = (unsigned)((u.pm * BM + h * HALF + R) * Kb + C * 2); }
    }
};

template <bool KM> struct EpiQKV {
    static constexpr bool PERM = true;
    bf16_t* QKV; const float* rope; float osc;
    __device__ __forceinline__ void operator()(const f32x4 (&acc)[2][2][4][2], const Unit& u, int wr, int wc, int fr, int fq) const {
        const int seg = u.pn >> 3, slab0 = (u.pn & 7) * 2;
        bf16_t* base = QKV + (size_t)seg * ((size_t)BATCH * NSLAB * SEQ * HD);
        const int row0 = u.pm * BM + wr * 64 + fr; const int b = (u.pm * BM) >> 13;
        const bool rot = (seg < 2) && (wc == 0);
        f32x4 cs0a = {0.f, 0.f, 0.f, 0.f}, cs0b = cs0a, cs1a = cs0a, cs1b = cs0a;
#pragma unroll
        for (int ai = 0; ai < 2; ++ai)
#pragma unroll
            for (int m = 0; m < 4; ++m) {
                const int row = row0 + ai * HALF + m * 16, s = row & (SEQ - 1);
                f32x4 cs = {1.f, 1.f, 1.f, 1.f}, sn = {0.f, 0.f, 0.f, 0.f};
                if (rot) { cs = *(const f32x4*)(rope + (size_t)row * 32 + 4 * fq); sn = *(const f32x4*)(rope + (size_t)row * 32 + 16 + 4 * fq); }
#pragma unroll
                for (int bj = 0; bj < 2; ++bj) {
                    f32x4 v0 = acc[ai][bj][m][0] * osc, v1 = acc[ai][bj][m][1] * osc;
                    if (rot) {
                        f32x4 w0, w1;
                        w0[0] = v0[0] * cs[0] - v0[1] * sn[0]; w0[1] = v0[1] * cs[0] + v0[0] * sn[0];
                        w0[2] = v0[2] * cs[1] - v0[3] * sn[1]; w0[3] = v0[3] * cs[1] + v0[2] * sn[1];
                        w1[0] = v1[0] * cs[2] - v1[1] * sn[2]; w1[1] = v1[1] * cs[2] + v1[0] * sn[2];
                        w1[2] = v1[2] * cs[3] - v1[3] * sn[3]; w1[3] = v1[3] * cs[3] + v1[2] * sn[3];
                        v0 = w0; v1 = w1;
                    }
                    u32x4 w; w.x = cvt_pk_bf16(v0[0], v0[1]); w.y = cvt_pk_bf16(v0[2], v0[3]); w.z = cvt_pk_bf16(v1[0], v1[1]); w.w = cvt_pk_bf16(v1[2], v1[3]);
                    *(u32x4*)(base + ((size_t)(b * NSLAB + slab0 + bj) * SEQ + s) * HD + wc * 32 + 8 * fq) = w;
                    if (KM && seg == 1) { const f32x4 ra = {bf_lo(w.x), bf_hi(w.x), bf_lo(w.y), bf_hi(w.y)}, rb = {bf_lo(w.z), bf_hi(w.z), bf_lo(w.w), bf_hi(w.w)};
                        if (bj == 0) { cs0a += ra; cs0b += rb; } else { cs1a += ra; cs1b += rb; } }
                }
            }
        if (KM && seg == 1) {
            bf16_t* km = (bf16_t*)((unsigned char*)QKV - WS_Q + WS_KMEAN);
            LAS float* kbuf = (LAS float*)(uintptr_t)(LDSCTL_OFF + 12288);
#define KM_RED(V, BJ, I0) do { _Pragma("unroll") for (int i = 0; i < 4; ++i) { float v = V[i]; v += dpp_mov<0xB1>(v); v += dpp_mov<0x4E>(v); v += dpp_mov<0x141>(v); v += dpp_mov<0x140>(v); \
                if (fr == 0) kbuf[((wr * 4 + wc) * 2 + (BJ)) * 32 + fq * 8 + (I0) + i] = v; } } while (0)
            KM_RED(cs0a, 0, 0); KM_RED(cs0b, 0, 4); KM_RED(cs1a, 1, 0); KM_RED(cs1b, 1, 4);
#undef KM_RED
            asm volatile("s_waitcnt lgkmcnt(0)" ::: "memory"); __builtin_amdgcn_s_barrier(); asm volatile("" ::: "memory");
            if (wr == 0) {
                const int l = fq * 16 + fr, bj = l >> 5, c32 = l & 31;
                const float mean = (kbuf[((0 * 4 + wc) * 2 + bj) * 32 + c32] + kbuf[((1 * 4 + wc) * 2 + bj) * 32 + c32]) * (1.f / 256.f);
                const unsigned hi = cvt_pk_bf16(mean, 0.f) & 0xffffu; const unsigned lo = cvt_pk_bf16(mean - bf_lo(hi), 0.f) & 0xffffu;
                const size_t ko = ((size_t)(b * NSLAB + slab0 + bj) * 64 + (u.pm & 31)) * HD + wc * 32 + c32;
                km[ko] = (bf16_t)hi; km[ko + 32 * HD] = (bf16_t)lo;
            }
        }
    }
};
struct EpiRes {
    static constexpr bool PERM = false;
    const float* xres; float* y; float osc;
    __device__ __forceinline__ void operator()(const f32x4 (&acc)[2][2][4][2], const Unit& u, int wr, int wc, int fr, int fq) const {
        const int row0 = u.pm * BM + wr * 64 + fr, col0 = u.pn * BM + wc * 32 + 4 * fq;
#pragma unroll
        for (int ai = 0; ai < 2; ++ai)
#pragma unroll
            for (int m = 0; m < 4; ++m) {
                const size_t ro = (size_t)(row0 + ai * HALF + m * 16) * DM + col0;
#pragma unroll
                for (int bj = 0; bj < 2; ++bj)
#pragma unroll
                    for (int n = 0; n < 2; ++n) { const f32x4 xr = *(const f32x4*)(xres + ro + bj * HALF + n * 16); *(f32x4*)(y + ro + bj * HALF + n * 16) = xr * ALPHA + acc[ai][bj][m][n] * osc; }
            }
    }
};
__device__ __forceinline__ float silu_mul(float g, float up) { return g * __builtin_amdgcn_rcpf(1.f + __builtin_amdgcn_exp2f(-1.4426950408889634f * g)) * up; }
template <bool OUT8> struct EpiSwiGLU {
    static constexpr bool PERM = true;
    bf16_t* H; float osc;
    __device__ __forceinline__ void operator()(const f32x4 (&acc)[2][2][4][2], const Unit& u, int wr, int wc, int fr, int fq) const {
        const int row0 = u.pm * BM + wr * 64 + fr, col0 = u.pn * 128 + wc * 32 + 8 * fq;
#pragma unroll
        for (int ai = 0; ai < 2; ++ai)
#pragma unroll
            for (int m = 0; m < 4; ++m) {
                const f32x4 g0 = acc[ai][0][m][0] * osc, g1 = acc[ai][0][m][1] * osc, u0 = acc[ai][1][m][0] * osc, u1 = acc[ai][1][m][1] * osc;
                if (OUT8) {
                    u32x2 w; w.x = pk4_fp8(silu_mul(g0[0], u0[0]), silu_mul(g0[1], u0[1]), silu_mul(g0[2], u0[2]), silu_mul(g0[3], u0[3]));
                    w.y = pk4_fp8(silu_mul(g1[0], u1[0]), silu_mul(g1[1], u1[1]), silu_mul(g1[2], u1[2]), silu_mul(g1[3], u1[3]));
                    *(u32x2*)((unsigned char*)H + (size_t)(row0 + ai * HALF + m * 16) * DE + col0) = w;
                } else {
                u32x4 w;
                w.x = cvt_pk_bf16(silu_mul(g0[0], u0[0]), silu_mul(g0[1], u0[1])); w.y = cvt_pk_bf16(silu_mul(g0[2], u0[2]), silu_mul(g0[3], u0[3]));
                w.z = cvt_pk_bf16(silu_mul(g1[0], u1[0]), silu_mul(g1[1], u1[1])); w.w = cvt_pk_bf16(silu_mul(g1[2], u1[2]), silu_mul(g1[3], u1[3]));
                *(u32x4*)(H + (size_t)(row0 + ai * HALF + m * 16) * DE + col0) = w;
                }
            }
    }
};
template <bool OUT8> struct EpiY {
    static constexpr bool PERM = true;
    bf16_t* Y; float osc;
    __device__ __forceinline__ void operator()(const f32x4 (&acc)[2][2][4][2], const Unit& u, int wr, int wc, int fr, int fq) const {
        const int row0 = u.pm * BM + wr * 64 + fr, col0 = u.pn * BM + wc * 32 + 8 * fq;
#pragma unroll
        for (int ai = 0; ai < 2; ++ai)
#pragma unroll
            for (int m = 0; m < 4; ++m) {
                bf16_t* rowp = Y + (size_t)(row0 + ai * HALF + m * 16) * DM + col0;
#pragma unroll
                for (int bj = 0; bj < 2; ++bj) { const f32x4 v0 = acc[ai][bj][m][0] * osc, v1 = acc[ai][bj][m][1] * osc;
                    if (OUT8) { u32x2 w; w.x = pk4_fp8(v0[0], v0[1], v0[2], v0[3]); w.y = pk4_fp8(v1[0], v1[1], v1[2], v1[3]);
                        *(u32x2*)((unsigned char*)Y + (size_t)(row0 + ai * HALF + m * 16) * DM + col0 + bj * HALF) = w; }
                    else { u32x4 w; w.x = cvt_pk_bf16(v0[0], v0[1]); w.y = cvt_pk_bf16(v0[2], v0[3]); w.z = cvt_pk_bf16(v1[0], v1[1]); w.w = cvt_pk_bf16(v1[2], v1[3]);
                        *(u32x4*)(rowp + bj * HALF) = w; } }
            }
    }
};

typedef int i32x4 __attribute__((ext_vector_type(4)));
typedef int i32x8 __attribute__((ext_vector_type(8)));
__device__ __forceinline__ i32x8 cat8(bf16x8 a, bf16x8 b) { const i32x4 x = __builtin_bit_cast(i32x4, a), y = __builtin_bit_cast(i32x4, b); return (i32x8){x[0], x[1], x[2], x[3], y[0], y[1], y[2], y[3]}; }
template <class Epi, class Sched, bool F8>
__device__ __forceinline__ void gemm_phase(LAS unsigned char* lds, const int K, const Sched& S, const Epi& E) {
    const int tid = threadIdx.x, wid = __builtin_amdgcn_readfirstlane(tid >> 6), lane = tid & 63, wr = wid >> 2, wc = wid & 3, fr = lane & 15, fq = lane >> 4;
    const int nt = K / 128;
    unsigned voffB[2];
#pragma unroll
    for (int i = 0; i < 2; ++i) { int R, C; stage_rc(tid * 16 + i * 8192, R, C); const int Rb = Epi::PERM ? ((R & ~31) + perm32(R & 31)) : R; voffB[i] = (unsigned)(Rb * K + C * 2); }
    const size_t kstep = (size_t)(BK * 2);
    const size_t hstep = (size_t)HALF * K;
    const unsigned ldsw = (unsigned)wid * 1024u;
    const int aoff = lds_byte(wr * 64 + fr, fq * 8), boff = lds_byte(wc * 32 + fr, fq * 8);
#define PG8_SA(b, h) (((b) * 2 + (h)) * HTB)
#define PG8_SB(b, h) ((4 + (b) * 2 + (h)) * HTB)
#define PG8_STAGE(bufoff, gbase, voff) do { _Pragma("unroll") for (int _i = 0; _i < 2; ++_i) \
        __builtin_amdgcn_global_load_lds((const unsigned*)((const char*)(gbase) + (voff)[_i]), (LAS unsigned*)(lds + (bufoff) + ldsw + _i * 8192), 16, 0, 0); } while (0)
#define PG8_LDA(dst, b, h) do { _Pragma("unroll") for (int m = 0; m < 4; ++m) _Pragma("unroll") for (int k = 0; k < 2; ++k) dst[m][k] = *(const LAS bf16x8*)(lds + PG8_SA(b, h) + aoff + m * 2048 + k * 1024); } while (0)
#define PG8_LDB(dst, b, h) do { _Pragma("unroll") for (int n = 0; n < 2; ++n) _Pragma("unroll") for (int k = 0; k < 2; ++k) dst[n][k] = *(const LAS bf16x8*)(lds + PG8_SB(b, h) + boff + n * 2048 + k * 1024); } while (0)
#define PG8_MMA(ai, bj, At, Bt) do { __builtin_amdgcn_s_setprio(1); _Pragma("unroll") for (int m = 0; m < 4; ++m) _Pragma("unroll") for (int n = 0; n < 2; ++n) { \
        if (F8) acc[ai][bj][m][n] = __builtin_amdgcn_mfma_scale_f32_16x16x128_f8f6f4(cat8(Bt[n][0], Bt[n][1]), cat8(At[m][0], At[m][1]), acc[ai][bj][m][n], 0, 0, 0, 0x7F7F7F7F, 0, 0x7F7F7F7F); \
        else { _Pragma("unroll") for (int k = 0; k < 2; ++k) acc[ai][bj][m][n] = __builtin_amdgcn_mfma_f32_16x16x32_bf16(Bt[n][k], At[m][k], acc[ai][bj][m][n], 0, 0, 0); } } \
        __builtin_amdgcn_s_setprio(0); } while (0)
#define PG8_WAIT_V(n) asm volatile("s_waitcnt vmcnt(" #n ")" ::: "memory")
#define PG8_WAIT_L(n) asm volatile("s_waitcnt lgkmcnt(" #n ")" ::: "memory")
#define PG8_BAR __builtin_amdgcn_s_barrier()
#define PG8_SCHED __builtin_amdgcn_sched_barrier(0)
    Unit cur, nxt; int ui = 0;
    if (!S.next(0, cur)) return;
    f32x4 acc[2][2][4][2];
#pragma unroll
    for (int a = 0; a < 2; ++a)
#pragma unroll
        for (int b = 0; b < 2; ++b)
#pragma unroll
            for (int m = 0; m < 4; ++m)
#pragma unroll
                for (int n = 0; n < 2; ++n) acc[a][b][m][n] = (f32x4){0.f, 0.f, 0.f, 0.f};
    bf16x8 At[4][2], B0[2][2], B1[2][2];
    unsigned cOff[2][2];
    const char* cA = S.a_base(cur); const char* cB = S.b_base(cur);
    S.a_off(cur, cOff);
    PG8_STAGE(PG8_SB(0, 0), cB, voffB); PG8_STAGE(PG8_SB(0, 1), cB + hstep, voffB); PG8_STAGE(PG8_SA(0, 0), cA, cOff[0]); PG8_STAGE(PG8_SA(0, 1), cA, cOff[1]);
    if (wr == 1) PG8_BAR;
    PG8_WAIT_V(2); PG8_BAR;
    PG8_STAGE(PG8_SB(1, 0), cB + kstep, voffB); PG8_STAGE(PG8_SA(1, 0), cA + kstep, cOff[0]); PG8_STAGE(PG8_SB(1, 1), cB + hstep + kstep, voffB);
    PG8_WAIT_V(6); PG8_BAR;
    for (;;) {
        const bool has_next = S.next(ui + 1, nxt);
        const char* nA = has_next ? S.a_base(nxt) : cA; const char* nB = has_next ? S.b_base(nxt) : cB;
#pragma unroll 1
        for (int t = 0; t < nt; t += 2) {
            const bool last = (t == nt - 2);
            const char* a1 = cA + (size_t)(t + 1) * kstep;
            const char* a2 = last ? nA : cA + (size_t)(t + 2) * kstep; const char* b2 = last ? nB : cB + (size_t)(t + 2) * kstep;
            const char* a3 = a2 + kstep; const char* b3 = b2 + kstep;
            PG8_LDB(B0, 0, 0); PG8_LDB(B1, 0, 1); PG8_SCHED; PG8_LDA(At, 0, 0); PG8_STAGE(PG8_SA(1, 1), a1, cOff[1]);
            if (last && has_next) S.a_off(nxt, cOff);
            PG8_WAIT_V(8); PG8_WAIT_L(0); PG8_BAR; PG8_MMA(0, 0, At, B0); PG8_MMA(0, 1, At, B1); PG8_BAR; PG8_SCHED;
            PG8_LDA(At, 0, 1); PG8_STAGE(PG8_SB(0, 0), b2, voffB); PG8_STAGE(PG8_SB(0, 1), b2 + hstep, voffB); PG8_STAGE(PG8_SA(0, 0), a2, cOff[0]);
            PG8_WAIT_V(8); PG8_WAIT_L(0); PG8_BAR; PG8_MMA(1, 0, At, B0); PG8_MMA(1, 1, At, B1); PG8_BAR; PG8_SCHED;
            PG8_LDB(B0, 1, 0); PG8_LDB(B1, 1, 1); PG8_SCHED; PG8_LDA(At, 1, 0); PG8_STAGE(PG8_SA(0, 1), a2, cOff[1]);
            PG8_WAIT_V(8); PG8_WAIT_L(0); PG8_BAR; PG8_MMA(0, 0, At, B0); PG8_MMA(0, 1, At, B1); PG8_BAR; PG8_SCHED;
            PG8_LDA(At, 1, 1); PG8_STAGE(PG8_SB(1, 0), b3, voffB); PG8_STAGE(PG8_SB(1, 1), b3 + hstep, voffB); PG8_STAGE(PG8_SA(1, 0), a3, cOff[0]);
            PG8_WAIT_V(8); PG8_WAIT_L(0); PG8_BAR; PG8_MMA(1, 0, At, B0); PG8_MMA(1, 1, At, B1); PG8_BAR; PG8_SCHED;
        }
        if (wr == 0) PG8_BAR;
        E(acc, cur, wr, wc, fr, fq);
        if (!has_next) break;
#pragma unroll
        for (int a = 0; a < 2; ++a)
#pragma unroll
            for (int b = 0; b < 2; ++b)
#pragma unroll
                for (int m = 0; m < 4; ++m)
#pragma unroll
                    for (int n = 0; n < 2; ++n) acc[a][b][m][n] = (f32x4){0.f, 0.f, 0.f, 0.f};
        cur = nxt; cA = nA; cB = nB; ++ui;
        if (wr == 1) PG8_BAR;
    }
    PG8_WAIT_V(0);
    PG8_BAR;
#undef PG8_SA
#undef PG8_SB
#undef PG8_STAGE
#undef PG8_LDA
#undef PG8_LDB
#undef PG8_MMA
#undef PG8_WAIT_V
#undef PG8_WAIT_L
#undef PG8_BAR
#undef PG8_SCHED
}
}

namespace att {
constexpr int D = 128, NW = 8, QBLK = 32, KVBLK = 64, QB = NW * QBLK;
constexpr float SCALE = 0.08838834764831845f;
constexpr float THR = 8.f;
constexpr int SHM_V = KVBLK * D * 2, SHM_K = KVBLK * D * 2;
constexpr int ATT_LDS = 2 * SHM_V + 2 * SHM_K + NW * 256 * 4;
#define KSWZ(row, colB) ((row) * 256 + ((colB) ^ (((row) & 7) << 4)))
__device__ __forceinline__ int v_st(int k, int c) { const int kk = (k & ~0xC) | ((k & 4) << 1) | ((k & 8) >> 1); return ((kk >> 3) * 4 + (c >> 5)) * 512 + ((kk & 7) * 32 + (c & 31)) * 2; }
__device__ __forceinline__ int v_rd_base(int lane) { return ((lane & 3) << 3) | (((lane >> 2) & 3) << 6) | (((lane >> 4) & 1) << 5) | (((lane >> 5) & 1) << 8); }
constexpr int v_rd_off(int d0, int ks, int half) { return d0 * 512 + ks * 4096 + half * 2048; }
__device__ __forceinline__ int crow(int r, int hi) { return (r & 3) + 8 * (r >> 2) + 4 * hi; }
__device__ __forceinline__ bf16x8 load8(const bf16_t* p) { return *reinterpret_cast<const bf16x8*>(p); }
__device__ __forceinline__ void mask_tile(f32x16& p0, f32x16& p1, int dq, unsigned W) {
    const float NEG = -__builtin_inff();
#pragma unroll
    for (int r = 0; r < 16; ++r) {
        const int c = (r & 3) + 8 * (r >> 2);
        if ((unsigned)(dq - c) >= W) p0[r] = NEG;
        if ((unsigned)(dq - c - 32) >= W) p1[r] = NEG;
    }
}
__device__ __forceinline__ void partialSM(f32x16& p0, f32x16& p1, float& m_reg, float& mn, float& alpha) {
    float pmax = p0[0];
#pragma unroll
    for (int r = 1; r < 16; ++r) pmax = fmaxf(pmax, p0[r]);
#pragma unroll
    for (int r = 0; r < 16; ++r) pmax = fmaxf(pmax, p1[r]);
    { auto rr = __builtin_amdgcn_permlane32_swap(__float_as_uint(pmax), __float_as_uint(pmax), false, false);
      pmax = fmaxf(__uint_as_float(rr[0]), __uint_as_float(rr[1])); }
    constexpr float C2 = 1.4426950408889634f * SCALE;
    if (__builtin_expect(__all((pmax - m_reg) * SCALE <= THR), 1)) { mn = m_reg; alpha = 1.f; }
    else { mn = fmaxf(m_reg, pmax); alpha = __builtin_amdgcn_exp2f((m_reg - mn) * C2); m_reg = mn; }
    const float mnL = -mn * C2;
#pragma unroll
    for (int r = 0; r < 16; ++r) p0[r] = fmaf(p0[r], C2, mnL);
#pragma unroll
    for (int r = 0; r < 16; ++r) p1[r] = fmaf(p1[r], C2, mnL);
#pragma unroll
    for (int r = 0; r < 16; ++r) p0[r] = __builtin_amdgcn_exp2f(p0[r]);
}
__device__ __forceinline__ void finishSM(f32x16& p0, f32x16& p1, float alpha, float& l_reg, bf16x8& pa0, bf16x8& pa1, bf16x8& pa2, bf16x8& pa3) {
#pragma unroll
    for (int r = 0; r < 16; ++r) p1[r] = __builtin_amdgcn_exp2f(p1[r]);
    float ps = 0;
#pragma unroll
    for (int r = 0; r < 16; ++r) ps += p0[r];
#pragma unroll
    for (int r = 0; r < 16; ++r) ps += p1[r];
    { auto rr = __builtin_amdgcn_permlane32_swap(__float_as_uint(ps), __float_as_uint(ps), false, false);
      ps = __uint_as_float(rr[0]) + __uint_as_float(rr[1]); }
    l_reg = l_reg * alpha + ps;
#define PK4(P, B_, OUT) do { unsigned a0 = cvt_pk_bf16(P[B_+0], P[B_+1]), a1 = cvt_pk_bf16(P[B_+2], P[B_+3]);                          \
        unsigned b0 = cvt_pk_bf16(P[B_+4], P[B_+5]), b1 = cvt_pk_bf16(P[B_+6], P[B_+7]);                                             \
        auto r0 = __builtin_amdgcn_permlane32_swap(a0, b0, false, false); auto r1 = __builtin_amdgcn_permlane32_swap(a1, b1, false, false); \
        u32x4 w = {r0[0], r1[0], r0[1], r1[1]}; OUT = *reinterpret_cast<bf16x8*>(&w); } while (0)
    PK4(p0, 0, pa0); PK4(p0, 8, pa1); PK4(p1, 0, pa2); PK4(p1, 8, pa3);
#undef PK4
}
template <int KB>
__device__ __forceinline__ void qkt(f32x16& p0, f32x16& p1, const char* K_lds, int r32, int hi, const bf16x8* qr) {
    p0 = f32x16{}; p1 = f32x16{};
    const char* kb[4];
#pragma unroll
    for (int dd = 0; dd < 4; ++dd) kb[dd] = K_lds + KB * SHM_K + KSWZ(r32, (dd * 16 + hi * 8) * 2);
#pragma unroll
    for (int d0 = 0; d0 < 8; ++d0) { const char* a = kb[d0 & 3] + (d0 >> 2) * 128;
        bf16x8 b0 = *reinterpret_cast<const bf16x8*>(a);
        bf16x8 b1 = *reinterpret_cast<const bf16x8*>(a + 32 * 256);
        p0 = __builtin_amdgcn_mfma_f32_32x32x16_bf16(b0, qr[d0], p0, 0, 0, 0);
        p1 = __builtin_amdgcn_mfma_f32_32x32x16_bf16(b1, qr[d0], p1, 0, 0, 0); }
}
template <int VB>
__device__ __forceinline__ void pv_tile(f32x16* o, int vb0, bf16x8 pa0, bf16x8 pa1, bf16x8 pa2, bf16x8 pa3) {
#define TRRD(dst, off) asm volatile("ds_read_b64_tr_b16 %0, %1 offset:%2" : "=&v"(dst) : "v"(vb0), "i"(off) : "memory")
#define PV_D0(d0) do { s16x4 l0, l1, l2, l3, h0, h1, h2, h3; constexpr int b_ = VB * SHM_V + v_rd_off(d0, 0, 0); \
        TRRD(l0, b_); TRRD(h0, b_ + 2048); TRRD(l1, b_ + 4096); TRRD(h1, b_ + 6144); TRRD(l2, b_ + 8192); TRRD(h2, b_ + 10240); TRRD(l3, b_ + 12288); TRRD(h3, b_ + 14336); \
        asm volatile("s_waitcnt lgkmcnt(0)" ::: "memory"); SBAR(); \
        o[d0] = __builtin_amdgcn_mfma_f32_32x32x16_bf16(pa0, (bf16x8){l0[0], l0[1], l0[2], l0[3], h0[0], h0[1], h0[2], h0[3]}, o[d0], 0, 0, 0);   \
        o[d0] = __builtin_amdgcn_mfma_f32_32x32x16_bf16(pa1, (bf16x8){l1[0], l1[1], l1[2], l1[3], h1[0], h1[1], h1[2], h1[3]}, o[d0], 0, 0, 0);   \
        o[d0] = __builtin_amdgcn_mfma_f32_32x32x16_bf16(pa2, (bf16x8){l2[0], l2[1], l2[2], l2[3], h2[0], h2[1], h2[2], h2[3]}, o[d0], 0, 0, 0);   \
        o[d0] = __builtin_amdgcn_mfma_f32_32x32x16_bf16(pa3, (bf16x8){l3[0], l3[1], l3[2], l3[3], h3[0], h3[1], h3[2], h3[3]}, o[d0], 0, 0, 0); } while (0)
    PV_D0(0); PV_D0(1); PV_D0(2); PV_D0(3);
#undef PV_D0
#undef TRRD
}
struct BlockRef { const bf16_t* Q; const bf16_t* K; const bf16_t* V; bf16_t* O; const unsigned* sel; const unsigned* list; float* ML; int P0, jlo, nvalid, nblk, hb; };
struct Seam { bf16x8 qr[8]; bf16x8 st_v0, st_v1, st_k0, st_k1; unsigned sel, qrow; };
#define ROW(p, k0, rr) ((p) + (size_t)((k0) + (rr)) * D + sc)
#define VMWN(n) asm volatile("s_waitcnt vmcnt(%0)" :: "i"(n) : "memory")
#define SLOAD_H(Kp, Vp, k0) do { S.st_v0 = load8(ROW(Vp, k0, sr)); S.st_v1 = load8(ROW(Vp, k0, 32 + sr));              \
                         S.st_k0 = load8(ROW(Kp, k0, sr)); S.st_k1 = load8(ROW(Kp, k0, 32 + sr)); } while (0)
#define SWRITE_HK(bf) do { *(bf16x8*)(K_lds + (bf) * SHM_K + kws) = S.st_k0; *(bf16x8*)(K_lds + (bf) * SHM_K + kws + 32 * 256) = S.st_k1; } while (0)
#define SWRITE_HV(bf) do { *(bf16x8*)(V_lds + (bf) * SHM_V + vst0) = S.st_v0; *(bf16x8*)(V_lds + (bf) * SHM_V + vst1) = S.st_v1; } while (0)
#define SWRITE_H(bf) do { SWRITE_HV(bf); SWRITE_HK(bf); } while (0)
template <bool SP>
__device__ __forceinline__ void attn_prime(const BlockRef& cur, char* lds, Seam& S) {
    int tid = threadIdx.x; asm volatile("" : "+v"(tid));
    const int wid = __builtin_amdgcn_readfirstlane(tid >> 6), lane = tid & 63, r32 = lane & 31, hi = lane >> 5;
    const int sr = tid >> 4, sc = (tid & 15) * 8, kws = KSWZ(sr, sc * 2); char* K_lds = lds + 2 * SHM_V;
    const int i = wid * QBLK + r32;
    unsigned q = (unsigned)i;
    if (SP) q = cur.list ? cur.list[i < cur.nvalid ? i : cur.nvalid - 1] : (unsigned)(cur.P0 + i);
    S.qrow = q; S.sel = SP ? cur.sel[q] : 0u;
#pragma unroll
    for (int d0 = 0; d0 < 8; ++d0) S.qr[d0] = load8(cur.Q + (size_t)q * D + d0 * 16 + hi * 8);
    SLOAD_H(cur.K, cur.V, SP ? cur.jlo * KVBLK : 0); VM_WAIT(); SWRITE_HK(0);
    __syncthreads();
}
template <bool SP>
__device__ __forceinline__ void attn_block(const BlockRef& cur, const BlockRef& nxt, const int ostride, char* lds, Seam& S) {
    int tid = threadIdx.x; asm volatile("" : "+v"(tid));
    const int wid = __builtin_amdgcn_readfirstlane(tid >> 6), lane = tid & 63, r32 = lane & 31, hi = lane >> 5;
    const int NT = SP ? 4 : cur.P0 / KVBLK + 4;
    const int jlo = SP ? cur.jlo : 0;
    const int qlo = cur.P0 + wid * QBLK, qm = qlo + r32 - 4 * hi;
    char* V_lds = lds; char* K_lds = lds + 2 * SHM_V;
    float* ws = (float*)(lds + 2 * SHM_V + 2 * SHM_K) + wid * 256; float* li_l = ws, * al_l = ws + 32;
    unsigned* rd = (unsigned*)(ws + 64); unsigned* nl = (unsigned*)(ws + 96);
    float m_reg = -1e30f, l_reg = 0; f32x16 o[4] = {};
    const int sr = tid >> 4, sc = (tid & 15) * 8, vst0 = v_st(sr, sc), vst1 = v_st(32 + sr, sc), kws = KSWZ(sr, sc * 2);
    const int vb0 = (int)(uintptr_t)V_lds + v_rd_base(lane);
    const bf16_t* Kh = cur.K; const bf16_t* Vh = cur.V;
    const bool causal = !SP || cur.list == nullptr;
#define RESC(a) do { if (__any((a) < 1.f)) { if (hi == 0) al_l[r32] = (a); asm volatile("s_waitcnt lgkmcnt(0)" ::: "memory");              \
                     for (int d_ = 0; d_ < 4; ++d_) for (int r = 0; r < 16; ++r) o[d_][r] *= al_l[crow(r, hi)]; } } while (0)
#define KBASE(t) ((jlo + (t)) * KVBLK)
#define MASKT(P0_, P1_, t) do { const int kb_ = KBASE(t); if (causal && kb_ + KVBLK - 1 > qlo) mask_tile(P0_, P1_, qm - kb_, 0x40000000u); } while (0)
    constexpr int NQL = 8;
#define SEAM_K0() do { VMWN(NQL); SWRITE_HK(0); SBAR(); } while (0)
    f32x16 pA0, pA1, pB0, pB1; float mnA, mnB, alA, alB; bf16x8 pa0, pa1, pa2, pa3;
    unsigned qn_tmp = 0u;
    if (SP) {
        if (hi == 0) { const bool valid = (cur.list == nullptr) || (wid * QBLK + r32 < cur.nvalid);
            const unsigned slot = cur.list ? (unsigned)__builtin_popcount(S.sel & ((1u << cur.nblk) - 1u)) : 3u;
            rd[r32] = valid ? (((unsigned)cur.hb + S.qrow) * 4u + slot) * 128u : (1u << 27); }
        if (nxt.list) { const int i = wid * QBLK + r32; qn_tmp = nxt.list[i < nxt.nvalid ? i : nxt.nvalid - 1]; }
    }
    SWRITE_HV(0); SBAR();
    if (NT > 1) { SLOAD_H(Kh, Vh, KBASE(1)); }
    SBAR(); qkt<0>(pA0, pA1, K_lds, r32, hi, S.qr);
    MASKT(pA0, pA1, 0); partialSM(pA0, pA1, m_reg, mnA, alA);
    if (NT > 1) { VM_WAIT(); SWRITE_H(1); }
    if (SP) nl[lane] = nxt.list ? qn_tmp : (unsigned)(nxt.P0 + wid * QBLK + r32);
    __syncthreads();
#define HALF_STEP(PX0, PX1, mnX, alX, PY0, PY1, alY, t, KB, VB, SB) do {                                                      \
        SBAR(); qkt<KB>(PX0, PX1, K_lds, r32, hi, S.qr);                                                                      \
        finishSM(PY0, PY1, alY, l_reg, pa0, pa1, pa2, pa3); SBAR();                                                           \
        if ((t) + 1 < NT) { SLOAD_H(Kh, Vh, KBASE((t) + 1)); SBAR(); }                                                        \
        pv_tile<VB>(o, vb0, pa0, pa1, pa2, pa3); MASKT(PX0, PX1, (t)); partialSM(PX0, PX1, m_reg, mnX, alX);                  \
        __syncthreads();                                                                                                      \
        if ((t) + 1 < NT) { VM_WAIT(); SWRITE_H(SB); }                                                                        \
        RESC(alX); __syncthreads(); } while (0)
    for (int t = 1; t + 1 < NT; t += 2) {
        HALF_STEP(pB0, pB1, mnB, alB, pA0, pA1, alA, t, 1, 0, 0);
        HALF_STEP(pA0, pA1, mnA, alA, pB0, pB1, alB, t + 1, 0, 1, 1);
    }
    const bool even = (NT & 1) == 0;
    if (even) { SBAR(); qkt<1>(pB0, pB1, K_lds, r32, hi, S.qr); SBAR(); }
    unsigned qn = (unsigned)(wid * QBLK + r32);
    if (SP) { qn = nl[lane]; S.qrow = qn; S.sel = nxt.sel[qn]; }
    SLOAD_H(nxt.K, nxt.V, SP ? nxt.jlo * KVBLK : 0); SBAR();
#pragma unroll
    for (int d0 = 0; d0 < 8; ++d0) S.qr[d0] = load8(nxt.Q + (size_t)qn * D + d0 * 16 + hi * 8);
    SBAR();
    finishSM(pA0, pA1, alA, l_reg, pa0, pa1, pa2, pa3); SBAR();
    pv_tile<0>(o, vb0, pa0, pa1, pa2, pa3);
    if (even) { MASKT(pB0, pB1, NT - 1); partialSM(pB0, pB1, m_reg, mnB, alB); __syncthreads(); RESC(alB);
        finishSM(pB0, pB1, alB, l_reg, pa0, pa1, pa2, pa3); SBAR(); pv_tile<1>(o, vb0, pa0, pa1, pa2, pa3); }
    SBAR(); SEAM_K0();
    if (hi == 0) li_l[r32] = l_reg; asm volatile("s_waitcnt lgkmcnt(0)" ::: "memory");
    float rli[16];
#pragma unroll
    for (int r = 0; r < 16; ++r) rli[r] = __builtin_amdgcn_rcpf(li_l[crow(r, hi)]);
    if (SP) {
        bf16_t* Ob = cur.O;
#pragma unroll
        for (int r = 0; r < 16; ++r) { const unsigned off = rd[crow(r, hi)];
#pragma unroll
            for (int d0 = 0; d0 < 4; ++d0) { const float v = o[d0][r] * rli[r];
                const float vn = __int_as_float(__builtin_amdgcn_mov_dpp(__float_as_int(v), 0xB1, 0xF, 0xF, true));
                if ((r32 & 1) == 0) *(unsigned*)(Ob + (size_t)off + d0 * 32 + r32) = cvt_pk_bf16(v, vn); } }
        if (hi == 0) { float* mlp = cur.ML + (size_t)(rd[r32] >> 7) * 2; f32x2 ml = {m_reg, l_reg}; *(f32x2*)mlp = ml; }
    } else {
        bf16_t* Ow = cur.O + (size_t)(wid * QBLK) * ostride;
#pragma unroll
        for (int r = 0; r < 16; ++r) { const int orow = crow(r, hi);
#pragma unroll
            for (int d0 = 0; d0 < 4; ++d0) { const float v = o[d0][r] * rli[r];
                const float vn = __int_as_float(__builtin_amdgcn_mov_dpp(__float_as_int(v), 0xB1, 0xF, 0xF, true));
                if ((r32 & 1) == 0) *(unsigned*)(Ow + (size_t)orow * ostride + d0 * 32 + r32) = cvt_pk_bf16(v, vn); } }
    }
    __syncthreads();
#undef RESC
#undef KBASE
#undef MASKT
#undef SEAM_K0
#undef HALF_STEP
}
#undef ROW
#undef VMWN
#undef SLOAD_H
#undef SWRITE_HK
#undef SWRITE_HV
#undef SWRITE_H
}

struct Args { const float* in[23]; float* out; unsigned char* ws; int ph_lo, ph_hi; };
typedef const __attribute__((address_space(4))) Args* KArgs;
__device__ __forceinline__ KArgs kargs() { KArgs p = (KArgs)__builtin_amdgcn_kernarg_segment_ptr(); asm volatile("" : "+s"(p)); return p; }
__device__ __forceinline__ int otid() { int t = threadIdx.x; asm volatile("" : "+v"(t)); return t; }
struct Geo { int G, bx, vcu, gw, NGW; };
__device__ __forceinline__ Geo geo() {
    Geo g; const int tid = otid(); const int wave = __builtin_amdgcn_readfirstlane(tid >> 6);
    g.G = gridDim.x; g.bx = blockIdx.x; g.vcu = (g.G % 8 == 0) ? (g.bx % 8) * (g.G / 8) + g.bx / 8 : g.bx; g.gw = g.vcu * NWAVES + wave; g.NGW = g.G * NWAVES; return g;
}
enum { I_X = 0, I_POS, I_LN1G, I_LN1B, I_LN2G, I_LN2B, I_DAWIN, I_DAWOUT, I_LQ1, I_LK1, I_LQ2, I_LK2, I_SUBLN, I_MBWIN, I_MBWOUT, I_WR, I_RB, I_WG, I_WU, I_WD, I_SG, I_SU, I_SD };

__device__ __forceinline__ int dst_row(int kind, int n) {
    if (kind == 1) { if (n < 4096) { int d = n & 127; const int h = n & ~127; if (d < 16) d = 2 * d; else if (d < 32) d = 2 * (d - 16) + 1; return h + d; } return n; }
    if (kind == 2) return ((n >> 7) << 8) + (n & 127);
    if (kind == 3) return ((n >> 7) << 8) + 128 + (n & 127);
    return n;
}
struct TrDesc { const float* W; unsigned char* WT; int K, N, k0, n0, kind, f8; };
constexpr int IT_IN = 32 * 192, IT_OUT = 32 * 64, IT_E = 512, IT_ATT = 2 * IT_IN + 2 * IT_OUT, IT_TOTAL = IT_ATT + 2 * NEX * 3 * IT_E;
__device__ __forceinline__ void tr_decode(KArgs a, int it, TrDesc& d) {
    unsigned char* ws = a->ws; int s;
    if (it < IT_ATT) {
        if (it < IT_IN) { d.W = a->in[I_DAWIN]; d.WT = ws + WS_WATT; d.K = DM; d.N = NQKV; d.kind = 1; d.f8 = FP8_QKV0; s = it; }
        else if (it < 2 * IT_IN) { d.W = a->in[I_MBWIN]; d.WT = ws + WS_WATT + 32 * MiB; d.K = DM; d.N = NQKV; d.kind = 1; d.f8 = FP8_QKV1; s = it - IT_IN; }
        else if (it < 2 * IT_IN + IT_OUT) { d.W = a->in[I_DAWOUT]; d.WT = ws + WS_WATT + 24 * MiB; d.K = DM; d.N = DM; d.kind = 0; d.f8 = FP8_OUT0; s = it - 2 * IT_IN; }
        else { d.W = a->in[I_MBWOUT]; d.WT = ws + WS_WATT + 56 * MiB; d.K = DM; d.N = DM; d.kind = 0; d.f8 = FP8_OUT1; s = it - 2 * IT_IN - IT_OUT; }
    } else {
        const int r = it - IT_ATT, le = r / (3 * IT_E), sub = r - le * (3 * IT_E), mtx = sub / IT_E; s = sub - mtx * IT_E;
        const int l = le / NEX, e = le - l * NEX;
        const size_t EW = (size_t)DM * DE;
        if (mtx < 2) {
            const float* src = (e < NE) ? a->in[mtx == 0 ? I_WG : I_WU] + ((size_t)l * NE + e) * EW : a->in[mtx == 0 ? I_SG : I_SU] + (size_t)l * EW;
            d.f8 = MOE_F8(l);
            d.W = src; d.WT = ws + WS_WGU + (size_t)l * NEX * (2 * EW) * 2 + (size_t)e * (2 * EW) * (d.f8 ? 1 : 2); d.K = DM; d.N = DE; d.kind = 2 + mtx;
        } else {
            const float* src = (e < NE) ? a->in[I_WD] + ((size_t)l * NE + e) * EW : a->in[I_SD] + (size_t)l * EW;
            d.f8 = MOE_F8(l);
            d.W = src; d.WT = ws + WS_WD + (size_t)l * NEX * EW * 2 + (size_t)e * EW * (d.f8 ? 1 : 2); d.K = DE; d.N = DM; d.kind = 0;
        }
    }
    const int nblk = d.N / 32; const int kb = s / nblk; d.k0 = kb * 64; d.n0 = (s - kb * nblk) * 32;
}
__device__ __forceinline__ void tr_load(const TrDesc& d, int lane, f32x4 (&v)[8]) {
    const int kk = lane >> 3, n4 = (lane & 7) * 4;
#pragma unroll
    for (int i = 0; i < 8; ++i) v[i] = *(const f32x4*)(d.W + (size_t)(d.k0 + kk + 8 * i) * d.N + d.n0 + n4);
}
__device__ __forceinline__ void tr_store(const TrDesc& d, int lane, const f32x4 (&v)[8], LAS float* scr) {
    const int kk = lane >> 3, n4 = (lane & 7) * 4, c = lane & 3;
#pragma unroll
    for (int hf = 0; hf < 2; ++hf) {
#pragma unroll
        for (int i = 0; i < 4; ++i)
#pragma unroll
            for (int q = 0; q < 4; ++q) scr[(kk + 8 * i) * 33 + n4 + q] = v[hf * 4 + i][q];
        LDS_WAIT();
#pragma unroll
        for (int j = 0; j < 2; ++j) { const int n = (lane >> 2) + 16 * j; const LAS float* s = scr + (8 * c) * 33 + n;
            const size_t eo = (size_t)dst_row(d.kind, d.n0 + n) * d.K + d.k0 + hf * 32 + 8 * c;
            if (d.f8) { u32x2 o; o.x = pk4_fp8(s[0 * 33] * W8_SCALE, s[1 * 33] * W8_SCALE, s[2 * 33] * W8_SCALE, s[3 * 33] * W8_SCALE); o.y = pk4_fp8(s[4 * 33] * W8_SCALE, s[5 * 33] * W8_SCALE, s[6 * 33] * W8_SCALE, s[7 * 33] * W8_SCALE);
                *(u32x2*)(d.WT + eo) = o; }
            else { u32x4 o; o.x = cvt_pk_bf16(s[0 * 33], s[1 * 33]); o.y = cvt_pk_bf16(s[2 * 33], s[3 * 33]); o.z = cvt_pk_bf16(s[4 * 33], s[5 * 33]); o.w = cvt_pk_bf16(s[6 * 33], s[7 * 33]);
                *(u32x4*)(d.WT + eo * 2) = o; } }
        LDS_WAIT();
    }
}
__device__ __forceinline__ void convert_items(KArgs a, LAS float* scr, int gw, int NGW, int lane, int it0, int it1) {
    TrDesc dA, dB, dC; f32x4 vA[8], vB[8], vC[8];
    int it = it0 + gw;
#define CV_LD(D, V, IT) do { if ((IT) < it1) { tr_decode(a, (IT), D); tr_load(D, lane, V); } } while (0)
    CV_LD(dA, vA, it); CV_LD(dB, vB, it + NGW); CV_LD(dC, vC, it + 2 * NGW);
    while (it < it1) {
        tr_store(dA, lane, vA, scr); CV_LD(dA, vA, it + 3 * NGW);
        if (it + NGW < it1) { tr_store(dB, lane, vB, scr); CV_LD(dB, vB, it + 4 * NGW); }
        if (it + 2 * NGW < it1) { tr_store(dC, lane, vC, scr); CV_LD(dC, vC, it + 5 * NGW); }
        it += 3 * NGW;
    }
#undef CV_LD
}
__device__ __forceinline__ void p0_prologue(KArgs a, LAS unsigned char* lds, int gw, int NGW, int wave, int lane) {
    LAS float* scr = (LAS float*)(lds + wave * 4224);
    convert_items(a, scr, gw, NGW, lane, 0, IT_IN);
    {
        const float* x = a->in[I_X]; bf16_t* xb = (bf16_t*)(a->ws + WS_XB);
        f32x4 vn[8];
        if (gw < NTOK) {
#pragma unroll
            for (int j = 0; j < 4; ++j) { vn[2 * j] = *(const f32x4*)(x + (size_t)gw * DM + 512 * j + 8 * lane); vn[2 * j + 1] = *(const f32x4*)(x + (size_t)gw * DM + 512 * j + 8 * lane + 4); } }
        for (int m = gw; m < NTOK; m += NGW) {
            f32x4 v[8];
#pragma unroll
            for (int j = 0; j < 8; ++j) v[j] = vn[j];
            if (m + NGW < NTOK) {
#pragma unroll
                for (int j = 0; j < 4; ++j) { vn[2 * j] = *(const f32x4*)(x + (size_t)(m + NGW) * DM + 512 * j + 8 * lane); vn[2 * j + 1] = *(const f32x4*)(x + (size_t)(m + NGW) * DM + 512 * j + 8 * lane + 4); } }
#pragma unroll
            for (int j = 0; j < 4; ++j) {
                if (FP8_QKV0) { u32x2 w; w.x = pk4_fp8(v[2 * j][0], v[2 * j][1], v[2 * j][2], v[2 * j][3]); w.y = pk4_fp8(v[2 * j + 1][0], v[2 * j + 1][1], v[2 * j + 1][2], v[2 * j + 1][3]);
                    *(u32x2*)((unsigned char*)xb + (size_t)m * DM + 512 * j + 8 * lane) = w; }
                else { u32x4 w; w.x = cvt_pk_bf16(v[2 * j][0], v[2 * j][1]); w.y = cvt_pk_bf16(v[2 * j][2], v[2 * j][3]); w.z = cvt_pk_bf16(v[2 * j + 1][0], v[2 * j + 1][1]); w.w = cvt_pk_bf16(v[2 * j + 1][2], v[2 * j + 1][3]);
                    *(u32x4*)(xb + (size_t)m * DM + 512 * j + 8 * lane) = w; } }
        }
    }
    {
        bf16_t* wf = (bf16_t*)(a->ws + WS_WRF);
        for (int idx = gw * 64 + lane; idx < 2 * 2 * 128 * 64; idx += NGW * 64) {
            const int ln = idx & 63, s = (idx >> 6) & 127, blk = (idx >> 13) & 1, l = idx >> 14;
            const int e = blk * 32 + (ln & 31), c = 16 * s + 8 * (ln >> 5);
            const float* w = a->in[I_WR] + ((size_t)l * DM + c) * NE + e;
            float v[8];
#pragma unroll
            for (int j = 0; j < 8; ++j) v[j] = w[(size_t)j * NE];
            u32x4 h, lo;
            h.x = cvt_pk_bf16(v[0], v[1]); h.y = cvt_pk_bf16(v[2], v[3]); h.z = cvt_pk_bf16(v[4], v[5]); h.w = cvt_pk_bf16(v[6], v[7]);
            lo.x = cvt_pk_bf16(v[0] - bf_lo(h.x), v[1] - bf_hi(h.x)); lo.y = cvt_pk_bf16(v[2] - bf_lo(h.y), v[3] - bf_hi(h.y));
            lo.z = cvt_pk_bf16(v[4] - bf_lo(h.z), v[5] - bf_hi(h.z)); lo.w = cvt_pk_bf16(v[6] - bf_lo(h.w), v[7] - bf_hi(h.w));
            const size_t fo = (((size_t)(l * 2 + 0) * 2 + blk) * 128 + s) * 64 + ln, fl = (((size_t)(l * 2 + 1) * 2 + blk) * 128 + s) * 64 + ln;
            *(u32x4*)(wf + fo * 8) = h; *(u32x4*)(wf + fl * 8) = lo;
        }
    }
    {
        const int* pos = (const int*)a->in[I_POS]; float* tab = (float*)(a->ws + WS_ROPE);
        for (int idx = gw * 64 + lane; idx < NTOK * 16; idx += NGW * 64) {
            const int t = idx >> 4, i = idx & 15;
            const float inv = powf(500000.f, -(float)(2 * i) / 32.f);
            const float ang = (float)pos[t] * inv;
            double rev = (double)ang * 0.15915494309189535; rev -= floor(rev);
            const float fr = (float)rev;
            tab[(size_t)t * 32 + i] = __builtin_amdgcn_cosf(fr); tab[(size_t)t * 32 + 16 + i] = __builtin_amdgcn_sinf(fr);
        }
    }
}

__device__ __forceinline__ void da_combine(KArgs a, int gw, int NGW, int lane) {
    float lam;
    {   const float* q1 = a->in[I_LQ1]; const float* k1 = a->in[I_LK1]; const float* q2 = a->in[I_LQ2]; const float* k2 = a->in[I_LK2];
        const float s1 = wave_sum(q1[lane] * k1[lane] + q1[lane + 64] * k1[lane + 64]);
        const float s2 = wave_sum(q2[lane] * k2[lane] + q2[lane + 64] * k2[lane + 64]);
        lam = expf(s1) - expf(s2) + LAMBDA_INIT; }
    const bf16_t* O = (const bf16_t*)(a->ws + WS_O); bf16_t* AO = (bf16_t*)(a->ws + WS_AOUT);
    const f32x4 g = *(const f32x4*)(a->in[I_SUBLN] + 4 * lane);
    for (int t = gw; t < NTOK; t += NGW) {
        const bf16_t* row = O + (size_t)t * 4096;
        u32x2 x1[8], x2[8];
#pragma unroll
        for (int h = 0; h < 8; ++h) { x1[h] = *(const u32x2*)(row + h * 512 + 4 * lane); x2[h] = *(const u32x2*)(row + h * 512 + 256 + 4 * lane); }
#pragma unroll
        for (int h = 0; h < 8; ++h) {
            f32x4 o;
            o[0] = bf_lo(x1[h].x) - lam * bf_lo(x2[h].x); o[1] = bf_hi(x1[h].x) - lam * bf_hi(x2[h].x);
            o[2] = bf_lo(x1[h].y) - lam * bf_lo(x2[h].y); o[3] = bf_hi(x1[h].y) - lam * bf_hi(x2[h].y);
            const float ss = wave_sum(o[0] * o[0] + o[1] * o[1] + o[2] * o[2] + o[3] * o[3]);
            const float sc = __builtin_amdgcn_rsqf(ss * (1.f / 256.f) + LN_EPS) * (1.f - LAMBDA_INIT);
            if (FP8_OUT0) { const float s8 = sc * AO8_SCALE; *(unsigned*)((unsigned char*)AO + (size_t)t * DM + h * 256 + 4 * lane) = pk4_fp8(o[0] * s8 * g[0], o[1] * s8 * g[1], o[2] * s8 * g[2], o[3] * s8 * g[3]); }
            else { u32x2 w; w.x = cvt_pk_bf16(o[0] * sc * g[0], o[1] * sc * g[1]); w.y = cvt_pk_bf16(o[2] * sc * g[2], o[3] * sc * g[3]);
                *(u32x2*)(AO + (size_t)t * DM + h * 256 + 4 * lane) = w; }
        }
    }
}

__device__ __forceinline__ void moba_kmean(KArgs a, int gw, int NGW, int lane) {
    const bf16_t* Kb = (const bf16_t*)(a->ws + WS_K); bf16_t* km = (bf16_t*)(a->ws + WS_KMEAN);
    for (int it = gw; it < BATCH * NSLAB * 32; it += NGW) {
        const int bh = it >> 5, n = it & 31;
        const bf16_t* p = Kb + ((size_t)bh * SEQ + (size_t)n * 256) * HD + 2 * lane;
        float s0 = 0.f, s1 = 0.f;
#pragma unroll 4
        for (int r = 0; r < 256; r += 8) {
            unsigned u[8];
#pragma unroll
            for (int q = 0; q < 8; ++q) u[q] = *(const unsigned*)(p + (size_t)(r + q) * HD);
#pragma unroll
            for (int q = 0; q < 8; ++q) { s0 += bf_lo(u[q]); s1 += bf_hi(u[q]); }
        }
        s0 *= (1.f / 256.f); s1 *= (1.f / 256.f);
        const unsigned hi = cvt_pk_bf16(s0, s1);
        const unsigned lo = cvt_pk_bf16(s0 - bf_lo(hi), s1 - bf_hi(hi));
        *(unsigned*)(km + ((size_t)bh * 64 + n) * HD + 2 * lane) = hi;
        *(unsigned*)(km + ((size_t)bh * 64 + 32 + n) * HD + 2 * lane) = lo;
    }
}
__device__ __forceinline__ void moba_gate(KArgs a, int gw, int NGW, int lane) {
    const bf16_t* Qb = (const bf16_t*)(a->ws + WS_Q); const bf16_t* km = (const bf16_t*)(a->ws + WS_KMEAN); unsigned* sel = (unsigned*)(a->ws + WS_SEL);
    unsigned* mcnt = (unsigned*)(a->ws + WS_CTL) + CW_MCNT; unsigned* qlist = (unsigned*)(a->ws + WS_QLIST);
    const int r32 = lane & 31, hi = lane >> 5;
    for (int it = gw; it < BATCH * NSLAB * (SEQ / 32); it += NGW) {
        const int bh = it >> 8, qg = it & 255, j = qg >> 3;
        const bf16_t* q = Qb + ((size_t)bh * SEQ + (size_t)qg * 32 + r32) * HD + hi * 8;
        const bf16_t* k = km + ((size_t)bh * 64 + r32) * HD + hi * 8;
        f32x16 p = {};
        bf16x8 qf[8], kh[8], kl[8];
#pragma unroll
        for (int d0 = 0; d0 < 8; ++d0) { qf[d0] = *(const bf16x8*)(q + d0 * 16); kh[d0] = *(const bf16x8*)(k + d0 * 16); kl[d0] = *(const bf16x8*)(k + 32 * HD + d0 * 16); }
        SBAR();
#pragma unroll
        for (int d0 = 0; d0 < 8; ++d0) {
            p = __builtin_amdgcn_mfma_f32_32x32x16_bf16(kh[d0], qf[d0], p, 0, 0, 0);
            p = __builtin_amdgcn_mfma_f32_32x32x16_bf16(kl[d0], qf[d0], p, 0, 0, 0);
        }
        float g[32];
#pragma unroll
        for (int r = 0; r < 16; ++r) {
            const float mine = p[r], other = __shfl_xor(mine, 32);
            const int qd = r >> 2, s = r & 3;
            g[8 * qd + s] = hi ? other : mine;
            g[8 * qd + 4 + s] = hi ? mine : other;
        }
        unsigned mask = 0u;
#pragma unroll
        for (int pass = 0; pass < 3; ++pass) {
            float best = -__builtin_inff(); int bi = -1;
#pragma unroll
            for (int n = 0; n < 32; ++n) { const bool ok = (n < j) && !((mask >> n) & 1u) && (g[n] > best); best = ok ? g[n] : best; bi = ok ? n : bi; }
            if (bi >= 0) mask |= 1u << bi;
        }
        if (hi == 0) sel[(size_t)bh * SEQ + (size_t)qg * 32 + r32] = mask;
        const bool rowlane = hi == 0;
        unsigned cntv = 0u;
        for (int n = 0; n < j; ++n) { const unsigned long long bb = __ballot(rowlane && ((mask >> n) & 1u)); if (lane == n) cntv = (unsigned)__popcll(bb); }
        unsigned basev = 0u;
        if (lane < j && cntv) basev = __hip_atomic_fetch_add(mcnt + bh * 32 + lane, cntv, __ATOMIC_RELAXED, __HIP_MEMORY_SCOPE_AGENT);
        for (int n = 0; n < j; ++n) { const unsigned long long bb = __ballot(rowlane && ((mask >> n) & 1u)); const unsigned base = (unsigned)__builtin_amdgcn_readlane((int)basev, n);
            if (rowlane && ((mask >> n) & 1u)) qlist[(size_t)(bh * 32 + n) * SEQ + base + (unsigned)__popcll(bb & ((1ull << lane) - 1ull))] = (unsigned)(qg * 32 + r32); }
    }
}

__device__ __forceinline__ void ln_router(KArgs a, int layer, LAS unsigned char* lds, int vcu, int G, int wave, int lane) {
    float* out = a->out; bf16_t* xb = (bf16_t*)(a->ws + WS_XB);
    const float* gam = a->in[I_LN1G] + layer * DM; const float* bet = a->in[I_LN1B] + layer * DM;
    const float rb = a->in[I_RB][layer * NE + lane];
    const bf16_t* wfh = (const bf16_t*)(a->ws + WS_WRF) + (size_t)(layer * 2 + 0) * 2 * 128 * 64 * 8;
    const bf16_t* wfl = (const bf16_t*)(a->ws + WS_WRF) + (size_t)(layer * 2 + 1) * 2 * 128 * 64 * 8;
    unsigned* gcount = (unsigned*)(a->ws + WS_CTL) + CW_CNT + layer * NE * 16;
    unsigned* list = (unsigned*)(a->ws + WS_LIST); unsigned* toke = (unsigned*)(a->ws + WS_TOKE); float* tokw = (float*)(a->ws + WS_TOKW);
    LAS unsigned char* xh = lds;
    LAS unsigned char* xl = lds + 65536;
    LAS float* part = (LAS float*)lds;
    LAS int* lcount = (LAS int*)(lds + LT_LCNT); LAS int* lbase = (LAS int*)(lds + LT_LBASE);
    LAS unsigned* ent = (LAS unsigned*)(lds + LT_ENT);
    const int t_beg = vcu * 64;
    if (threadIdx.x < 64) lcount[threadIdx.x] = 0;
    const int n32 = lane & 31, h5 = lane >> 5;
    f32x4 vn[8], gg[8], bb[8];
    {   const float* yr = out + (size_t)(t_beg + wave * 2) * DM;
#pragma unroll
        for (int j = 0; j < 8; ++j) vn[j] = *(const f32x4*)(yr + 256 * j + 4 * lane);
#pragma unroll
        for (int j = 0; j < 8; ++j) { gg[j] = *(const f32x4*)(gam + 256 * j + 4 * lane); bb[j] = *(const f32x4*)(bet + 256 * j + 4 * lane); } }
    __syncthreads();
#pragma unroll 1
    for (int it = 0; it < 4; ++it) {
#pragma unroll 1
        for (int k = 0; k < 2; ++k) {
            const int lt = 2 * wave + k, t = t_beg + 16 * it + lt; float* yr = out + (size_t)t * DM;
            f32x4 v[8]; float s = 0.f;
#pragma unroll
            for (int j = 0; j < 8; ++j) { v[j] = vn[j]; s += (v[j][0] + v[j][1]) + (v[j][2] + v[j][3]); }
            {
                const int tn = (k == 0) ? t + 1 : t + 15;
                if (k == 0 || it < 3) { const float* yn = out + (size_t)tn * DM;
#pragma unroll
                    for (int j = 0; j < 8; ++j) vn[j] = *(const f32x4*)(yn + 256 * j + 4 * lane); } }
            const float mean = wave_sum(s) * (1.f / DM); float s2 = 0.f;
#pragma unroll
            for (int j = 0; j < 8; ++j) { v[j] = v[j] - mean; s2 += (v[j][0] * v[j][0] + v[j][1] * v[j][1]) + (v[j][2] * v[j][2] + v[j][3] * v[j][3]); }
            const float rstd = __builtin_amdgcn_rsqf(wave_sum(s2) * (1.f / DM) + LN_EPS);
#pragma unroll
            for (int j = 0; j < 8; ++j) {
                const f32x4 xv = v[j] * rstd * gg[j] + bb[j];
                *(f32x4*)(yr + 256 * j + 4 * lane) = xv;
                u32x2 w; w.x = cvt_pk_bf16(xv[0], xv[1]); w.y = cvt_pk_bf16(xv[2], xv[3]);
                if (MOE_F8(layer)) *(unsigned*)((unsigned char*)xb + (size_t)t * DM + 256 * j + 4 * lane) = pk4_fp8(xv[0], xv[1], xv[2], xv[3]);
                else *(u32x2*)(xb + (size_t)t * DM + 256 * j + 4 * lane) = w;
                u32x2 wl; wl.x = cvt_pk_bf16(xv[0] - bf_lo(w.x), xv[1] - bf_hi(w.x)); wl.y = cvt_pk_bf16(xv[2] - bf_lo(w.y), xv[3] - bf_hi(w.y));
                const int chunk = 32 * j + (lane >> 1), sw = lt * 4096 + ((chunk ^ lt) << 4) + 8 * (lane & 1);
                *(LAS u32x2*)(xh + sw) = w;
                *(LAS u32x2*)(xl + sw) = wl;
            }
        }
        __syncthreads();
        f32x16 acc0 = {}, acc1 = {};
        {
            const int row = n32 & 15;
            const bf16_t* wh0 = wfh + ((size_t)(0 * 128 + wave * 16) * 64 + lane) * 8; const bf16_t* wh1 = wfh + ((size_t)(1 * 128 + wave * 16) * 64 + lane) * 8;
            const bf16_t* wl0 = wfl + ((size_t)(0 * 128 + wave * 16) * 64 + lane) * 8; const bf16_t* wl1 = wfl + ((size_t)(1 * 128 + wave * 16) * 64 + lane) * 8;
#pragma unroll 1
            for (int sg = 0; sg < 16; sg += 4) {
                bf16x8 ah0[4], ah1[4], al0[4], al1[4];
#pragma unroll
                for (int u = 0; u < 4; ++u) { const int s = sg + u; ah0[u] = *(const bf16x8*)(wh0 + s * 512); ah1[u] = *(const bf16x8*)(wh1 + s * 512); al0[u] = *(const bf16x8*)(wl0 + s * 512); al1[u] = *(const bf16x8*)(wl1 + s * 512); }
                SBAR();
#pragma unroll
                for (int u = 0; u < 4; ++u) { const int s = sg + u;
                    const int off = row * 4096 + (((wave * 32 + 2 * s + h5) ^ row) << 4);
                    const bf16x8 bh = *(const LAS bf16x8*)(xh + off), bl = *(const LAS bf16x8*)(xl + off);
                    acc0 = __builtin_amdgcn_mfma_f32_32x32x16_bf16(ah0[u], bh, acc0, 0, 0, 0); acc1 = __builtin_amdgcn_mfma_f32_32x32x16_bf16(ah1[u], bh, acc1, 0, 0, 0);
                    acc0 = __builtin_amdgcn_mfma_f32_32x32x16_bf16(ah0[u], bl, acc0, 0, 0, 0); acc1 = __builtin_amdgcn_mfma_f32_32x32x16_bf16(ah1[u], bl, acc1, 0, 0, 0);
                    acc0 = __builtin_amdgcn_mfma_f32_32x32x16_bf16(al0[u], bh, acc0, 0, 0, 0); acc1 = __builtin_amdgcn_mfma_f32_32x32x16_bf16(al1[u], bh, acc1, 0, 0, 0); }
                SBAR();
            }
        }
        __syncthreads();
        if (n32 < 16) {
#pragma unroll
            for (int i = 0; i < 16; ++i) { const int e = (i & 3) + 8 * (i >> 2) + 4 * h5; part[(wave * 16 + n32) * 64 + e] = acc0[i]; part[(wave * 16 + n32) * 64 + 32 + e] = acc1[i]; }
        }
        __syncthreads();
#pragma unroll 1
        for (int k = 0; k < 2; ++k) {
            const int lt = 2 * wave + k, ti = 16 * it + lt;
            float logit = 0.f;
#pragma unroll
            for (int w = 0; w < 8; ++w) logit += part[(w * 16 + lt) * 64 + lane];
            const float sc = 1.f / (1.f + expf(-logit));
            const float bs = sc + rb;
            float m1 = bs;
            m1 = fmaxf(m1, dpp_mov<0xB1>(m1)); m1 = fmaxf(m1, dpp_mov<0x4E>(m1)); m1 = fmaxf(m1, dpp_mov<0x141>(m1));
            const unsigned long long eq = __ballot(bs == m1);
            const int gbase = lane & ~7;
            const int first = gbase + __builtin_ctz((unsigned)((eq >> gbase) & 0xffu));
            float m2 = (lane == first) ? -__builtin_inff() : bs;
            m2 = fmaxf(m2, dpp_mov<0xB1>(m2)); m2 = fmaxf(m2, dpp_mov<0x4E>(m2)); m2 = fmaxf(m2, dpp_mov<0x141>(m2));
            const float gs = m1 + m2; const int grp = lane >> 3;
            int grank = 0;
#pragma unroll
            for (int g2 = 0; g2 < 8; ++g2) { const float v = __int_as_float(__builtin_amdgcn_readlane(__float_as_int(gs), g2 * 8)); grank += (v > gs || (v == gs && g2 < grp)) ? 1 : 0; }
            const float masked = (grank < 4) ? bs : -__builtin_inff();
            int rank = 0;
#pragma unroll 8
            for (int e2 = 0; e2 < 64; ++e2) { const float v = __int_as_float(__builtin_amdgcn_readlane(__float_as_int(masked), e2)); rank += (v > masked || (v == masked && e2 < lane)) ? 1 : 0; }
            const bool selk = rank < 8;
            const float wsum = wave_sum(selk ? sc : 0.f);
            if (selk) {
                const int lp = __hip_atomic_fetch_add(lcount + lane, 1, __ATOMIC_RELAXED, __HIP_MEMORY_SCOPE_WORKGROUP);
                ent[(ti * 8 + rank) * 2] = ((unsigned)lane << 20) | (unsigned)lp;
                ((LAS float*)ent)[(ti * 8 + rank) * 2 + 1] = sc / wsum * ROUTED_SCALE;
            }
        }
        __syncthreads();
    }
    if (threadIdx.x < 64) { const int n = lcount[threadIdx.x]; lbase[threadIdx.x] = n > 0 ? (int)__hip_atomic_fetch_add(gcount + threadIdx.x * 16, (unsigned)n, __ATOMIC_RELAXED, __HIP_MEMORY_SCOPE_AGENT) : 0; }
    __syncthreads();
    for (int i = threadIdx.x; i < 64 * 8; i += NWAVES * 64) {
        const unsigned ep = ent[i * 2]; const float w = ((LAS float*)ent)[i * 2 + 1];
        const int e = ep >> 20, pos = lbase[e] + (int)(ep & 0xfffffu), t = t_beg + (i >> 3);
        list[(size_t)e * NTOK + pos] = (unsigned)t;
        toke[(size_t)t * 8 + (i & 7)] = ((unsigned)e << 20) | (unsigned)pos;
        tokw[(size_t)t * 8 + (i & 7)] = w;
    }
    __syncthreads();
}

__device__ __forceinline__ int moe_tables(KArgs a, int layer, LAS unsigned char* lds) {
    const unsigned* gcount = (const unsigned*)(a->ws + WS_CTL) + CW_CNT + layer * NE * 16;
    LAS int* P = (LAS int*)(lds + LT_P); LAS int* cnt = (LAS int*)(lds + LT_CNT); LAS int* tile_e = (LAS int*)(lds + LT_TILE);
    __syncthreads();
    if (threadIdx.x < NEX) cnt[threadIdx.x] = (threadIdx.x < NE) ? (int)__hip_atomic_load(gcount + threadIdx.x * 16, __ATOMIC_RELAXED, __HIP_MEMORY_SCOPE_AGENT) : NTOK;
    __syncthreads();
    if (threadIdx.x == 0) { int s = 0; for (int e = 0; e < NEX; ++e) { P[e] = s; s += (cnt[e] + 255) >> 8; } P[NEX] = s; }
    __syncthreads();
    if (threadIdx.x < NEX) { const int e = threadIdx.x; for (int t = P[e]; t < P[e + 1]; ++t) tile_e[t] = e; }
    __syncthreads();
    return P[NEX];
}

__device__ __forceinline__ void moe_combine(KArgs a, int layer, LAS unsigned char* lds, int gw, int NGW, int lane) {
    float* out = a->out; bf16_t* xb = (bf16_t*)(a->ws + WS_XB); const bf16_t* Y = (const bf16_t*)(a->ws + WS_Y);
    const unsigned* toke = (const unsigned*)(a->ws + WS_TOKE); const float* tokw = (const float*)(a->ws + WS_TOKW);
    const float* gam = a->in[I_LN2G] + layer * DM; const float* bet = a->in[I_LN2B] + layer * DM;
    const LAS int* P = (const LAS int*)(lds + LT_P);
    const int sh_base = P[NE] * 256;
    unsigned epn = 0u; float wn = 0.f;
    if (gw < NTOK && lane < 8) { epn = toke[(size_t)gw * 8 + lane]; wn = tokw[(size_t)gw * 8 + lane]; }
    for (int t = gw; t < NTOK; t += NGW) {
        const unsigned ep = epn; float w = wn;
        if (t + NGW < NTOK && lane < 8) { epn = toke[(size_t)(t + NGW) * 8 + lane]; wn = tokw[(size_t)(t + NGW) * 8 + lane]; }
        int slot = P[ep >> 20] * 256 + (int)(ep & 0xfffffu);
        if (lane == 8) { slot = sh_base + t; w = 1.f; }
        f32x4 acc[8]; u32x4 y[9][4]; float wk[9];
#pragma unroll
        for (int j = 0; j < 4; ++j) { acc[2 * j] = *(const f32x4*)(out + (size_t)t * DM + 512 * j + 8 * lane); acc[2 * j + 1] = *(const f32x4*)(out + (size_t)t * DM + 512 * j + 8 * lane + 4); }
        const bool y8 = MOE_Y8(layer);
#pragma unroll
        for (int q = 0; q < 9; ++q) { const int sl = __builtin_amdgcn_readlane(slot, q); wk[q] = __int_as_float(__builtin_amdgcn_readlane(__float_as_int(w), q)) * (y8 ? Y8_INV : 1.f);
#pragma unroll
            for (int j = 0; j < 4; ++j) {
                if (y8) { const u32x2 t2 = __builtin_nontemporal_load((const u32x2*)((const unsigned char*)Y + (size_t)sl * DM + 512 * j + 8 * lane)); y[q][j] = (u32x4){t2.x, t2.y, 0u, 0u}; }
                else y[q][j] = __builtin_nontemporal_load((const u32x4*)(Y + (size_t)sl * DM + 512 * j + 8 * lane)); } }
#pragma unroll
        for (int j = 0; j < 8; ++j) acc[j] = acc[j] * ALPHA;
#pragma unroll
        for (int q = 0; q < 9; ++q)
#pragma unroll
            for (int j = 0; j < 4; ++j) {
                if (y8) {
                    const f32x2 a0 = __builtin_amdgcn_cvt_pk_f32_fp8((int)y[q][j].x, false), a1 = __builtin_amdgcn_cvt_pk_f32_fp8((int)y[q][j].x, true);
                    const f32x2 b0 = __builtin_amdgcn_cvt_pk_f32_fp8((int)y[q][j].y, false), b1 = __builtin_amdgcn_cvt_pk_f32_fp8((int)y[q][j].y, true);
                    acc[2 * j][0] += wk[q] * a0[0]; acc[2 * j][1] += wk[q] * a0[1]; acc[2 * j][2] += wk[q] * a1[0]; acc[2 * j][3] += wk[q] * a1[1];
                    acc[2 * j + 1][0] += wk[q] * b0[0]; acc[2 * j + 1][1] += wk[q] * b0[1]; acc[2 * j + 1][2] += wk[q] * b1[0]; acc[2 * j + 1][3] += wk[q] * b1[1];
                } else {
                acc[2 * j][0] += wk[q] * bf_lo(y[q][j].x); acc[2 * j][1] += wk[q] * bf_hi(y[q][j].x); acc[2 * j][2] += wk[q] * bf_lo(y[q][j].y); acc[2 * j][3] += wk[q] * bf_hi(y[q][j].y);
                acc[2 * j + 1][0] += wk[q] * bf_lo(y[q][j].z); acc[2 * j + 1][1] += wk[q] * bf_hi(y[q][j].z); acc[2 * j + 1][2] += wk[q] * bf_lo(y[q][j].w); acc[2 * j + 1][3] += wk[q] * bf_hi(y[q][j].w);
                }
            }
        float s = 0.f;
#pragma unroll
        for (int j = 0; j < 8; ++j) s += (acc[j][0] + acc[j][1]) + (acc[j][2] + acc[j][3]);
        const float mean = wave_sum(s) * (1.f / DM); float s2 = 0.f;
#pragma unroll
        for (int j = 0; j < 8; ++j) { acc[j] = acc[j] - mean; s2 += (acc[j][0] * acc[j][0] + acc[j][1] * acc[j][1]) + (acc[j][2] * acc[j][2] + acc[j][3] * acc[j][3]); }
        const float rstd = __builtin_amdgcn_rsqf(wave_sum(s2) * (1.f / DM) + LN_EPS);
#pragma unroll
        for (int j = 0; j < 4; ++j) {
            const int c = 512 * j + 8 * lane;
            const f32x4 x0 = acc[2 * j] * rstd * *(const f32x4*)(gam + c) + *(const f32x4*)(bet + c);
            const f32x4 x1 = acc[2 * j + 1] * rstd * *(const f32x4*)(gam + c + 4) + *(const f32x4*)(bet + c + 4);
            *(f32x4*)(out + (size_t)t * DM + c) = x0; *(f32x4*)(out + (size_t)t * DM + c + 4) = x1;
            if (layer == 0) {
                if (FP8_QKV1) { u32x2 wv; wv.x = pk4_fp8(x0[0], x0[1], x0[2], x0[3]); wv.y = pk4_fp8(x1[0], x1[1], x1[2], x1[3]); *(u32x2*)((unsigned char*)xb + (size_t)t * DM + c) = wv; }
                else { u32x4 wv; wv.x = cvt_pk_bf16(x0[0], x0[1]); wv.y = cvt_pk_bf16(x0[2], x0[3]); wv.z = cvt_pk_bf16(x1[0], x1[1]); wv.w = cvt_pk_bf16(x1[2], x1[3]);
                    *(u32x4*)(xb + (size_t)t * DM + c) = wv; } }
        }
    }
}

__device__ __forceinline__ void attn_ref(KArgs a, int L, int pass, att::BlockRef& r) {
    const int xcd = L & 7, k = L >> 3, vh = xcd * 8 + (k >> 4), x = k & 15;
    const int qb = pass ? 31 - x : x;
    const bf16_t* Q = (const bf16_t*)(a->ws + WS_Q); const bf16_t* K = (const bf16_t*)(a->ws + WS_K); const bf16_t* V = (const bf16_t*)(a->ws + WS_V);
    r.P0 = qb * 256;
    const int half = vh & 1, bm = vh >> 1, b = bm >> 4, m = bm & 15;
    r.Q = Q + ((size_t)bm * SEQ + r.P0) * HD; r.K = K + (size_t)bm * SEQ * HD;
    r.V = V + (size_t)(b * NSLAB + (m >> 1) * 2 + half) * SEQ * HD;
    r.O = (bf16_t*)(a->ws + WS_O) + ((size_t)b * SEQ + r.P0) * 4096 + (m * 2 + half) * HD;
    r.sel = nullptr; r.list = nullptr; r.ML = nullptr; r.jlo = 0; r.nvalid = 256; r.nblk = 0; r.hb = 0;
}
__device__ __forceinline__ void attn_phase_da(KArgs a, char* lds, int G) {
    constexpr int total = 64 * 16;
    const int conv_slot = (int)(blockIdx.x & 3u);
    int L = blockIdx.x; if (L >= total) return;
    int pass = 0, item = 0; att::BlockRef cur, nxt; attn_ref(a, L, 0, cur);
    att::Seam S;
    att::attn_prime<false>(cur, lds, S);
    for (;;) {
        if (pass == 0) {
            if (conv_slot == item) {
                const int tid0 = otid(); const Geo cg = geo();
                convert_items(a, (LAS float*)((LAS unsigned char*)lds + att::ATT_LDS + __builtin_amdgcn_readfirstlane(tid0 >> 6) * 4224), cg.gw, cg.NGW, tid0 & 63, IT_IN, IT_TOTAL);
            }
            ++item;
        }
        const bool more_pass = pass == 0, more_item = L + G < total, last = !more_pass && !more_item;
        int passn = pass + 1, Ln = L;
        if (!more_pass) { passn = 0; Ln = more_item ? L + G : L; }
        if (last) nxt = cur; else attn_ref(a, Ln, passn, nxt);
        att::attn_block<false>(cur, nxt, 4096, lds, S);
        if (last) break;
        cur = nxt; pass = passn; L = Ln;
    }
}
__device__ __forceinline__ void moba_ref(KArgs a, LAS unsigned char* lds, int B, att::BlockRef& r) {
    const LAS int* PB = (const LAS int*)(lds + LT_PB); const LAS int* MC = (const LAS int*)(lds + LT_MC);
    int lo = 0, hi = 1024;
    while (hi - lo > 1) { const int mid = (lo + hi) >> 1; if (PB[mid] <= B) lo = mid; else hi = mid; }
    const int id = lo, bh = id >> 5, n = id & 31, c = B - PB[id];
    r.Q = (const bf16_t*)(a->ws + WS_Q) + (size_t)bh * SEQ * HD; r.K = (const bf16_t*)(a->ws + WS_K) + (size_t)bh * SEQ * HD; r.V = (const bf16_t*)(a->ws + WS_V) + (size_t)bh * SEQ * HD;
    r.O = (bf16_t*)(a->ws + WS_OP); r.ML = (float*)(a->ws + WS_ML); r.sel = (const unsigned*)(a->ws + WS_SEL) + (size_t)bh * SEQ;
    r.hb = bh * SEQ; r.jlo = 4 * n; r.nblk = n; r.P0 = n * 256;
    if (c == 0) { r.list = nullptr; r.nvalid = 256; }
    else { r.list = (const unsigned*)(a->ws + WS_QLIST) + (size_t)id * SEQ + (size_t)(c - 1) * 256; const int rem = MC[id] - (c - 1) * 256; r.nvalid = rem < 256 ? rem : 256; }
}
__device__ __forceinline__ void attn_phase_moba(KArgs a, LAS unsigned char* lds, char* lds_gen, int G) {
    LAS int* MC = (LAS int*)(lds + LT_MC); LAS int* PB = (LAS int*)(lds + LT_PB); LAS int* SC = (LAS int*)(lds + LT_SC);
    const unsigned* mcnt = (const unsigned*)(a->ws + WS_CTL) + CW_MCNT;
    const int t = threadIdx.x;
    __syncthreads();
    const int c0 = (int)__hip_atomic_load(mcnt + 2 * t, __ATOMIC_RELAXED, __HIP_MEMORY_SCOPE_AGENT), c1 = (int)__hip_atomic_load(mcnt + 2 * t + 1, __ATOMIC_RELAXED, __HIP_MEMORY_SCOPE_AGENT);
    MC[2 * t] = c0; MC[2 * t + 1] = c1;
    const int s0 = 1 + ((c0 + 255) >> 8), s1 = s0 + 1 + ((c1 + 255) >> 8);
    SC[t] = s1;
    __syncthreads();
    for (int off = 1; off < 512; off <<= 1) { const int v = SC[t] + (t >= off ? SC[t - off] : 0); __syncthreads(); SC[t] = v; __syncthreads(); }
    const int excl = t > 0 ? SC[t - 1] : 0;
    PB[2 * t] = excl; PB[2 * t + 1] = excl + s0; if (t == 511) PB[1024] = SC[511];
    __syncthreads();
    const int NB = PB[1024];
    int B = blockIdx.x; if (B >= NB) return;
    att::BlockRef cur, nxt; moba_ref(a, lds, B, cur);
    att::Seam S;
    att::attn_prime<true>(cur, lds_gen, S);
    for (;;) {
        const int Bn = B + G; const bool last = Bn >= NB;
        if (last) nxt = cur; else moba_ref(a, lds, Bn, nxt);
        att::attn_block<true>(cur, nxt, 0, lds_gen, S);
        if (last) break;
        cur = nxt; B = Bn;
    }
}
__device__ __forceinline__ void moba_kv_phase(KArgs a, LAS unsigned char* lds, char* lds_gen) {
    using namespace att;
    LAS int* PB = (LAS int*)(lds + LDSCTL_OFF + 1024); LAS int* MC = (LAS int*)(lds + LDSCTL_OFF + 5632); LAS int* SC = (LAS int*)lds;
    volatile LAS int* QW = (volatile LAS int*)(lds + LDSCTL_OFF + 14400);
    const unsigned* mcnt = (const unsigned*)(a->ws + WS_CTL) + CW_MCNT; unsigned* sq = (unsigned*)(a->ws + WS_CTL) + CW_SQ;
    int tid = threadIdx.x; asm volatile("" : "+v"(tid));
    const int wid = __builtin_amdgcn_readfirstlane(tid >> 6), lane = tid & 63, r32 = lane & 31, hi = lane >> 5;
    __syncthreads();
    {   const int c0 = (int)__hip_atomic_load(mcnt + 2 * tid, __ATOMIC_RELAXED, __HIP_MEMORY_SCOPE_AGENT), c1 = (int)__hip_atomic_load(mcnt + 2 * tid + 1, __ATOMIC_RELAXED, __HIP_MEMORY_SCOPE_AGENT);
        MC[2 * tid] = c0; MC[2 * tid + 1] = c1;
        const int s0 = (8 + ((c0 + 31) >> 5) + 31) >> 5, s1 = s0 + ((8 + ((c1 + 31) >> 5) + 31) >> 5);
        SC[tid] = s1;
        __syncthreads();
        for (int off = 1; off < 512; off <<= 1) { const int v = SC[tid] + (tid >= off ? SC[tid - off] : 0); __syncthreads(); SC[tid] = v; __syncthreads(); }
        const int excl = tid > 0 ? SC[tid - 1] : 0;
        PB[2 * tid] = excl; PB[2 * tid + 1] = excl + s0; if (tid == 511) PB[1024] = SC[511];
        __syncthreads(); }
    const int NP = PB[1024];
    char* V_lds = lds_gen; char* K_lds = lds_gen + 65536;
    float* ws = (float*)(lds_gen + LDSCTL_OFF + 10240) + wid * 128; float* li_l = ws, * al_l = ws + 32; unsigned* rd = (unsigned*)(ws + 64);
    const int vb0 = (int)(uintptr_t)V_lds + v_rd_base(lane);
    const int sr = tid >> 4, sc = (tid & 15) * 8;
    const bf16_t* Qb = (const bf16_t*)(a->ws + WS_Q); const bf16_t* Kb = (const bf16_t*)(a->ws + WS_K); const bf16_t* Vb = (const bf16_t*)(a->ws + WS_V);
    const unsigned* selb = (const unsigned*)(a->ws + WS_SEL); const unsigned* qlb = (const unsigned*)(a->ws + WS_QLIST);
    bf16_t* OPb = (bf16_t*)(a->ws + WS_OP); float* MLb = (float*)(a->ws + WS_ML);
    for (;;) {
        if (tid == 0) *QW = (int)__hip_atomic_fetch_add(sq, 1u, __ATOMIC_RELAXED, __HIP_MEMORY_SCOPE_AGENT);
        __syncthreads();
        const int I = *QW;
        if (I >= NP) break;
        int lo = 0, hb = 1024;
        while (hb - lo > 1) { const int mid = (lo + hb) >> 1; if (PB[mid] <= I) lo = mid; else hb = mid; }
        const int id = lo, bh = id >> 5, n = id & 31, part = I - PB[id], cnt = MC[id];
        {
            const bf16_t* Kh = Kb + ((size_t)bh * SEQ + (size_t)n * 256) * HD; const bf16_t* Vh = Vb + ((size_t)bh * SEQ + (size_t)n * 256) * HD;
            bf16x8 kv[8], vv[8];
#pragma unroll
            for (int i = 0; i < 8; ++i) { kv[i] = load8(Kh + (size_t)(sr + 32 * i) * HD + sc); vv[i] = load8(Vh + (size_t)(sr + 32 * i) * HD + sc); }
#pragma unroll
            for (int i = 0; i < 8; ++i) { const int tl = i >> 1, row = sr + 32 * (i & 1);
                *(bf16x8*)(K_lds + tl * SHM_K + KSWZ(row, sc * 2)) = kv[i]; *(bf16x8*)(V_lds + tl * SHM_V + v_st(row, sc)) = vv[i]; }
        }
        __syncthreads();
        const int nch = 8 + ((cnt + 31) >> 5), c_beg = 32 * part, c_end = (c_beg + 32 < nch) ? c_beg + 32 : nch;
#pragma unroll 1
        for (int cg = c_beg + wid; cg < c_end; cg += 8) {
            const bool own = cg < 8;
            const int li0 = (cg - 8) * 32 + r32;
            unsigned q; if (own) q = (unsigned)(n * 256 + cg * 32 + r32); else q = qlb[(size_t)id * SEQ + (li0 < cnt ? li0 : cnt - 1)];
            const bool valid = own || (li0 < cnt);
            unsigned slot = 3u; if (!own) slot = (unsigned)__builtin_popcount(selb[(size_t)bh * SEQ + q] & ((1u << n) - 1u));
            bf16x8 qr[8];
#pragma unroll
            for (int d0 = 0; d0 < 8; ++d0) qr[d0] = load8(Qb + ((size_t)bh * SEQ + q) * HD + d0 * 16 + hi * 8);
            if (hi == 0) rd[r32] = valid ? (((unsigned)(bh * SEQ) + q) * 4u + slot) * 128u : (1u << 27);
            const int NTu = own ? ((cg * 32 + 31) >> 6) + 1 : 4;
            const int qlo = n * 256 + cg * 32, qm = qlo + r32 - 4 * hi;
            float m_reg = -1e30f, l_reg = 0.f; f32x16 o[4] = {};
#define KV_STEP(T) do { if ((T) < NTu) { f32x16 p0, p1; float mn, al; bf16x8 pa0, pa1, pa2, pa3;                                        \
                qkt<T>(p0, p1, K_lds, r32, hi, qr);                                                                                       \
                if (own) { const int kb_ = n * 256 + (T) * KVBLK; if (kb_ + KVBLK - 1 > qlo) mask_tile(p0, p1, qm - kb_, 0x40000000u); }   \
                partialSM(p0, p1, m_reg, mn, al);                                                                                        \
                if (__any(al < 1.f)) { if (hi == 0) al_l[r32] = al; asm volatile("s_waitcnt lgkmcnt(0)" ::: "memory");                     \
                    for (int d_ = 0; d_ < 4; ++d_) for (int r = 0; r < 16; ++r) o[d_][r] *= al_l[crow(r, hi)]; }                           \
                finishSM(p0, p1, al, l_reg, pa0, pa1, pa2, pa3); SBAR();                                                                  \
                pv_tile<T>(o, vb0, pa0, pa1, pa2, pa3); } } while (0)
            KV_STEP(0); KV_STEP(1); KV_STEP(2); KV_STEP(3);
#undef KV_STEP
            if (hi == 0) li_l[r32] = l_reg; asm volatile("s_waitcnt lgkmcnt(0)" ::: "memory");
            float rli[16];
#pragma unroll
            for (int r = 0; r < 16; ++r) rli[r] = __builtin_amdgcn_rcpf(li_l[crow(r, hi)]);
#pragma unroll
            for (int r = 0; r < 16; ++r) { const unsigned off = rd[crow(r, hi)];
#pragma unroll
                for (int d0 = 0; d0 < 4; ++d0) { const float v = o[d0][r] * rli[r];
                    const float vn = __int_as_float(__builtin_amdgcn_mov_dpp(__float_as_int(v), 0xB1, 0xF, 0xF, true));
                    if ((r32 & 1) == 0) *(unsigned*)(OPb + (size_t)off + d0 * 32 + r32) = cvt_pk_bf16(v, vn); } }
            if (hi == 0) { float* mlp = MLb + (size_t)(rd[r32] >> 7) * 2; f32x2 ml = {m_reg, l_reg}; *(f32x2*)mlp = ml; }
        }
    }
}
__device__ __forceinline__ void moba_merge(KArgs a, int gw, int NGW, int lane) {
    const bf16_t* OP = (const bf16_t*)(a->ws + WS_OP); const float* ML = (const float*)(a->ws + WS_ML); const unsigned* sel = (const unsigned*)(a->ws + WS_SEL);
    bf16_t* AO = (bf16_t*)(a->ws + WS_AOUT);
    constexpr float C2 = 1.4426950408889634f * att::SCALE;
    const int h = lane >> 2, part = lane & 3;
    for (int t = gw; t < NTOK; t += NGW) {
        const int b = t >> 13, s = t & (SEQ - 1), bh = b * NSLAB + h;
        const size_t base = ((size_t)bh * SEQ + s) * 4;
        const int nsel = __builtin_popcount(sel[(size_t)bh * SEQ + s]);
        f32x2 ml[4]; u32x4 ov[4][4];
#pragma unroll
        for (int k = 0; k < 4; ++k) { ml[k] = *(const f32x2*)(ML + (base + k) * 2);
#pragma unroll
            for (int j = 0; j < 4; ++j) ov[k][j] = *(const u32x4*)(OP + (base + k) * 128 + part * 32 + j * 8); }
        float M = ml[3][0];
#pragma unroll
        for (int k = 0; k < 3; ++k) M = (k < nsel) ? fmaxf(M, ml[k][0]) : M;
        float w[4], W = 0.f;
#pragma unroll
        for (int k = 0; k < 4; ++k) { const bool valid = (k == 3) || (k < nsel); w[k] = valid ? ml[k][1] * __builtin_amdgcn_exp2f((ml[k][0] - M) * C2) : 0.f; W += w[k]; }
        const float rW = 1.f / W;
        float acc[32];
#pragma unroll
        for (int i = 0; i < 32; ++i) acc[i] = 0.f;
#pragma unroll
        for (int k = 0; k < 4; ++k) { const bool valid = (k == 3) || (k < nsel); const float wk = w[k] * rW;
#pragma unroll
            for (int j = 0; j < 4; ++j) { const u32x4 u = ov[k][j];
                acc[8 * j + 0] += valid ? wk * bf_lo(u.x) : 0.f; acc[8 * j + 1] += valid ? wk * bf_hi(u.x) : 0.f; acc[8 * j + 2] += valid ? wk * bf_lo(u.y) : 0.f; acc[8 * j + 3] += valid ? wk * bf_hi(u.y) : 0.f;
                acc[8 * j + 4] += valid ? wk * bf_lo(u.z) : 0.f; acc[8 * j + 5] += valid ? wk * bf_hi(u.z) : 0.f; acc[8 * j + 6] += valid ? wk * bf_lo(u.w) : 0.f; acc[8 * j + 7] += valid ? wk * bf_hi(u.w) : 0.f; } }
#pragma unroll
        for (int j = 0; j < 4; ++j) {
            if (FP8_OUT1) { u32x2 o; o.x = pk4_fp8(acc[8 * j] * AO8_SCALE, acc[8 * j + 1] * AO8_SCALE, acc[8 * j + 2] * AO8_SCALE, acc[8 * j + 3] * AO8_SCALE); o.y = pk4_fp8(acc[8 * j + 4] * AO8_SCALE, acc[8 * j + 5] * AO8_SCALE, acc[8 * j + 6] * AO8_SCALE, acc[8 * j + 7] * AO8_SCALE);
                *(u32x2*)((unsigned char*)AO + (size_t)t * DM + h * HD + part * 32 + j * 8) = o; }
            else { u32x4 o; o.x = cvt_pk_bf16(acc[8 * j], acc[8 * j + 1]); o.y = cvt_pk_bf16(acc[8 * j + 2], acc[8 * j + 3]); o.z = cvt_pk_bf16(acc[8 * j + 4], acc[8 * j + 5]); o.w = cvt_pk_bf16(acc[8 * j + 6], acc[8 * j + 7]);
                *(u32x4*)(AO + (size_t)t * DM + h * HD + part * 32 + j * 8) = o; } }
    }
}

#ifndef PHMASK
#define PHMASK 0x7ffff
#endif
#define IN(k) (((PHMASK >> (k)) & 1) && lo <= (k) && (k) < hi)
#define SEAM(k) do { if (IN(k) && IN((k) + 1)) xcd_barrier(bar); } while (0)
template <int LAYER>
__device__ __forceinline__ void layer_program(LAS unsigned char* lds, unsigned char* lds_gen, const XcdBarrier& bar, const int lo, const int hi) {
    constexpr int pb = LAYER == 0 ? 1 : 9;
    constexpr int po = LAYER == 0 ? 4 : 14;
    if (IN(pb)) {
        KArgs ka = kargs(); unsigned char* ws = ka->ws;
        constexpr bool F8 = LAYER == 0 ? (bool)FP8_QKV0 : (bool)FP8_QKV1; constexpr int Kb = F8 ? DM : DM * 2;
        pg8::SchedDense S; S.init(ws + WS_XB, ws + WS_WATT + (LAYER == 0 ? 0 : 32 * MiB), NTOK, NQKV, Kb, gridDim.x, blockIdx.x);
        constexpr bool KM = LAYER == 1;
        pg8::EpiQKV<KM> E{(bf16_t*)(ws + WS_Q), (const float*)(ws + WS_ROPE), F8 ? W8_INV : 1.f};
        pg8::gemm_phase<pg8::EpiQKV<KM>, pg8::SchedDense, F8>(lds, Kb, S, E);
    }
    SEAM(pb);
    if (LAYER == 0) {
        if (IN(2)) { KArgs ka = kargs();
            if (__builtin_amdgcn_readfirstlane(threadIdx.x) >= 256) __builtin_amdgcn_s_setprio(1);
            attn_phase_da(ka, (char*)lds_gen, gridDim.x);
            __builtin_amdgcn_s_setprio(0); }
        SEAM(2);
        if (IN(3)) { KArgs ka = kargs(); const Geo g = geo(); da_combine(ka, g.gw, g.NGW, otid() & 63); }
        SEAM(3);
    } else {
        if (IN(11)) { KArgs ka = kargs(); const Geo g = geo(); moba_gate(ka, g.gw, g.NGW, otid() & 63); }
        SEAM(11);
        if (IN(12)) { KArgs ka = kargs();
            if (__builtin_amdgcn_readfirstlane(threadIdx.x) >= 256) __builtin_amdgcn_s_setprio(1);
            moba_kv_phase(ka, lds, (char*)lds_gen);
            __builtin_amdgcn_s_setprio(0); }
        SEAM(12);
        if (IN(13)) { KArgs ka = kargs(); const Geo g = geo(); moba_merge(ka, g.gw, g.NGW, otid() & 63); }
        SEAM(13);
    }
    if (IN(po)) {
        KArgs ka = kargs(); unsigned char* ws = ka->ws;
        constexpr bool F8 = LAYER == 0 ? (bool)FP8_OUT0 : (bool)FP8_OUT1; constexpr int Kb = F8 ? DM : DM * 2;
        pg8::SchedDense S; S.init(ws + WS_AOUT, ws + WS_WATT + (LAYER == 0 ? 24 * MiB : 56 * MiB), NTOK, DM, Kb, gridDim.x, blockIdx.x);
        pg8::EpiRes E{LAYER == 0 ? ka->in[I_X] : ka->out, ka->out, F8 ? W8_INV * AO8_INV : 1.f};
        pg8::gemm_phase<pg8::EpiRes, pg8::SchedDense, F8>(lds, Kb, S, E);
    }
    SEAM(po);
    if (IN(po + 1)) { KArgs ka = kargs(); const Geo g = geo(); const int tid = otid(); ln_router(ka, LAYER, lds, g.vcu, g.G, __builtin_amdgcn_readfirstlane(tid >> 6), tid & 63); }
    SEAM(po + 1);
    if (IN(po + 2)) {
        KArgs ka = kargs(); unsigned char* ws = ka->ws;
        const int ntt = moe_tables(ka, LAYER, lds);
        constexpr bool F8 = MOE_F8(LAYER); constexpr int Kb = F8 ? DM : DM * 2;
        pg8::SchedMoe1 S{(const char*)(ws + WS_XB), (const char*)(ws + WS_WGU) + (size_t)LAYER * NEX * 1024 * DM * 2, (const unsigned*)(ws + WS_LIST),
                         (const LAS int*)(lds + LT_P), (const LAS int*)(lds + LT_CNT), (const LAS int*)(lds + LT_TILE), ntt * 4, (int)gridDim.x, (int)blockIdx.x, Kb};
        pg8::EpiSwiGLU<F8> E{(bf16_t*)(ws + WS_H), F8 ? W8_INV : 1.f};
        pg8::gemm_phase<pg8::EpiSwiGLU<F8>, pg8::SchedMoe1, F8>(lds, Kb, S, E);
    }
    SEAM(po + 2);
    if (IN(po + 3)) {
        KArgs ka = kargs(); unsigned char* ws = ka->ws;
        const int ntt = moe_tables(ka, LAYER, lds);
        constexpr bool F8 = MOE_F8(LAYER); constexpr int Kb = F8 ? DE : DE * 2;
        pg8::SchedMoe2 S{(const char*)(ws + WS_H), (const char*)(ws + WS_WD) + (size_t)LAYER * NEX * DM * DE * 2, (const LAS int*)(lds + LT_TILE), ntt * 8, (int)gridDim.x, (int)blockIdx.x, Kb};
        constexpr bool Y8 = MOE_Y8(LAYER);
        pg8::EpiY<Y8> E{(bf16_t*)(ws + WS_Y), (F8 ? W8_INV : 1.f) * (Y8 ? Y8_SCALE : 1.f)};
        pg8::gemm_phase<pg8::EpiY<Y8>, pg8::SchedMoe2, F8>(lds, Kb, S, E);
    }
    SEAM(po + 3);
    if (IN(po + 4)) { KArgs ka = kargs(); const Geo g = geo(); (void)moe_tables(ka, LAYER, lds); moe_combine(ka, LAYER, lds, g.gw, g.NGW, otid() & 63); }
    if (LAYER == 0) SEAM(8);
}
__global__ void __launch_bounds__(NWAVES * 64, 2) fwd_kernel(Args args) {
    extern __shared__ __attribute__((aligned(16))) unsigned char lds_raw[];
    LAS unsigned char* lds = (LAS unsigned char*)lds_raw;
    volatile LAS unsigned* MISC = (volatile LAS unsigned*)(lds + MISC_OFF);
    for (int u = threadIdx.x; u < (LDS_BYTES - LDSCTL_OFF) / 4; u += NWAVES * 64) ((LAS unsigned*)(lds + LDSCTL_OFF))[u] = 0u;
    __syncthreads();
    XcdBarrier bar = xcd_barrier_post((unsigned*)(args.ws + WS_CTL) + CW_BAR, MISC + 8);
    const int lo = args.ph_lo, hi = args.ph_hi;
    if (IN(0)) { KArgs ka = kargs(); const Geo g = geo(); const int tid = otid(); p0_prologue(ka, lds, g.gw, g.NGW, __builtin_amdgcn_readfirstlane(tid >> 6), tid & 63); }
    SEAM(0);
    layer_program<0>(lds, lds_raw, bar, lo, hi);
    layer_program<1>(lds, lds_raw, bar, lo, hi);
}
#undef IN
#undef SEAM

extern "C" void kernel_launch(void* const* d_in, const int* in_sizes, int n_in, void* d_out, int out_size, void* d_ws, size_t ws_size, hipStream_t stream) {
    static int grid = 0;
    if (grid == 0) {
        if (n_in != 23 || out_size != NTOK * DM || ws_size < WS_END) { fprintf(stderr, "kernel_launch: unexpected shapes (n_in %d, out %d, ws %zu; need ws >= %zu)\n", n_in, out_size, ws_size, (size_t)WS_END); grid = -1; return; }
        int dev = 0, cus = 0, per_cu = 0;
        if (hipGetDevice(&dev) != hipSuccess || hipDeviceGetAttribute(&cus, hipDeviceAttributeMultiprocessorCount, dev) != hipSuccess) { grid = -1; return; }
        if (hipFuncSetAttribute((const void*)fwd_kernel, hipFuncAttributeMaxDynamicSharedMemorySize, LDS_BYTES) != hipSuccess) { fprintf(stderr, "kernel_launch: hipFuncSetAttribute failed\n"); grid = -1; return; }
        if (hipOccupancyMaxActiveBlocksPerMultiprocessor(&per_cu, (const void*)fwd_kernel, NWAVES * 64, LDS_BYTES) != hipSuccess || per_cu < 1) fprintf(stderr, "kernel_launch: occupancy query reports %d\n", per_cu);
        (void)hipGetLastError();
        grid = 256;
    }
    if (grid < 0) return;
    if (hipMemsetAsync((char*)d_ws + WS_CTL, 0, CTL_ZERO_BYTES, stream) != hipSuccess) return;
    Args a{};
    for (int i = 0; i < 23; ++i) a.in[i] = (const float*)d_in[i];
    a.out = (float*)d_out; a.ws = (unsigned char*)d_ws;
#ifndef MK_SPLIT
    a.ph_lo = 0; a.ph_hi = 19;
    hipLaunchKernelGGL(fwd_kernel, dim3(grid), dim3(NWAVES * 64), LDS_BYTES, stream, a);
#else
    for (int p = 0; p < 19; ++p) { a.ph_lo = p; a.ph_hi = p + 1; hipLaunchKernelGGL(fwd_kernel, dim3(grid), dim3(NWAVES * 64), LDS_BYTES, stream, a); }
#endif
}
```

```cpp
#define FP8_Y0 1
#include <hip/hip_runtime.h>
#include <cstdio>
#include <cstdint>

#define GAS __attribute__((address_space(1)))
#define LAS __attribute__((address_space(3)))
typedef unsigned short bf16_t;
typedef short bf16x8 __attribute__((ext_vector_type(8)));
typedef short s16x4 __attribute__((ext_vector_type(4)));
typedef float f32x2 __attribute__((ext_vector_type(2)));
typedef float f32x4 __attribute__((ext_vector_type(4)));
typedef float f32x16 __attribute__((ext_vector_type(16)));
typedef unsigned u32x2 __attribute__((ext_vector_type(2)));
typedef unsigned u32x4 __attribute__((ext_vector_type(4)));

constexpr int BATCH = 2, SEQ = 8192, DM = 2048, NTOK = BATCH * SEQ;
constexpr int NE = 64, NEX = 65  , DE = 512, NQKV = 6144, HD = 128, NSLAB = 16;
constexpr float LN_EPS = 1e-5f;
constexpr float ALPHA = 1.4142135623730951f;
constexpr float LAMBDA_INIT = 0.2f;
constexpr float ROUTED_SCALE = 2.5f;
constexpr int NWAVES = 8;
constexpr int MAXTILES = 640;

constexpr size_t MiB = 1u << 20;
constexpr size_t WS_CTL = 0, CTL_ZERO_BYTES = 1 * MiB;
constexpr size_t WS_TOKE = 2 * MiB;
constexpr size_t WS_TOKW = 3 * MiB;
constexpr size_t WS_LIST = 4 * MiB;
constexpr size_t WS_SEL = 8 * MiB;
constexpr size_t WS_KMEAN = 9 * MiB;
constexpr size_t WS_ROPE = 10 * MiB;
constexpr size_t WS_WRF = 12 * MiB;
constexpr size_t WS_WATT = 16 * MiB;
constexpr size_t WS_WGU = 80 * MiB;
constexpr size_t WS_WD = 600 * MiB;
constexpr size_t WS_XB = 860 * MiB;
constexpr size_t WS_C = 924 * MiB;
constexpr size_t WS_Q = WS_C, WS_K = WS_C + 64 * MiB, WS_V = WS_C + 128 * MiB;
constexpr size_t WS_O = WS_C + 192 * MiB;
constexpr size_t WS_AOUT = WS_C + 320 * MiB;
constexpr size_t WS_H = WS_C;
constexpr size_t WS_Y = WS_C + 160 * MiB;
constexpr size_t WS_QLIST = WS_C + 192 * MiB;
constexpr size_t WS_OP = WS_C + 384 * MiB;
constexpr size_t WS_ML = WS_C + 641 * MiB;
constexpr size_t WS_END = WS_C + 800 * MiB;
constexpr int CW_BAR = 4096;
constexpr int CW_CNT = 8192;
constexpr int CW_MCNT = 12288;
constexpr int CW_SQ = 13440;

constexpr int RING_BYTES = 131072;
constexpr int LDSCTL_OFF = RING_BYTES, MISC_OFF = LDSCTL_OFF + 320;
constexpr int LT_P = LDSCTL_OFF + 1024;
constexpr int LT_CNT = LDSCTL_OFF + 1536;
constexpr int LT_TILE = LDSCTL_OFF + 2048;
constexpr int LT_LCNT = LDSCTL_OFF + 5120;
constexpr int LT_LBASE = LDSCTL_OFF + 5632;
constexpr int LT_ENT = LDSCTL_OFF + 6144;
constexpr int LT_MC = 114688;
constexpr int LT_PB = 118784;
constexpr int LT_SC = 123904;
constexpr int LDS_BYTES = 147456;

#ifndef FP8_QKV0
#define FP8_QKV0 0
#endif
#ifndef FP8_QKV1
#define FP8_QKV1 1
#endif
#ifndef FP8_OUT0
#define FP8_OUT0 0
#endif
#ifndef FP8_OUT1
#define FP8_OUT1 1
#endif
#ifndef FP8_Y1
#define FP8_Y1 1
#endif
#ifndef FP8_MOE1
#define FP8_MOE1 1
#endif
#ifndef FP8_MOE0
#define FP8_MOE0 1
#endif
#ifndef FP8_Y0
#define FP8_Y0 0
#endif
#define MOE_F8(l) ((l) == 0 ? (bool)FP8_MOE0 : (bool)FP8_MOE1)
#define MOE_Y8(l) ((l) == 0 ? (bool)(FP8_MOE0 && FP8_Y0) : (bool)(FP8_MOE1 && FP8_Y1))
constexpr float W8_SCALE = 64.f, W8_INV = 1.f / 64.f;
constexpr float AO8_SCALE = 16.f, AO8_INV = 1.f / 16.f;
constexpr float Y8_SCALE = 16.f, Y8_INV = 1.f / 16.f;
#define LDS_WAIT() asm volatile("s_waitcnt lgkmcnt(0)" ::: "memory")
#define VM_WAIT() asm volatile("s_waitcnt vmcnt(0)" ::: "memory")
#define SBAR() __builtin_amdgcn_sched_barrier(0)

__device__ __forceinline__ unsigned cvt_pk_bf16(float lo, float hi) { unsigned r; asm volatile("v_cvt_pk_bf16_f32 %0, %1, %2" : "=v"(r) : "v"(lo), "v"(hi)); return r; }
__device__ __forceinline__ unsigned pk4_fp8(float a, float b, float c, float d) { int p = __builtin_amdgcn_cvt_pk_fp8_f32(a, b, 0, false); p = __builtin_amdgcn_cvt_pk_fp8_f32(c, d, p, true); return (unsigned)p; }
__device__ __forceinline__ float bf_lo(unsigned u) { return __uint_as_float(u << 16); }
__device__ __forceinline__ float bf_hi(unsigned u) { return __uint_as_float(u & 0xffff0000u); }
template <int CTRL> __device__ __forceinline__ float dpp_mov(float v) { return __int_as_float(__builtin_amdgcn_update_dpp(0, __float_as_int(v), CTRL, 0xF, 0xF, true)); }
__device__ __forceinline__ float wave_sum(float v) {
    v += dpp_mov<0xB1>(v);
    v += dpp_mov<0x4E>(v);
    v += dpp_mov<0x141>(v);
    v += dpp_mov<0x140>(v);
    const float r0 = __int_as_float(__builtin_amdgcn_readlane(__float_as_int(v), 0)), r1 = __int_as_float(__builtin_amdgcn_readlane(__float_as_int(v), 16));
    const float r2 = __int_as_float(__builtin_amdgcn_readlane(__float_as_int(v), 32)), r3 = __int_as_float(__builtin_amdgcn_readlane(__float_as_int(v), 48));
    return (r0 + r1) + (r2 + r3);
}

#define XB_TMO      128
#define XB_XCNT(j)  (256  + 64 * (j))
#define XB_XSUB(j)  (1280 + 64 * (j))
#define XB_XGEN(j)  (2304 + 64 * (j))
#define XB_TOP      3328
#define XB_TOPGEN   3392
#define XCD_BAR_WORDS 3456
#define XB_SPIN_CAP (1u << 18)
__device__ __forceinline__ unsigned xb_ld(unsigned* p)              { return __hip_atomic_load(p, __ATOMIC_RELAXED, __HIP_MEMORY_SCOPE_AGENT); }
__device__ __forceinline__ unsigned xb_add(unsigned* p, unsigned v) { return __hip_atomic_fetch_add(p, v, __ATOMIC_RELAXED, __HIP_MEMORY_SCOPE_AGENT); }
__device__ __forceinline__ unsigned xb_xcc_id() { return (unsigned)__builtin_amdgcn_s_getreg((3 << 11) | 20) & 0xFu; }
#define XB_SPIN(cond, bar) do { unsigned _sp = 0; while (cond) { __builtin_amdgcn_s_sleep(1); \
    if ((++_sp & 255u) == 0u) { if (xb_ld(&(bar)[XB_TMO])) break; if (_sp > XB_SPIN_CAP) { atomicAdd(&(bar)[XB_TMO], 1u); break; } } } } while (0)
struct XcdBarrier { unsigned* bar; unsigned x; volatile LAS unsigned* st; };
__device__ __forceinline__ XcdBarrier xcd_barrier_post(unsigned* bar, volatile LAS unsigned* st) {
    XcdBarrier b; b.bar = bar; b.x = xb_xcc_id(); b.st = st;
    if (threadIdx.x == 0) (void)xb_add(&bar[XB_XCNT(b.x)], 1u);
    return b;
}
__device__ __forceinline__ void xcd_barrier_complete(unsigned* bar, unsigned x, unsigned& nloc, unsigned& nx) {
    const unsigned G = gridDim.x * gridDim.y * gridDim.z;
    unsigned sum, cnt, mine, sp = 0u;
    for (;;) {
        sum = 0u; cnt = 0u; mine = 0u;
#pragma unroll
        for (unsigned j = 0; j < 16; ++j) { const unsigned c = xb_ld(&bar[XB_XCNT(j)]); sum += c; cnt += (c > 0u) ? 1u : 0u; mine = (j == x) ? c : mine; }
        if (sum == G) break;
        __builtin_amdgcn_s_sleep(1);
        if ((++sp & 255u) == 0u) { if (xb_ld(&bar[XB_TMO])) break; if (sp > XB_SPIN_CAP) { atomicAdd(&bar[XB_TMO], 1u); break; } }
    }
    nloc = mine > 0u ? mine : 1u; nx = cnt > 0u ? cnt : 1u;
}
__device__ __forceinline__ void xcd_barrier(const XcdBarrier& b) {
    asm volatile("s_waitcnt vmcnt(0)" ::: "memory");
    __syncthreads();
    if (threadIdx.x == 0) {
        unsigned* bar = b.bar;
        __builtin_amdgcn_s_waitcnt(0);
        unsigned nloc = b.st[0], nx = b.st[1];
        if (nloc == 0u) { xcd_barrier_complete(bar, b.x, nloc, nx); b.st[0] = nloc; b.st[1] = nx; }
        const unsigned old = xb_add(&bar[XB_XSUB(b.x)], 1u);
        const unsigned gen = old / nloc;
        if (old + 1u == (gen + 1u) * nloc) {
            __builtin_amdgcn_fence(__ATOMIC_RELEASE, "agent");
            asm volatile("s_waitcnt vmcnt(0)" ::: "memory");
            const unsigned og = xb_add(&bar[XB_TOP], 1u);
            const unsigned tg = og / nx;
            if (og + 1u == (tg + 1u) * nx) xb_add(&bar[XB_TOPGEN], 1u);
            else XB_SPIN(xb_ld(&bar[XB_TOPGEN]) == tg, bar);
            __builtin_amdgcn_fence(__ATOMIC_ACQUIRE, "agent");
            xb_add(&bar[XB_XGEN(b.x)], 1u);
            asm volatile("s_waitcnt vmcnt(0)" ::: "memory");
        } else {
            XB_SPIN(xb_ld(&bar[XB_XGEN(b.x)]) == gen, bar);
            __builtin_amdgcn_fence(__ATOMIC_ACQUIRE, "agent");
            asm volatile("s_waitcnt vmcnt(0)" ::: "memory");
        }
    }
    __syncthreads();
}

namespace pg8 {
constexpr int BM = 256, BK = 64, HALF = 128, HTB = HALF * BK * 2, NXCD = 8, WGM = 8;
__device__ __forceinline__ int lds_byte(int r, int c) { const int st = (r >> 4) * 2 + (c >> 5), rr = r & 15, cc = c & 31, ob = rr * 64 + cc * 2; return st * 1024 + (ob ^ (((ob >> 9) & 1) << 5)); }
__device__ __forceinline__ void stage_rc(int b, int& R, int& C) { const int st = b / 1024, sb = b % 1024, swz = sb ^ (((sb >> 9) & 1) << 5); R = (st >> 1) * 16 + swz / 64; C = (st & 1) * 32 + (swz % 64) / 2; }
__device__ __forceinline__ int perm32(int rho) { const int n = rho >> 4, i = rho & 15; return 8 * (i >> 2) + 4 * n + (i & 3); }
struct Unit { int pm, pn, e, aux; };
__device__ __forceinline__ int xcd_remap(int L, int nwg) { const int q = nwg / NXCD, r = nwg % NXCD, xcd = L % NXCD, off = L / NXCD; return (xcd < r ? xcd * (q + 1) : r * (q + 1) + (xcd - r) * q) + off; }

struct SchedDense {
    const char* A; const char* Bt; int Kb, nM, nN, nwg, G, c;
    __device__ __forceinline__ void init(const void* A_, const void* Bt_, int M, int N, int Kb_, int G_, int c_) { A = (const char*)A_; Bt = (const char*)Bt_; Kb = Kb_; nM = M / BM; nN = N / BM; nwg = nM * nN; G = G_; c = c_; }
    __device__ __forceinline__ bool next(int i, Unit& u) const {
        const long L = (long)i * G + c; if (L >= nwg) return false;
        const int wgid = xcd_remap((int)L, nwg);
        const int nig = WGM * nN, gid = wgid / nig, fm = gid * WGM, gsz = (nM - fm) < WGM ? (nM - fm) : WGM;
        u.pm = fm + ((wgid % nig) % gsz); u.pn = (wgid % nig) / gsz; u.e = 0; u.aux = 0; return true;
    }
    __device__ __forceinline__ const char* a_base(const Unit&) const { return A; }
    __device__ __forceinline__ const char* b_base(const Unit& u) const { return Bt + (size_t)u.pn * BM * Kb; }
    __device__ __forceinline__ void a_off(const Unit& u, unsigned (&off)[2][2]) const {
        int tz = threadIdx.x; asm volatile("" : "+v"(tz));
#pragma unroll
        for (int i = 0; i < 2; ++i) { int R, C; stage_rc(tz * 16 + i * 8192, R, C);
#pragma unroll
            for (int h = 0; h < 2; ++h) off[h][i] = (unsigned)((u.pm * BM + h * HALF + R) * Kb + C * 2); }
    }
};
struct SchedMoe1 {
    const char* X; const char* W; const unsigned* list; const LAS int* P; const LAS int* cnt; const LAS int* tile_e; int U, G, c, Kb;
    __device__ __forceinline__ bool next(int i, Unit& u) const {
        const long L = (long)i * G + c; if (L >= U) return false;
        const int wgid = xcd_remap((int)L, U);
        u.pm = wgid >> 2; u.pn = wgid & 3; u.e = tile_e[u.pm]; u.aux = u.pm - P[u.e]; return true;
    }
    __device__ __forceinline__ const char* a_base(const Unit&) const { return X; }
    __device__ __forceinline__ const char* b_base(const Unit& u) const { return W + ((size_t)u.e * 1024 + (size_t)u.pn * 256) * Kb; }
    __device__ __forceinline__ void a_off(const Unit& u, unsigned (&off)[2][2]) const {
        const int n = cnt[u.e];
        int tz = threadIdx.x; asm volatile("" : "+v"(tz));
#pragma unroll
        for (int i = 0; i < 2; ++i) { int R, C; stage_rc(tz * 16 + i * 8192, R, C);
#pragma unroll
            for (int h = 0; h < 2; ++h) {
                const int r = u.aux * BM + h * HALF + R;
                unsigned tok;
                if (u.e == NE) tok = (unsigned)r;
                else tok = (r < n) ? list[(size_t)u.e * NTOK + r] : 0u;
                off[h][i] = tok * (unsigned)Kb + (unsigned)C * 2u;
            } }
    }
};
struct SchedMoe2 {
    const char* Hb; const char* W; const LAS int* tile_e; int U, G, c, Kb;
    __device__ __forceinline__ bool next(int i, Unit& u) const {
        const long L = (long)i * G + c; if (L >= U) return false;
        const int wgid = xcd_remap((int)L, U);
        u.pm = wgid >> 3; u.pn = wgid & 7; u.e = tile_e[u.pm]; u.aux = 0; return true;
    }
    __device__ __forceinline__ const char* a_base(const Unit&) const { return Hb; }
    __device__ __forceinline__ const char* b_base(const Unit& u) const { return W + ((size_t)u.e * DM + (size_t)u.pn * 256) * Kb; }
    __device__ __forceinline__ void a_off(const Unit& u, unsigned (&off)[2][2]) const {
        int tz = threadIdx.x; asm volatile("" : "+v"(tz));
#pragma unroll
        for (int i = 0; i < 2; ++i) { int R, C; stage_rc(tz * 16 + i * 8192, R, C);
#pragma unroll
            for (int h = 0; h < 2; ++h) off[h][i] = (unsigned)((u.pm * BM + h * HALF + R) * Kb + C * 2); }
    }
};

template <bool KM> struct EpiQKV {
    static constexpr bool PERM = true;
    bf16_t* QKV; const float* rope; float osc;
    __device__ __forceinline__ void operator()(const f32x4 (&acc)[2][2][4][2], const Unit& u, int wr, int wc, int fr, int fq) const {
        const int seg = u.pn >> 3, slab0 = (u.pn & 7) * 2;
        bf16_t* base = QKV + (size_t)seg * ((size_t)BATCH * NSLAB * SEQ * HD);
        const int row0 = u.pm * BM + wr * 64 + fr; const int b = (u.pm * BM) >> 13;
        const bool rot = (seg < 2) && (wc == 0);
        f32x4 cs0a = {0.f, 0.f, 0.f, 0.f}, cs0b = cs0a, cs1a = cs0a, cs1b = cs0a;
#pragma unroll
        for (int ai = 0; ai < 2; ++ai)
#pragma unroll
            for (int m = 0; m < 4; ++m) {
                const int row = row0 + ai * HALF + m * 16, s = row & (SEQ - 1);
                f32x4 cs = {1.f, 1.f, 1.f, 1.f}, sn = {0.f, 0.f, 0.f, 0.f};
                if (rot) { cs = *(const f32x4*)(rope + (size_t)row * 32 + 4 * fq); sn = *(const f32x4*)(rope + (size_t)row * 32 + 16 + 4 * fq); }
#pragma unroll
                for (int bj = 0; bj < 2; ++bj) {
                    f32x4 v0 = acc[ai][bj][m][0] * osc, v1 = acc[ai][bj][m][1] * osc;
                    if (rot) {
                        f32x4 w0, w1;
                        w0[0] = v0[0] * cs[0] - v0[1] * sn[0]; w0[1] = v0[1] * cs[0] + v0[0] * sn[0];
                        w0[2] = v0[2] * cs[1] - v0[3] * sn[1]; w0[3] = v0[3] * cs[1] + v0[2] * sn[1];
                        w1[0] = v1[0] * cs[2] - v1[1] * sn[2]; w1[1] = v1[1] * cs[2] + v1[0] * sn[2];
                        w1[2] = v1[2] * cs[3] - v1[3] * sn[3]; w1[3] = v1[3] * cs[3] + v1[2] * sn[3];
                        v0 = w0; v1 = w1;
                    }
                    u32x4 w; w.x = cvt_pk_bf16(v0[0], v0[1]); w.y = cvt_pk_bf16(v0[2], v0[3]); w.z = cvt_pk_bf16(v1[0], v1[1]); w.w = cvt_pk_bf16(v1[2], v1[3]);
                    *(u32x4*)(base + ((size_t)(b * NSLAB + slab0 + bj) * SEQ + s) * HD + wc * 32 + 8 * fq) = w;
                    if (KM && seg == 1) { const f32x4 ra = {bf_lo(w.x), bf_hi(w.x), bf_lo(w.y), bf_hi(w.y)}, rb = {bf_lo(w.z), bf_hi(w.z), bf_lo(w.w), bf_hi(w.w)};
                        if (bj == 0) { cs0a += ra; cs0b += rb; } else { cs1a += ra; cs1b += rb; } }
                }
            }
        if (KM && seg == 1) {
            bf16_t* km = (bf16_t*)((unsigned char*)QKV - WS_Q + WS_KMEAN);
            LAS float* kbuf = (LAS float*)(uintptr_t)(LDSCTL_OFF + 12288);
#define KM_RED(V, BJ, I0) do { _Pragma("unroll") for (int i = 0; i < 4; ++i) { float v = V[i]; v += dpp_mov<0xB1>(v); v += dpp_mov<0x4E>(v); v += dpp_mov<0x141>(v); v += dpp_mov<0x140>(v); \
                if (fr == 0) kbuf[((wr * 4 + wc) * 2 + (BJ)) * 32 + fq * 8 + (I0) + i] = v; } } while (0)
            KM_RED(cs0a, 0, 0); KM_RED(cs0b, 0, 4); KM_RED(cs1a, 1, 0); KM_RED(cs1b, 1, 4);
#undef KM_RED
            asm volatile("s_waitcnt lgkmcnt(0)" ::: "memory"); __builtin_amdgcn_s_barrier(); asm volatile("" ::: "memory");
            if (wr == 0) {
                const int l = fq * 16 + fr, bj = l >> 5, c32 = l & 31;
                const float mean = (kbuf[((0 * 4 + wc) * 2 + bj) * 32 + c32] + kbuf[((1 * 4 + wc) * 2 + bj) * 32 + c32]) * (1.f / 256.f);
                const unsigned hi = cvt_pk_bf16(mean, 0.f) & 0xffffu; const unsigned lo = cvt_pk_bf16(mean - bf_lo(hi), 0.f) & 0xffffu;
                const size_t ko = ((size_t)(b * NSLAB + slab0 + bj) * 64 + (u.pm & 31)) * HD + wc * 32 + c32;
                km[ko] = (bf16_t)hi; km[ko + 32 * HD] = (bf16_t)lo;
            }
        }
    }
};
struct EpiRes {
    static constexpr bool PERM = false;
    const float* xres; float* y; float osc;
    __device__ __forceinline__ void operator()(const f32x4 (&acc)[2][2][4][2], const Unit& u, int wr, int wc, int fr, int fq) const {
        const int row0 = u.pm * BM + wr * 64 + fr, col0 = u.pn * BM + wc * 32 + 4 * fq;
#pragma unroll
        for (int ai = 0; ai < 2; ++ai)
#pragma unroll
            for (int m = 0; m < 4; ++m) {
                const size_t ro = (size_t)(row0 + ai * HALF + m * 16) * DM + col0;
#pragma unroll
                for (int bj = 0; bj < 2; ++bj)
#pragma unroll
                    for (int n = 0; n < 2; ++n) { const f32x4 xr = *(const f32x4*)(xres + ro + bj * HALF + n * 16); *(f32x4*)(y + ro + bj * HALF + n * 16) = xr * ALPHA + acc[ai][bj][m][n] * osc; }
            }
    }
};
__device__ __forceinline__ float silu_mul(float g, float up) { return g * __builtin_amdgcn_rcpf(1.f + __builtin_amdgcn_exp2f(-1.4426950408889634f * g)) * up; }
template <bool OUT8> struct EpiSwiGLU {
    static constexpr bool PERM = true;
    bf16_t* H; float osc;
    __device__ __forceinline__ void operator()(const f32x4 (&acc)[2][2][4][2], const Unit& u, int wr, int wc, int fr, int fq) const {
        const int row0 = u.pm * BM + wr * 64 + fr, col0 = u.pn * 128 + wc * 32 + 8 * fq;
#pragma unroll
        for (int ai = 0; ai < 2; ++ai)
#pragma unroll
            for (int m = 0; m < 4; ++m) {
                const f32x4 g0 = acc[ai][0][m][0] * osc, g1 = acc[ai][0][m][1] * osc, u0 = acc[ai][1][m][0] * osc, u1 = acc[ai][1][m][1] * osc;
                if (OUT8) {
                    u32x2 w; w.x = pk4_fp8(silu_mul(g0[0], u0[0]), silu_mul(g0[1], u0[1]), silu_mul(g0[2], u0[2]), silu_mul(g0[3], u0[3]));
                    w.y = pk4_fp8(silu_mul(g1[0], u1[0]), silu_mul(g1[1], u1[1]), silu_mul(g1[2], u1[2]), silu_mul(g1[3], u1[3]));
                    *(u32x2*)((unsigned char*)H + (size_t)(row0 + ai * HALF + m * 16) * DE + col0) = w;
                } else {
                u32x4 w;
                w.x = cvt_pk_bf16(silu_mul(g0[0], u0[0]), silu_mul(g0[1], u0[1])); w.y = cvt_pk_bf16(silu_mul(g0[2], u0[2]), silu_mul(g0[3], u0[3]));
                w.z = cvt_pk_bf16(silu_mul(g1[0], u1[0]), silu_mul(g1[1], u1[1])); w.w = cvt_pk_bf16(silu_mul(g1[2], u1[2]), silu_mul(g1[3], u1[3]));
                *(u32x4*)(H + (size_t)(row0 + ai * HALF + m * 16) * DE + col0) = w;
                }
            }
    }
};
template <bool OUT8> struct EpiY {
    static constexpr bool PERM = true;
    bf16_t* Y; float osc;
    __device__ __forceinline__ void operator()(const f32x4 (&acc)[2][2][4][2], const Unit& u, int wr, int wc, int fr, int fq) const {
        const int row0 = u.pm * BM + wr * 64 + fr, col0 = u.pn * BM + wc * 32 + 8 * fq;
#pragma unroll
        for (int ai = 0; ai < 2; ++ai)
#pragma unroll
            for (int m = 0; m < 4; ++m) {
                bf16_t* rowp = Y + (size_t)(row0 + ai * HALF + m * 16) * DM + col0;
#pragma unroll
                for (int bj = 0; bj < 2; ++bj) { const f32x4 v0 = acc[ai][bj][m][0] * osc, v1 = acc[ai][bj][m][1] * osc;
                    if (OUT8) { u32x2 w; w.x = pk4_fp8(v0[0], v0[1], v0[2], v0[3]); w.y = pk4_fp8(v1[0], v1[1], v1[2], v1[3]);
                        *(u32x2*)((unsigned char*)Y + (size_t)(row0 + ai * HALF + m * 16) * DM + col0 + bj * HALF) = w; }
                    else { u32x4 w; w.x = cvt_pk_bf16(v0[0], v0[1]); w.y = cvt_pk_bf16(v0[2], v0[3]); w.z = cvt_pk_bf16(v1[0], v1[1]); w.w = cvt_pk_bf16(v1[2], v1[3]);
                        *(u32x4*)(rowp + bj * HALF) = w; } }
            }
    }
};

typedef int i32x4 __attribute__((ext_vector_type(4)));
typedef int i32x8 __attribute__((ext_vector_type(8)));
__device__ __forceinline__ i32x8 cat8(bf16x8 a, bf16x8 b) { const i32x4 x = __builtin_bit_cast(i32x4, a), y = __builtin_bit_cast(i32x4, b); return (i32x8){x[0], x[1], x[2], x[3], y[0], y[1], y[2], y[3]}; }
template <class Epi, class Sched, bool F8>
__device__ __forceinline__ void gemm_phase(LAS unsigned char* lds, const int K, const Sched& S, const Epi& E) {
    const int tid = threadIdx.x, wid = __builtin_amdgcn_readfirstlane(tid >> 6), lane = tid & 63, wr = wid >> 2, wc = wid & 3, fr = lane & 15, fq = lane >> 4;
    const int nt = K / 128;
    unsigned voffB[2];
#pragma unroll
    for (int i = 0; i < 2; ++i) { int R, C; stage_rc(tid * 16 + i * 8192, R, C); const int Rb = Epi::PERM ? ((R & ~31) + perm32(R & 31)) : R; voffB[i] = (unsigned)(Rb * K + C * 2); }
    const size_t kstep = (size_t)(BK * 2);
    const size_t hstep = (size_t)HALF * K;
    const unsigned ldsw = (unsigned)wid * 1024u;
    const int aoff = lds_byte(wr * 64 + fr, fq * 8), boff = lds_byte(wc * 32 + fr, fq * 8);
#define PG8_SA(b, h) (((b) * 2 + (h)) * HTB)
#define PG8_SB(b, h) ((4 + (b) * 2 + (h)) * HTB)
#define PG8_STAGE(bufoff, gbase, voff) do { _Pragma("unroll") for (int _i = 0; _i < 2; ++_i) \
        __builtin_amdgcn_global_load_lds((const unsigned*)((const char*)(gbase) + (voff)[_i]), (LAS unsigned*)(lds + (bufoff) + ldsw + _i * 8192), 16, 0, 0); } while (0)
#define PG8_LDA(dst, b, h) do { _Pragma("unroll") for (int m = 0; m < 4; ++m) _Pragma("unroll") for (int k = 0; k < 2; ++k) dst[m][k] = *(const LAS bf16x8*)(lds + PG8_SA(b, h) + aoff + m * 2048 + k * 1024); } while (0)
#define PG8_LDB(dst, b, h) do { _Pragma("unroll") for (int n = 0; n < 2; ++n) _Pragma("unroll") for (int k = 0; k < 2; ++k) dst[n][k] = *(const LAS bf16x8*)(lds + PG8_SB(b, h) + boff + n * 2048 + k * 1024); } while (0)
#define PG8_MMA(ai, bj, At, Bt) do { __builtin_amdgcn_s_setprio(1); _Pragma("unroll") for (int m = 0; m < 4; ++m) _Pragma("unroll") for (int n = 0; n < 2; ++n) { \
        if (F8) acc[ai][bj][m][n] = __builtin_amdgcn_mfma_scale_f32_16x16x128_f8f6f4(cat8(Bt[n][0], Bt[n][1]), cat8(At[m][0], At[m][1]), acc[ai][bj][m][n], 0, 0, 0, 0x7F7F7F7F, 0, 0x7F7F7F7F); \
        else { _Pragma("unroll") for (int k = 0; k < 2; ++k) acc[ai][bj][m][n] = __builtin_amdgcn_mfma_f32_16x16x32_bf16(Bt[n][k], At[m][k], acc[ai][bj][m][n], 0, 0, 0); } } \
        __builtin_amdgcn_s_setprio(0); } while (0)
#define PG8_WAIT_V(n) asm volatile("s_waitcnt vmcnt(" #n ")" ::: "memory")
#define PG8_WAIT_L(n) asm volatile("s_waitcnt lgkmcnt(" #n ")" ::: "memory")
#define PG8_BAR __builtin_amdgcn_s_barrier()
#define PG8_SCHED __builtin_amdgcn_sched_barrier(0)
    Unit cur, nxt; int ui = 0;
    if (!S.next(0, cur)) return;
    f32x4 acc[2][2][4][2];
#pragma unroll
    for (int a = 0; a < 2; ++a)
#pragma unroll
        for (int b = 0; b < 2; ++b)
#pragma unroll
            for (int m = 0; m < 4; ++m)
#pragma unroll
                for (int n = 0; n < 2; ++n) acc[a][b][m][n] = (f32x4){0.f, 0.f, 0.f, 0.f};
    bf16x8 At[4][2], B0[2][2], B1[2][2];
    unsigned cOff[2][2];
    const char* cA = S.a_base(cur); const char* cB = S.b_base(cur);
    S.a_off(cur, cOff);
    PG8_STAGE(PG8_SB(0, 0), cB, voffB); PG8_STAGE(PG8_SB(0, 1), cB + hstep, voffB); PG8_STAGE(PG8_SA(0, 0), cA, cOff[0]); PG8_STAGE(PG8_SA(0, 1), cA, cOff[1]);
    if (wr == 1) PG8_BAR;
    PG8_WAIT_V(2); PG8_BAR;
    PG8_STAGE(PG8_SB(1, 0), cB + kstep, voffB); PG8_STAGE(PG8_SA(1, 0), cA + kstep, cOff[0]); PG8_STAGE(PG8_SB(1, 1), cB + hstep + kstep, voffB);
    PG8_WAIT_V(6); PG8_BAR;
    for (;;) {
        const bool has_next = S.next(ui + 1, nxt);
        const char* nA = has_next ? S.a_base(nxt) : cA; const char* nB = has_next ? S.b_base(nxt) : cB;
#pragma unroll 1
        for (int t = 0; t < nt; t += 2) {
            const bool last = (t == nt - 2);
            const char* a1 = cA + (size_t)(t + 1) * kstep;
            const char* a2 = last ? nA : cA + (size_t)(t + 2) * kstep; const char* b2 = last ? nB : cB + (size_t)(t + 2) * kstep;
            const char* a3 = a2 + kstep; const char* b3 = b2 + kstep;
            PG8_LDB(B0, 0, 0); PG8_LDB(B1, 0, 1); PG8_SCHED; PG8_LDA(At, 0, 0); PG8_STAGE(PG8_SA(1, 1), a1, cOff[1]);
            if (last && has_next) S.a_off(nxt, cOff);
            PG8_WAIT_V(8); PG8_WAIT_L(0); PG8_BAR; PG8_MMA(0, 0, At, B0); PG8_MMA(0, 1, At, B1); PG8_BAR; PG8_SCHED;
            PG8_LDA(At, 0, 1); PG8_STAGE(PG8_SB(0, 0), b2, voffB); PG8_STAGE(PG8_SB(0, 1), b2 + hstep, voffB); PG8_STAGE(PG8_SA(0, 0), a2, cOff[0]);
            PG8_WAIT_V(8); PG8_WAIT_L(0); PG8_BAR; PG8_MMA(1, 0, At, B0); PG8_MMA(1, 1, At, B1); PG8_BAR; PG8_SCHED;
            PG8_LDB(B0, 1, 0); PG8_LDB(B1, 1, 1); PG8_SCHED; PG8_LDA(At, 1, 0); PG8_STAGE(PG8_SA(0, 1), a2, cOff[1]);
            PG8_WAIT_V(8); PG8_WAIT_L(0); PG8_BAR; PG8_MMA(0, 0, At, B0); PG8_MMA(0, 1, At, B1); PG8_BAR; PG8_SCHED;
            PG8_LDA(At, 1, 1); PG8_STAGE(PG8_SB(1, 0), b3, voffB); PG8_STAGE(PG8_SB(1, 1), b3 + hstep, voffB); PG8_STAGE(PG8_SA(1, 0), a3, cOff[0]);
            PG8_WAIT_V(8); PG8_WAIT_L(0); PG8_BAR; PG8_MMA(1, 0, At, B0); PG8_MMA(1, 1, At, B1); PG8_BAR; PG8_SCHED;
        }
        if (wr == 0) PG8_BAR;
        E(acc, cur, wr, wc, fr, fq);
        if (!has_next) break;
#pragma unroll
        for (int a = 0; a < 2; ++a)
#pragma unroll
            for (int b = 0; b < 2; ++b)
#pragma unroll
                for (int m = 0; m < 4; ++m)
#pragma unroll
                    for (int n = 0; n < 2; ++n) acc[a][b][m][n] = (f32x4){0.f, 0.f, 0.f, 0.f};
        cur = nxt; cA = nA; cB = nB; ++ui;
        if (wr == 1) PG8_BAR;
    }
    PG8_WAIT_V(0);
    PG8_BAR;
#undef PG8_SA
#undef PG8_SB
#undef PG8_STAGE
#undef PG8_LDA
#undef PG8_LDB
#undef PG8_MMA
#undef PG8_WAIT_V
#undef PG8_WAIT_L
#undef PG8_BAR
#undef PG8_SCHED
}
}

namespace att {
constexpr int D = 128, NW = 8, QBLK = 32, KVBLK = 64, QB = NW * QBLK;
constexpr float SCALE = 0.08838834764831845f;
constexpr float THR = 8.f;
constexpr int SHM_V = KVBLK * D * 2, SHM_K = KVBLK * D * 2;
constexpr int ATT_LDS = 2 * SHM_V + 2 * SHM_K + NW * 256 * 4;
#define KSWZ(row, colB) ((row) * 256 + ((colB) ^ (((row) & 7) << 4)))
__device__ __forceinline__ int v_st(int k, int c) { const int kk = (k & ~0xC) | ((k & 4) << 1) | ((k & 8) >> 1); return ((kk >> 3) * 4 + (c >> 5)) * 512 + ((kk & 7) * 32 + (c & 31)) * 2; }
__device__ __forceinline__ int v_rd_base(int lane) { return ((lane & 3) << 3) | (((lane >> 2) & 3) << 6) | (((lane >> 4) & 1) << 5) | (((lane >> 5) & 1) << 8); }
constexpr int v_rd_off(int d0, int ks, int half) { return d0 * 512 + ks * 4096 + half * 2048; }
__device__ __forceinline__ int crow(int r, int hi) { return (r & 3) + 8 * (r >> 2) + 4 * hi; }
__device__ __forceinline__ bf16x8 load8(const bf16_t* p) { return *reinterpret_cast<const bf16x8*>(p); }
__device__ __forceinline__ void mask_tile(f32x16& p0, f32x16& p1, int dq, unsigned W) {
    const float NEG = -__builtin_inff();
#pragma unroll
    for (int r = 0; r < 16; ++r) {
        const int c = (r & 3) + 8 * (r >> 2);
        if ((unsigned)(dq - c) >= W) p0[r] = NEG;
        if ((unsigned)(dq - c - 32) >= W) p1[r] = NEG;
    }
}
__device__ __forceinline__ void partialSM(f32x16& p0, f32x16& p1, float& m_reg, float& mn, float& alpha) {
    float pmax = p0[0];
#pragma unroll
    for (int r = 1; r < 16; ++r) pmax = fmaxf(pmax, p0[r]);
#pragma unroll
    for (int r = 0; r < 16; ++r) pmax = fmaxf(pmax, p1[r]);
    { auto rr = __builtin_amdgcn_permlane32_swap(__float_as_uint(pmax), __float_as_uint(pmax), false, false);
      pmax = fmaxf(__uint_as_float(rr[0]), __uint_as_float(rr[1])); }
    constexpr float C2 = 1.4426950408889634f * SCALE;
    if (__builtin_expect(__all((pmax - m_reg) * SCALE <= THR), 1)) { mn = m_reg; alpha = 1.f; }
    else { mn = fmaxf(m_reg, pmax); alpha = __builtin_amdgcn_exp2f((m_reg - mn) * C2); m_reg = mn; }
    const float mnL = -mn * C2;
#pragma unroll
    for (int r = 0; r < 16; ++r) p0[r] = fmaf(p0[r], C2, mnL);
#pragma unroll
    for (int r = 0; r < 16; ++r) p1[r] = fmaf(p1[r], C2, mnL);
#pragma unroll
    for (int r = 0; r < 16; ++r) p0[r] = __builtin_amdgcn_exp2f(p0[r]);
}
__device__ __forceinline__ void finishSM(f32x16& p0, f32x16& p1, float alpha, float& l_reg, bf16x8& pa0, bf16x8& pa1, bf16x8& pa2, bf16x8& pa3) {
#pragma unroll
    for (int r = 0; r < 16; ++r) p1[r] = __builtin_amdgcn_exp2f(p1[r]);
    float ps = 0;
#pragma unroll
    for (int r = 0; r < 16; ++r) ps += p0[r];
#pragma unroll
    for (int r = 0; r < 16; ++r) ps += p1[r];
    { auto rr = __builtin_amdgcn_permlane32_swap(__float_as_uint(ps), __float_as_uint(ps), false, false);
      ps = __uint_as_float(rr[0]) + __uint_as_float(rr[1]); }
    l_reg = l_reg * alpha + ps;
#define PK4(P, B_, OUT) do { unsigned a0 = cvt_pk_bf16(P[B_+0], P[B_+1]), a1 = cvt_pk_bf16(P[B_+2], P[B_+3]);                          \
        unsigned b0 = cvt_pk_bf16(P[B_+4], P[B_+5]), b1 = cvt_pk_bf16(P[B_+6], P[B_+7]);                                             \
        auto r0 = __builtin_amdgcn_permlane32_swap(a0, b0, false, false); auto r1 = __builtin_amdgcn_permlane32_swap(a1, b1, false, false); \
        u32x4 w = {r0[0], r1[0], r0[1], r1[1]}; OUT = *reinterpret_cast<bf16x8*>(&w); } while (0)
    PK4(p0, 0, pa0); PK4(p0, 8, pa1); PK4(p1, 0, pa2); PK4(p1, 8, pa3);
#undef PK4
}
template <int KB>
__device__ __forceinline__ void qkt(f32x16& p0, f32x16& p1, const char* K_lds, int r32, int hi, const bf16x8* qr) {
    p0 = f32x16{}; p1 = f32x16{};
    const char* kb[4];
#pragma unroll
    for (int dd = 0; dd < 4; ++dd) kb[dd] = K_lds + KB * SHM_K + KSWZ(r32, (dd * 16 + hi * 8) * 2);
#pragma unroll
    for (int d0 = 0; d0 < 8; ++d0) { const char* a = kb[d0 & 3] + (d0 >> 2) * 128;
        bf16x8 b0 = *reinterpret_cast<const bf16x8*>(a);
        bf16x8 b1 = *reinterpret_cast<const bf16x8*>(a + 32 * 256);
        p0 = __builtin_amdgcn_mfma_f32_32x32x16_bf16(b0, qr[d0], p0, 0, 0, 0);
        p1 = __builtin_amdgcn_mfma_f32_32x32x16_bf16(b1, qr[d0], p1, 0, 0, 0); }
}
template <int VB>
__device__ __forceinline__ void pv_tile(f32x16* o, int vb0, bf16x8 pa0, bf16x8 pa1, bf16x8 pa2, bf16x8 pa3) {
#define TRRD(dst, off) asm volatile("ds_read_b64_tr_b16 %0, %1 offset:%2" : "=&v"(dst) : "v"(vb0), "i"(off) : "memory")
#define PV_D0(d0) do { s16x4 l0, l1, l2, l3, h0, h1, h2, h3; constexpr int b_ = VB * SHM_V + v_rd_off(d0, 0, 0); \
        TRRD(l0, b_); TRRD(h0, b_ + 2048); TRRD(l1, b_ + 4096); TRRD(h1, b_ + 6144); TRRD(l2, b_ + 8192); TRRD(h2, b_ + 10240); TRRD(l3, b_ + 12288); TRRD(h3, b_ + 14336); \
        asm volatile("s_waitcnt lgkmcnt(0)" ::: "memory"); SBAR(); \
        o[d0] = __builtin_amdgcn_mfma_f32_32x32x16_bf16(pa0, (bf16x8){l0[0], l0[1], l0[2], l0[3], h0[0], h0[1], h0[2], h0[3]}, o[d0], 0, 0, 0);   \
        o[d0] = __builtin_amdgcn_mfma_f32_32x32x16_bf16(pa1, (bf16x8){l1[0], l1[1], l1[2], l1[3], h1[0], h1[1], h1[2], h1[3]}, o[d0], 0, 0, 0);   \
        o[d0] = __builtin_amdgcn_mfma_f32_32x32x16_bf16(pa2, (bf16x8){l2[0], l2[1], l2[2], l2[3], h2[0], h2[1], h2[2], h2[3]}, o[d0], 0, 0, 0);   \
        o[d0] = __builtin_amdgcn_mfma_f32_32x32x16_bf16(pa3, (bf16x8){l3[0], l3[1], l3[2], l3[3], h3[0], h3[1], h3[2], h3[3]}, o[d0], 0, 0, 0); } while (0)
    PV_D0(0); PV_D0(1); PV_D0(2); PV_D0(3);
#undef PV_D0
#undef TRRD
}
struct BlockRef { const bf16_t* Q; const bf16_t* K; const bf16_t* V; bf16_t* O; const unsigned* sel; const unsigned* list; float* ML; int P0, jlo, nvalid, nblk, hb; };
struct Seam { bf16x8 qr[8]; bf16x8 st_v0, st_v1, st_k0, st_k1; unsigned sel, qrow; };
#define ROW(p, k0, rr) ((p) + (size_t)((k0) + (rr)) * D + sc)
#define VMWN(n) asm volatile("s_waitcnt vmcnt(%0)" :: "i"(n) : "memory")
#define SLOAD_H(Kp, Vp, k0) do { S.st_v0 = load8(ROW(Vp, k0, sr)); S.st_v1 = load8(ROW(Vp, k0, 32 + sr));              \
                         S.st_k0 = load8(ROW(Kp, k0, sr)); S.st_k1 = load8(ROW(Kp, k0, 32 + sr)); } while (0)
#define SWRITE_HK(bf) do { *(bf16x8*)(K_lds + (bf) * SHM_K + kws) = S.st_k0; *(bf16x8*)(K_lds + (bf) * SHM_K + kws + 32 * 256) = S.st_k1; } while (0)
#define SWRITE_HV(bf) do { *(bf16x8*)(V_lds + (bf) * SHM_V + vst0) = S.st_v0; *(bf16x8*)(V_lds + (bf) * SHM_V + vst1) = S.st_v1; } while (0)
#define SWRITE_H(bf) do { SWRITE_HV(bf); SWRITE_HK(bf); } while (0)
template <bool SP>
__device__ __forceinline__ void attn_prime(const BlockRef& cur, char* lds, Seam& S) {
    int tid = threadIdx.x; asm volatile("" : "+v"(tid));
    const int wid = __builtin_amdgcn_readfirstlane(tid >> 6), lane = tid & 63, r32 = lane & 31, hi = lane >> 5;
    const int sr = tid >> 4, sc = (tid & 15) * 8, kws = KSWZ(sr, sc * 2); char* K_lds = lds + 2 * SHM_V;
    const int i = wid * QBLK + r32;
    unsigned q = (unsigned)i;
    if (SP) q = cur.list ? cur.list[i < cur.nvalid ? i : cur.nvalid - 1] : (unsigned)(cur.P0 + i);
    S.qrow = q; S.sel = SP ? cur.sel[q] : 0u;
#pragma unroll
    for (int d0 = 0; d0 < 8; ++d0) S.qr[d0] = load8(cur.Q + (size_t)q * D + d0 * 16 + hi * 8);
    SLOAD_H(cur.K, cur.V, SP ? cur.jlo * KVBLK : 0); VM_WAIT(); SWRITE_HK(0);
    __syncthreads();
}
template <bool SP>
__device__ __forceinline__ void attn_block(const BlockRef& cur, const BlockRef& nxt, const int ostride, char* lds, Seam& S) {
    int tid = threadIdx.x; asm volatile("" : "+v"(tid));
    const int wid = __builtin_amdgcn_readfirstlane(tid >> 6), lane = tid & 63, r32 = lane & 31, hi = lane >> 5;
    const int NT = SP ? 4 : cur.P0 / KVBLK + 4;
    const int jlo = SP ? cur.jlo : 0;
    const int qlo = cur.P0 + wid * QBLK, qm = qlo + r32 - 4 * hi;
    char* V_lds = lds; char* K_lds = lds + 2 * SHM_V;
    float* ws = (float*)(lds + 2 * SHM_V + 2 * SHM_K) + wid * 256; float* li_l = ws, * al_l = ws + 32;
    unsigned* rd = (unsigned*)(ws + 64); unsigned* nl = (unsigned*)(ws + 96);
    float m_reg = -1e30f, l_reg = 0; f32x16 o[4] = {};
    const int sr = tid >> 4, sc = (tid & 15) * 8, vst0 = v_st(sr, sc), vst1 = v_st(32 + sr, sc), kws = KSWZ(sr, sc * 2);
    const int vb0 = (int)(uintptr_t)V_lds + v_rd_base(lane);
    const bf16_t* Kh = cur.K; const bf16_t* Vh = cur.V;
    const bool causal = !SP || cur.list == nullptr;
#define RESC(a) do { if (__any((a) < 1.f)) { if (hi == 0) al_l[r32] = (a); asm volatile("s_waitcnt lgkmcnt(0)" ::: "memory");              \
                     for (int d_ = 0; d_ < 4; ++d_) for (int r = 0; r < 16; ++r) o[d_][r] *= al_l[crow(r, hi)]; } } while (0)
#define KBASE(t) ((jlo + (t)) * KVBLK)
#define MASKT(P0_, P1_, t) do { const int kb_ = KBASE(t); if (causal && kb_ + KVBLK - 1 > qlo) mask_tile(P0_, P1_, qm - kb_, 0x40000000u); } while (0)
    constexpr int NQL = 8;
#define SEAM_K0() do { VMWN(NQL); SWRITE_HK(0); SBAR(); } while (0)
    f32x16 pA0, pA1, pB0, pB1; float mnA, mnB, alA, alB; bf16x8 pa0, pa1, pa2, pa3;
    unsigned qn_tmp = 0u;
    if (SP) {
        if (hi == 0) { const bool valid = (cur.list == nullptr) || (wid * QBLK + r32 < cur.nvalid);
            const unsigned slot = cur.list ? (unsigned)__builtin_popcount(S.sel & ((1u << cur.nblk) - 1u)) : 3u;
            rd[r32] = valid ? (((unsigned)cur.hb + S.qrow) * 4u + slot) * 128u : (1u << 27); }
        if (nxt.list) { const int i = wid * QBLK + r32; qn_tmp = nxt.list[i < nxt.nvalid ? i : nxt.nvalid - 1]; }
    }
    SWRITE_HV(0); SBAR();
    if (NT > 1) { SLOAD_H(Kh, Vh, KBASE(1)); }
    SBAR(); qkt<0>(pA0, pA1, K_lds, r32, hi, S.qr);
    MASKT(pA0, pA1, 0); partialSM(pA0, pA1, m_reg, mnA, alA);
    if (NT > 1) { VM_WAIT(); SWRITE_H(1); }
    if (SP) nl[lane] = nxt.list ? qn_tmp : (unsigned)(nxt.P0 + wid * QBLK + r32);
    __syncthreads();
#define HALF_STEP(PX0, PX1, mnX, alX, PY0, PY1, alY, t, KB, VB, SB) do {                                                      \
        SBAR(); qkt<KB>(PX0, PX1, K_lds, r32, hi, S.qr);                                                                      \
        finishSM(PY0, PY1, alY, l_reg, pa0, pa1, pa2, pa3); SBAR();                                                           \
        if ((t) + 1 < NT) { SLOAD_H(Kh, Vh, KBASE((t) + 1)); SBAR(); }                                                        \
        pv_tile<VB>(o, vb0, pa0, pa1, pa2, pa3); MASKT(PX0, PX1, (t)); partialSM(PX0, PX1, m_reg, mnX, alX);                  \
        __syncthreads();                                                                                                      \
        if ((t) + 1 < NT) { VM_WAIT(); SWRITE_H(SB); }                                                                        \
        RESC(alX); __syncthreads(); } while (0)
    for (int t = 1; t + 1 < NT; t += 2) {
        HALF_STEP(pB0, pB1, mnB, alB, pA0, pA1, alA, t, 1, 0, 0);
        HALF_STEP(pA0, pA1, mnA, alA, pB0, pB1, alB, t + 1, 0, 1, 1);
    }
    const bool even = (NT & 1) == 0;
    if (even) { SBAR(); qkt<1>(pB0, pB1, K_lds, r32, hi, S.qr); SBAR(); }
    unsigned qn = (unsigned)(wid * QBLK + r32);
    if (SP) { qn = nl[lane]; S.qrow = qn; S.sel = nxt.sel[qn]; }
    SLOAD_H(nxt.K, nxt.V, SP ? nxt.jlo * KVBLK : 0); SBAR();
#pragma unroll
    for (int d0 = 0; d0 < 8; ++d0) S.qr[d0] = load8(nxt.Q + (size_t)qn * D + d0 * 16 + hi * 8);
    SBAR();
    finishSM(pA0, pA1, alA, l_reg, pa0, pa1, pa2, pa3); SBAR();
    pv_tile<0>(o, vb0, pa0, pa1, pa2, pa3);
    if (even) { MASKT(pB0, pB1, NT - 1); partialSM(pB0, pB1, m_reg, mnB, alB); __syncthreads(); RESC(alB);
        finishSM(pB0, pB1, alB, l_reg, pa0, pa1, pa2, pa3); SBAR(); pv_tile<1>(o, vb0, pa0, pa1, pa2, pa3); }
    SBAR(); SEAM_K0();
    if (hi == 0) li_l[r32] = l_reg; asm volatile("s_waitcnt lgkmcnt(0)" ::: "memory");
    float rli[16];
#pragma unroll
    for (int r = 0; r < 16; ++r) rli[r] = __builtin_amdgcn_rcpf(li_l[crow(r, hi)]);
    if (SP) {
        bf16_t* Ob = cur.O;
#pragma unroll
        for (int r = 0; r < 16; ++r) { const unsigned off = rd[crow(r, hi)];
#pragma unroll
            for (int d0 = 0; d0 < 4; ++d0) { const float v = o[d0][r] * rli[r];
                const float vn = __int_as_float(__builtin_amdgcn_mov_dpp(__float_as_int(v), 0xB1, 0xF, 0xF, true));
                if ((r32 & 1) == 0) *(unsigned*)(Ob + (size_t)off + d0 * 32 + r32) = cvt_pk_bf16(v, vn); } }
        if (hi == 0) { float* mlp = cur.ML + (size_t)(rd[r32] >> 7) * 2; f32x2 ml = {m_reg, l_reg}; *(f32x2*)mlp = ml; }
    } else {
        bf16_t* Ow = cur.O + (size_t)(wid * QBLK) * ostride;
#pragma unroll
        for (int r = 0; r < 16; ++r) { const int orow = crow(r, hi);
#pragma unroll
            for (int d0 = 0; d0 < 4; ++d0) { const float v = o[d0][r] * rli[r];
                const float vn = __int_as_float(__builtin_amdgcn_mov_dpp(__float_as_int(v), 0xB1, 0xF, 0xF, true));
                if ((r32 & 1) == 0) *(unsigned*)(Ow + (size_t)orow * ostride + d0 * 32 + r32) = cvt_pk_bf16(v, vn); } }
    }
    __syncthreads();
#undef RESC
#undef KBASE
#undef MASKT
#undef SEAM_K0
#undef HALF_STEP
}
#undef ROW
#undef VMWN
#undef SLOAD_H
#undef SWRITE_HK
#undef SWRITE_HV
#undef SWRITE_H
}

struct Args { const float* in[23]; float* out; unsigned char* ws; int ph_lo, ph_hi; };
typedef const __attribute__((address_space(4))) Args* KArgs;
__device__ __forceinline__ KArgs kargs() { KArgs p = (KArgs)__builtin_amdgcn_kernarg_segment_ptr(); asm volatile("" : "+s"(p)); return p; }
__device__ __forceinline__ int otid() { int t = threadIdx.x; asm volatile("" : "+v"(t)); return t; }
struct Geo { int G, bx, vcu, gw, NGW; };
__device__ __forceinline__ Geo geo() {
    Geo g; const int tid = otid(); const int wave = __builtin_amdgcn_readfirstlane(tid >> 6);
    g.G = gridDim.x; g.bx = blockIdx.x; g.vcu = (g.G % 8 == 0) ? (g.bx % 8) * (g.G / 8) + g.bx / 8 : g.bx; g.gw = g.vcu * NWAVES + wave; g.NGW = g.G * NWAVES; return g;
}
enum { I_X = 0, I_POS, I_LN1G, I_LN1B, I_LN2G, I_LN2B, I_DAWIN, I_DAWOUT, I_LQ1, I_LK1, I_LQ2, I_LK2, I_SUBLN, I_MBWIN, I_MBWOUT, I_WR, I_RB, I_WG, I_WU, I_WD, I_SG, I_SU, I_SD };

__device__ __forceinline__ int dst_row(int kind, int n) {
    if (kind == 1) { if (n < 4096) { int d = n & 127; const int h = n & ~127; if (d < 16) d = 2 * d; else if (d < 32) d = 2 * (d - 16) + 1; return h + d; } return n; }
    if (kind == 2) return ((n >> 7) << 8) + (n & 127);
    if (kind == 3) return ((n >> 7) << 8) + 128 + (n & 127);
    return n;
}
struct TrDesc { const float* W; unsigned char* WT; int K, N, k0, n0, kind, f8; };
constexpr int IT_IN = 32 * 192, IT_OUT = 32 * 64, IT_E = 512, IT_ATT = 2 * IT_IN + 2 * IT_OUT, IT_TOTAL = IT_ATT + 2 * NEX * 3 * IT_E;
__device__ __forceinline__ void tr_decode(KArgs a, int it, TrDesc& d) {
    unsigned char* ws = a->ws; int s;
    if (it < IT_ATT) {
        if (it < IT_IN) { d.W = a->in[I_DAWIN]; d.WT = ws + WS_WATT; d.K = DM; d.N = NQKV; d.kind = 1; d.f8 = FP8_QKV0; s = it; }
        else if (it < 2 * IT_IN) { d.W = a->in[I_MBWIN]; d.WT = ws + WS_WATT + 32 * MiB; d.K = DM; d.N = NQKV; d.kind = 1; d.f8 = FP8_QKV1; s = it - IT_IN; }
        else if (it < 2 * IT_IN + IT_OUT) { d.W = a->in[I_DAWOUT]; d.WT = ws + WS_WATT + 24 * MiB; d.K = DM; d.N = DM; d.kind = 0; d.f8 = FP8_OUT0; s = it - 2 * IT_IN; }
        else { d.W = a->in[I_MBWOUT]; d.WT = ws + WS_WATT + 56 * MiB; d.K = DM; d.N = DM; d.kind = 0; d.f8 = FP8_OUT1; s = it - 2 * IT_IN - IT_OUT; }
    } else {
        const int r = it - IT_ATT, le = r / (3 * IT_E), sub = r - le * (3 * IT_E), mtx = sub / IT_E; s = sub - mtx * IT_E;
        const int l = le / NEX, e = le - l * NEX;
        const size_t EW = (size_t)DM * DE;
        if (mtx < 2) {
            const float* src = (e < NE) ? a->in[mtx == 0 ? I_WG : I_WU] + ((size_t)l * NE + e) * EW : a->in[mtx == 0 ? I_SG : I_SU] + (size_t)l * EW;
            d.f8 = MOE_F8(l);
            d.W = src; d.WT = ws + WS_WGU + (size_t)l * NEX * (2 * EW) * 2 + (size_t)e * (2 * EW) * (d.f8 ? 1 : 2); d.K = DM; d.N = DE; d.kind = 2 + mtx;
        } else {
            const float* src = (e < NE) ? a->in[I_WD] + ((size_t)l * NE + e) * EW : a->in[I_SD] + (size_t)l * EW;
            d.f8 = MOE_F8(l);
            d.W = src; d.WT = ws + WS_WD + (size_t)l * NEX * EW * 2 + (size_t)e * EW * (d.f8 ? 1 : 2); d.K = DE; d.N = DM; d.kind = 0;
        }
    }
    const int nblk = d.N / 32; const int kb = s / nblk; d.k0 = kb * 64; d.n0 = (s - kb * nblk) * 32;
}
__device__ __forceinline__ void tr_load(const TrDesc& d, int lane, f32x4 (&v)[8]) {
    const int kk = lane >> 3, n4 = (lane & 7) * 4;
#pragma unroll
    for (int i = 0; i < 8; ++i) v[i] = __builtin_nontemporal_load((const f32x4*)(d.W + (size_t)(d.k0 + kk + 8 * i) * d.N + d.n0 + n4));
}
__device__ __forceinline__ void tr_store(const TrDesc& d, int lane, const f32x4 (&v)[8], LAS float* scr) {
    const int kk = lane >> 3, n4 = (lane & 7) * 4, c = lane & 3;
#pragma unroll
    for (int hf = 0; hf < 2; ++hf) {
#pragma unroll
        for (int i = 0; i < 4; ++i)
#pragma unroll
            for (int q = 0; q < 4; ++q) scr[(kk + 8 * i) * 33 + n4 + q] = v[hf * 4 + i][q];
        LDS_WAIT();
#pragma unroll
        for (int j = 0; j < 2; ++j) { const int n = (lane >> 2) + 16 * j; const LAS float* s = scr + (8 * c) * 33 + n;
            const size_t eo = (size_t)dst_row(d.kind, d.n0 + n) * d.K + d.k0 + hf * 32 + 8 * c;
            if (d.f8) { u32x2 o; o.x = pk4_fp8(s[0 * 33] * W8_SCALE, s[1 * 33] * W8_SCALE, s[2 * 33] * W8_SCALE, s[3 * 33] * W8_SCALE); o.y = pk4_fp8(s[4 * 33] * W8_SCALE, s[5 * 33] * W8_SCALE, s[6 * 33] * W8_SCALE, s[7 * 33] * W8_SCALE);
                *(u32x2*)(d.WT + eo) = o; }
            else { u32x4 o; o.x = cvt_pk_bf16(s[0 * 33], s[1 * 33]); o.y = cvt_pk_bf16(s[2 * 33], s[3 * 33]); o.z = cvt_pk_bf16(s[4 * 33], s[5 * 33]); o.w = cvt_pk_bf16(s[6 * 33], s[7 * 33]);
                *(u32x4*)(d.WT + eo * 2) = o; } }
        LDS_WAIT();
    }
}
__device__ __forceinline__ void convert_items(KArgs a, LAS float* scr, int gw, int NGW, int lane, int it0, int it1) {
    TrDesc dA, dB, dC; f32x4 vA[8], vB[8], vC[8];
    int it = it0 + gw;
#define CV_LD(D, V, IT) do { if ((IT) < it1) { tr_decode(a, (IT), D); tr_load(D, lane, V); } } while (0)
    CV_LD(dA, vA, it); CV_LD(dB, vB, it + NGW); CV_LD(dC, vC, it + 2 * NGW);
    while (it < it1) {
        tr_store(dA, lane, vA, scr); CV_LD(dA, vA, it + 3 * NGW);
        if (it + NGW < it1) { tr_store(dB, lane, vB, scr); CV_LD(dB, vB, it + 4 * NGW); }
        if (it + 2 * NGW < it1) { tr_store(dC, lane, vC, scr); CV_LD(dC, vC, it + 5 * NGW); }
        it += 3 * NGW;
    }
#undef CV_LD
}
__device__ __forceinline__ void p0_prologue(KArgs a, LAS unsigned char* lds, int gw, int NGW, int wave, int lane) {
    LAS float* scr = (LAS float*)(lds + wave * 4224);
    convert_items(a, scr, gw, NGW, lane, 0, IT_IN);
    {
        const float* x = a->in[I_X]; bf16_t* xb = (bf16_t*)(a->ws + WS_XB);
        f32x4 vn[8];
        if (gw < NTOK) {
#pragma unroll
            for (int j = 0; j < 4; ++j) { vn[2 * j] = *(const f32x4*)(x + (size_t)gw * DM + 512 * j + 8 * lane); vn[2 * j + 1] = *(const f32x4*)(x + (size_t)gw * DM + 512 * j + 8 * lane + 4); } }
        for (int m = gw; m < NTOK; m += NGW) {
            f32x4 v[8];
#pragma unroll
            for (int j = 0; j < 8; ++j) v[j] = vn[j];
            if (m + NGW < NTOK) {
#pragma unroll
                for (int j = 0; j < 4; ++j) { vn[2 * j] = *(const f32x4*)(x + (size_t)(m + NGW) * DM + 512 * j + 8 * lane); vn[2 * j + 1] = *(const f32x4*)(x + (size_t)(m + NGW) * DM + 512 * j + 8 * lane + 4); } }
#pragma unroll
            for (int j = 0; j < 4; ++j) {
                if (FP8_QKV0) { u32x2 w; w.x = pk4_fp8(v[2 * j][0], v[2 * j][1], v[2 * j][2], v[2 * j][3]); w.y = pk4_fp8(v[2 * j + 1][0], v[2 * j + 1][1], v[2 * j + 1][2], v[2 * j + 1][3]);
                    *(u32x2*)((unsigned char*)xb + (size_t)m * DM + 512 * j + 8 * lane) = w; }
                else { u32x4 w; w.x = cvt_pk_bf16(v[2 * j][0], v[2 * j][1]); w.y = cvt_pk_bf16(v[2 * j][2], v[2 * j][3]); w.z = cvt_pk_bf16(v[2 * j + 1][0], v[2 * j + 1][1]); w.w = cvt_pk_bf16(v[2 * j + 1][2], v[2 * j + 1][3]);
                    *(u32x4*)(xb + (size_t)m * DM + 512 * j + 8 * lane) = w; } }
        }
    }
    {
        bf16_t* wf = (bf16_t*)(a->ws + WS_WRF);
        for (int idx = gw * 64 + lane; idx < 2 * 2 * 128 * 64; idx += NGW * 64) {
            const int ln = idx & 63, s = (idx >> 6) & 127, blk = (idx >> 13) & 1, l = idx >> 14;
            const int e = blk * 32 + (ln & 31), c = 16 * s + 8 * (ln >> 5);
            const float* w = a->in[I_WR] + ((size_t)l * DM + c) * NE + e;
            float v[8];
#pragma unroll
            for (int j = 0; j < 8; ++j) v[j] = w[(size_t)j * NE];
            u32x4 h, lo;
            h.x = cvt_pk_bf16(v[0], v[1]); h.y = cvt_pk_bf16(v[2], v[3]); h.z = cvt_pk_bf16(v[4], v[5]); h.w = cvt_pk_bf16(v[6], v[7]);
            lo.x = cvt_pk_bf16(v[0] - bf_lo(h.x), v[1] - bf_hi(h.x)); lo.y = cvt_pk_bf16(v[2] - bf_lo(h.y), v[3] - bf_hi(h.y));
            lo.z = cvt_pk_bf16(v[4] - bf_lo(h.z), v[5] - bf_hi(h.z)); lo.w = cvt_pk_bf16(v[6] - bf_lo(h.w), v[7] - bf_hi(h.w));
            const size_t fo = (((size_t)(l * 2 + 0) * 2 + blk) * 128 + s) * 64 + ln, fl = (((size_t)(l * 2 + 1) * 2 + blk) * 128 + s) * 64 + ln;
            *(u32x4*)(wf + fo * 8) = h; *(u32x4*)(wf + fl * 8) = lo;
        }
    }
    {
        const int* pos = (const int*)a->in[I_POS]; float* tab = (float*)(a->ws + WS_ROPE);
        for (int idx = gw * 64 + lane; idx < NTOK * 16; idx += NGW * 64) {
            const int t = idx >> 4, i = idx & 15;
            const float inv = powf(500000.f, -(float)(2 * i) / 32.f);
            const float ang = (float)pos[t] * inv;
            double rev = (double)ang * 0.15915494309189535; rev -= floor(rev);
            const float fr = (float)rev;
            tab[(size_t)t * 32 + i] = __builtin_amdgcn_cosf(fr); tab[(size_t)t * 32 + 16 + i] = __builtin_amdgcn_sinf(fr);
        }
    }
}

__device__ __forceinline__ void da_combine(KArgs a, int gw, int NGW, int lane) {
    float lam;
    {   const float* q1 = a->in[I_LQ1]; const float* k1 = a->in[I_LK1]; const float* q2 = a->in[I_LQ2]; const float* k2 = a->in[I_LK2];
        const float s1 = wave_sum(q1[lane] * k1[lane] + q1[lane + 64] * k1[lane + 64]);
        const float s2 = wave_sum(q2[lane] * k2[lane] + q2[lane + 64] * k2[lane + 64]);
        lam = expf(s1) - expf(s2) + LAMBDA_INIT; }
    const bf16_t* O = (const bf16_t*)(a->ws + WS_O); bf16_t* AO = (bf16_t*)(a->ws + WS_AOUT);
    const f32x4 g = *(const f32x4*)(a->in[I_SUBLN] + 4 * lane);
    for (int t = gw; t < NTOK; t += NGW) {
        const bf16_t* row = O + (size_t)t * 4096;
        u32x2 x1[8], x2[8];
#pragma unroll
        for (int h = 0; h < 8; ++h) { x1[h] = *(const u32x2*)(row + h * 512 + 4 * lane); x2[h] = *(const u32x2*)(row + h * 512 + 256 + 4 * lane); }
#pragma unroll
        for (int h = 0; h < 8; ++h) {
            f32x4 o;
            o[0] = bf_lo(x1[h].x) - lam * bf_lo(x2[h].x); o[1] = bf_hi(x1[h].x) - lam * bf_hi(x2[h].x);
            o[2] = bf_lo(x1[h].y) - lam * bf_lo(x2[h].y); o[3] = bf_hi(x1[h].y) - lam * bf_hi(x2[h].y);
            const float ss = wave_sum(o[0] * o[0] + o[1] * o[1] + o[2] * o[2] + o[3] * o[3]);
            const float sc = __builtin_amdgcn_rsqf(ss * (1.f / 256.f) + LN_EPS) * (1.f - LAMBDA_INIT);
            if (FP8_OUT0) { const float s8 = sc * AO8_SCALE; *(unsigned*)((unsigned char*)AO + (size_t)t * DM + h * 256 + 4 * lane) = pk4_fp8(o[0] * s8 * g[0], o[1] * s8 * g[1], o[2] * s8 * g[2], o[3] * s8 * g[3]); }
            else { u32x2 w; w.x = cvt_pk_bf16(o[0] * sc * g[0], o[1] * sc * g[1]); w.y = cvt_pk_bf16(o[2] * sc * g[2], o[3] * sc * g[3]);
                *(u32x2*)(AO + (size_t)t * DM + h * 256 + 4 * lane) = w; }
        }
    }
}

__device__ __forceinline__ void moba_kmean(KArgs a, int gw, int NGW, int lane) {
    const bf16_t* Kb = (const bf16_t*)(a->ws + WS_K); bf16_t* km = (bf16_t*)(a->ws + WS_KMEAN);
    for (int it = gw; it < BATCH * NSLAB * 32; it += NGW) {
        const int bh = it >> 5, n = it & 31;
        const bf16_t* p = Kb + ((size_t)bh * SEQ + (size_t)n * 256) * HD + 2 * lane;
        float s0 = 0.f, s1 = 0.f;
#pragma unroll 4
        for (int r = 0; r < 256; r += 8) {
            unsigned u[8];
#pragma unroll
            for (int q = 0; q < 8; ++q) u[q] = *(const unsigned*)(p + (size_t)(r + q) * HD);
#pragma unroll
            for (int q = 0; q < 8; ++q) { s0 += bf_lo(u[q]); s1 += bf_hi(u[q]); }
        }
        s0 *= (1.f / 256.f); s1 *= (1.f / 256.f);
        const unsigned hi = cvt_pk_bf16(s0, s1);
        const unsigned lo = cvt_pk_bf16(s0 - bf_lo(hi), s1 - bf_hi(hi));
        *(unsigned*)(km + ((size_t)bh * 64 + n) * HD + 2 * lane) = hi;
        *(unsigned*)(km + ((size_t)bh * 64 + 32 + n) * HD + 2 * lane) = lo;
    }
}
__device__ __forceinline__ void moba_gate(KArgs a, int gw, int NGW, int lane) {
    const bf16_t* Qb = (const bf16_t*)(a->ws + WS_Q); const bf16_t* km = (const bf16_t*)(a->ws + WS_KMEAN); unsigned* sel = (unsigned*)(a->ws + WS_SEL);
    unsigned* mcnt = (unsigned*)(a->ws + WS_CTL) + CW_MCNT; unsigned* qlist = (unsigned*)(a->ws + WS_QLIST);
    const int r32 = lane & 31, hi = lane >> 5;
    for (int it = gw; it < BATCH * NSLAB * (SEQ / 32); it += NGW) {
        const int bh = it >> 8, qg = it & 255, j = qg >> 3;
        const bf16_t* q = Qb + ((size_t)bh * SEQ + (size_t)qg * 32 + r32) * HD + hi * 8;
        const bf16_t* k = km + ((size_t)bh * 64 + r32) * HD + hi * 8;
        f32x16 p = {};
        bf16x8 qf[8], kh[8], kl[8];
#pragma unroll
        for (int d0 = 0; d0 < 8; ++d0) { qf[d0] = *(const bf16x8*)(q + d0 * 16); kh[d0] = *(const bf16x8*)(k + d0 * 16); kl[d0] = *(const bf16x8*)(k + 32 * HD + d0 * 16); }
        SBAR();
#pragma unroll
        for (int d0 = 0; d0 < 8; ++d0) {
            p = __builtin_amdgcn_mfma_f32_32x32x16_bf16(kh[d0], qf[d0], p, 0, 0, 0);
            p = __builtin_amdgcn_mfma_f32_32x32x16_bf16(kl[d0], qf[d0], p, 0, 0, 0);
        }
        float g[32];
#pragma unroll
        for (int r = 0; r < 16; ++r) {
            const float mine = p[r], other = __shfl_xor(mine, 32);
            const int qd = r >> 2, s = r & 3;
            g[8 * qd + s] = hi ? other : mine;
            g[8 * qd + 4 + s] = hi ? mine : other;
        }
        unsigned mask = 0u;
#pragma unroll
        for (int pass = 0; pass < 3; ++pass) {
            float best = -__builtin_inff(); int bi = -1;
#pragma unroll
            for (int n = 0; n < 32; ++n) { const bool ok = (n < j) && !((mask >> n) & 1u) && (g[n] > best); best = ok ? g[n] : best; bi = ok ? n : bi; }
            if (bi >= 0) mask |= 1u << bi;
        }
        if (hi == 0) sel[(size_t)bh * SEQ + (size_t)qg * 32 + r32] = mask;
        const bool rowlane = hi == 0;
        unsigned cntv = 0u;
        for (int n = 0; n < j; ++n) { const unsigned long long bb = __ballot(rowlane && ((mask >> n) & 1u)); if (lane == n) cntv = (unsigned)__popcll(bb); }
        unsigned basev = 0u;
        if (lane < j && cntv) basev = __hip_atomic_fetch_add(mcnt + bh * 32 + lane, cntv, __ATOMIC_RELAXED, __HIP_MEMORY_SCOPE_AGENT);
        for (int n = 0; n < j; ++n) { const unsigned long long bb = __ballot(rowlane && ((mask >> n) & 1u)); const unsigned base = (unsigned)__builtin_amdgcn_readlane((int)basev, n);
            if (rowlane && ((mask >> n) & 1u)) qlist[(size_t)(bh * 32 + n) * SEQ + base + (unsigned)__popcll(bb & ((1ull << lane) - 1ull))] = (unsigned)(qg * 32 + r32); }
    }
}

__device__ __forceinline__ void ln_router(KArgs a, int layer, LAS unsigned char* lds, int vcu, int G, int wave, int lane) {
    float* out = a->out; bf16_t* xb = (bf16_t*)(a->ws + WS_XB);
    const float* gam = a->in[I_LN1G] + layer * DM; const float* bet = a->in[I_LN1B] + layer * DM;
    const float rb = a->in[I_RB][layer * NE + lane];
    const bf16_t* wfh = (const bf16_t*)(a->ws + WS_WRF) + (size_t)(layer * 2 + 0) * 2 * 128 * 64 * 8;
    const bf16_t* wfl = (const bf16_t*)(a->ws + WS_WRF) + (size_t)(layer * 2 + 1) * 2 * 128 * 64 * 8;
    unsigned* gcount = (unsigned*)(a->ws + WS_CTL) + CW_CNT + layer * NE * 16;
    unsigned* list = (unsigned*)(a->ws + WS_LIST); unsigned* toke = (unsigned*)(a->ws + WS_TOKE); float* tokw = (float*)(a->ws + WS_TOKW);
    LAS unsigned char* xh = lds;
    LAS unsigned char* xl = lds + 65536;
    LAS float* part = (LAS float*)lds;
    LAS int* lcount = (LAS int*)(lds + LT_LCNT); LAS int* lbase = (LAS int*)(lds + LT_LBASE);
    LAS unsigned* ent = (LAS unsigned*)(lds + LT_ENT);
    const int t_beg = vcu * 64;
    if (threadIdx.x < 64) lcount[threadIdx.x] = 0;
    const int n32 = lane & 31, h5 = lane >> 5;
    f32x4 vn[8], gg[8], bb[8];
    {   const float* yr = out + (size_t)(t_beg + wave * 2) * DM;
#pragma unroll
        for (int j = 0; j < 8; ++j) vn[j] = *(const f32x4*)(yr + 256 * j + 4 * lane);
#pragma unroll
        for (int j = 0; j < 8; ++j) { gg[j] = *(const f32x4*)(gam + 256 * j + 4 * lane); bb[j] = *(const f32x4*)(bet + 256 * j + 4 * lane); } }
    __syncthreads();
#pragma unroll 1
    for (int it = 0; it < 4; ++it) {
#pragma unroll 1
        for (int k = 0; k < 2; ++k) {
            const int lt = 2 * wave + k, t = t_beg + 16 * it + lt; float* yr = out + (size_t)t * DM;
            f32x4 v[8]; float s = 0.f;
#pragma unroll
            for (int j = 0; j < 8; ++j) { v[j] = vn[j]; s += (v[j][0] + v[j][1]) + (v[j][2] + v[j][3]); }
            {
                const int tn = (k == 0) ? t + 1 : t + 15;
                if (k == 0 || it < 3) { const float* yn = out + (size_t)tn * DM;
#pragma unroll
                    for (int j = 0; j < 8; ++j) vn[j] = *(const f32x4*)(yn + 256 * j + 4 * lane); } }
            const float mean = wave_sum(s) * (1.f / DM); float s2 = 0.f;
#pragma unroll
            for (int j = 0; j < 8; ++j) { v[j] = v[j] - mean; s2 += (v[j][0] * v[j][0] + v[j][1] * v[j][1]) + (v[j][2] * v[j][2] + v[j][3] * v[j][3]); }
            const float rstd = __builtin_amdgcn_rsqf(wave_sum(s2) * (1.f / DM) + LN_EPS);
#pragma unroll
            for (int j = 0; j < 8; ++j) {
                const f32x4 xv = v[j] * rstd * gg[j] + bb[j];
                *(f32x4*)(yr + 256 * j + 4 * lane) = xv;
                u32x2 w; w.x = cvt_pk_bf16(xv[0], xv[1]); w.y = cvt_pk_bf16(xv[2], xv[3]);
                if (MOE_F8(layer)) *(unsigned*)((unsigned char*)xb + (size_t)t * DM + 256 * j + 4 * lane) = pk4_fp8(xv[0], xv[1], xv[2], xv[3]);
                else *(u32x2*)(xb + (size_t)t * DM + 256 * j + 4 * lane) = w;
                u32x2 wl; wl.x = cvt_pk_bf16(xv[0] - bf_lo(w.x), xv[1] - bf_hi(w.x)); wl.y = cvt_pk_bf16(xv[2] - bf_lo(w.y), xv[3] - bf_hi(w.y));
                const int chunk = 32 * j + (lane >> 1), sw = lt * 4096 + ((chunk ^ lt) << 4) + 8 * (lane & 1);
                *(LAS u32x2*)(xh + sw) = w;
                *(LAS u32x2*)(xl + sw) = wl;
            }
        }
        __syncthreads();
        f32x16 acc0 = {}, acc1 = {};
        {
            const int row = n32 & 15;
            const bf16_t* wh0 = wfh + ((size_t)(0 * 128 + wave * 16) * 64 + lane) * 8; const bf16_t* wh1 = wfh + ((size_t)(1 * 128 + wave * 16) * 64 + lane) * 8;
            const bf16_t* wl0 = wfl + ((size_t)(0 * 128 + wave * 16) * 64 + lane) * 8; const bf16_t* wl1 = wfl + ((size_t)(1 * 128 + wave * 16) * 64 + lane) * 8;
#pragma unroll 1
            for (int sg = 0; sg < 16; sg += 4) {
                bf16x8 ah0[4], ah1[4], al0[4], al1[4];
#pragma unroll
                for (int u = 0; u < 4; ++u) { const int s = sg + u; ah0[u] = *(const bf16x8*)(wh0 + s * 512); ah1[u] = *(const bf16x8*)(wh1 + s * 512); al0[u] = *(const bf16x8*)(wl0 + s * 512); al1[u] = *(const bf16x8*)(wl1 + s * 512); }
                SBAR();
#pragma unroll
                for (int u = 0; u < 4; ++u) { const int s = sg + u;
                    const int off = row * 4096 + (((wave * 32 + 2 * s + h5) ^ row) << 4);
                    const bf16x8 bh = *(const LAS bf16x8*)(xh + off), bl = *(const LAS bf16x8*)(xl + off);
                    acc0 = __builtin_amdgcn_mfma_f32_32x32x16_bf16(ah0[u], bh, acc0, 0, 0, 0); acc1 = __builtin_amdgcn_mfma_f32_32x32x16_bf16(ah1[u], bh, acc1, 0, 0, 0);
                    acc0 = __builtin_amdgcn_mfma_f32_32x32x16_bf16(ah0[u], bl, acc0, 0, 0, 0); acc1 = __builtin_amdgcn_mfma_f32_32x32x16_bf16(ah1[u], bl, acc1, 0, 0, 0);
                    acc0 = __builtin_amdgcn_mfma_f32_32x32x16_bf16(al0[u], bh, acc0, 0, 0, 0); acc1 = __builtin_amdgcn_mfma_f32_32x32x16_bf16(al1[u], bh, acc1, 0, 0, 0); }
                SBAR();
            }
        }
        __syncthreads();
        if (n32 < 16) {
#pragma unroll
            for (int i = 0; i < 16; ++i) { const int e = (i & 3) + 8 * (i >> 2) + 4 * h5; part[(wave * 16 + n32) * 64 + e] = acc0[i]; part[(wave * 16 + n32) * 64 + 32 + e] = acc1[i]; }
        }
        __syncthreads();
#pragma unroll 1
        for (int k = 0; k < 2; ++k) {
            const int lt = 2 * wave + k, ti = 16 * it + lt;
            float logit = 0.f;
#pragma unroll
            for (int w = 0; w < 8; ++w) logit += part[(w * 16 + lt) * 64 + lane];
            const float sc = 1.f / (1.f + expf(-logit));
            const float bs = sc + rb;
            float m1 = bs;
            m1 = fmaxf(m1, dpp_mov<0xB1>(m1)); m1 = fmaxf(m1, dpp_mov<0x4E>(m1)); m1 = fmaxf(m1, dpp_mov<0x141>(m1));
            const unsigned long long eq = __ballot(bs == m1);
            const int gbase = lane & ~7;
            const int first = gbase + __builtin_ctz((unsigned)((eq >> gbase) & 0xffu));
            float m2 = (lane == first) ? -__builtin_inff() : bs;
            m2 = fmaxf(m2, dpp_mov<0xB1>(m2)); m2 = fmaxf(m2, dpp_mov<0x4E>(m2)); m2 = fmaxf(m2, dpp_mov<0x141>(m2));
            const float gs = m1 + m2; const int grp = lane >> 3;
            int grank = 0;
#pragma unroll
            for (int g2 = 0; g2 < 8; ++g2) { const float v = __int_as_float(__builtin_amdgcn_readlane(__float_as_int(gs), g2 * 8)); grank += (v > gs || (v == gs && g2 < grp)) ? 1 : 0; }
            const float masked = (grank < 4) ? bs : -__builtin_inff();
            int rank = 0;
#pragma unroll 8
            for (int e2 = 0; e2 < 64; ++e2) { const float v = __int_as_float(__builtin_amdgcn_readlane(__float_as_int(masked), e2)); rank += (v > masked || (v == masked && e2 < lane)) ? 1 : 0; }
            const bool selk = rank < 8;
            const float wsum = wave_sum(selk ? sc : 0.f);
            if (selk) {
                const int lp = __hip_atomic_fetch_add(lcount + lane, 1, __ATOMIC_RELAXED, __HIP_MEMORY_SCOPE_WORKGROUP);
                ent[(ti * 8 + rank) * 2] = ((unsigned)lane << 20) | (unsigned)lp;
                ((LAS float*)ent)[(ti * 8 + rank) * 2 + 1] = sc / wsum * ROUTED_SCALE;
            }
        }
        __syncthreads();
    }
    if (threadIdx.x < 64) { const int n = lcount[threadIdx.x]; lbase[threadIdx.x] = n > 0 ? (int)__hip_atomic_fetch_add(gcount + threadIdx.x * 16, (unsigned)n, __ATOMIC_RELAXED, __HIP_MEMORY_SCOPE_AGENT) : 0; }
    __syncthreads();
    for (int i = threadIdx.x; i < 64 * 8; i += NWAVES * 64) {
        const unsigned ep = ent[i * 2]; const float w = ((LAS float*)ent)[i * 2 + 1];
        const int e = ep >> 20, pos = lbase[e] + (int)(ep & 0xfffffu), t = t_beg + (i >> 3);
        list[(size_t)e * NTOK + pos] = (unsigned)t;
        toke[(size_t)t * 8 + (i & 7)] = ((unsigned)e << 20) | (unsigned)pos;
        tokw[(size_t)t * 8 + (i & 7)] = w;
    }
    __syncthreads();
}

__device__ __forceinline__ int moe_tables(KArgs a, int layer, LAS unsigned char* lds) {
    const unsigned* gcount = (const unsigned*)(a->ws + WS_CTL) + CW_CNT + layer * NE * 16;
    LAS int* P = (LAS int*)(lds + LT_P); LAS int* cnt = (LAS int*)(lds + LT_CNT); LAS int* tile_e = (LAS int*)(lds + LT_TILE);
    __syncthreads();
    if (threadIdx.x < NEX) cnt[threadIdx.x] = (threadIdx.x < NE) ? (int)__hip_atomic_load(gcount + threadIdx.x * 16, __ATOMIC_RELAXED, __HIP_MEMORY_SCOPE_AGENT) : NTOK;
    __syncthreads();
    if (threadIdx.x == 0) { int s = 0; for (int e = 0; e < NEX; ++e) { P[e] = s; s += (cnt[e] + 255) >> 8; } P[NEX] = s; }
    __syncthreads();
    if (threadIdx.x < NEX) { const int e = threadIdx.x; for (int t = P[e]; t < P[e + 1]; ++t) tile_e[t] = e; }
    __syncthreads();
    return P[NEX];
}

__device__ __forceinline__ void moe_combine(KArgs a, int layer, LAS unsigned char* lds, int gw, int NGW, int lane) {
    float* out = a->out; bf16_t* xb = (bf16_t*)(a->ws + WS_XB); const bf16_t* Y = (const bf16_t*)(a->ws + WS_Y);
    const unsigned* toke = (const unsigned*)(a->ws + WS_TOKE); const float* tokw = (const float*)(a->ws + WS_TOKW);
    const float* gam = a->in[I_LN2G] + layer * DM; const float* bet = a->in[I_LN2B] + layer * DM;
    const LAS int* P = (const LAS int*)(lds + LT_P);
    const int sh_base = P[NE] * 256;
    unsigned epn = 0u; float wn = 0.f;
    if (gw < NTOK && lane < 8) { epn = toke[(size_t)gw * 8 + lane]; wn = tokw[(size_t)gw * 8 + lane]; }
    for (int t = gw; t < NTOK; t += NGW) {
        const unsigned ep = epn; float w = wn;
        if (t + NGW < NTOK && lane < 8) { epn = toke[(size_t)(t + NGW) * 8 + lane]; wn = tokw[(size_t)(t + NGW) * 8 + lane]; }
        int slot = P[ep >> 20] * 256 + (int)(ep & 0xfffffu);
        if (lane == 8) { slot = sh_base + t; w = 1.f; }
        f32x4 acc[8]; u32x4 y[9][4]; float wk[9];
#pragma unroll
        for (int j = 0; j < 4; ++j) { acc[2 * j] = *(const f32x4*)(out + (size_t)t * DM + 512 * j + 8 * lane); acc[2 * j + 1] = *(const f32x4*)(out + (size_t)t * DM + 512 * j + 8 * lane + 4); }
        const bool y8 = MOE_Y8(layer);
#pragma unroll
        for (int q = 0; q < 9; ++q) { const int sl = __builtin_amdgcn_readlane(slot, q); wk[q] = __int_as_float(__builtin_amdgcn_readlane(__float_as_int(w), q)) * (y8 ? Y8_INV : 1.f);
#pragma unroll
            for (int j = 0; j < 4; ++j) {
                if (y8) { const u32x2 t2 = __builtin_nontemporal_load((const u32x2*)((const unsigned char*)Y + (size_t)sl * DM + 512 * j + 8 * lane)); y[q][j] = (u32x4){t2.x, t2.y, 0u, 0u}; }
                else y[q][j] = __builtin_nontemporal_load((const u32x4*)(Y + (size_t)sl * DM + 512 * j + 8 * lane)); } }
#pragma unroll
        for (int j = 0; j < 8; ++j) acc[j] = acc[j] * ALPHA;
#pragma unroll
        for (int q = 0; q < 9; ++q)
#pragma unroll
            for (int j = 0; j < 4; ++j) {
                if (y8) {
                    const f32x2 a0 = __builtin_amdgcn_cvt_pk_f32_fp8((int)y[q][j].x, false), a1 = __builtin_amdgcn_cvt_pk_f32_fp8((int)y[q][j].x, true);
                    const f32x2 b0 = __builtin_amdgcn_cvt_pk_f32_fp8((int)y[q][j].y, false), b1 = __builtin_amdgcn_cvt_pk_f32_fp8((int)y[q][j].y, true);
                    acc[2 * j][0] += wk[q] * a0[0]; acc[2 * j][1] += wk[q] * a0[1]; acc[2 * j][2] += wk[q] * a1[0]; acc[2 * j][3] += wk[q] * a1[1];
                    acc[2 * j + 1][0] += wk[q] * b0[0]; acc[2 * j + 1][1] += wk[q] * b0[1]; acc[2 * j + 1][2] += wk[q] * b1[0]; acc[2 * j + 1][3] += wk[q] * b1[1];
                } else {
                acc[2 * j][0] += wk[q] * bf_lo(y[q][j].x); acc[2 * j][1] += wk[q] * bf_hi(y[q][j].x); acc[2 * j][2] += wk[q] * bf_lo(y[q][j].y); acc[2 * j][3] += wk[q] * bf_hi(y[q][j].y);
                acc[2 * j + 1][0] += wk[q] * bf_lo(y[q][j].z); acc[2 * j + 1][1] += wk[q] * bf_hi(y[q][j].z); acc[2 * j + 1][2] += wk[q] * bf_lo(y[q][j].w); acc[2 * j + 1][3] += wk[q] * bf_hi(y[q][j].w);
                }
            }
        float s = 0.f;
#pragma unroll
        for (int j = 0; j < 8; ++j) s += (acc[j][0] + acc[j][1]) + (acc[j][2] + acc[j][3]);
        const float mean = wave_sum(s) * (1.f / DM); float s2 = 0.f;
#pragma unroll
        for (int j = 0; j < 8; ++j) { acc[j] = acc[j] - mean; s2 += (acc[j][0] * acc[j][0] + acc[j][1] * acc[j][1]) + (acc[j][2] * acc[j][2] + acc[j][3] * acc[j][3]); }
        const float rstd = __builtin_amdgcn_rsqf(wave_sum(s2) * (1.f / DM) + LN_EPS);
#pragma unroll
        for (int j = 0; j < 4; ++j) {
            const int c = 512 * j + 8 * lane;
            const f32x4 x0 = acc[2 * j] * rstd * *(const f32x4*)(gam + c) + *(const f32x4*)(bet + c);
            const f32x4 x1 = acc[2 * j + 1] * rstd * *(const f32x4*)(gam + c + 4) + *(const f32x4*)(bet + c + 4);
            *(f32x4*)(out + (size_t)t * DM + c) = x0; *(f32x4*)(out + (size_t)t * DM + c + 4) = x1;
            if (layer == 0) {
                if (FP8_QKV1) { u32x2 wv; wv.x = pk4_fp8(x0[0], x0[1], x0[2], x0[3]); wv.y = pk4_fp8(x1[0], x1[1], x1[2], x1[3]); *(u32x2*)((unsigned char*)xb + (size_t)t * DM + c) = wv; }
                else { u32x4 wv; wv.x = cvt_pk_bf16(x0[0], x0[1]); wv.y = cvt_pk_bf16(x0[2], x0[3]); wv.z = cvt_pk_bf16(x1[0], x1[1]); wv.w = cvt_pk_bf16(x1[2], x1[3]);
                    *(u32x4*)(xb + (size_t)t * DM + c) = wv; } }
        }
    }
}

__device__ __forceinline__ void attn_ref(KArgs a, int L, int pass, att::BlockRef& r) {
    const int xcd = L & 7, k = L >> 3, vh = xcd * 8 + (k >> 4), x = k & 15;
    const int qb = pass ? 31 - x : x;
    const bf16_t* Q = (const bf16_t*)(a->ws + WS_Q); const bf16_t* K = (const bf16_t*)(a->ws + WS_K); const bf16_t* V = (const bf16_t*)(a->ws + WS_V);
    r.P0 = qb * 256;
    const int half = vh & 1, bm = vh >> 1, b = bm >> 4, m = bm & 15;
    r.Q = Q + ((size_t)bm * SEQ + r.P0) * HD; r.K = K + (size_t)bm * SEQ * HD;
    r.V = V + (size_t)(b * NSLAB + (m >> 1) * 2 + half) * SEQ * HD;
    r.O = (bf16_t*)(a->ws + WS_O) + ((size_t)b * SEQ + r.P0) * 4096 + (m * 2 + half) * HD;
    r.sel = nullptr; r.list = nullptr; r.ML = nullptr; r.jlo = 0; r.nvalid = 256; r.nblk = 0; r.hb = 0;
}
__device__ __forceinline__ void attn_phase_da(KArgs a, char* lds, int G) {
    constexpr int total = 64 * 16;
    const int conv_slot = (int)(blockIdx.x & 3u);
    int L = blockIdx.x; if (L >= total) return;
    int pass = 0, item = 0; att::BlockRef cur, nxt; attn_ref(a, L, 0, cur);
    att::Seam S;
    att::attn_prime<false>(cur, lds, S);
    for (;;) {
        if (pass == 0) {
            if (conv_slot == item) {
                const int tid0 = otid(); const Geo cg = geo();
                convert_items(a, (LAS float*)((LAS unsigned char*)lds + att::ATT_LDS + __builtin_amdgcn_readfirstlane(tid0 >> 6) * 4224), cg.gw, cg.NGW, tid0 & 63, IT_IN, IT_TOTAL);
            }
            ++item;
        }
        const bool more_pass = pass == 0, more_item = L + G < total, last = !more_pass && !more_item;
        int passn = pass + 1, Ln = L;
        if (!more_pass) { passn = 0; Ln = more_item ? L + G : L; }
        if (last) nxt = cur; else attn_ref(a, Ln, passn, nxt);
        att::attn_block<false>(cur, nxt, 4096, lds, S);
        if (last) break;
        cur = nxt; pass = passn; L = Ln;
    }
}
__device__ __forceinline__ void moba_ref(KArgs a, LAS unsigned char* lds, int B, att::BlockRef& r) {
    const LAS int* PB = (const LAS int*)(lds + LT_PB); const LAS int* MC = (const LAS int*)(lds + LT_MC);
    int lo = 0, hi = 1024;
    while (hi - lo > 1) { const int mid = (lo + hi) >> 1; if (PB[mid] <= B) lo = mid; else hi = mid; }
    const int id = lo, bh = id >> 5, n = id & 31, c = B - PB[id];
    r.Q = (const bf16_t*)(a->ws + WS_Q) + (size_t)bh * SEQ * HD; r.K = (const bf16_t*)(a->ws + WS_K) + (size_t)bh * SEQ * HD; r.V = (const bf16_t*)(a->ws + WS_V) + (size_t)bh * SEQ * HD;
    r.O = (bf16_t*)(a->ws + WS_OP); r.ML = (float*)(a->ws + WS_ML); r.sel = (const unsigned*)(a->ws + WS_SEL) + (size_t)bh * SEQ;
    r.hb = bh * SEQ; r.jlo = 4 * n; r.nblk = n; r.P0 = n * 256;
    if (c == 0) { r.list = nullptr; r.nvalid = 256; }
    else { r.list = (const unsigned*)(a->ws + WS_QLIST) + (size_t)id * SEQ + (size_t)(c - 1) * 256; const int rem = MC[id] - (c - 1) * 256; r.nvalid = rem < 256 ? rem : 256; }
}
__device__ __forceinline__ void attn_phase_moba(KArgs a, LAS unsigned char* lds, char* lds_gen, int G) {
    LAS int* MC = (LAS int*)(lds + LT_MC); LAS int* PB = (LAS int*)(lds + LT_PB); LAS int* SC = (LAS int*)(lds + LT_SC);
    const unsigned* mcnt = (const unsigned*)(a->ws + WS_CTL) + CW_MCNT;
    const int t = threadIdx.x;
    __syncthreads();
    const int c0 = (int)__hip_atomic_load(mcnt + 2 * t, __ATOMIC_RELAXED, __HIP_MEMORY_SCOPE_AGENT), c1 = (int)__hip_atomic_load(mcnt + 2 * t + 1, __ATOMIC_RELAXED, __HIP_MEMORY_SCOPE_AGENT);
    MC[2 * t] = c0; MC[2 * t + 1] = c1;
    const int s0 = 1 + ((c0 + 255) >> 8), s1 = s0 + 1 + ((c1 + 255) >> 8);
    SC[t] = s1;
    __syncthreads();
    for (int off = 1; off < 512; off <<= 1) { const int v = SC[t] + (t >= off ? SC[t - off] : 0); __syncthreads(); SC[t] = v; __syncthreads(); }
    const int excl = t > 0 ? SC[t - 1] : 0;
    PB[2 * t] = excl; PB[2 * t + 1] = excl + s0; if (t == 511) PB[1024] = SC[511];
    __syncthreads();
    const int NB = PB[1024];
    int B = blockIdx.x; if (B >= NB) return;
    att::BlockRef cur, nxt; moba_ref(a, lds, B, cur);
    att::Seam S;
    att::attn_prime<true>(cur, lds_gen, S);
    for (;;) {
        const int Bn = B + G; const bool last = Bn >= NB;
        if (last) nxt = cur; else moba_ref(a, lds, Bn, nxt);
        att::attn_block<true>(cur, nxt, 0, lds_gen, S);
        if (last) break;
        cur = nxt; B = Bn;
    }
}
__device__ __forceinline__ void moba_kv_phase(KArgs a, LAS unsigned char* lds, char* lds_gen) {
    using namespace att;
    LAS int* PB = (LAS int*)(lds + LDSCTL_OFF + 1024); LAS int* MC = (LAS int*)(lds + LDSCTL_OFF + 5632); LAS int* SC = (LAS int*)lds;
    volatile LAS int* QW = (volatile LAS int*)(lds + LDSCTL_OFF + 14400);
    const unsigned* mcnt = (const unsigned*)(a->ws + WS_CTL) + CW_MCNT; unsigned* sq = (unsigned*)(a->ws + WS_CTL) + CW_SQ;
    int tid = threadIdx.x; asm volatile("" : "+v"(tid));
    const int wid = __builtin_amdgcn_readfirstlane(tid >> 6), lane = tid & 63, r32 = lane & 31, hi = lane >> 5;
    __syncthreads();
    {   const int c0 = (int)__hip_atomic_load(mcnt + 2 * tid, __ATOMIC_RELAXED, __HIP_MEMORY_SCOPE_AGENT), c1 = (int)__hip_atomic_load(mcnt + 2 * tid + 1, __ATOMIC_RELAXED, __HIP_MEMORY_SCOPE_AGENT);
        MC[2 * tid] = c0; MC[2 * tid + 1] = c1;
        const int s0 = (8 + ((c0 + 31) >> 5) + 31) >> 5, s1 = s0 + ((8 + ((c1 + 31) >> 5) + 31) >> 5);
        SC[tid] = s1;
        __syncthreads();
        for (int off = 1; off < 512; off <<= 1) { const int v = SC[tid] + (tid >= off ? SC[tid - off] : 0); __syncthreads(); SC[tid] = v; __syncthreads(); }
        const int excl = tid > 0 ? SC[tid - 1] : 0;
        PB[2 * tid] = excl; PB[2 * tid + 1] = excl + s0; if (tid == 511) PB[1024] = SC[511];
        __syncthreads(); }
    const int NP = PB[1024];
    char* V_lds = lds_gen; char* K_lds = lds_gen + 65536;
    float* ws = (float*)(lds_gen + LDSCTL_OFF + 10240) + wid * 128; float* li_l = ws, * al_l = ws + 32; unsigned* rd = (unsigned*)(ws + 64);
    const int vb0 = (int)(uintptr_t)V_lds + v_rd_base(lane);
    const int sr = tid >> 4, sc = (tid & 15) * 8;
    const bf16_t* Qb = (const bf16_t*)(a->ws + WS_Q); const bf16_t* Kb = (const bf16_t*)(a->ws + WS_K); const bf16_t* Vb = (const bf16_t*)(a->ws + WS_V);
    const unsigned* selb = (const unsigned*)(a->ws + WS_SEL); const unsigned* qlb = (const unsigned*)(a->ws + WS_QLIST);
    bf16_t* OPb = (bf16_t*)(a->ws + WS_OP); float* MLb = (float*)(a->ws + WS_ML);
    for (;;) {
        if (tid == 0) *QW = (int)__hip_atomic_fetch_add(sq, 1u, __ATOMIC_RELAXED, __HIP_MEMORY_SCOPE_AGENT);
        __syncthreads();
        const int I = *QW;
        if (I >= NP) break;
        int lo = 0, hb = 1024;
        while (hb - lo > 1) { const int mid = (lo + hb) >> 1; if (PB[mid] <= I) lo = mid; else hb = mid; }
        const int id = lo, bh = id >> 5, n = id & 31, part = I - PB[id], cnt = MC[id];
        {
            const bf16_t* Kh = Kb + ((size_t)bh * SEQ + (size_t)n * 256) * HD; const bf16_t* Vh = Vb + ((size_t)bh * SEQ + (size_t)n * 256) * HD;
            bf16x8 kv[8], vv[8];
#pragma unroll
            for (int i = 0; i < 8; ++i) { kv[i] = load8(Kh + (size_t)(sr + 32 * i) * HD + sc); vv[i] = load8(Vh + (size_t)(sr + 32 * i) * HD + sc); }
#pragma unroll
            for (int i = 0; i < 8; ++i) { const int tl = i >> 1, row = sr + 32 * (i & 1);
                *(bf16x8*)(K_lds + tl * SHM_K + KSWZ(row, sc * 2)) = kv[i]; *(bf16x8*)(V_lds + tl * SHM_V + v_st(row, sc)) = vv[i]; }
        }
        __syncthreads();
        const int nch = 8 + ((cnt + 31) >> 5), c_beg = 32 * part, c_end = (c_beg + 32 < nch) ? c_beg + 32 : nch;
#pragma unroll 1
        for (int cg = c_beg + wid; cg < c_end; cg += 8) {
            const bool own = cg < 8;
            const int li0 = (cg - 8) * 32 + r32;
            unsigned q; if (own) q = (unsigned)(n * 256 + cg * 32 + r32); else q = qlb[(size_t)id * SEQ + (li0 < cnt ? li0 : cnt - 1)];
            const bool valid = own || (li0 < cnt);
            unsigned slot = 3u; if (!own) slot = (unsigned)__builtin_popcount(selb[(size_t)bh * SEQ + q] & ((1u << n) - 1u));
            bf16x8 qr[8];
#pragma unroll
            for (int d0 = 0; d0 < 8; ++d0) qr[d0] = load8(Qb + ((size_t)bh * SEQ + q) * HD + d0 * 16 + hi * 8);
            if (hi == 0) rd[r32] = valid ? (((unsigned)(bh * SEQ) + q) * 4u + slot) * 128u : (1u << 27);
            const int NTu = own ? ((cg * 32 + 31) >> 6) + 1 : 4;
            const int qlo = n * 256 + cg * 32, qm = qlo + r32 - 4 * hi;
            float m_reg = -1e30f, l_reg = 0.f; f32x16 o[4] = {};
#define KV_STEP(T) do { if ((T) < NTu) { f32x16 p0, p1; float mn, al; bf16x8 pa0, pa1, pa2, pa3;                                        \
                qkt<T>(p0, p1, K_lds, r32, hi, qr);                                                                                       \
                if (own) { const int kb_ = n * 256 + (T) * KVBLK; if (kb_ + KVBLK - 1 > qlo) mask_tile(p0, p1, qm - kb_, 0x40000000u); }   \
                partialSM(p0, p1, m_reg, mn, al);                                                                                        \
                if (__any(al < 1.f)) { if (hi == 0) al_l[r32] = al; asm volatile("s_waitcnt lgkmcnt(0)" ::: "memory");                     \
                    for (int d_ = 0; d_ < 4; ++d_) for (int r = 0; r < 16; ++r) o[d_][r] *= al_l[crow(r, hi)]; }                           \
                finishSM(p0, p1, al, l_reg, pa0, pa1, pa2, pa3); SBAR();                                                                  \
                pv_tile<T>(o, vb0, pa0, pa1, pa2, pa3); } } while (0)
            KV_STEP(0); KV_STEP(1); KV_STEP(2); KV_STEP(3);
#undef KV_STEP
            if (hi == 0) li_l[r32] = l_reg; asm volatile("s_waitcnt lgkmcnt(0)" ::: "memory");
            float rli[16];
#pragma unroll
            for (int r = 0; r < 16; ++r) rli[r] = __builtin_amdgcn_rcpf(li_l[crow(r, hi)]);
#pragma unroll
            for (int r = 0; r < 16; ++r) { const unsigned off = rd[crow(r, hi)];
#pragma unroll
                for (int d0 = 0; d0 < 4; ++d0) { const float v = o[d0][r] * rli[r];
                    const float vn = __int_as_float(__builtin_amdgcn_mov_dpp(__float_as_int(v), 0xB1, 0xF, 0xF, true));
                    if ((r32 & 1) == 0) *(unsigned*)(OPb + (size_t)off + d0 * 32 + r32) = cvt_pk_bf16(v, vn); } }
            if (hi == 0) { float* mlp = MLb + (size_t)(rd[r32] >> 7) * 2; f32x2 ml = {m_reg, l_reg}; *(f32x2*)mlp = ml; }
        }
    }
}
__device__ __forceinline__ void moba_merge(KArgs a, int gw, int NGW, int lane) {
    const bf16_t* OP = (const bf16_t*)(a->ws + WS_OP); const float* ML = (const float*)(a->ws + WS_ML); const unsigned* sel = (const unsigned*)(a->ws + WS_SEL);
    bf16_t* AO = (bf16_t*)(a->ws + WS_AOUT);
    constexpr float C2 = 1.4426950408889634f * att::SCALE;
    const int h = lane >> 2, part = lane & 3;
    for (int t = gw; t < NTOK; t += NGW) {
        const int b = t >> 13, s = t & (SEQ - 1), bh = b * NSLAB + h;
        const size_t base = ((size_t)bh * SEQ + s) * 4;
        const int nsel = __builtin_popcount(sel[(size_t)bh * SEQ + s]);
        f32x2 ml[4]; u32x4 ov[4][4];
#pragma unroll
        for (int k = 0; k < 4; ++k) { ml[k] = *(const f32x2*)(ML + (base + k) * 2);
#pragma unroll
            for (int j = 0; j < 4; ++j) ov[k][j] = *(const u32x4*)(OP + (base + k) * 128 + part * 32 + j * 8); }
        float M = ml[3][0];
#pragma unroll
        for (int k = 0; k < 3; ++k) M = (k < nsel) ? fmaxf(M, ml[k][0]) : M;
        float w[4], W = 0.f;
#pragma unroll
        for (int k = 0; k < 4; ++k) { const bool valid = (k == 3) || (k < nsel); w[k] = valid ? ml[k][1] * __builtin_amdgcn_exp2f((ml[k][0] - M) * C2) : 0.f; W += w[k]; }
        const float rW = 1.f / W;
        float acc[32];
#pragma unroll
        for (int i = 0; i < 32; ++i) acc[i] = 0.f;
#pragma unroll
        for (int k = 0; k < 4; ++k) { const bool valid = (k == 3) || (k < nsel); const float wk = w[k] * rW;
#pragma unroll
            for (int j = 0; j < 4; ++j) { const u32x4 u = ov[k][j];
                acc[8 * j + 0] += valid ? wk * bf_lo(u.x) : 0.f; acc[8 * j + 1] += valid ? wk * bf_hi(u.x) : 0.f; acc[8 * j + 2] += valid ? wk * bf_lo(u.y) : 0.f; acc[8 * j + 3] += valid ? wk * bf_hi(u.y) : 0.f;
                acc[8 * j + 4] += valid ? wk * bf_lo(u.z) : 0.f; acc[8 * j + 5] += valid ? wk * bf_hi(u.z) : 0.f; acc[8 * j + 6] += valid ? wk * bf_lo(u.w) : 0.f; acc[8 * j + 7] += valid ? wk * bf_hi(u.w) : 0.f; } }
#pragma unroll
        for (int j = 0; j < 4; ++j) {
            if (FP8_OUT1) { u32x2 o; o.x = pk4_fp8(acc[8 * j] * AO8_SCALE, acc[8 * j + 1] * AO8_SCALE, acc[8 * j + 2] * AO8_SCALE, acc[8 * j + 3] * AO8_SCALE); o.y = pk4_fp8(acc[8 * j + 4] * AO8_SCALE, acc[8 * j + 5] * AO8_SCALE, acc[8 * j + 6] * AO8_SCALE, acc[8 * j + 7] * AO8_SCALE);
                *(u32x2*)((unsigned char*)AO + (size_t)t * DM + h * HD + part * 32 + j * 8) = o; }
            else { u32x4 o; o.x = cvt_pk_bf16(acc[8 * j], acc[8 * j + 1]); o.y = cvt_pk_bf16(acc[8 * j + 2], acc[8 * j + 3]); o.z = cvt_pk_bf16(acc[8 * j + 4], acc[8 * j + 5]); o.w = cvt_pk_bf16(acc[8 * j + 6], acc[8 * j + 7]);
                *(u32x4*)(AO + (size_t)t * DM + h * HD + part * 32 + j * 8) = o; } }
    }
}

#ifndef PHMASK
#define PHMASK 0x7ffff
#endif
#define IN(k) (((PHMASK >> (k)) & 1) && lo <= (k) && (k) < hi)
#define SEAM(k) do { if (IN(k) && IN((k) + 1)) xcd_barrier(bar); } while (0)
template <int LAYER>
__device__ __forceinline__ void layer_program(LAS unsigned char* lds, unsigned char* lds_gen, const XcdBarrier& bar, const int lo, const int hi) {
    constexpr int pb = LAYER == 0 ? 1 : 9;
    constexpr int po = LAYER == 0 ? 4 : 14;
    if (IN(pb)) {
        KArgs ka = kargs(); unsigned char* ws = ka->ws;
        constexpr bool F8 = LAYER == 0 ? (bool)FP8_QKV0 : (bool)FP8_QKV1; constexpr int Kb = F8 ? DM : DM * 2;
        pg8::SchedDense S; S.init(ws + WS_XB, ws + WS_WATT + (LAYER == 0 ? 0 : 32 * MiB), NTOK, NQKV, Kb, gridDim.x, blockIdx.x);
        constexpr bool KM = LAYER == 1;
        pg8::EpiQKV<KM> E{(bf16_t*)(ws + WS_Q), (const float*)(ws + WS_ROPE), F8 ? W8_INV : 1.f};
        pg8::gemm_phase<pg8::EpiQKV<KM>, pg8::SchedDense, F8>(lds, Kb, S, E);
    }
    SEAM(pb);
    if (LAYER == 0) {
        if (IN(2)) { KArgs ka = kargs();
            if (__builtin_amdgcn_readfirstlane(threadIdx.x) >= 256) __builtin_amdgcn_s_setprio(1);
            attn_phase_da(ka, (char*)lds_gen, gridDim.x);
            __builtin_amdgcn_s_setprio(0); }
        SEAM(2);
        if (IN(3)) { KArgs ka = kargs(); const Geo g = geo(); da_combine(ka, g.gw, g.NGW, otid() & 63); }
        SEAM(3);
    } else {
        if (IN(11)) { KArgs ka = kargs(); const Geo g = geo(); moba_gate(ka, g.gw, g.NGW, otid() & 63); }
        SEAM(11);
        if (IN(12)) { KArgs ka = kargs();
            if (__builtin_amdgcn_readfirstlane(threadIdx.x) >= 256) __builtin_amdgcn_s_setprio(1);
            moba_kv_phase(ka, lds, (char*)lds_gen);
            __builtin_amdgcn_s_setprio(0); }
        SEAM(12);
        if (IN(13)) { KArgs ka = kargs(); const Geo g = geo(); moba_merge(ka, g.gw, g.NGW, otid() & 63); }
        SEAM(13);
    }
    if (IN(po)) {
        KArgs ka = kargs(); unsigned char* ws = ka->ws;
        constexpr bool F8 = LAYER == 0 ? (bool)FP8_OUT0 : (bool)FP8_OUT1; constexpr int Kb = F8 ? DM : DM * 2;
        pg8::SchedDense S; S.init(ws + WS_AOUT, ws + WS_WATT + (LAYER == 0 ? 24 * MiB : 56 * MiB), NTOK, DM, Kb, gridDim.x, blockIdx.x);
        pg8::EpiRes E{LAYER == 0 ? ka->in[I_X] : ka->out, ka->out, F8 ? W8_INV * AO8_INV : 1.f};
        pg8::gemm_phase<pg8::EpiRes, pg8::SchedDense, F8>(lds, Kb, S, E);
    }
    SEAM(po);
    if (IN(po + 1)) { KArgs ka = kargs(); const Geo g = geo(); const int tid = otid(); ln_router(ka, LAYER, lds, g.vcu, g.G, __builtin_amdgcn_readfirstlane(tid >> 6), tid & 63); }
    SEAM(po + 1);
    if (IN(po + 2)) {
        KArgs ka = kargs(); unsigned char* ws = ka->ws;
        const int ntt = moe_tables(ka, LAYER, lds);
        constexpr bool F8 = MOE_F8(LAYER); constexpr int Kb = F8 ? DM : DM * 2;
        pg8::SchedMoe1 S{(const char*)(ws + WS_XB), (const char*)(ws + WS_WGU) + (size_t)LAYER * NEX * 1024 * DM * 2, (const unsigned*)(ws + WS_LIST),
                         (const LAS int*)(lds + LT_P), (const LAS int*)(lds + LT_CNT), (const LAS int*)(lds + LT_TILE), ntt * 4, (int)gridDim.x, (int)blockIdx.x, Kb};
        pg8::EpiSwiGLU<F8> E{(bf16_t*)(ws + WS_H), F8 ? W8_INV : 1.f};
        pg8::gemm_phase<pg8::EpiSwiGLU<F8>, pg8::SchedMoe1, F8>(lds, Kb, S, E);
    }
    SEAM(po + 2);
    if (IN(po + 3)) {
        KArgs ka = kargs(); unsigned char* ws = ka->ws;
        const int ntt = moe_tables(ka, LAYER, lds);
        constexpr bool F8 = MOE_F8(LAYER); constexpr int Kb = F8 ? DE : DE * 2;
        pg8::SchedMoe2 S{(const char*)(ws + WS_H), (const char*)(ws + WS_WD) + (size_t)LAYER * NEX * DM * DE * 2, (const LAS int*)(lds + LT_TILE), ntt * 8, (int)gridDim.x, (int)blockIdx.x, Kb};
        constexpr bool Y8 = MOE_Y8(LAYER);
        pg8::EpiY<Y8> E{(bf16_t*)(ws + WS_Y), (F8 ? W8_INV : 1.f) * (Y8 ? Y8_SCALE : 1.f)};
        pg8::gemm_phase<pg8::EpiY<Y8>, pg8::SchedMoe2, F8>(lds, Kb, S, E);
    }
    SEAM(po + 3);
    if (IN(po + 4)) { KArgs ka = kargs(); const Geo g = geo(); (void)moe_tables(ka, LAYER, lds); moe_combine(ka, LAYER, lds, g.gw, g.NGW, otid() & 63); }
    if (LAYER == 0) SEAM(8);
}
__global__ void __launch_bounds__(NWAVES * 64, 2) fwd_kernel(Args args) {
    extern __shared__ __attribute__((aligned(16))) unsigned char lds_raw[];
    LAS unsigned char* lds = (LAS unsigned char*)lds_raw;
    volatile LAS unsigned* MISC = (volatile LAS unsigned*)(lds + MISC_OFF);
    for (int u = threadIdx.x; u < (LDS_BYTES - LDSCTL_OFF) / 4; u += NWAVES * 64) ((LAS unsigned*)(lds + LDSCTL_OFF))[u] = 0u;
    __syncthreads();
    XcdBarrier bar = xcd_barrier_post((unsigned*)(args.ws + WS_CTL) + CW_BAR, MISC + 8);
    const int lo = args.ph_lo, hi = args.ph_hi;
    if (IN(0)) { KArgs ka = kargs(); const Geo g = geo(); const int tid = otid(); p0_prologue(ka, lds, g.gw, g.NGW, __builtin_amdgcn_readfirstlane(tid >> 6), tid & 63); }
    SEAM(0);
    layer_program<0>(lds, lds_raw, bar, lo, hi);
    layer_program<1>(lds, lds_raw, bar, lo, hi);
}
#undef IN
#undef SEAM

extern "C" void kernel_launch(void* const* d_in, const int* in_sizes, int n_in, void* d_out, int out_size, void* d_ws, size_t ws_size, hipStream_t stream) {
    static int grid = 0;
    if (grid == 0) {
        if (n_in != 23 || out_size != NTOK * DM || ws_size < WS_END) { fprintf(stderr, "kernel_launch: unexpected shapes (n_in %d, out %d, ws %zu; need ws >= %zu)\n", n_in, out_size, ws_size, (size_t)WS_END); grid = -1; return; }
        int dev = 0, cus = 0, per_cu = 0;
        if (hipGetDevice(&dev) != hipSuccess || hipDeviceGetAttribute(&cus, hipDeviceAttributeMultiprocessorCount, dev) != hipSuccess) { grid = -1; return; }
        if (hipFuncSetAttribute((const void*)fwd_kernel, hipFuncAttributeMaxDynamicSharedMemorySize, LDS_BYTES) != hipSuccess) { fprintf(stderr, "kernel_launch: hipFuncSetAttribute failed\n"); grid = -1; return; }
        if (hipOccupancyMaxActiveBlocksPerMultiprocessor(&per_cu, (const void*)fwd_kernel, NWAVES * 64, LDS_BYTES) != hipSuccess || per_cu < 1) fprintf(stderr, "kernel_launch: occupancy query reports %d\n", per_cu);
        (void)hipGetLastError();
        grid = 256;
    }
    if (grid < 0) return;
    if (hipMemsetAsync((char*)d_ws + WS_CTL, 0, CTL_ZERO_BYTES, stream) != hipSuccess) return;
    Args a{};
    for (int i = 0; i < 23; ++i) a.in[i] = (const float*)d_in[i];
    a.out = (float*)d_out; a.ws = (unsigned char*)d_ws;
#ifndef MK_SPLIT
    a.ph_lo = 0; a.ph_hi = 19;
    hipLaunchKernelGGL(fwd_kernel, dim3(grid), dim3(NWAVES * 64), LDS_BYTES, stream, a);
#else
    for (int p = 0; p < 19; ++p) { a.ph_lo = p; a.ph_hi = p + 1; hipLaunchKernelGGL(fwd_kernel, dim3(grid), dim3(NWAVES * 64), LDS_BYTES, stream, a); }
#endif
}
```

```cpp
#include <hip/hip_runtime.h>
#include <cstdio>
#include <cstdint>

#define GAS __attribute__((address_space(1)))
#define LAS __attribute__((address_space(3)))
typedef unsigned short bf16_t;
typedef short bf16x8 __attribute__((ext_vector_type(8)));
typedef short s16x4 __attribute__((ext_vector_type(4)));
typedef float f32x2 __attribute__((ext_vector_type(2)));
typedef float f32x4 __attribute__((ext_vector_type(4)));
typedef float f32x16 __attribute__((ext_vector_type(16)));
typedef unsigned u32x2 __attribute__((ext_vector_type(2)));
typedef unsigned u32x4 __attribute__((ext_vector_type(4)));

constexpr int BATCH = 2, SEQ = 8192, DM = 2048, NTOK = BATCH * SEQ;
constexpr int NE = 64, NEX = 65  , DE = 512, NQKV = 6144, HD = 128, NSLAB = 16;
constexpr float LN_EPS = 1e-5f;
constexpr float ALPHA = 1.4142135623730951f;
constexpr float LAMBDA_INIT = 0.2f;
constexpr float ROUTED_SCALE = 2.5f;
constexpr int NWAVES = 8;
constexpr int MAXTILES = 640;

constexpr size_t MiB = 1u << 20;
constexpr size_t WS_CTL = 0, CTL_ZERO_BYTES = 1 * MiB;
constexpr size_t WS_TOKE = 2 * MiB;
constexpr size_t WS_TOKW = 3 * MiB;
constexpr size_t WS_LIST = 4 * MiB;
constexpr size_t WS_SEL = 8 * MiB;
constexpr size_t WS_KMEAN = 9 * MiB;
constexpr size_t WS_ROPE = 10 * MiB;
constexpr size_t WS_WRF = 12 * MiB;
constexpr size_t WS_WATT = 16 * MiB;
constexpr size_t WS_WGU = 80 * MiB;
constexpr size_t WS_WD = 600 * MiB;
constexpr size_t WS_XB = 860 * MiB;
constexpr size_t WS_C = 924 * MiB;
constexpr size_t WS_Q = WS_C, WS_K = WS_C + 64 * MiB, WS_V = WS_C + 128 * MiB;
constexpr size_t WS_O = WS_C + 192 * MiB;
constexpr size_t WS_AOUT = WS_C + 320 * MiB;
constexpr size_t WS_H = WS_C;
constexpr size_t WS_Y = WS_C + 160 * MiB;
constexpr size_t WS_QLIST = WS_C + 192 * MiB;
constexpr size_t WS_OP = WS_C + 384 * MiB;
constexpr size_t WS_ML = WS_C + 641 * MiB;
constexpr size_t WS_RES = WS_C + 800 * MiB;
constexpr size_t WS_END = WS_C + 864 * MiB;
constexpr int CW_BAR = 4096;
constexpr int CW_CNT = 8192;
constexpr int CW_MCNT = 12288;
constexpr int CW_SQ = 13440;

constexpr int RING_BYTES = 131072;
constexpr int LDSCTL_OFF = RING_BYTES, MISC_OFF = LDSCTL_OFF + 320;
constexpr int LT_P = LDSCTL_OFF + 1024;
constexpr int LT_CNT = LDSCTL_OFF + 1536;
constexpr int LT_TILE = LDSCTL_OFF + 2048;
constexpr int LT_LCNT = LDSCTL_OFF + 5120;
constexpr int LT_LBASE = LDSCTL_OFF + 5632;
constexpr int LT_ENT = LDSCTL_OFF + 6144;
constexpr int LT_MC = 114688;
constexpr int LT_PB = 118784;
constexpr int LT_SC = 123904;
constexpr int LDS_OSCR = 147456;
constexpr int LDS_BYTES = 163840;

#ifndef FP8_QKV0
#define FP8_QKV0 0
#endif
#ifndef FP8_QKV1
#define FP8_QKV1 1
#endif
#ifndef FP8_OUT0
#define FP8_OUT0 0
#endif
#ifndef FP8_OUT1
#define FP8_OUT1 1
#endif
#ifndef FP8_Y1
#define FP8_Y1 1
#endif
#ifndef FP8_MOE1
#define FP8_MOE1 1
#endif
#ifndef FP8_MOE0
#define FP8_MOE0 1
#endif
#ifndef FP8_Y0
#define FP8_Y0 1
#endif
#define MOE_F8(l) ((l) == 0 ? (bool)FP8_MOE0 : (bool)FP8_MOE1)
#define MOE_Y8(l) ((l) == 0 ? (bool)(FP8_MOE0 && FP8_Y0) : (bool)(FP8_MOE1 && FP8_Y1))
constexpr float W8_SCALE = 64.f, W8_INV = 1.f / 64.f;
constexpr float AO8_SCALE = 16.f, AO8_INV = 1.f / 16.f;
constexpr float Y8_SCALE = 16.f, Y8_INV = 1.f / 16.f;
#define LDS_WAIT() asm volatile("s_waitcnt lgkmcnt(0)" ::: "memory")
#define VM_WAIT() asm volatile("s_waitcnt vmcnt(0)" ::: "memory")
#define SBAR() __builtin_amdgcn_sched_barrier(0)

__device__ __forceinline__ unsigned cvt_pk_bf16(float lo, float hi) { unsigned r; asm volatile("v_cvt_pk_bf16_f32 %0, %1, %2" : "=v"(r) : "v"(lo), "v"(hi)); return r; }
__device__ __forceinline__ unsigned pk4_fp8(float a, float b, float c, float d) { int p = __builtin_amdgcn_cvt_pk_fp8_f32(a, b, 0, false); p = __builtin_amdgcn_cvt_pk_fp8_f32(c, d, p, true); return (unsigned)p; }
__device__ __forceinline__ float bf_lo(unsigned u) { return __uint_as_float(u << 16); }
__device__ __forceinline__ float bf_hi(unsigned u) { return __uint_as_float(u & 0xffff0000u); }
template <int CTRL> __device__ __forceinline__ float dpp_mov(float v) { return __int_as_float(__builtin_amdgcn_update_dpp(0, __float_as_int(v), CTRL, 0xF, 0xF, true)); }
__device__ __forceinline__ float wave_sum(float v) {
    v += dpp_mov<0xB1>(v);
    v += dpp_mov<0x4E>(v);
    v += dpp_mov<0x141>(v);
    v += dpp_mov<0x140>(v);
    const float r0 = __int_as_float(__builtin_amdgcn_readlane(__float_as_int(v), 0)), r1 = __int_as_float(__builtin_amdgcn_readlane(__float_as_int(v), 16));
    const float r2 = __int_as_float(__builtin_amdgcn_readlane(__float_as_int(v), 32)), r3 = __int_as_float(__builtin_amdgcn_readlane(__float_as_int(v), 48));
    return (r0 + r1) + (r2 + r3);
}

#define XB_TMO      128
#define XB_XCNT(j)  (256  + 64 * (j))
#define XB_XSUB(j)  (1280 + 64 * (j))
#define XB_XGEN(j)  (2304 + 64 * (j))
#define XB_TOP      3328
#define XB_TOPGEN   3392
#define XCD_BAR_WORDS 3456
#define XB_SPIN_CAP (1u << 18)
__device__ __forceinline__ unsigned xb_ld(unsigned* p)              { return __hip_atomic_load(p, __ATOMIC_RELAXED, __HIP_MEMORY_SCOPE_AGENT); }
__device__ __forceinline__ unsigned xb_add(unsigned* p, unsigned v) { return __hip_atomic_fetch_add(p, v, __ATOMIC_RELAXED, __HIP_MEMORY_SCOPE_AGENT); }
__device__ __forceinline__ unsigned xb_xcc_id() { return (unsigned)__builtin_amdgcn_s_getreg((3 << 11) | 20) & 0xFu; }
#define XB_SPIN(cond, bar) do { unsigned _sp = 0; while (cond) { __builtin_amdgcn_s_sleep(1); \
    if ((++_sp & 255u) == 0u) { if (xb_ld(&(bar)[XB_TMO])) break; if (_sp > XB_SPIN_CAP) { atomicAdd(&(bar)[XB_TMO], 1u); break; } } } } while (0)
struct XcdBarrier { unsigned* bar; unsigned x; volatile LAS unsigned* st; };
__device__ __forceinline__ XcdBarrier xcd_barrier_post(unsigned* bar, volatile LAS unsigned* st) {
    XcdBarrier b; b.bar = bar; b.x = xb_xcc_id(); b.st = st;
    if (threadIdx.x == 0) (void)xb_add(&bar[XB_XCNT(b.x)], 1u);
    return b;
}
__device__ __forceinline__ void xcd_barrier_complete(unsigned* bar, unsigned x, unsigned& nloc, unsigned& nx) {
    const unsigned G = gridDim.x * gridDim.y * gridDim.z;
    unsigned sum, cnt, mine, sp = 0u;
    for (;;) {
        sum = 0u; cnt = 0u; mine = 0u;
#pragma unroll
        for (unsigned j = 0; j < 16; ++j) { const unsigned c = xb_ld(&bar[XB_XCNT(j)]); sum += c; cnt += (c > 0u) ? 1u : 0u; mine = (j == x) ? c : mine; }
        if (sum == G) break;
        __builtin_amdgcn_s_sleep(1);
        if ((++sp & 255u) == 0u) { if (xb_ld(&bar[XB_TMO])) break; if (sp > XB_SPIN_CAP) { atomicAdd(&bar[XB_TMO], 1u); break; } }
    }
    nloc = mine > 0u ? mine : 1u; nx = cnt > 0u ? cnt : 1u;
}
__device__ __forceinline__ void xcd_barrier(const XcdBarrier& b) {
    asm volatile("s_waitcnt vmcnt(0)" ::: "memory");
    __syncthreads();
    if (threadIdx.x == 0) {
        unsigned* bar = b.bar;
        __builtin_amdgcn_s_waitcnt(0);
        unsigned nloc = b.st[0], nx = b.st[1];
        if (nloc == 0u) { xcd_barrier_complete(bar, b.x, nloc, nx); b.st[0] = nloc; b.st[1] = nx; }
        const unsigned old = xb_add(&bar[XB_XSUB(b.x)], 1u);
        const unsigned gen = old / nloc;
        if (old + 1u == (gen + 1u) * nloc) {
            __builtin_amdgcn_fence(__ATOMIC_RELEASE, "agent");
            asm volatile("s_waitcnt vmcnt(0)" ::: "memory");
            const unsigned og = xb_add(&bar[XB_TOP], 1u);
            const unsigned tg = og / nx;
            if (og + 1u == (tg + 1u) * nx) xb_add(&bar[XB_TOPGEN], 1u);
            else XB_SPIN(xb_ld(&bar[XB_TOPGEN]) == tg, bar);
            __builtin_amdgcn_fence(__ATOMIC_ACQUIRE, "agent");
            xb_add(&bar[XB_XGEN(b.x)], 1u);
            asm volatile("s_waitcnt vmcnt(0)" ::: "memory");
        } else {
            XB_SPIN(xb_ld(&bar[XB_XGEN(b.x)]) == gen, bar);
            __builtin_amdgcn_fence(__ATOMIC_ACQUIRE, "agent");
            asm volatile("s_waitcnt vmcnt(0)" ::: "memory");
        }
    }
    __syncthreads();
}

namespace pg8 {
constexpr int BM = 256, BK = 64, HALF = 128, HTB = HALF * BK * 2, NXCD = 8, WGM = 8;
__device__ __forceinline__ int lds_byte(int r, int c) { const int st = (r >> 4) * 2 + (c >> 5), rr = r & 15, cc = c & 31, ob = rr * 64 + cc * 2; return st * 1024 + (ob ^ (((ob >> 9) & 1) << 5)); }
__device__ __forceinline__ void stage_rc(int b, int& R, int& C) { const int st = b / 1024, sb = b % 1024, swz = sb ^ (((sb >> 9) & 1) << 5); R = (st >> 1) * 16 + swz / 64; C = (st & 1) * 32 + (swz % 64) / 2; }
__device__ __forceinline__ int perm32(int rho) { const int n = rho >> 4, i = rho & 15; return 8 * (i >> 2) + 4 * n + (i & 3); }
struct Unit { int pm, pn, e, aux; };
__device__ __forceinline__ int xcd_remap(int L, int nwg) { const int q = nwg / NXCD, r = nwg % NXCD, xcd = L % NXCD, off = L / NXCD; return (xcd < r ? xcd * (q + 1) : r * (q + 1) + (xcd - r) * q) + off; }

struct SchedDense {
    const char* A; const char* Bt; int Kb, nM, nN, nwg, G, c;
    __device__ __forceinline__ void init(const void* A_, const void* Bt_, int M, int N, int Kb_, int G_, int c_) { A = (const char*)A_; Bt = (const char*)Bt_; Kb = Kb_; nM = M / BM; nN = N / BM; nwg = nM * nN; G = G_; c = c_; }
    __device__ __forceinline__ bool next(int i, Unit& u) const {
        const long L = (long)i * G + c; if (L >= nwg) return false;
        const int wgid = xcd_remap((int)L, nwg);
        const int nig = WGM * nN, gid = wgid / nig, fm = gid * WGM, gsz = (nM - fm) < WGM ? (nM - fm) : WGM;
        u.pm = fm + ((wgid % nig) % gsz); u.pn = (wgid % nig) / gsz; u.e = 0; u.aux = 0; return true;
    }
    __device__ __forceinline__ const char* a_base(const Unit&) const { return A; }
    __device__ __forceinline__ const char* b_base(const Unit& u) const { return Bt + (size_t)u.pn * BM * Kb; }
    __device__ __forceinline__ void a_off(const Unit& u, unsigned (&off)[2][2]) const {
        int tz = threadIdx.x; asm volatile("" : "+v"(tz));
#pragma unroll
        for (int i = 0; i < 2; ++i) { int R, C; stage_rc(tz * 16 + i * 8192, R, C);
#pragma unroll
            for (int h = 0; h < 2; ++h) off[h][i] = (unsigned)((u.pm * BM + h * HALF + R) * Kb + C * 2); }
    }
};
struct SchedMoe1 {
    const char* X; const char* W; const unsigned* list; const LAS int* P; const LAS int* cnt; const LAS int* tile_e; int U, G, c, Kb;
    __device__ __forceinline__ bool next(int i, Unit& u) const {
        const long L = (long)i * G + c; if (L >= U) return false;
        const int wgid = xcd_remap((int)L, U);
        u.pm = wgid >> 2; u.pn = wgid & 3; u.e = tile_e[u.pm]; u.aux = u.pm - P[u.e]; return true;
    }
    __device__ __forceinline__ const char* a_base(const Unit&) const { return X; }
    __device__ __forceinline__ const char* b_base(const Unit& u) const { return W + ((size_t)u.e * 1024 + (size_t)u.pn * 256) * Kb; }
    __device__ __forceinline__ void a_off(const Unit& u, unsigned (&off)[2][2]) const {
        const int n = cnt[u.e];
        int tz = threadIdx.x; asm volatile("" : "+v"(tz));
        const bool sh = u.e == NE;
        const unsigned* lp = list + (size_t)(sh ? 0 : u.e) * NTOK;
        unsigned tok[2][2];
#pragma unroll
        for (int i = 0; i < 2; ++i) { int R, C; stage_rc(tz * 16 + i * 8192, R, C);
#pragma unroll
            for (int h = 0; h < 2; ++h) { const int r = u.aux * BM + h * HALF + R; tok[h][i] = lp[(sh || r < n) ? r : n - 1]; } }
#pragma unroll
        for (int i = 0; i < 2; ++i) { int R, C; stage_rc(tz * 16 + i * 8192, R, C);
#pragma unroll
            for (int h = 0; h < 2; ++h) { const int r = u.aux * BM + h * HALF + R;
                const unsigned t = sh ? (unsigned)r : ((r < n) ? tok[h][i] : 0u);
                off[h][i] = t * (unsigned)Kb + (unsigned)C * 2u; } }
    }
};
struct SchedMoe2 {
    const char* Hb; const char* W; const LAS int* tile_e; int U, G, c, Kb;
    __device__ __forceinline__ bool next(int i, Unit& u) const {
        const long L = (long)i * G + c; if (L >= U) return false;
        const int wgid = xcd_remap((int)L, U);
        u.pm = wgid >> 3; u.pn = wgid & 7; u.e = tile_e[u.pm]; u.aux = 0; return true;
    }
    __device__ __forceinline__ const char* a_base(const Unit&) const { return Hb; }
    __device__ __forceinline__ const char* b_base(const Unit& u) const { return W + ((size_t)u.e * DM + (size_t)u.pn * 256) * Kb; }
    __device__ __forceinline__ void a_off(const Unit& u, unsigned (&off)[2][2]) const {
        int tz = threadIdx.x; asm volatile("" : "+v"(tz));
#pragma unroll
        for (int i = 0; i < 2; ++i) { int R, C; stage_rc(tz * 16 + i * 8192, R, C);
#pragma unroll
            for (int h = 0; h < 2; ++h) off[h][i] = (unsigned)((u.pm * BM + h * HALF + R) * Kb + C * 2); }
    }
};

template <bool KM> struct EpiQKV {
    static constexpr bool PERM = true;
    bf16_t* QKV; const float* rope; float osc;
    __device__ __forceinline__ void operator()(const f32x4 (&acc)[2][2][4][2], const Unit& u, int wr, int wc, int fr, int fq) const {
        const int seg = u.pn >> 3, slab0 = (u.pn & 7) * 2;
        bf16_t* base = QKV + (size_t)seg * ((size_t)BATCH * NSLAB * SEQ * HD);
        const int row0 = u.pm * BM + wr * 64 + fr; const int b = (u.pm * BM) >> 13;
        const bool rot = (seg < 2) && (wc == 0);
        f32x4 cs0a = {0.f, 0.f, 0.f, 0.f}, cs0b = cs0a, cs1a = cs0a, cs1b = cs0a;
#pragma unroll
        for (int ai = 0; ai < 2; ++ai)
#pragma unroll
            for (int m = 0; m < 4; ++m) {
                const int row = row0 + ai * HALF + m * 16, s = row & (SEQ - 1);
                f32x4 cs = {1.f, 1.f, 1.f, 1.f}, sn = {0.f, 0.f, 0.f, 0.f};
                if (rot) { cs = *(const f32x4*)(rope + (size_t)row * 32 + 4 * fq); sn = *(const f32x4*)(rope + (size_t)row * 32 + 16 + 4 * fq); }
#pragma unroll
                for (int bj = 0; bj < 2; ++bj) {
                    f32x4 v0 = acc[ai][bj][m][0] * osc, v1 = acc[ai][bj][m][1] * osc;
                    if (rot) {
                        f32x4 w0, w1;
                        w0[0] = v0[0] * cs[0] - v0[1] * sn[0]; w0[1] = v0[1] * cs[0] + v0[0] * sn[0];
                        w0[2] = v0[2] * cs[1] - v0[3] * sn[1]; w0[3] = v0[3] * cs[1] + v0[2] * sn[1];
                        w1[0] = v1[0] * cs[2] - v1[1] * sn[2]; w1[1] = v1[1] * cs[2] + v1[0] * sn[2];
                        w1[2] = v1[2] * cs[3] - v1[3] * sn[3]; w1[3] = v1[3] * cs[3] + v1[2] * sn[3];
                        v0 = w0; v1 = w1;
                    }
                    u32x4 w; w.x = cvt_pk_bf16(v0[0], v0[1]); w.y = cvt_pk_bf16(v0[2], v0[3]); w.z = cvt_pk_bf16(v1[0], v1[1]); w.w = cvt_pk_bf16(v1[2], v1[3]);
                    *(u32x4*)(base + ((size_t)(b * NSLAB + slab0 + bj) * SEQ + s) * HD + wc * 32 + 8 * fq) = w;
                    if (KM && seg == 1) { const f32x4 ra = {bf_lo(w.x), bf_hi(w.x), bf_lo(w.y), bf_hi(w.y)}, rb = {bf_lo(w.z), bf_hi(w.z), bf_lo(w.w), bf_hi(w.w)};
                        if (bj == 0) { cs0a += ra; cs0b += rb; } else { cs1a += ra; cs1b += rb; } }
                }
            }
        if (KM && seg == 1) {
            bf16_t* km = (bf16_t*)((unsigned char*)QKV - WS_Q + WS_KMEAN);
            LAS float* kbuf = (LAS float*)(uintptr_t)(LDSCTL_OFF + 12288);
#define KM_RED(V, BJ, I0) do { _Pragma("unroll") for (int i = 0; i < 4; ++i) { float v = V[i]; v += dpp_mov<0xB1>(v); v += dpp_mov<0x4E>(v); v += dpp_mov<0x141>(v); v += dpp_mov<0x140>(v); \
                if (fr == 0) kbuf[((wr * 4 + wc) * 2 + (BJ)) * 32 + fq * 8 + (I0) + i] = v; } } while (0)
            KM_RED(cs0a, 0, 0); KM_RED(cs0b, 0, 4); KM_RED(cs1a, 1, 0); KM_RED(cs1b, 1, 4);
#undef KM_RED
            asm volatile("s_waitcnt lgkmcnt(0)" ::: "memory"); __builtin_amdgcn_s_barrier(); asm volatile("" ::: "memory");
            if (wr == 0) {
                const int l = fq * 16 + fr, bj = l >> 5, c32 = l & 31;
                const float mean = (kbuf[((0 * 4 + wc) * 2 + bj) * 32 + c32] + kbuf[((1 * 4 + wc) * 2 + bj) * 32 + c32]) * (1.f / 256.f);
                const unsigned hi = cvt_pk_bf16(mean, 0.f) & 0xffffu; const unsigned lo = cvt_pk_bf16(mean - bf_lo(hi), 0.f) & 0xffffu;
                const size_t ko = ((size_t)(b * NSLAB + slab0 + bj) * 64 + (u.pm & 31)) * HD + wc * 32 + c32;
                km[ko] = (bf16_t)hi; km[ko + 32 * HD] = (bf16_t)lo;
            }
        }
    }
};
struct EpiRes {
    static constexpr bool PERM = false;
    const float* xres; float* y; float osc;
    __device__ __forceinline__ void operator()(const f32x4 (&acc)[2][2][4][2], const Unit& u, int wr, int wc, int fr, int fq) const {
        const int row0 = u.pm * BM + wr * 64 + fr, col0 = u.pn * BM + wc * 32 + 4 * fq;
#pragma unroll
        for (int ai = 0; ai < 2; ++ai)
#pragma unroll
            for (int m = 0; m < 4; ++m) {
                const size_t ro = (size_t)(row0 + ai * HALF + m * 16) * DM + col0;
#pragma unroll
                for (int bj = 0; bj < 2; ++bj)
#pragma unroll
                    for (int n = 0; n < 2; ++n) { const f32x4 xr = *(const f32x4*)(xres + ro + bj * HALF + n * 16); *(f32x4*)(y + ro + bj * HALF + n * 16) = xr * ALPHA + acc[ai][bj][m][n] * osc; }
            }
    }
};
__device__ __forceinline__ float silu_mul(float g, float up) { return g * __builtin_amdgcn_rcpf(1.f + __builtin_amdgcn_exp2f(-1.4426950408889634f * g)) * up; }
template <bool OUT8> struct EpiSwiGLU {
    static constexpr bool PERM = true;
    bf16_t* H; float osc;
    __device__ __forceinline__ void operator()(const f32x4 (&acc)[2][2][4][2], const Unit& u, int wr, int wc, int fr, int fq) const {
        const int row0 = u.pm * BM + wr * 64 + fr, col0 = u.pn * 128 + wc * 32 + 8 * fq;
        if (OUT8) {
#pragma unroll
            for (int ai = 0; ai < 2; ++ai)
#pragma unroll
                for (int mp = 0; mp < 4; mp += 2) {
                    u32x2 w[2];
#pragma unroll
                    for (int k = 0; k < 2; ++k) { const int m = mp + k;
                        const f32x4 g0 = acc[ai][0][m][0] * osc, g1 = acc[ai][0][m][1] * osc, u0 = acc[ai][1][m][0] * osc, u1 = acc[ai][1][m][1] * osc;
                        w[k].x = pk4_fp8(silu_mul(g0[0], u0[0]), silu_mul(g0[1], u0[1]), silu_mul(g0[2], u0[2]), silu_mul(g0[3], u0[3]));
                        w[k].y = pk4_fp8(silu_mul(g1[0], u1[0]), silu_mul(g1[1], u1[1]), silu_mul(g1[2], u1[2]), silu_mul(g1[3], u1[3])); }
                    const auto r0 = __builtin_amdgcn_permlane16_swap(w[0].x, w[1].x, false, false); const auto r1 = __builtin_amdgcn_permlane16_swap(w[0].y, w[1].y, false, false);
                    const u32x4 o = {r0[0], r1[0], r0[1], r1[1]};
                    *(u32x4*)((unsigned char*)H + (size_t)(u.pm * BM + wr * 64 + fr + ai * HALF + (mp + (fq & 1)) * 16) * DE + u.pn * 128 + wc * 32 + 16 * (fq >> 1)) = o;
                }
            return;
        }
#pragma unroll
        for (int ai = 0; ai < 2; ++ai)
#pragma unroll
            for (int m = 0; m < 4; ++m) {
                const f32x4 g0 = acc[ai][0][m][0] * osc, g1 = acc[ai][0][m][1] * osc, u0 = acc[ai][1][m][0] * osc, u1 = acc[ai][1][m][1] * osc;
                if (OUT8) {
                    u32x2 w; w.x = pk4_fp8(silu_mul(g0[0], u0[0]), silu_mul(g0[1], u0[1]), silu_mul(g0[2], u0[2]), silu_mul(g0[3], u0[3]));
                    w.y = pk4_fp8(silu_mul(g1[0], u1[0]), silu_mul(g1[1], u1[1]), silu_mul(g1[2], u1[2]), silu_mul(g1[3], u1[3]));
                    *(u32x2*)((unsigned char*)H + (size_t)(row0 + ai * HALF + m * 16) * DE + col0) = w;
                } else {
                u32x4 w;
                w.x = cvt_pk_bf16(silu_mul(g0[0], u0[0]), silu_mul(g0[1], u0[1])); w.y = cvt_pk_bf16(silu_mul(g0[2], u0[2]), silu_mul(g0[3], u0[3]));
                w.z = cvt_pk_bf16(silu_mul(g1[0], u1[0]), silu_mul(g1[1], u1[1])); w.w = cvt_pk_bf16(silu_mul(g1[2], u1[2]), silu_mul(g1[3], u1[3]));
                *(u32x4*)(H + (size_t)(row0 + ai * HALF + m * 16) * DE + col0) = w;
                }
            }
    }
};
template <bool OUT8> struct EpiY {
    static constexpr bool PERM = true;
    bf16_t* Y; float osc;
    __device__ __forceinline__ void operator()(const f32x4 (&acc)[2][2][4][2], const Unit& u, int wr, int wc, int fr, int fq) const {
        const int row0 = u.pm * BM + wr * 64 + fr, col0 = u.pn * BM + wc * 32 + 8 * fq;
        if (OUT8) {
#pragma unroll
            for (int ai = 0; ai < 2; ++ai)
#pragma unroll
                for (int bj = 0; bj < 2; ++bj)
#pragma unroll
                    for (int mp = 0; mp < 4; mp += 2) {
                        u32x2 w[2];
#pragma unroll
                        for (int k = 0; k < 2; ++k) { const f32x4 v0 = acc[ai][bj][mp + k][0] * osc, v1 = acc[ai][bj][mp + k][1] * osc;
                            w[k].x = pk4_fp8(v0[0], v0[1], v0[2], v0[3]); w[k].y = pk4_fp8(v1[0], v1[1], v1[2], v1[3]); }
                        const auto r0 = __builtin_amdgcn_permlane16_swap(w[0].x, w[1].x, false, false); const auto r1 = __builtin_amdgcn_permlane16_swap(w[0].y, w[1].y, false, false);
                        const u32x4 o = {r0[0], r1[0], r0[1], r1[1]};
                        *(u32x4*)((unsigned char*)Y + (size_t)(row0 + ai * HALF + (mp + (fq & 1)) * 16) * DM + u.pn * BM + wc * 32 + 16 * (fq >> 1) + bj * HALF) = o;
                    }
            return;
        }
#pragma unroll
        for (int ai = 0; ai < 2; ++ai)
#pragma unroll
            for (int m = 0; m < 4; ++m) {
                bf16_t* rowp = Y + (size_t)(row0 + ai * HALF + m * 16) * DM + col0;
#pragma unroll
                for (int bj = 0; bj < 2; ++bj) { const f32x4 v0 = acc[ai][bj][m][0] * osc, v1 = acc[ai][bj][m][1] * osc;
                    if (OUT8) { u32x2 w; w.x = pk4_fp8(v0[0], v0[1], v0[2], v0[3]); w.y = pk4_fp8(v1[0], v1[1], v1[2], v1[3]);
                        *(u32x2*)((unsigned char*)Y + (size_t)(row0 + ai * HALF + m * 16) * DM + col0 + bj * HALF) = w; }
                    else { u32x4 w; w.x = cvt_pk_bf16(v0[0], v0[1]); w.y = cvt_pk_bf16(v0[2], v0[3]); w.z = cvt_pk_bf16(v1[0], v1[1]); w.w = cvt_pk_bf16(v1[2], v1[3]);
                        *(u32x4*)(rowp + bj * HALF) = w; } }
            }
    }
};

typedef int i32x4 __attribute__((ext_vector_type(4)));
typedef int i32x8 __attribute__((ext_vector_type(8)));
__device__ __forceinline__ i32x8 cat8(bf16x8 a, bf16x8 b) { const i32x4 x = __builtin_bit_cast(i32x4, a), y = __builtin_bit_cast(i32x4, b); return (i32x8){x[0], x[1], x[2], x[3], y[0], y[1], y[2], y[3]}; }
template <class Epi, class Sched, bool F8>
__device__ __forceinline__ void gemm_phase(LAS unsigned char* lds, const int K, const Sched& S, const Epi& E) {
    const int tid = threadIdx.x, wid = __builtin_amdgcn_readfirstlane(tid >> 6), lane = tid & 63, wr = wid >> 2, wc = wid & 3, fr = lane & 15, fq = lane >> 4;
    const int nt = K / 128;
    unsigned voffB[2];
#pragma unroll
    for (int i = 0; i < 2; ++i) { int R, C; stage_rc(tid * 16 + i * 8192, R, C); const int Rb = Epi::PERM ? ((R & ~31) + perm32(R & 31)) : R; voffB[i] = (unsigned)(Rb * K + C * 2); }
    const size_t kstep = (size_t)(BK * 2);
    const size_t hstep = (size_t)HALF * K;
    const unsigned ldsw = (unsigned)wid * 1024u;
    const int aoff = lds_byte(wr * 64 + fr, fq * 8), boff = lds_byte(wc * 32 + fr, fq * 8);
#define PG8_SA(b, h) (((b) * 2 + (h)) * HTB)
#define PG8_SB(b, h) ((4 + (b) * 2 + (h)) * HTB)
#define PG8_STAGE(bufoff, gbase, voff) do { _Pragma("unroll") for (int _i = 0; _i < 2; ++_i) \
        __builtin_amdgcn_global_load_lds((const unsigned*)((const char*)(gbase) + (voff)[_i]), (LAS unsigned*)(lds + (bufoff) + ldsw + _i * 8192), 16, 0, 0); } while (0)
#define PG8_LDA(dst, b, h) do { _Pragma("unroll") for (int m = 0; m < 4; ++m) _Pragma("unroll") for (int k = 0; k < 2; ++k) dst[m][k] = *(const LAS bf16x8*)(lds + PG8_SA(b, h) + aoff + m * 2048 + k * 1024); } while (0)
#define PG8_LDB(dst, b, h) do { _Pragma("unroll") for (int n = 0; n < 2; ++n) _Pragma("unroll") for (int k = 0; k < 2; ++k) dst[n][k] = *(const LAS bf16x8*)(lds + PG8_SB(b, h) + boff + n * 2048 + k * 1024); } while (0)
#define PG8_MMA(ai, bj, At, Bt) do { __builtin_amdgcn_s_setprio(1); _Pragma("unroll") for (int m = 0; m < 4; ++m) _Pragma("unroll") for (int n = 0; n < 2; ++n) { \
        if (F8) acc[ai][bj][m][n] = __builtin_amdgcn_mfma_scale_f32_16x16x128_f8f6f4(cat8(Bt[n][0], Bt[n][1]), cat8(At[m][0], At[m][1]), acc[ai][bj][m][n], 0, 0, 0, 0x7F7F7F7F, 0, 0x7F7F7F7F); \
        else { _Pragma("unroll") for (int k = 0; k < 2; ++k) acc[ai][bj][m][n] = __builtin_amdgcn_mfma_f32_16x16x32_bf16(Bt[n][k], At[m][k], acc[ai][bj][m][n], 0, 0, 0); } } \
        __builtin_amdgcn_s_setprio(0); } while (0)
#define PG8_WAIT_V(n) asm volatile("s_waitcnt vmcnt(" #n ")" ::: "memory")
#define PG8_WAIT_L(n) asm volatile("s_waitcnt lgkmcnt(" #n ")" ::: "memory")
#define PG8_BAR __builtin_amdgcn_s_barrier()
#define PG8_SCHED __builtin_amdgcn_sched_barrier(0)
    Unit cur, nxt; int ui = 0;
    if (!S.next(0, cur)) return;
    f32x4 acc[2][2][4][2];
#pragma unroll
    for (int a = 0; a < 2; ++a)
#pragma unroll
        for (int b = 0; b < 2; ++b)
#pragma unroll
            for (int m = 0; m < 4; ++m)
#pragma unroll
                for (int n = 0; n < 2; ++n) acc[a][b][m][n] = (f32x4){0.f, 0.f, 0.f, 0.f};
    bf16x8 At[4][2], B0[2][2], B1[2][2];
    unsigned cOff[2][2];
    const char* cA = S.a_base(cur); const char* cB = S.b_base(cur);
    S.a_off(cur, cOff);
    PG8_STAGE(PG8_SB(0, 0), cB, voffB); PG8_STAGE(PG8_SB(0, 1), cB + hstep, voffB); PG8_STAGE(PG8_SA(0, 0), cA, cOff[0]); PG8_STAGE(PG8_SA(0, 1), cA, cOff[1]);
    if (wr == 1) PG8_BAR;
    PG8_WAIT_V(2); PG8_BAR;
    PG8_STAGE(PG8_SB(1, 0), cB + kstep, voffB); PG8_STAGE(PG8_SA(1, 0), cA + kstep, cOff[0]); PG8_STAGE(PG8_SB(1, 1), cB + hstep + kstep, voffB);
    PG8_WAIT_V(6); PG8_BAR;
    for (;;) {
        const bool has_next = S.next(ui + 1, nxt);
        const char* nA = has_next ? S.a_base(nxt) : cA; const char* nB = has_next ? S.b_base(nxt) : cB;
#pragma unroll 1
        for (int t = 0; t < nt; t += 2) {
            const bool last = (t == nt - 2);
            const char* a1 = cA + (size_t)(t + 1) * kstep;
            const char* a2 = last ? nA : cA + (size_t)(t + 2) * kstep; const char* b2 = last ? nB : cB + (size_t)(t + 2) * kstep;
            const char* a3 = a2 + kstep; const char* b3 = b2 + kstep;
            PG8_LDB(B0, 0, 0); PG8_LDB(B1, 0, 1); PG8_SCHED; PG8_LDA(At, 0, 0); PG8_STAGE(PG8_SA(1, 1), a1, cOff[1]);
            if (last && has_next) S.a_off(nxt, cOff);
            PG8_WAIT_V(8); PG8_WAIT_L(0); PG8_BAR; PG8_MMA(0, 0, At, B0); PG8_MMA(0, 1, At, B1); PG8_BAR; PG8_SCHED;
            PG8_LDA(At, 0, 1); PG8_STAGE(PG8_SB(0, 0), b2, voffB); PG8_STAGE(PG8_SB(0, 1), b2 + hstep, voffB); PG8_STAGE(PG8_SA(0, 0), a2, cOff[0]);
            PG8_WAIT_V(8); PG8_WAIT_L(0); PG8_BAR; PG8_MMA(1, 0, At, B0); PG8_MMA(1, 1, At, B1); PG8_BAR; PG8_SCHED;
            PG8_LDB(B0, 1, 0); PG8_LDB(B1, 1, 1); PG8_SCHED; PG8_LDA(At, 1, 0); PG8_STAGE(PG8_SA(0, 1), a2, cOff[1]);
            PG8_WAIT_V(8); PG8_WAIT_L(0); PG8_BAR; PG8_MMA(0, 0, At, B0); PG8_MMA(0, 1, At, B1); PG8_BAR; PG8_SCHED;
            PG8_LDA(At, 1, 1); PG8_STAGE(PG8_SB(1, 0), b3, voffB); PG8_STAGE(PG8_SB(1, 1), b3 + hstep, voffB); PG8_STAGE(PG8_SA(1, 0), a3, cOff[0]);
            PG8_WAIT_V(8); PG8_WAIT_L(0); PG8_BAR; PG8_MMA(1, 0, At, B0); PG8_MMA(1, 1, At, B1); PG8_BAR; PG8_SCHED;
        }
        if (wr == 0) PG8_BAR;
        E(acc, cur, wr, wc, fr, fq);
        if (!has_next) break;
#pragma unroll
        for (int a = 0; a < 2; ++a)
#pragma unroll
            for (int b = 0; b < 2; ++b)
#pragma unroll
                for (int m = 0; m < 4; ++m)
#pragma unroll
                    for (int n = 0; n < 2; ++n) acc[a][b][m][n] = (f32x4){0.f, 0.f, 0.f, 0.f};
        cur = nxt; cA = nA; cB = nB; ++ui;
        if (wr == 1) PG8_BAR;
    }
    PG8_WAIT_V(0);
    PG8_BAR;
#undef PG8_SA
#undef PG8_SB
#undef PG8_STAGE
#undef PG8_LDA
#undef PG8_LDB
#undef PG8_MMA
#undef PG8_WAIT_V
#undef PG8_WAIT_L
#undef PG8_BAR
#undef PG8_SCHED
}
}

namespace att {
constexpr int D = 128, NW = 8, QBLK = 32, KVBLK = 64, QB = NW * QBLK;
constexpr float SCALE = 0.08838834764831845f;
constexpr float THR = 8.f;
constexpr int SHM_V = KVBLK * D * 2, SHM_K = KVBLK * D * 2;
constexpr int ATT_LDS = 2 * SHM_V + 2 * SHM_K + NW * 256 * 4;
#define KSWZ(row, colB) ((row) * 256 + ((colB) ^ (((row) & 7) << 4)))
__device__ __forceinline__ int v_st(int k, int c) { const int kk = (k & ~0xC) | ((k & 4) << 1) | ((k & 8) >> 1); return ((kk >> 3) * 4 + (c >> 5)) * 512 + ((kk & 7) * 32 + (c & 31)) * 2; }
__device__ __forceinline__ int v_rd_base(int lane) { return ((lane & 3) << 3) | (((lane >> 2) & 3) << 6) | (((lane >> 4) & 1) << 5) | (((lane >> 5) & 1) << 8); }
constexpr int v_rd_off(int d0, int ks, int half) { return d0 * 512 + ks * 4096 + half * 2048; }
__device__ __forceinline__ int crow(int r, int hi) { return (r & 3) + 8 * (r >> 2) + 4 * hi; }
__device__ __forceinline__ bf16x8 load8(const bf16_t* p) { return *reinterpret_cast<const bf16x8*>(p); }
__device__ __forceinline__ void mask_tile(f32x16& p0, f32x16& p1, int dq, unsigned W) {
    const float NEG = -__builtin_inff();
#pragma unroll
    for (int r = 0; r < 16; ++r) {
        const int c = (r & 3) + 8 * (r >> 2);
        if ((unsigned)(dq - c) >= W) p0[r] = NEG;
        if ((unsigned)(dq - c - 32) >= W) p1[r] = NEG;
    }
}
__device__ __forceinline__ void partialSM(f32x16& p0, f32x16& p1, float& m_reg, float& mn, float& alpha) {
    float pmax = p0[0];
#pragma unroll
    for (int r = 1; r < 16; ++r) pmax = fmaxf(pmax, p0[r]);
#pragma unroll
    for (int r = 0; r < 16; ++r) pmax = fmaxf(pmax, p1[r]);
    { auto rr = __builtin_amdgcn_permlane32_swap(__float_as_uint(pmax), __float_as_uint(pmax), false, false);
      pmax = fmaxf(__uint_as_float(rr[0]), __uint_as_float(rr[1])); }
    constexpr float C2 = 1.4426950408889634f * SCALE;
    if (__builtin_expect(__all((pmax - m_reg) * SCALE <= THR), 1)) { mn = m_reg; alpha = 1.f; }
    else { mn = fmaxf(m_reg, pmax); alpha = __builtin_amdgcn_exp2f((m_reg - mn) * C2); m_reg = mn; }
    const float mnL = -mn * C2;
#pragma unroll
    for (int r = 0; r < 16; ++r) p0[r] = fmaf(p0[r], C2, mnL);
#pragma unroll
    for (int r = 0; r < 16; ++r) p1[r] = fmaf(p1[r], C2, mnL);
#pragma unroll
    for (int r = 0; r < 16; ++r) p0[r] = __builtin_amdgcn_exp2f(p0[r]);
}
__device__ __forceinline__ void finishSM(f32x16& p0, f32x16& p1, float alpha, float& l_reg, bf16x8& pa0, bf16x8& pa1, bf16x8& pa2, bf16x8& pa3) {
#pragma unroll
    for (int r = 0; r < 16; ++r) p1[r] = __builtin_amdgcn_exp2f(p1[r]);
    float ps = 0;
#pragma unroll
    for (int r = 0; r < 16; ++r) ps += p0[r];
#pragma unroll
    for (int r = 0; r < 16; ++r) ps += p1[r];
    { auto rr = __builtin_amdgcn_permlane32_swap(__float_as_uint(ps), __float_as_uint(ps), false, false);
      ps = __uint_as_float(rr[0]) + __uint_as_float(rr[1]); }
    l_reg = l_reg * alpha + ps;
#define PK4(P, B_, OUT) do { unsigned a0 = cvt_pk_bf16(P[B_+0], P[B_+1]), a1 = cvt_pk_bf16(P[B_+2], P[B_+3]);                          \
        unsigned b0 = cvt_pk_bf16(P[B_+4], P[B_+5]), b1 = cvt_pk_bf16(P[B_+6], P[B_+7]);                                             \
        auto r0 = __builtin_amdgcn_permlane32_swap(a0, b0, false, false); auto r1 = __builtin_amdgcn_permlane32_swap(a1, b1, false, false); \
        u32x4 w = {r0[0], r1[0], r0[1], r1[1]}; OUT = *reinterpret_cast<bf16x8*>(&w); } while (0)
    PK4(p0, 0, pa0); PK4(p0, 8, pa1); PK4(p1, 0, pa2); PK4(p1, 8, pa3);
#undef PK4
}
template <int KB>
__device__ __forceinline__ void qkt(f32x16& p0, f32x16& p1, const char* K_lds, int r32, int hi, const bf16x8* qr) {
    p0 = f32x16{}; p1 = f32x16{};
    const char* kb[4];
#pragma unroll
    for (int dd = 0; dd < 4; ++dd) kb[dd] = K_lds + KB * SHM_K + KSWZ(r32, (dd * 16 + hi * 8) * 2);
#pragma unroll
    for (int d0 = 0; d0 < 8; ++d0) { const char* a = kb[d0 & 3] + (d0 >> 2) * 128;
        bf16x8 b0 = *reinterpret_cast<const bf16x8*>(a);
        bf16x8 b1 = *reinterpret_cast<const bf16x8*>(a + 32 * 256);
        p0 = __builtin_amdgcn_mfma_f32_32x32x16_bf16(b0, qr[d0], p0, 0, 0, 0);
        p1 = __builtin_amdgcn_mfma_f32_32x32x16_bf16(b1, qr[d0], p1, 0, 0, 0); }
}
template <int VB>
__device__ __forceinline__ void pv_tile(f32x16* o, int vb0, bf16x8 pa0, bf16x8 pa1, bf16x8 pa2, bf16x8 pa3) {
#define TRRD(dst, off) asm volatile("ds_read_b64_tr_b16 %0, %1 offset:%2" : "=&v"(dst) : "v"(vb0), "i"(off) : "memory")
#define PV_D0(d0) do { s16x4 l0, l1, l2, l3, h0, h1, h2, h3; constexpr int b_ = VB * SHM_V + v_rd_off(d0, 0, 0); \
        TRRD(l0, b_); TRRD(h0, b_ + 2048); TRRD(l1, b_ + 4096); TRRD(h1, b_ + 6144); TRRD(l2, b_ + 8192); TRRD(h2, b_ + 10240); TRRD(l3, b_ + 12288); TRRD(h3, b_ + 14336); \
        asm volatile("s_waitcnt lgkmcnt(0)" ::: "memory"); SBAR(); \
        o[d0] = __builtin_amdgcn_mfma_f32_32x32x16_bf16(pa0, (bf16x8){l0[0], l0[1], l0[2], l0[3], h0[0], h0[1], h0[2], h0[3]}, o[d0], 0, 0, 0);   \
        o[d0] = __builtin_amdgcn_mfma_f32_32x32x16_bf16(pa1, (bf16x8){l1[0], l1[1], l1[2], l1[3], h1[0], h1[1], h1[2], h1[3]}, o[d0], 0, 0, 0);   \
        o[d0] = __builtin_amdgcn_mfma_f32_32x32x16_bf16(pa2, (bf16x8){l2[0], l2[1], l2[2], l2[3], h2[0], h2[1], h2[2], h2[3]}, o[d0], 0, 0, 0);   \
        o[d0] = __builtin_amdgcn_mfma_f32_32x32x16_bf16(pa3, (bf16x8){l3[0], l3[1], l3[2], l3[3], h3[0], h3[1], h3[2], h3[3]}, o[d0], 0, 0, 0); } while (0)
    PV_D0(0); PV_D0(1); PV_D0(2); PV_D0(3);
#undef PV_D0
#undef TRRD
}
struct BlockRef { const bf16_t* Q; const bf16_t* K; const bf16_t* V; bf16_t* O; const unsigned* sel; const unsigned* list; float* ML; int P0, jlo, nvalid, nblk, hb; };
struct Seam { bf16x8 qr[8]; bf16x8 st_v0, st_v1, st_k0, st_k1; unsigned sel, qrow; };
#define ROW(p, k0, rr) ((p) + (size_t)((k0) + (rr)) * D + sc)
#define VMWN(n) asm volatile("s_waitcnt vmcnt(%0)" :: "i"(n) : "memory")
#define SLOAD_H(Kp, Vp, k0) do { S.st_v0 = load8(ROW(Vp, k0, sr)); S.st_v1 = load8(ROW(Vp, k0, 32 + sr));              \
                         S.st_k0 = load8(ROW(Kp, k0, sr)); S.st_k1 = load8(ROW(Kp, k0, 32 + sr)); } while (0)
#define SWRITE_HK(bf) do { *(bf16x8*)(K_lds + (bf) * SHM_K + kws) = S.st_k0; *(bf16x8*)(K_lds + (bf) * SHM_K + kws + 32 * 256) = S.st_k1; } while (0)
#define SWRITE_HV(bf) do { *(bf16x8*)(V_lds + (bf) * SHM_V + vst0) = S.st_v0; *(bf16x8*)(V_lds + (bf) * SHM_V + vst1) = S.st_v1; } while (0)
#define SWRITE_H(bf) do { SWRITE_HV(bf); SWRITE_HK(bf); } while (0)
template <bool SP>
__device__ __forceinline__ void attn_prime(const BlockRef& cur, char* lds, Seam& S) {
    int tid = threadIdx.x; asm volatile("" : "+v"(tid));
    const int wid = __builtin_amdgcn_readfirstlane(tid >> 6), lane = tid & 63, r32 = lane & 31, hi = lane >> 5;
    const int sr = tid >> 4, sc = (tid & 15) * 8, kws = KSWZ(sr, sc * 2); char* K_lds = lds + 2 * SHM_V;
    const int i = wid * QBLK + r32;
    unsigned q = (unsigned)i;
    if (SP) q = cur.list ? cur.list[i < cur.nvalid ? i : cur.nvalid - 1] : (unsigned)(cur.P0 + i);
    S.qrow = q; S.sel = SP ? cur.sel[q] : 0u;
#pragma unroll
    for (int d0 = 0; d0 < 8; ++d0) S.qr[d0] = load8(cur.Q + (size_t)q * D + d0 * 16 + hi * 8);
    SLOAD_H(cur.K, cur.V, SP ? cur.jlo * KVBLK : 0); VM_WAIT(); SWRITE_HK(0);
    __syncthreads();
}
template <bool SP>
__device__ __forceinline__ void attn_block(const BlockRef& cur, const BlockRef& nxt, const int ostride, char* lds, Seam& S) {
    int tid = threadIdx.x; asm volatile("" : "+v"(tid));
    const int wid = __builtin_amdgcn_readfirstlane(tid >> 6), lane = tid & 63, r32 = lane & 31, hi = lane >> 5;
    const int NT = SP ? 4 : cur.P0 / KVBLK + 4;
    const int jlo = SP ? cur.jlo : 0;
    const int qlo = cur.P0 + wid * QBLK, qm = qlo + r32 - 4 * hi;
    char* V_lds = lds; char* K_lds = lds + 2 * SHM_V;
    float* ws = (float*)(lds + 2 * SHM_V + 2 * SHM_K) + wid * 256; float* li_l = ws, * al_l = ws + 32;
    unsigned* rd = (unsigned*)(ws + 64); unsigned* nl = (unsigned*)(ws + 96);
    float m_reg = -1e30f, l_reg = 0; f32x16 o[4] = {};
    const int sr = tid >> 4, sc = (tid & 15) * 8, vst0 = v_st(sr, sc), vst1 = v_st(32 + sr, sc), kws = KSWZ(sr, sc * 2);
    const int vb0 = (int)(uintptr_t)V_lds + v_rd_base(lane);
    const bf16_t* Kh = cur.K; const bf16_t* Vh = cur.V;
    const bool causal = !SP || cur.list == nullptr;
#define RESC(a) do { if (__any((a) < 1.f)) { if (hi == 0) al_l[r32] = (a); asm volatile("s_waitcnt lgkmcnt(0)" ::: "memory");              \
                     for (int d_ = 0; d_ < 4; ++d_) for (int r = 0; r < 16; ++r) o[d_][r] *= al_l[crow(r, hi)]; } } while (0)
#define KBASE(t) ((jlo + (t)) * KVBLK)
#define MASKT(P0_, P1_, t) do { const int kb_ = KBASE(t); if (causal && kb_ + KVBLK - 1 > qlo) mask_tile(P0_, P1_, qm - kb_, 0x40000000u); } while (0)
    constexpr int NQL = 8;
#define SEAM_K0() do { VMWN(NQL); SWRITE_HK(0); SBAR(); } while (0)
    f32x16 pA0, pA1, pB0, pB1; float mnA, mnB, alA, alB; bf16x8 pa0, pa1, pa2, pa3;
    unsigned qn_tmp = 0u;
    if (SP) {
        if (hi == 0) { const bool valid = (cur.list == nullptr) || (wid * QBLK + r32 < cur.nvalid);
            const unsigned slot = cur.list ? (unsigned)__builtin_popcount(S.sel & ((1u << cur.nblk) - 1u)) : 3u;
            rd[r32] = valid ? (((unsigned)cur.hb + S.qrow) * 4u + slot) * 128u : (1u << 27); }
        if (nxt.list) { const int i = wid * QBLK + r32; qn_tmp = nxt.list[i < nxt.nvalid ? i : nxt.nvalid - 1]; }
    }
    SWRITE_HV(0); SBAR();
    if (NT > 1) { SLOAD_H(Kh, Vh, KBASE(1)); }
    SBAR(); qkt<0>(pA0, pA1, K_lds, r32, hi, S.qr);
    MASKT(pA0, pA1, 0); partialSM(pA0, pA1, m_reg, mnA, alA);
    if (NT > 1) { VM_WAIT(); SWRITE_H(1); }
    if (SP) nl[lane] = nxt.list ? qn_tmp : (unsigned)(nxt.P0 + wid * QBLK + r32);
    __syncthreads();
#define HALF_STEP(PX0, PX1, mnX, alX, PY0, PY1, alY, t, KB, VB, SB) do {                                                      \
        SBAR(); qkt<KB>(PX0, PX1, K_lds, r32, hi, S.qr);                                                                      \
        finishSM(PY0, PY1, alY, l_reg, pa0, pa1, pa2, pa3); SBAR();                                                           \
        if ((t) + 1 < NT) { SLOAD_H(Kh, Vh, KBASE((t) + 1)); SBAR(); }                                                        \
        pv_tile<VB>(o, vb0, pa0, pa1, pa2, pa3); MASKT(PX0, PX1, (t)); partialSM(PX0, PX1, m_reg, mnX, alX);                  \
        __syncthreads();                                                                                                      \
        if ((t) + 1 < NT) { VM_WAIT(); SWRITE_H(SB); }                                                                        \
        RESC(alX); __syncthreads(); } while (0)
    for (int t = 1; t + 1 < NT; t += 2) {
        HALF_STEP(pB0, pB1, mnB, alB, pA0, pA1, alA, t, 1, 0, 0);
        HALF_STEP(pA0, pA1, mnA, alA, pB0, pB1, alB, t + 1, 0, 1, 1);
    }
    const bool even = (NT & 1) == 0;
    if (even) { SBAR(); qkt<1>(pB0, pB1, K_lds, r32, hi, S.qr); SBAR(); }
    unsigned qn = (unsigned)(wid * QBLK + r32);
    if (SP) { qn = nl[lane]; S.qrow = qn; S.sel = nxt.sel[qn]; }
    SLOAD_H(nxt.K, nxt.V, SP ? nxt.jlo * KVBLK : 0); SBAR();
#pragma unroll
    for (int d0 = 0; d0 < 8; ++d0) S.qr[d0] = load8(nxt.Q + (size_t)qn * D + d0 * 16 + hi * 8);
    SBAR();
    finishSM(pA0, pA1, alA, l_reg, pa0, pa1, pa2, pa3); SBAR();
    pv_tile<0>(o, vb0, pa0, pa1, pa2, pa3);
    if (even) { MASKT(pB0, pB1, NT - 1); partialSM(pB0, pB1, m_reg, mnB, alB); __syncthreads(); RESC(alB);
        finishSM(pB0, pB1, alB, l_reg, pa0, pa1, pa2, pa3); SBAR(); pv_tile<1>(o, vb0, pa0, pa1, pa2, pa3); }
    SBAR(); SEAM_K0();
    if (hi == 0) li_l[r32] = l_reg; asm volatile("s_waitcnt lgkmcnt(0)" ::: "memory");
    float rli[16];
#pragma unroll
    for (int r = 0; r < 16; ++r) rli[r] = __builtin_amdgcn_rcpf(li_l[crow(r, hi)]);
    if (SP) {
        bf16_t* Ob = cur.O;
#pragma unroll
        for (int r = 0; r < 16; ++r) { const unsigned off = rd[crow(r, hi)];
#pragma unroll
            for (int d0 = 0; d0 < 4; ++d0) { const float v = o[d0][r] * rli[r];
                const float vn = __int_as_float(__builtin_amdgcn_mov_dpp(__float_as_int(v), 0xB1, 0xF, 0xF, true));
                if ((r32 & 1) == 0) *(unsigned*)(Ob + (size_t)off + d0 * 32 + r32) = cvt_pk_bf16(v, vn); } }
        if (hi == 0) { float* mlp = cur.ML + (size_t)(rd[r32] >> 7) * 2; f32x2 ml = {m_reg, l_reg}; *(f32x2*)mlp = ml; }
    } else {
        bf16_t* Ow = cur.O + (size_t)(wid * QBLK) * ostride;
#pragma unroll
        for (int r = 0; r < 16; ++r) { const int orow = crow(r, hi);
#pragma unroll
            for (int d0 = 0; d0 < 4; ++d0) { const float v = o[d0][r] * rli[r];
                const float vn = __int_as_float(__builtin_amdgcn_mov_dpp(__float_as_int(v), 0xB1, 0xF, 0xF, true));
                if ((r32 & 1) == 0) *(unsigned*)(Ow + (size_t)orow * ostride + d0 * 32 + r32) = cvt_pk_bf16(v, vn); } }
    }
    __syncthreads();
#undef RESC
#undef KBASE
#undef MASKT
#undef SEAM_K0
#undef HALF_STEP
}
#undef ROW
#undef VMWN
#undef SLOAD_H
#undef SWRITE_HK
#undef SWRITE_HV
#undef SWRITE_H
}

struct Args { const float* in[23]; float* out; unsigned char* ws; int ph_lo, ph_hi; };
typedef const __attribute__((address_space(4))) Args* KArgs;
__device__ __forceinline__ KArgs kargs() { KArgs p = (KArgs)__builtin_amdgcn_kernarg_segment_ptr(); asm volatile("" : "+s"(p)); return p; }
__device__ __forceinline__ int otid() { int t = threadIdx.x; asm volatile("" : "+v"(t)); return t; }
struct Geo { int G, bx, vcu, gw, NGW; };
__device__ __forceinline__ Geo geo() {
    Geo g; const int tid = otid(); const int wave = __builtin_amdgcn_readfirstlane(tid >> 6);
    g.G = gridDim.x; g.bx = blockIdx.x; g.vcu = (g.G % 8 == 0) ? (g.bx % 8) * (g.G / 8) + g.bx / 8 : g.bx; g.gw = g.vcu * NWAVES + wave; g.NGW = g.G * NWAVES; return g;
}
enum { I_X = 0, I_POS, I_LN1G, I_LN1B, I_LN2G, I_LN2B, I_DAWIN, I_DAWOUT, I_LQ1, I_LK1, I_LQ2, I_LK2, I_SUBLN, I_MBWIN, I_MBWOUT, I_WR, I_RB, I_WG, I_WU, I_WD, I_SG, I_SU, I_SD };

__device__ __forceinline__ int dst_row(int kind, int n) {
    if (kind == 1) { if (n < 4096) { int d = n & 127; const int h = n & ~127; if (d < 16) d = 2 * d; else if (d < 32) d = 2 * (d - 16) + 1; return h + d; } return n; }
    if (kind == 2) return ((n >> 7) << 8) + (n & 127);
    if (kind == 3) return ((n >> 7) << 8) + 128 + (n & 127);
    return n;
}
struct TrDesc { const float* W; unsigned char* WT; int K, N, k0, n0, kind, f8; };
constexpr int IT_IN = 32 * 192, IT_OUT = 32 * 64, IT_E = 512, IT_ATT = 2 * IT_IN + 2 * IT_OUT, IT_TOTAL = IT_ATT + 2 * NEX * 3 * IT_E;
__device__ __forceinline__ void tr_decode(KArgs a, int it, TrDesc& d) {
    unsigned char* ws = a->ws; int s;
    if (it < IT_ATT) {
        if (it < IT_IN) { d.W = a->in[I_DAWIN]; d.WT = ws + WS_WATT; d.K = DM; d.N = NQKV; d.kind = 1; d.f8 = FP8_QKV0; s = it; }
        else if (it < 2 * IT_IN) { d.W = a->in[I_MBWIN]; d.WT = ws + WS_WATT + 32 * MiB; d.K = DM; d.N = NQKV; d.kind = 1; d.f8 = FP8_QKV1; s = it - IT_IN; }
        else if (it < 2 * IT_IN + IT_OUT) { d.W = a->in[I_DAWOUT]; d.WT = ws + WS_WATT + 24 * MiB; d.K = DM; d.N = DM; d.kind = 0; d.f8 = FP8_OUT0; s = it - 2 * IT_IN; }
        else { d.W = a->in[I_MBWOUT]; d.WT = ws + WS_WATT + 56 * MiB; d.K = DM; d.N = DM; d.kind = 0; d.f8 = FP8_OUT1; s = it - 2 * IT_IN - IT_OUT; }
    } else {
        const int r = it - IT_ATT, le = r / (3 * IT_E), sub = r - le * (3 * IT_E), mtx = sub / IT_E; s = sub - mtx * IT_E;
        const int l = le / NEX, e = le - l * NEX;
        const size_t EW = (size_t)DM * DE;
        if (mtx < 2) {
            const float* src = (e < NE) ? a->in[mtx == 0 ? I_WG : I_WU] + ((size_t)l * NE + e) * EW : a->in[mtx == 0 ? I_SG : I_SU] + (size_t)l * EW;
            d.f8 = MOE_F8(l);
            d.W = src; d.WT = ws + WS_WGU + (size_t)l * NEX * (2 * EW) * 2 + (size_t)e * (2 * EW) * (d.f8 ? 1 : 2); d.K = DM; d.N = DE; d.kind = 2 + mtx;
        } else {
            const float* src = (e < NE) ? a->in[I_WD] + ((size_t)l * NE + e) * EW : a->in[I_SD] + (size_t)l * EW;
            d.f8 = MOE_F8(l);
            d.W = src; d.WT = ws + WS_WD + (size_t)l * NEX * EW * 2 + (size_t)e * EW * (d.f8 ? 1 : 2); d.K = DE; d.N = DM; d.kind = 0;
        }
    }
    const int nblk = d.N / 32; const int kb = s / nblk; d.k0 = kb * 64; d.n0 = (s - kb * nblk) * 32;
}
__device__ __forceinline__ void tr_load(const TrDesc& d, int lane, f32x4 (&v)[8]) {
    const int kb = lane >> 3, n4 = (lane & 7) * 4;
#pragma unroll
    for (int i = 0; i < 8; ++i) v[i] = __builtin_nontemporal_load((const f32x4*)(d.W + (size_t)(d.k0 + 8 * kb + i) * d.N + d.n0 + n4));
}
__device__ __forceinline__ void tr_store(const TrDesc& d, int lane, const f32x4 (&v)[8], LAS float*) {
    const int kb = lane >> 3, n4 = (lane & 7) * 4;
#pragma unroll
    for (int q = 0; q < 4; ++q) {
        const size_t eo = (size_t)dst_row(d.kind, d.n0 + n4 + q) * d.K + d.k0 + 8 * kb;
        if (d.f8) { u32x2 o; o.x = pk4_fp8(v[0][q] * W8_SCALE, v[1][q] * W8_SCALE, v[2][q] * W8_SCALE, v[3][q] * W8_SCALE); o.y = pk4_fp8(v[4][q] * W8_SCALE, v[5][q] * W8_SCALE, v[6][q] * W8_SCALE, v[7][q] * W8_SCALE);
            *(u32x2*)(d.WT + eo) = o; }
        else { u32x4 o; o.x = cvt_pk_bf16(v[0][q], v[1][q]); o.y = cvt_pk_bf16(v[2][q], v[3][q]); o.z = cvt_pk_bf16(v[4][q], v[5][q]); o.w = cvt_pk_bf16(v[6][q], v[7][q]);
            *(u32x4*)(d.WT + eo * 2) = o; }
    }
}
__device__ __forceinline__ void convert_items(KArgs a, LAS float* scr, int gw, int NGW, int lane, int it0, int it1) {
    TrDesc dA, dB, dC; f32x4 vA[8], vB[8], vC[8];
    int it = it0 + gw;
#define CV_LD(D, V, IT) do { if ((IT) < it1) { tr_decode(a, (IT), D); tr_load(D, lane, V); } } while (0)
    CV_LD(dA, vA, it); CV_LD(dB, vB, it + NGW); CV_LD(dC, vC, it + 2 * NGW);
    while (it < it1) {
        tr_store(dA, lane, vA, scr); CV_LD(dA, vA, it + 3 * NGW);
        if (it + NGW < it1) { tr_store(dB, lane, vB, scr); CV_LD(dB, vB, it + 4 * NGW); }
        if (it + 2 * NGW < it1) { tr_store(dC, lane, vC, scr); CV_LD(dC, vC, it + 5 * NGW); }
        it += 3 * NGW;
    }
#undef CV_LD
}
__device__ __forceinline__ void p0_prologue(KArgs a, LAS unsigned char* lds, int gw, int NGW, int wave, int lane) {
    LAS float* scr = (LAS float*)(lds + wave * 4224);
    convert_items(a, scr, gw, NGW, lane, 0, IT_IN);
    {
        const float* x = a->in[I_X]; bf16_t* xb = (bf16_t*)(a->ws + WS_XB);
        f32x4 vn[8];
        if (gw < NTOK) {
#pragma unroll
            for (int j = 0; j < 4; ++j) { vn[2 * j] = *(const f32x4*)(x + (size_t)gw * DM + 512 * j + 8 * lane); vn[2 * j + 1] = *(const f32x4*)(x + (size_t)gw * DM + 512 * j + 8 * lane + 4); } }
        for (int m = gw; m < NTOK; m += NGW) {
            f32x4 v[8];
#pragma unroll
            for (int j = 0; j < 8; ++j) v[j] = vn[j];
            if (m + NGW < NTOK) {
#pragma unroll
                for (int j = 0; j < 4; ++j) { vn[2 * j] = *(const f32x4*)(x + (size_t)(m + NGW) * DM + 512 * j + 8 * lane); vn[2 * j + 1] = *(const f32x4*)(x + (size_t)(m + NGW) * DM + 512 * j + 8 * lane + 4); } }
#pragma unroll
            for (int j = 0; j < 4; ++j) {
                if (FP8_QKV0) { u32x2 w; w.x = pk4_fp8(v[2 * j][0], v[2 * j][1], v[2 * j][2], v[2 * j][3]); w.y = pk4_fp8(v[2 * j + 1][0], v[2 * j + 1][1], v[2 * j + 1][2], v[2 * j + 1][3]);
                    *(u32x2*)((unsigned char*)xb + (size_t)m * DM + 512 * j + 8 * lane) = w; }
                else { u32x4 w; w.x = cvt_pk_bf16(v[2 * j][0], v[2 * j][1]); w.y = cvt_pk_bf16(v[2 * j][2], v[2 * j][3]); w.z = cvt_pk_bf16(v[2 * j + 1][0], v[2 * j + 1][1]); w.w = cvt_pk_bf16(v[2 * j + 1][2], v[2 * j + 1][3]);
                    *(u32x4*)(xb + (size_t)m * DM + 512 * j + 8 * lane) = w; } }
        }
    }
    {
        bf16_t* wf = (bf16_t*)(a->ws + WS_WRF);
        for (int idx = gw * 64 + lane; idx < 2 * 2 * 128 * 64; idx += NGW * 64) {
            const int ln = idx & 63, s = (idx >> 6) & 127, blk = (idx >> 13) & 1, l = idx >> 14;
            const int e = blk * 32 + (ln & 31), c = 16 * s + 8 * (ln >> 5);
            const float* w = a->in[I_WR] + ((size_t)l * DM + c) * NE + e;
            float v[8];
#pragma unroll
            for (int j = 0; j < 8; ++j) v[j] = w[(size_t)j * NE];
            u32x4 h, lo;
            h.x = cvt_pk_bf16(v[0], v[1]); h.y = cvt_pk_bf16(v[2], v[3]); h.z = cvt_pk_bf16(v[4], v[5]); h.w = cvt_pk_bf16(v[6], v[7]);
            lo.x = cvt_pk_bf16(v[0] - bf_lo(h.x), v[1] - bf_hi(h.x)); lo.y = cvt_pk_bf16(v[2] - bf_lo(h.y), v[3] - bf_hi(h.y));
            lo.z = cvt_pk_bf16(v[4] - bf_lo(h.z), v[5] - bf_hi(h.z)); lo.w = cvt_pk_bf16(v[6] - bf_lo(h.w), v[7] - bf_hi(h.w));
            const size_t fo = (((size_t)(l * 2 + 0) * 2 + blk) * 128 + s) * 64 + ln, fl = (((size_t)(l * 2 + 1) * 2 + blk) * 128 + s) * 64 + ln;
            *(u32x4*)(wf + fo * 8) = h; *(u32x4*)(wf + fl * 8) = lo;
        }
    }
    {
        const int* pos = (const int*)a->in[I_POS]; float* tab = (float*)(a->ws + WS_ROPE);
        for (int idx = gw * 64 + lane; idx < NTOK * 16; idx += NGW * 64) {
            const int t = idx >> 4, i = idx & 15;
            const float inv = powf(500000.f, -(float)(2 * i) / 32.f);
            const float ang = (float)pos[t] * inv;
            double rev = (double)ang * 0.15915494309189535; rev -= floor(rev);
            const float fr = (float)rev;
            tab[(size_t)t * 32 + i] = __builtin_amdgcn_cosf(fr); tab[(size_t)t * 32 + 16 + i] = __builtin_amdgcn_sinf(fr);
        }
    }
}

__device__ __forceinline__ void da_combine(KArgs a, int gw, int NGW, int lane) {
    float lam;
    {   const float* q1 = a->in[I_LQ1]; const float* k1 = a->in[I_LK1]; const float* q2 = a->in[I_LQ2]; const float* k2 = a->in[I_LK2];
        const float s1 = wave_sum(q1[lane] * k1[lane] + q1[lane + 64] * k1[lane + 64]);
        const float s2 = wave_sum(q2[lane] * k2[lane] + q2[lane + 64] * k2[lane + 64]);
        lam = expf(s1) - expf(s2) + LAMBDA_INIT; }
    const bf16_t* O = (const bf16_t*)(a->ws + WS_O); bf16_t* AO = (bf16_t*)(a->ws + WS_AOUT);
    const f32x4 g = *(const f32x4*)(a->in[I_SUBLN] + 4 * lane);
    u32x2 n1[8], n2[8];
    if (gw < NTOK) { const bf16_t* row = O + (size_t)gw * 4096;
#pragma unroll
        for (int h = 0; h < 8; ++h) { n1[h] = __builtin_nontemporal_load((const u32x2*)(row + h * 512 + 4 * lane)); n2[h] = __builtin_nontemporal_load((const u32x2*)(row + h * 512 + 256 + 4 * lane)); } }
    for (int t = gw; t < NTOK; t += NGW) {
        u32x2 x1[8], x2[8];
#pragma unroll
        for (int h = 0; h < 8; ++h) { x1[h] = n1[h]; x2[h] = n2[h]; }
        if (t + NGW < NTOK) { const bf16_t* row = O + (size_t)(t + NGW) * 4096;
#pragma unroll
            for (int h = 0; h < 8; ++h) { n1[h] = __builtin_nontemporal_load((const u32x2*)(row + h * 512 + 4 * lane)); n2[h] = __builtin_nontemporal_load((const u32x2*)(row + h * 512 + 256 + 4 * lane)); } }
#pragma unroll
        for (int h = 0; h < 8; ++h) {
            f32x4 o;
            o[0] = bf_lo(x1[h].x) - lam * bf_lo(x2[h].x); o[1] = bf_hi(x1[h].x) - lam * bf_hi(x2[h].x);
            o[2] = bf_lo(x1[h].y) - lam * bf_lo(x2[h].y); o[3] = bf_hi(x1[h].y) - lam * bf_hi(x2[h].y);
            const float ss = wave_sum(o[0] * o[0] + o[1] * o[1] + o[2] * o[2] + o[3] * o[3]);
            const float sc = __builtin_amdgcn_rsqf(ss * (1.f / 256.f) + LN_EPS) * (1.f - LAMBDA_INIT);
            if (FP8_OUT0) { const float s8 = sc * AO8_SCALE; *(unsigned*)((unsigned char*)AO + (size_t)t * DM + h * 256 + 4 * lane) = pk4_fp8(o[0] * s8 * g[0], o[1] * s8 * g[1], o[2] * s8 * g[2], o[3] * s8 * g[3]); }
            else { u32x2 w; w.x = cvt_pk_bf16(o[0] * sc * g[0], o[1] * sc * g[1]); w.y = cvt_pk_bf16(o[2] * sc * g[2], o[3] * sc * g[3]);
                *(u32x2*)(AO + (size_t)t * DM + h * 256 + 4 * lane) = w; }
        }
    }
}

__device__ __forceinline__ void moba_kmean(KArgs a, int gw, int NGW, int lane) {
    const bf16_t* Kb = (const bf16_t*)(a->ws + WS_K); bf16_t* km = (bf16_t*)(a->ws + WS_KMEAN);
    for (int it = gw; it < BATCH * NSLAB * 32; it += NGW) {
        const int bh = it >> 5, n = it & 31;
        const bf16_t* p = Kb + ((size_t)bh * SEQ + (size_t)n * 256) * HD + 2 * lane;
        float s0 = 0.f, s1 = 0.f;
#pragma unroll 4
        for (int r = 0; r < 256; r += 8) {
            unsigned u[8];
#pragma unroll
            for (int q = 0; q < 8; ++q) u[q] = *(const unsigned*)(p + (size_t)(r + q) * HD);
#pragma unroll
            for (int q = 0; q < 8; ++q) { s0 += bf_lo(u[q]); s1 += bf_hi(u[q]); }
        }
        s0 *= (1.f / 256.f); s1 *= (1.f / 256.f);
        const unsigned hi = cvt_pk_bf16(s0, s1);
        const unsigned lo = cvt_pk_bf16(s0 - bf_lo(hi), s1 - bf_hi(hi));
        *(unsigned*)(km + ((size_t)bh * 64 + n) * HD + 2 * lane) = hi;
        *(unsigned*)(km + ((size_t)bh * 64 + 32 + n) * HD + 2 * lane) = lo;
    }
}
__device__ __forceinline__ void moba_gate(KArgs a, int gw, int NGW, int lane) {
    const bf16_t* Qb = (const bf16_t*)(a->ws + WS_Q); const bf16_t* km = (const bf16_t*)(a->ws + WS_KMEAN); unsigned* sel = (unsigned*)(a->ws + WS_SEL);
    unsigned* mcnt = (unsigned*)(a->ws + WS_CTL) + CW_MCNT; unsigned* qlist = (unsigned*)(a->ws + WS_QLIST);
    const int r32 = lane & 31, hi = lane >> 5;
    const int per = (BATCH * NSLAB * (SEQ / 32)) / NGW, wpb = 256 / per;
    const int bh = gw / wpb;
    bf16x8 kh[8], kl[8];
    {   const bf16_t* k = km + ((size_t)bh * 64 + r32) * HD + hi * 8;
#pragma unroll
        for (int d0 = 0; d0 < 8; ++d0) { kh[d0] = *(const bf16x8*)(k + d0 * 16); kl[d0] = *(const bf16x8*)(k + 32 * HD + d0 * 16); } }
    for (int i = 0; i < per; ++i) {
        const int qg = (gw - bh * wpb) + wpb * i, j = qg >> 3;
        const bf16_t* q = Qb + ((size_t)bh * SEQ + (size_t)qg * 32 + r32) * HD + hi * 8;
        f32x16 p = {};
        bf16x8 qf[8];
#pragma unroll
        for (int d0 = 0; d0 < 8; ++d0) qf[d0] = *(const bf16x8*)(q + d0 * 16);
        SBAR();
#pragma unroll
        for (int d0 = 0; d0 < 8; ++d0) {
            p = __builtin_amdgcn_mfma_f32_32x32x16_bf16(kh[d0], qf[d0], p, 0, 0, 0);
            p = __builtin_amdgcn_mfma_f32_32x32x16_bf16(kl[d0], qf[d0], p, 0, 0, 0);
        }
        float g[32];
#pragma unroll
        for (int r = 0; r < 16; ++r) {
            const float mine = p[r], other = __shfl_xor(mine, 32);
            const int qd = r >> 2, s = r & 3;
            g[8 * qd + s] = hi ? other : mine;
            g[8 * qd + 4 + s] = hi ? mine : other;
        }
        unsigned mask = 0u;
#pragma unroll
        for (int pass = 0; pass < 3; ++pass) {
            float best = -__builtin_inff(); int bi = -1;
#pragma unroll
            for (int n = 0; n < 32; ++n) { const bool ok = (n < j) && !((mask >> n) & 1u) && (g[n] > best); best = ok ? g[n] : best; bi = ok ? n : bi; }
            if (bi >= 0) mask |= 1u << bi;
        }
        if (hi == 0) sel[(size_t)bh * SEQ + (size_t)qg * 32 + r32] = mask;
        const bool rowlane = hi == 0;
        unsigned cntv = 0u;
        for (int n = 0; n < j; ++n) { const unsigned long long bb = __ballot(rowlane && ((mask >> n) & 1u)); if (lane == n) cntv = (unsigned)__popcll(bb); }
        unsigned basev = 0u;
        if (lane < j && cntv) basev = __hip_atomic_fetch_add(mcnt + bh * 32 + lane, cntv, __ATOMIC_RELAXED, __HIP_MEMORY_SCOPE_AGENT);
        for (int n = 0; n < j; ++n) { const unsigned long long bb = __ballot(rowlane && ((mask >> n) & 1u)); const unsigned base = (unsigned)__builtin_amdgcn_readlane((int)basev, n);
            if (rowlane && ((mask >> n) & 1u)) qlist[(size_t)(bh * 32 + n) * SEQ + base + (unsigned)__popcll(bb & ((1ull << lane) - 1ull))] = (unsigned)(qg * 32 + r32); }
    }
}

__device__ __forceinline__ void ln_router(KArgs a, int layer, LAS unsigned char* lds, int vcu, int G, int wave, int lane) {
    float* out = a->out; bf16_t* xb = (bf16_t*)(a->ws + WS_XB);
    const float* xres = a->in[I_X]; bf16_t* res = (bf16_t*)(a->ws + WS_RES); const bf16_t* br = (const bf16_t*)(a->ws + WS_Q);
    const float* gam = a->in[I_LN1G] + layer * DM; const float* bet = a->in[I_LN1B] + layer * DM;
    const float rb = a->in[I_RB][layer * NE + lane];
    const bf16_t* wfh = (const bf16_t*)(a->ws + WS_WRF) + (size_t)(layer * 2 + 0) * 2 * 128 * 64 * 8;
    const bf16_t* wfl = (const bf16_t*)(a->ws + WS_WRF) + (size_t)(layer * 2 + 1) * 2 * 128 * 64 * 8;
    unsigned* gcount = (unsigned*)(a->ws + WS_CTL) + CW_CNT + layer * NE * 16;
    unsigned* list = (unsigned*)(a->ws + WS_LIST); unsigned* toke = (unsigned*)(a->ws + WS_TOKE); float* tokw = (float*)(a->ws + WS_TOKW);
    LAS unsigned char* xh = lds;
    LAS unsigned char* xl = lds + 65536;
    LAS float* part = (LAS float*)lds;
    LAS int* lcount = (LAS int*)(lds + LT_LCNT); LAS int* lbase = (LAS int*)(lds + LT_LBASE);
    LAS unsigned* ent = (LAS unsigned*)(lds + LT_ENT);
    const int t_beg = vcu * 64;
    if (threadIdx.x < 64) lcount[threadIdx.x] = 0;
    const int n32 = lane & 31, h5 = lane >> 5;
    f32x4 vn[8], gg[8]; u32x2 an[8], rn[8];
    {   const int t4 = threadIdx.x * 4; *(LAS f32x4*)(lds + (t4 < 1024 ? LDSCTL_OFF + 1024 : LDSCTL_OFF + 10240 - 4096) + t4 * 4) = *(const f32x4*)(bet + t4); }
    {   const float* yr = xres + (size_t)(t_beg + wave * 2) * DM; const bf16_t* ar = br + (size_t)(t_beg + wave * 2) * DM; const bf16_t* rr = res + (size_t)(t_beg + wave * 2) * DM;
#pragma unroll
        for (int j = 0; j < 8; ++j) { if (layer == 0) vn[j] = *(const f32x4*)(yr + 256 * j + 4 * lane); else rn[j] = *(const u32x2*)(rr + 256 * j + 4 * lane); an[j] = *(const u32x2*)(ar + 256 * j + 4 * lane); }
#pragma unroll
        for (int j = 0; j < 8; ++j) gg[j] = *(const f32x4*)(gam + 256 * j + 4 * lane); }
    __syncthreads();
#pragma unroll 1
    for (int it = 0; it < 4; ++it) {
#pragma unroll
        for (int k = 0; k < 2; ++k) {
            const int lt = 2 * wave + k, t = t_beg + 16 * it + lt; bf16_t* yr = res + (size_t)t * DM;
            f32x4 v[8]; float s = 0.f;
#pragma unroll
            for (int j = 0; j < 8; ++j) { const f32x4 xr = layer == 0 ? vn[j] : (f32x4){bf_lo(rn[j].x), bf_hi(rn[j].x), bf_lo(rn[j].y), bf_hi(rn[j].y)};
                v[j] = xr * ALPHA + (f32x4){bf_lo(an[j].x), bf_hi(an[j].x), bf_lo(an[j].y), bf_hi(an[j].y)}; s += (v[j][0] + v[j][1]) + (v[j][2] + v[j][3]); }
            {
                const int tn = (k == 0) ? t + 1 : t + 15;
                if (k == 0 || it < 3) { const float* yn = xres + (size_t)tn * DM; const bf16_t* arn = br + (size_t)tn * DM; const bf16_t* rrn = res + (size_t)tn * DM;
#pragma unroll
                    for (int j = 0; j < 8; ++j) { if (layer == 0) vn[j] = *(const f32x4*)(yn + 256 * j + 4 * lane); else rn[j] = *(const u32x2*)(rrn + 256 * j + 4 * lane); an[j] = *(const u32x2*)(arn + 256 * j + 4 * lane); } } }
            const float mean = wave_sum(s) * (1.f / DM); float s2 = 0.f;
#pragma unroll
            for (int j = 0; j < 8; ++j) { v[j] = v[j] - mean; s2 += (v[j][0] * v[j][0] + v[j][1] * v[j][1]) + (v[j][2] * v[j][2] + v[j][3] * v[j][3]); }
            const float rstd = __builtin_amdgcn_rsqf(wave_sum(s2) * (1.f / DM) + LN_EPS);
#pragma unroll
            for (int j = 0; j < 8; ++j) {
                const f32x4 xv = v[j] * rstd * gg[j] + *(const LAS f32x4*)(lds + (j < 4 ? LDSCTL_OFF + 1024 : LDSCTL_OFF + 10240 - 4096) + 1024 * j + 16 * lane);
                u32x2 w; w.x = cvt_pk_bf16(xv[0], xv[1]); w.y = cvt_pk_bf16(xv[2], xv[3]);
                *(u32x2*)(yr + 256 * j + 4 * lane) = w;
                if (MOE_F8(layer)) *(unsigned*)((unsigned char*)xb + (size_t)t * DM + 256 * j + 4 * lane) = pk4_fp8(xv[0], xv[1], xv[2], xv[3]);
                else *(u32x2*)(xb + (size_t)t * DM + 256 * j + 4 * lane) = w;
                u32x2 wl; wl.x = cvt_pk_bf16(xv[0] - bf_lo(w.x), xv[1] - bf_hi(w.x)); wl.y = cvt_pk_bf16(xv[2] - bf_lo(w.y), xv[3] - bf_hi(w.y));
                const int chunk = 32 * j + (lane >> 1), sw = lt * 4096 + ((chunk ^ lt) << 4) + 8 * (lane & 1);
                *(LAS u32x2*)(xh + sw) = w;
                *(LAS u32x2*)(xl + sw) = wl;
            }
        }
        __syncthreads();
        f32x16 acc0 = {}, acc1 = {};
        {
            const int row = n32 & 15;
            const bf16_t* wh0 = wfh + ((size_t)(0 * 128 + wave * 16) * 64 + lane) * 8; const bf16_t* wh1 = wfh + ((size_t)(1 * 128 + wave * 16) * 64 + lane) * 8;
            const bf16_t* wl0 = wfl + ((size_t)(0 * 128 + wave * 16) * 64 + lane) * 8; const bf16_t* wl1 = wfl + ((size_t)(1 * 128 + wave * 16) * 64 + lane) * 8;
#pragma unroll 1
            for (int sg = 0; sg < 16; sg += 4) {
                bf16x8 ah0[4], ah1[4], al0[4], al1[4];
#pragma unroll
                for (int u = 0; u < 4; ++u) { const int s = sg + u; ah0[u] = *(const bf16x8*)(wh0 + s * 512); ah1[u] = *(const bf16x8*)(wh1 + s * 512); al0[u] = *(const bf16x8*)(wl0 + s * 512); al1[u] = *(const bf16x8*)(wl1 + s * 512); }
                SBAR();
#pragma unroll
                for (int u = 0; u < 4; ++u) { const int s = sg + u;
                    const int off = row * 4096 + (((wave * 32 + 2 * s + h5) ^ row) << 4);
                    const bf16x8 bh = *(const LAS bf16x8*)(xh + off), bl = *(const LAS bf16x8*)(xl + off);
                    acc0 = __builtin_amdgcn_mfma_f32_32x32x16_bf16(ah0[u], bh, acc0, 0, 0, 0); acc1 = __builtin_amdgcn_mfma_f32_32x32x16_bf16(ah1[u], bh, acc1, 0, 0, 0);
                    acc0 = __builtin_amdgcn_mfma_f32_32x32x16_bf16(ah0[u], bl, acc0, 0, 0, 0); acc1 = __builtin_amdgcn_mfma_f32_32x32x16_bf16(ah1[u], bl, acc1, 0, 0, 0);
                    acc0 = __builtin_amdgcn_mfma_f32_32x32x16_bf16(al0[u], bh, acc0, 0, 0, 0); acc1 = __builtin_amdgcn_mfma_f32_32x32x16_bf16(al1[u], bh, acc1, 0, 0, 0); }
                SBAR();
            }
        }
        __syncthreads();
        if (n32 < 16) {
#pragma unroll
            for (int i = 0; i < 16; ++i) { const int e = (i & 3) + 8 * (i >> 2) + 4 * h5; part[(wave * 16 + n32) * 64 + e] = acc0[i]; part[(wave * 16 + n32) * 64 + 32 + e] = acc1[i]; }
        }
        __syncthreads();
#pragma unroll 1
        for (int k = 0; k < 2; ++k) {
            const int lt = 2 * wave + k, ti = 16 * it + lt;
            float logit = 0.f;
#pragma unroll
            for (int w = 0; w < 8; ++w) logit += part[(w * 16 + lt) * 64 + lane];
            const float sc = 1.f / (1.f + expf(-logit));
            const float bs = sc + rb;
            float m1 = bs;
            m1 = fmaxf(m1, dpp_mov<0xB1>(m1)); m1 = fmaxf(m1, dpp_mov<0x4E>(m1)); m1 = fmaxf(m1, dpp_mov<0x141>(m1));
            const unsigned long long eq = __ballot(bs == m1);
            const int gbase = lane & ~7;
            const int first = gbase + __builtin_ctz((unsigned)((eq >> gbase) & 0xffu));
            float m2 = (lane == first) ? -__builtin_inff() : bs;
            m2 = fmaxf(m2, dpp_mov<0xB1>(m2)); m2 = fmaxf(m2, dpp_mov<0x4E>(m2)); m2 = fmaxf(m2, dpp_mov<0x141>(m2));
            const float gs = m1 + m2; const int grp = lane >> 3;
            int grank = 0;
#pragma unroll
            for (int g2 = 0; g2 < 8; ++g2) { const float v = __int_as_float(__builtin_amdgcn_readlane(__float_as_int(gs), g2 * 8)); grank += (v > gs || (v == gs && g2 < grp)) ? 1 : 0; }
            const float masked = (grank < 4) ? bs : -__builtin_inff();
            int rank = 0;
#pragma unroll 8
            for (int e2 = 0; e2 < 64; ++e2) { const float v = __int_as_float(__builtin_amdgcn_readlane(__float_as_int(masked), e2)); rank += (v > masked || (v == masked && e2 < lane)) ? 1 : 0; }
            const bool selk = rank < 8;
            const float wsum = wave_sum(selk ? sc : 0.f);
            if (selk) {
                const int lp = __hip_atomic_fetch_add(lcount + lane, 1, __ATOMIC_RELAXED, __HIP_MEMORY_SCOPE_WORKGROUP);
                ent[(ti * 8 + rank) * 2] = ((unsigned)lane << 20) | (unsigned)lp;
                ((LAS float*)ent)[(ti * 8 + rank) * 2 + 1] = sc / wsum * ROUTED_SCALE;
            }
        }
        __syncthreads();
    }
    if (threadIdx.x < 64) { const int n = lcount[threadIdx.x]; lbase[threadIdx.x] = n > 0 ? (int)__hip_atomic_fetch_add(gcount + threadIdx.x * 16, (unsigned)n, __ATOMIC_RELAXED, __HIP_MEMORY_SCOPE_AGENT) : 0; }
    __syncthreads();
    for (int i = threadIdx.x; i < 64 * 8; i += NWAVES * 64) {
        const unsigned ep = ent[i * 2]; const float w = ((LAS float*)ent)[i * 2 + 1];
        const int e = ep >> 20, pos = lbase[e] + (int)(ep & 0xfffffu), t = t_beg + (i >> 3);
        list[(size_t)e * NTOK + pos] = (unsigned)t;
        toke[(size_t)t * 8 + (i & 7)] = ((unsigned)e << 20) | (unsigned)pos;
        tokw[(size_t)t * 8 + (i & 7)] = w;
    }
    __syncthreads();
}

__device__ __forceinline__ int moe_tables(KArgs a, int layer, LAS unsigned char* lds) {
    const unsigned* gcount = (const unsigned*)(a->ws + WS_CTL) + CW_CNT + layer * NE * 16;
    LAS int* P = (LAS int*)(lds + LT_P); LAS int* cnt = (LAS int*)(lds + LT_CNT); LAS int* tile_e = (LAS int*)(lds + LT_TILE);
    __syncthreads();
    if (threadIdx.x < NEX) cnt[threadIdx.x] = (threadIdx.x < NE) ? (int)__hip_atomic_load(gcount + threadIdx.x * 16, __ATOMIC_RELAXED, __HIP_MEMORY_SCOPE_AGENT) : NTOK;
    __syncthreads();
    if (threadIdx.x < 64) {
        const int ln = threadIdx.x, t = (cnt[ln] + 255) >> 8; int incl = t;
#pragma unroll
        for (int off = 1; off < 64; off <<= 1) { const int o = __shfl_up(incl, off); if (ln >= off) incl += o; }
        P[ln] = incl - t;
        if (ln == 63) { P[NE] = incl; P[NEX] = incl + ((cnt[NE] + 255) >> 8); }
    }
    __syncthreads();
    if (threadIdx.x < NEX) { const int e = threadIdx.x; for (int t = P[e]; t < P[e + 1]; ++t) tile_e[t] = e; }
    __syncthreads();
    return P[NEX];
}

__device__ __forceinline__ void moe_combine(KArgs a, int layer, LAS unsigned char* lds, int gw, int NGW, int lane) {
    float* out = a->out; bf16_t* xb = (bf16_t*)(a->ws + WS_XB); const bf16_t* Y = (const bf16_t*)(a->ws + WS_Y); bf16_t* res = (bf16_t*)(a->ws + WS_RES);
    const unsigned* toke = (const unsigned*)(a->ws + WS_TOKE); const float* tokw = (const float*)(a->ws + WS_TOKW);
    const float* gam = a->in[I_LN2G] + layer * DM; const float* bet = a->in[I_LN2B] + layer * DM;
    const LAS int* P = (const LAS int*)(lds + LT_P);
    const int sh_base = P[NE] * 256;
    unsigned epn = 0u; float wn = 0.f;
    if (gw < NTOK && lane < 8) { epn = toke[(size_t)gw * 8 + lane]; wn = tokw[(size_t)gw * 8 + lane]; }
    for (int t = gw; t < NTOK; t += NGW) {
        const unsigned ep = epn; float w = wn;
        if (t + NGW < NTOK && lane < 8) { epn = toke[(size_t)(t + NGW) * 8 + lane]; wn = tokw[(size_t)(t + NGW) * 8 + lane]; }
        int slot = P[ep >> 20] * 256 + (int)(ep & 0xfffffu);
        if (lane == 8) { slot = sh_base + t; w = 1.f; }
        f32x4 acc[8]; u32x4 y[9][4]; float wk[9];
#pragma unroll
        for (int j = 0; j < 4; ++j) { const u32x4 r = *(const u32x4*)(res + (size_t)t * DM + 512 * j + 8 * lane);
            acc[2 * j] = (f32x4){bf_lo(r.x), bf_hi(r.x), bf_lo(r.y), bf_hi(r.y)}; acc[2 * j + 1] = (f32x4){bf_lo(r.z), bf_hi(r.z), bf_lo(r.w), bf_hi(r.w)}; }
        const bool y8 = MOE_Y8(layer);
#pragma unroll
        for (int q = 0; q < 9; ++q) { const int sl = __builtin_amdgcn_readlane(slot, q); wk[q] = __int_as_float(__builtin_amdgcn_readlane(__float_as_int(w), q)) * (y8 ? Y8_INV : 1.f);
#pragma unroll
            for (int j = 0; j < 4; ++j) {
                if (y8) { const u32x2 t2 = __builtin_nontemporal_load((const u32x2*)((const unsigned char*)Y + (size_t)sl * DM + 512 * j + 8 * lane)); y[q][j] = (u32x4){t2.x, t2.y, 0u, 0u}; }
                else y[q][j] = __builtin_nontemporal_load((const u32x4*)(Y + (size_t)sl * DM + 512 * j + 8 * lane)); } }
#pragma unroll
        for (int j = 0; j < 8; ++j) acc[j] = acc[j] * ALPHA;
#pragma unroll
        for (int q = 0; q < 9; ++q)
#pragma unroll
            for (int j = 0; j < 4; ++j) {
                if (y8) {
                    const f32x2 a0 = __builtin_amdgcn_cvt_pk_f32_fp8((int)y[q][j].x, false), a1 = __builtin_amdgcn_cvt_pk_f32_fp8((int)y[q][j].x, true);
                    const f32x2 b0 = __builtin_amdgcn_cvt_pk_f32_fp8((int)y[q][j].y, false), b1 = __builtin_amdgcn_cvt_pk_f32_fp8((int)y[q][j].y, true);
                    acc[2 * j][0] += wk[q] * a0[0]; acc[2 * j][1] += wk[q] * a0[1]; acc[2 * j][2] += wk[q] * a1[0]; acc[2 * j][3] += wk[q] * a1[1];
                    acc[2 * j + 1][0] += wk[q] * b0[0]; acc[2 * j + 1][1] += wk[q] * b0[1]; acc[2 * j + 1][2] += wk[q] * b1[0]; acc[2 * j + 1][3] += wk[q] * b1[1];
                } else {
                acc[2 * j][0] += wk[q] * bf_lo(y[q][j].x); acc[2 * j][1] += wk[q] * bf_hi(y[q][j].x); acc[2 * j][2] += wk[q] * bf_lo(y[q][j].y); acc[2 * j][3] += wk[q] * bf_hi(y[q][j].y);
                acc[2 * j + 1][0] += wk[q] * bf_lo(y[q][j].z); acc[2 * j + 1][1] += wk[q] * bf_hi(y[q][j].z); acc[2 * j + 1][2] += wk[q] * bf_lo(y[q][j].w); acc[2 * j + 1][3] += wk[q] * bf_hi(y[q][j].w);
                }
            }
        float s = 0.f;
#pragma unroll
        for (int j = 0; j < 8; ++j) s += (acc[j][0] + acc[j][1]) + (acc[j][2] + acc[j][3]);
        const float mean = wave_sum(s) * (1.f / DM); float s2 = 0.f;
#pragma unroll
        for (int j = 0; j < 8; ++j) { acc[j] = acc[j] - mean; s2 += (acc[j][0] * acc[j][0] + acc[j][1] * acc[j][1]) + (acc[j][2] * acc[j][2] + acc[j][3] * acc[j][3]); }
        const float rstd = __builtin_amdgcn_rsqf(wave_sum(s2) * (1.f / DM) + LN_EPS);
#pragma unroll
        for (int j = 0; j < 4; ++j) {
            const int c = 512 * j + 8 * lane;
            const f32x4 x0 = acc[2 * j] * rstd * *(const f32x4*)(gam + c) + *(const f32x4*)(bet + c);
            const f32x4 x1 = acc[2 * j + 1] * rstd * *(const f32x4*)(gam + c + 4) + *(const f32x4*)(bet + c + 4);
            if (layer == 1) { *(f32x4*)(out + (size_t)t * DM + c) = x0; *(f32x4*)(out + (size_t)t * DM + c + 4) = x1; }
            else { u32x4 rv; rv.x = cvt_pk_bf16(x0[0], x0[1]); rv.y = cvt_pk_bf16(x0[2], x0[3]); rv.z = cvt_pk_bf16(x1[0], x1[1]); rv.w = cvt_pk_bf16(x1[2], x1[3]); *(u32x4*)(res + (size_t)t * DM + c) = rv; }
            if (layer == 0) {
                if (FP8_QKV1) { u32x2 wv; wv.x = pk4_fp8(x0[0], x0[1], x0[2], x0[3]); wv.y = pk4_fp8(x1[0], x1[1], x1[2], x1[3]); *(u32x2*)((unsigned char*)xb + (size_t)t * DM + c) = wv; }
                else { u32x4 wv; wv.x = cvt_pk_bf16(x0[0], x0[1]); wv.y = cvt_pk_bf16(x0[2], x0[3]); wv.z = cvt_pk_bf16(x1[0], x1[1]); wv.w = cvt_pk_bf16(x1[2], x1[3]);
                    *(u32x4*)(xb + (size_t)t * DM + c) = wv; } }
        }
    }
}

__device__ __forceinline__ void attn_ref(KArgs a, int L, int pass, att::BlockRef& r) {
    const int xcd = L & 7, k = L >> 3, vh = xcd * 8 + (k >> 4), x = k & 15;
    const int qb = pass ? 31 - x : x;
    const bf16_t* Q = (const bf16_t*)(a->ws + WS_Q); const bf16_t* K = (const bf16_t*)(a->ws + WS_K); const bf16_t* V = (const bf16_t*)(a->ws + WS_V);
    r.P0 = qb * 256;
    const int half = vh & 1, bm = vh >> 1, b = bm >> 4, m = bm & 15;
    r.Q = Q + ((size_t)bm * SEQ + r.P0) * HD; r.K = K + (size_t)bm * SEQ * HD;
    r.V = V + (size_t)(b * NSLAB + (m >> 1) * 2 + half) * SEQ * HD;
    r.O = (bf16_t*)(a->ws + WS_O) + ((size_t)b * SEQ + r.P0) * 4096 + (m * 2 + half) * HD;
    r.sel = nullptr; r.list = nullptr; r.ML = nullptr; r.jlo = 0; r.nvalid = 256; r.nblk = 0; r.hb = 0;
}
__device__ __forceinline__ void attn_phase_da(KArgs a, char* lds, int G) {
    constexpr int total = 64 * 16;
    const int conv_slot = (int)(blockIdx.x & 3u);
    int L = blockIdx.x; if (L >= total) return;
    int pass = 0, item = 0; att::BlockRef cur, nxt; attn_ref(a, L, 0, cur);
    att::Seam S;
    att::attn_prime<false>(cur, lds, S);
    for (;;) {
        if (pass == 0) {
            if (conv_slot == item) {
                const int tid0 = otid(); const Geo cg = geo();
                convert_items(a, (LAS float*)((LAS unsigned char*)lds + att::ATT_LDS + __builtin_amdgcn_readfirstlane(tid0 >> 6) * 4224), cg.gw, cg.NGW, tid0 & 63, IT_IN, IT_TOTAL);
            }
            ++item;
        }
        const bool more_pass = pass == 0, more_item = L + G < total, last = !more_pass && !more_item;
        int passn = pass + 1, Ln = L;
        if (!more_pass) { passn = 0; Ln = more_item ? L + G : L; }
        if (last) nxt = cur; else attn_ref(a, Ln, passn, nxt);
        att::attn_block<false>(cur, nxt, 4096, lds, S);
        if (last) break;
        cur = nxt; pass = passn; L = Ln;
    }
}
__device__ __forceinline__ void moba_ref(KArgs a, LAS unsigned char* lds, int B, att::BlockRef& r) {
    const LAS int* PB = (const LAS int*)(lds + LT_PB); const LAS int* MC = (const LAS int*)(lds + LT_MC);
    int lo = 0, hi = 1024;
    while (hi - lo > 1) { const int mid = (lo + hi) >> 1; if (PB[mid] <= B) lo = mid; else hi = mid; }
    const int id = lo, bh = id >> 5, n = id & 31, c = B - PB[id];
    r.Q = (const bf16_t*)(a->ws + WS_Q) + (size_t)bh * SEQ * HD; r.K = (const bf16_t*)(a->ws + WS_K) + (size_t)bh * SEQ * HD; r.V = (const bf16_t*)(a->ws + WS_V) + (size_t)bh * SEQ * HD;
    r.O = (bf16_t*)(a->ws + WS_OP); r.ML = (float*)(a->ws + WS_ML); r.sel = (const unsigned*)(a->ws + WS_SEL) + (size_t)bh * SEQ;
    r.hb = bh * SEQ; r.jlo = 4 * n; r.nblk = n; r.P0 = n * 256;
    if (c == 0) { r.list = nullptr; r.nvalid = 256; }
    else { r.list = (const unsigned*)(a->ws + WS_QLIST) + (size_t)id * SEQ + (size_t)(c - 1) * 256; const int rem = MC[id] - (c - 1) * 256; r.nvalid = rem < 256 ? rem : 256; }
}
__device__ __forceinline__ void attn_phase_moba(KArgs a, LAS unsigned char* lds, char* lds_gen, int G) {
    LAS int* MC = (LAS int*)(lds + LT_MC); LAS int* PB = (LAS int*)(lds + LT_PB); LAS int* SC = (LAS int*)(lds + LT_SC);
    const unsigned* mcnt = (const unsigned*)(a->ws + WS_CTL) + CW_MCNT;
    const int t = threadIdx.x;
    __syncthreads();
    const int c0 = (int)__hip_atomic_load(mcnt + 2 * t, __ATOMIC_RELAXED, __HIP_MEMORY_SCOPE_AGENT), c1 = (int)__hip_atomic_load(mcnt + 2 * t + 1, __ATOMIC_RELAXED, __HIP_MEMORY_SCOPE_AGENT);
    MC[2 * t] = c0; MC[2 * t + 1] = c1;
    const int s0 = 1 + ((c0 + 255) >> 8), s1 = s0 + 1 + ((c1 + 255) >> 8);
    SC[t] = s1;
    __syncthreads();
    for (int off = 1; off < 512; off <<= 1) { const int v = SC[t] + (t >= off ? SC[t - off] : 0); __syncthreads(); SC[t] = v; __syncthreads(); }
    const int excl = t > 0 ? SC[t - 1] : 0;
    PB[2 * t] = excl; PB[2 * t + 1] = excl + s0; if (t == 511) PB[1024] = SC[511];
    __syncthreads();
    const int NB = PB[1024];
    int B = blockIdx.x; if (B >= NB) return;
    att::BlockRef cur, nxt; moba_ref(a, lds, B, cur);
    att::Seam S;
    att::attn_prime<true>(cur, lds_gen, S);
    for (;;) {
        const int Bn = B + G; const bool last = Bn >= NB;
        if (last) nxt = cur; else moba_ref(a, lds, Bn, nxt);
        att::attn_block<true>(cur, nxt, 0, lds_gen, S);
        if (last) break;
        cur = nxt; B = Bn;
    }
}
__device__ __forceinline__ void moba_kv_phase(KArgs a, LAS unsigned char* lds, char* lds_gen) {
    using namespace att;
    LAS int* PB = (LAS int*)(lds + LDSCTL_OFF + 1024); LAS int* MC = (LAS int*)(lds + LDSCTL_OFF + 5632); LAS int* SC = (LAS int*)lds;
    volatile LAS int* QW = (volatile LAS int*)(lds + LDSCTL_OFF + 14400);
    const unsigned* mcnt = (const unsigned*)(a->ws + WS_CTL) + CW_MCNT; unsigned* sq = (unsigned*)(a->ws + WS_CTL) + CW_SQ;
    int tid = threadIdx.x; asm volatile("" : "+v"(tid));
    const int wid = __builtin_amdgcn_readfirstlane(tid >> 6), lane = tid & 63, r32 = lane & 31, hi = lane >> 5;
    __syncthreads();
    {   const int c0 = (int)__hip_atomic_load(mcnt + 2 * tid, __ATOMIC_RELAXED, __HIP_MEMORY_SCOPE_AGENT), c1 = (int)__hip_atomic_load(mcnt + 2 * tid + 1, __ATOMIC_RELAXED, __HIP_MEMORY_SCOPE_AGENT);
        MC[2 * tid] = c0; MC[2 * tid + 1] = c1;
        const int s0 = (8 + ((c0 + 31) >> 5) + 31) >> 5, s1 = s0 + ((8 + ((c1 + 31) >> 5) + 31) >> 5);
        SC[tid] = s1;
        __syncthreads();
        for (int off = 1; off < 512; off <<= 1) { const int v = SC[tid] + (tid >= off ? SC[tid - off] : 0); __syncthreads(); SC[tid] = v; __syncthreads(); }
        const int excl = tid > 0 ? SC[tid - 1] : 0;
        PB[2 * tid] = excl; PB[2 * tid + 1] = excl + s0; if (tid == 511) PB[1024] = SC[511];
        __syncthreads(); }
    const int NP = PB[1024];
    char* V_lds = lds_gen; char* K_lds = lds_gen + 65536;
    float* ws = (float*)(lds_gen + LDSCTL_OFF + 10240) + wid * 128; float* li_l = ws, * al_l = ws + 32; unsigned* rd = (unsigned*)(ws + 64);
    const int vb0 = (int)(uintptr_t)V_lds + v_rd_base(lane);
    const bf16_t* Qb = (const bf16_t*)(a->ws + WS_Q); const bf16_t* Kb = (const bf16_t*)(a->ws + WS_K); const bf16_t* Vb = (const bf16_t*)(a->ws + WS_V);
    const unsigned* selb = (const unsigned*)(a->ws + WS_SEL); const unsigned* qlb = (const unsigned*)(a->ws + WS_QLIST);
    bf16_t* OPb = (bf16_t*)(a->ws + WS_OP); float* MLb = (float*)(a->ws + WS_ML);
    for (;;) {
        if (tid == 0) *QW = (int)__hip_atomic_fetch_add(sq, 1u, __ATOMIC_RELAXED, __HIP_MEMORY_SCOPE_AGENT);
        __syncthreads();
        const int I = *QW;
        if (I >= NP) break;
        int lo = 0, hb = 1024;
        while (hb - lo > 1) { const int mid = (lo + hb) >> 1; if (PB[mid] <= I) lo = mid; else hb = mid; }
        const int id = lo, bh = id >> 5, n = id & 31, part = I - PB[id], cnt = MC[id];
        {
            const bf16_t* Kh = Kb + ((size_t)bh * SEQ + (size_t)n * 256) * HD; const bf16_t* Vh = Vb + ((size_t)bh * SEQ + (size_t)n * 256) * HD;
            int ts_ = tid; asm volatile("" : "+v"(ts_)); const int sr = ts_ >> 4, sc = (ts_ & 15) * 8;
            bf16x8 kv[8], vv[8];
#pragma unroll
            for (int i = 0; i < 8; ++i) { kv[i] = load8(Kh + (size_t)(sr + 32 * i) * HD + sc); vv[i] = load8(Vh + (size_t)(sr + 32 * i) * HD + sc); }
#pragma unroll
            for (int i = 0; i < 8; ++i) { const int tl = i >> 1, row = sr + 32 * (i & 1);
                *(bf16x8*)(K_lds + tl * SHM_K + KSWZ(row, sc * 2)) = kv[i]; *(bf16x8*)(V_lds + tl * SHM_V + v_st(row, sc)) = vv[i]; }
        }
        __syncthreads();
        const int nch = 8 + ((cnt + 31) >> 5), c_beg = 32 * part, c_end = (c_beg + 32 < nch) ? c_beg + 32 : nch;
#pragma unroll 1
        for (int cg = c_beg + wid; cg < c_end; cg += 8) {
            const bool own = cg < 8;
            const int li0 = (cg - 8) * 32 + r32;
            unsigned q; if (own) q = (unsigned)(n * 256 + cg * 32 + r32); else q = qlb[(size_t)id * SEQ + (li0 < cnt ? li0 : cnt - 1)];
            const bool valid = own || (li0 < cnt);
            unsigned slot = 3u; if (!own) slot = (unsigned)__builtin_popcount(selb[(size_t)bh * SEQ + q] & ((1u << n) - 1u));
            bf16x8 qr[8];
#pragma unroll
            for (int d0 = 0; d0 < 8; ++d0) qr[d0] = load8(Qb + ((size_t)bh * SEQ + q) * HD + d0 * 16 + hi * 8);
            if (hi == 0) rd[r32] = valid ? (((unsigned)(bh * SEQ) + q) * 4u + slot) * 128u : (1u << 27);
            const int NTu = own ? ((cg * 32 + 31) >> 6) + 1 : 4;
            const int qlo = n * 256 + cg * 32, qm = qlo + r32 - 4 * hi;
            float m_reg = -1e30f, l_reg = 0.f; f32x16 o[4] = {};
            f32x16 pA0, pA1, pB0, pB1; float mnA, mnB, alA, alB; bf16x8 pa0, pa1, pa2, pa3;
#define KV_MASK(P0, P1, t_) do { if (own) { const int kb_ = n * 256 + (t_) * KVBLK; if (kb_ + KVBLK - 1 > qlo) mask_tile(P0, P1, qm - kb_, 0x40000000u); } } while (0)
#define KV_RESC(al) do { if (__any((al) < 1.f)) { if (hi == 0) al_l[r32] = (al); asm volatile("s_waitcnt lgkmcnt(0)" ::: "memory");          \
                    for (int d_ = 0; d_ < 4; ++d_) for (int r = 0; r < 16; ++r) o[d_][r] *= al_l[crow(r, hi)]; } } while (0)
#define KV_HALF(PX0, PX1, mnX, alX, PY0, PY1, alY, t_) do {                                                                              \
                SBAR(); qkt<0>(PX0, PX1, K_lds + (t_) * SHM_K, r32, hi, qr); finishSM(PY0, PY1, alY, l_reg, pa0, pa1, pa2, pa3); SBAR();    \
                pv_tile<0>(o, vb0 + ((t_) - 1) * SHM_V, pa0, pa1, pa2, pa3); KV_MASK(PX0, PX1, t_); partialSM(PX0, PX1, m_reg, mnX, alX); SBAR(); \
                KV_RESC(alX); } while (0)
            qkt<0>(pA0, pA1, K_lds, r32, hi, qr); KV_MASK(pA0, pA1, 0); partialSM(pA0, pA1, m_reg, mnA, alA); KV_RESC(alA);
            if (NTu > 2) { KV_HALF(pB0, pB1, mnB, alB, pA0, pA1, alA, 1); KV_HALF(pA0, pA1, mnA, alA, pB0, pB1, alB, 2); }
            const bool even = (NTu & 1) == 0;
            if (even) { SBAR(); qkt<0>(pB0, pB1, K_lds + (NTu - 1) * SHM_K, r32, hi, qr); SBAR(); }
            finishSM(pA0, pA1, alA, l_reg, pa0, pa1, pa2, pa3); SBAR();
            pv_tile<0>(o, vb0 + (even ? NTu - 2 : NTu - 1) * SHM_V, pa0, pa1, pa2, pa3);
            if (even) { KV_MASK(pB0, pB1, NTu - 1); partialSM(pB0, pB1, m_reg, mnB, alB); KV_RESC(alB);
                finishSM(pB0, pB1, alB, l_reg, pa0, pa1, pa2, pa3); SBAR(); pv_tile<0>(o, vb0 + (NTu - 1) * SHM_V, pa0, pa1, pa2, pa3); }
#undef KV_MASK
#undef KV_RESC
#undef KV_HALF
            if (hi == 0) li_l[r32] = l_reg; asm volatile("s_waitcnt lgkmcnt(0)" ::: "memory");
            float rli[16];
#pragma unroll
            for (int r = 0; r < 16; ++r) rli[r] = __builtin_amdgcn_rcpf(li_l[crow(r, hi)]);
#pragma unroll
            for (int d0 = 0; d0 < 4; ++d0) {
                LAS unsigned char* osw = lds + LDS_OSCR + wid * 2048; const LAS unsigned* rdl = (const LAS unsigned*)(lds + LDSCTL_OFF + 10240) + wid * 128 + 64;
#pragma unroll
                for (int r = 0; r < 16; ++r) { const float v = o[d0][r] * rli[r];
                    const float vn = __int_as_float(__builtin_amdgcn_mov_dpp(__float_as_int(v), 0xB1, 0xF, 0xF, true));
                    if ((r32 & 1) == 0) *(LAS unsigned*)(osw + crow(r, hi) * 64 + r32 * 2) = cvt_pk_bf16(v, vn); }
#pragma unroll
                for (int i = 0; i < 2; ++i) { const int s = lane + 64 * i, row = s >> 2, seg = s & 3;
                    const u32x4 w = *(const LAS u32x4*)(osw + row * 64 + seg * 16); const unsigned off = rdl[row];
                    *(u32x4*)(OPb + (size_t)off + d0 * 32 + seg * 8) = w; } }
            if (hi == 0) { float* mlp = MLb + (size_t)(rd[r32] >> 7) * 2; f32x2 ml = {m_reg, l_reg}; *(f32x2*)mlp = ml; }
        }
    }
}
__device__ __forceinline__ void moba_merge(KArgs a, int gw, int NGW, int lane) {
    const bf16_t* OP = (const bf16_t*)(a->ws + WS_OP); const float* ML = (const float*)(a->ws + WS_ML); const unsigned* sel = (const unsigned*)(a->ws + WS_SEL);
    bf16_t* AO = (bf16_t*)(a->ws + WS_AOUT);
    constexpr float C2 = 1.4426950408889634f * att::SCALE;
    const int h = lane >> 2, part = lane & 3;
    for (int t = gw; t < NTOK; t += NGW) {
        const int b = t >> 13, s = t & (SEQ - 1), bh = b * NSLAB + h;
        const size_t base = ((size_t)bh * SEQ + s) * 4;
        const int nsel = __builtin_popcount(sel[(size_t)bh * SEQ + s]);
        f32x2 ml[4]; u32x4 ov[4][4];
#pragma unroll
        for (int k = 0; k < 4; ++k) { ml[k] = *(const f32x2*)(ML + (base + k) * 2);
#pragma unroll
            for (int j = 0; j < 4; ++j) ov[k][j] = *(const u32x4*)(OP + (base + k) * 128 + part * 32 + j * 8); }
        float M = ml[3][0];
#pragma unroll
        for (int k = 0; k < 3; ++k) M = (k < nsel) ? fmaxf(M, ml[k][0]) : M;
        float w[4], W = 0.f;
#pragma unroll
        for (int k = 0; k < 4; ++k) { const bool valid = (k == 3) || (k < nsel); w[k] = valid ? ml[k][1] * __builtin_amdgcn_exp2f((ml[k][0] - M) * C2) : 0.f; W += w[k]; }
        const float rW = 1.f / W;
        float acc[32];
#pragma unroll
        for (int i = 0; i < 32; ++i) acc[i] = 0.f;
#pragma unroll
        for (int k = 0; k < 4; ++k) { const bool valid = (k == 3) || (k < nsel); const float wk = w[k] * rW;
#pragma unroll
            for (int j = 0; j < 4; ++j) { const u32x4 u = ov[k][j];
                acc[8 * j + 0] += valid ? wk * bf_lo(u.x) : 0.f; acc[8 * j + 1] += valid ? wk * bf_hi(u.x) : 0.f; acc[8 * j + 2] += valid ? wk * bf_lo(u.y) : 0.f; acc[8 * j + 3] += valid ? wk * bf_hi(u.y) : 0.f;
                acc[8 * j + 4] += valid ? wk * bf_lo(u.z) : 0.f; acc[8 * j + 5] += valid ? wk * bf_hi(u.z) : 0.f; acc[8 * j + 6] += valid ? wk * bf_lo(u.w) : 0.f; acc[8 * j + 7] += valid ? wk * bf_hi(u.w) : 0.f; } }
#pragma unroll
        for (int j = 0; j < 4; ++j) {
            if (FP8_OUT1) { u32x2 o; o.x = pk4_fp8(acc[8 * j] * AO8_SCALE, acc[8 * j + 1] * AO8_SCALE, acc[8 * j + 2] * AO8_SCALE, acc[8 * j + 3] * AO8_SCALE); o.y = pk4_fp8(acc[8 * j + 4] * AO8_SCALE, acc[8 * j + 5] * AO8_SCALE, acc[8 * j + 6] * AO8_SCALE, acc[8 * j + 7] * AO8_SCALE);
                *(u32x2*)((unsigned char*)AO + (size_t)t * DM + h * HD + part * 32 + j * 8) = o; }
            else { u32x4 o; o.x = cvt_pk_bf16(acc[8 * j], acc[8 * j + 1]); o.y = cvt_pk_bf16(acc[8 * j + 2], acc[8 * j + 3]); o.z = cvt_pk_bf16(acc[8 * j + 4], acc[8 * j + 5]); o.w = cvt_pk_bf16(acc[8 * j + 6], acc[8 * j + 7]);
                *(u32x4*)(AO + (size_t)t * DM + h * HD + part * 32 + j * 8) = o; } }
    }
}

#ifndef PHMASK
#define PHMASK 0x7ffff
#endif
#define IN(k) (((PHMASK >> (k)) & 1) && lo <= (k) && (k) < hi)
#define SEAM(k) do { if (IN(k) && IN((k) + 1)) xcd_barrier(bar); } while (0)
template <int LAYER>
__device__ __forceinline__ void layer_program(LAS unsigned char* lds, unsigned char* lds_gen, const XcdBarrier& bar, const int lo, const int hi) {
    constexpr int pb = LAYER == 0 ? 1 : 9;
    constexpr int po = LAYER == 0 ? 4 : 14;
    if (IN(pb)) {
        KArgs ka = kargs(); unsigned char* ws = ka->ws;
        constexpr bool F8 = LAYER == 0 ? (bool)FP8_QKV0 : (bool)FP8_QKV1; constexpr int Kb = F8 ? DM : DM * 2;
        pg8::SchedDense S; S.init(ws + WS_XB, ws + WS_WATT + (LAYER == 0 ? 0 : 32 * MiB), NTOK, NQKV, Kb, gridDim.x, blockIdx.x);
        constexpr bool KM = LAYER == 1;
        pg8::EpiQKV<KM> E{(bf16_t*)(ws + WS_Q), (const float*)(ws + WS_ROPE), F8 ? W8_INV : 1.f};
        pg8::gemm_phase<pg8::EpiQKV<KM>, pg8::SchedDense, F8>(lds, Kb, S, E);
    }
    SEAM(pb);
    if (LAYER == 0) {
        if (IN(2)) { KArgs ka = kargs();
            if (__builtin_amdgcn_readfirstlane(threadIdx.x) >= 256) __builtin_amdgcn_s_setprio(1);
            attn_phase_da(ka, (char*)lds_gen, gridDim.x);
            __builtin_amdgcn_s_setprio(0); }
        SEAM(2);
        if (IN(3)) { KArgs ka = kargs(); const Geo g = geo(); da_combine(ka, g.gw, g.NGW, otid() & 63); }
        SEAM(3);
    } else {
        if (IN(11)) { KArgs ka = kargs(); const Geo g = geo(); moba_gate(ka, g.gw, g.NGW, otid() & 63); }
        SEAM(11);
        if (IN(12)) { KArgs ka = kargs();
            if (__builtin_amdgcn_readfirstlane(threadIdx.x) >= 256) __builtin_amdgcn_s_setprio(1);
            moba_kv_phase(ka, lds, (char*)lds_gen);
            __builtin_amdgcn_s_setprio(0); }
        SEAM(12);
        if (IN(13)) { KArgs ka = kargs(); const Geo g = geo(); moba_merge(ka, g.gw, g.NGW, otid() & 63); }
        SEAM(13);
    }
    if (IN(po)) {
        KArgs ka = kargs(); unsigned char* ws = ka->ws;
        constexpr bool F8 = LAYER == 0 ? (bool)FP8_OUT0 : (bool)FP8_OUT1; constexpr int Kb = F8 ? DM : DM * 2;
        pg8::SchedDense S; S.init(ws + WS_AOUT, ws + WS_WATT + (LAYER == 0 ? 24 * MiB : 56 * MiB), NTOK, DM, Kb, gridDim.x, blockIdx.x);
        pg8::EpiY<false> E{(bf16_t*)(ws + WS_Q), F8 ? W8_INV * AO8_INV : 1.f};
        pg8::gemm_phase<pg8::EpiY<false>, pg8::SchedDense, F8>(lds, Kb, S, E);
    }
    SEAM(po);
    if (IN(po + 1)) { KArgs ka = kargs(); const Geo g = geo(); const int tid = otid(); ln_router(ka, LAYER, lds, g.vcu, g.G, __builtin_amdgcn_readfirstlane(tid >> 6), tid & 63); }
    SEAM(po + 1);
    if (IN(po + 2)) {
        KArgs ka = kargs(); unsigned char* ws = ka->ws;
        const int ntt = moe_tables(ka, LAYER, lds);
        constexpr bool F8 = MOE_F8(LAYER); constexpr int Kb = F8 ? DM : DM * 2;
        pg8::SchedMoe1 S{(const char*)(ws + WS_XB), (const char*)(ws + WS_WGU) + (size_t)LAYER * NEX * 1024 * DM * 2, (const unsigned*)(ws + WS_LIST),
                         (const LAS int*)(lds + LT_P), (const LAS int*)(lds + LT_CNT), (const LAS int*)(lds + LT_TILE), ntt * 4, (int)gridDim.x, (int)blockIdx.x, Kb};
        pg8::EpiSwiGLU<F8> E{(bf16_t*)(ws + WS_H), F8 ? W8_INV : 1.f};
        pg8::gemm_phase<pg8::EpiSwiGLU<F8>, pg8::SchedMoe1, F8>(lds, Kb, S, E);
    }
    SEAM(po + 2);
    if (IN(po + 3)) {
        KArgs ka = kargs(); unsigned char* ws = ka->ws;
        const int ntt = IN(po + 2) ? ((const LAS int*)(lds + LT_P))[NEX] : moe_tables(ka, LAYER, lds);
        constexpr bool F8 = MOE_F8(LAYER); constexpr int Kb = F8 ? DE : DE * 2;
        pg8::SchedMoe2 S{(const char*)(ws + WS_H), (const char*)(ws + WS_WD) + (size_t)LAYER * NEX * DM * DE * 2, (const LAS int*)(lds + LT_TILE), ntt * 8, (int)gridDim.x, (int)blockIdx.x, Kb};
        constexpr bool Y8 = MOE_Y8(LAYER);
        pg8::EpiY<Y8> E{(bf16_t*)(ws + WS_Y), (F8 ? W8_INV : 1.f) * (Y8 ? Y8_SCALE : 1.f)};
        pg8::gemm_phase<pg8::EpiY<Y8>, pg8::SchedMoe2, F8>(lds, Kb, S, E);
    }
    SEAM(po + 3);
    if (IN(po + 4)) { KArgs ka = kargs(); const Geo g = geo(); if (!IN(po + 2)) (void)moe_tables(ka, LAYER, lds); moe_combine(ka, LAYER, lds, g.gw, g.NGW, otid() & 63); }
    if (LAYER == 0) SEAM(8);
}
__global__ void __launch_bounds__(NWAVES * 64, 2) fwd_kernel(Args args) {
    extern __shared__ __attribute__((aligned(16))) unsigned char lds_raw[];
    LAS unsigned char* lds = (LAS unsigned char*)lds_raw;
    volatile LAS unsigned* MISC = (volatile LAS unsigned*)(lds + MISC_OFF);
    for (int u = threadIdx.x; u < (LDS_BYTES - LDSCTL_OFF) / 4; u += NWAVES * 64) ((LAS unsigned*)(lds + LDSCTL_OFF))[u] = 0u;
    __syncthreads();
    XcdBarrier bar = xcd_barrier_post((unsigned*)(args.ws + WS_CTL) + CW_BAR, MISC + 8);
    const int lo = args.ph_lo, hi = args.ph_hi;
    if (IN(0)) { KArgs ka = kargs(); const Geo g = geo(); const int tid = otid(); p0_prologue(ka, lds, g.gw, g.NGW, __builtin_amdgcn_readfirstlane(tid >> 6), tid & 63); }
    SEAM(0);
    layer_program<0>(lds, lds_raw, bar, lo, hi);
    layer_program<1>(lds, lds_raw, bar, lo, hi);
}
#undef IN
#undef SEAM

extern "C" void kernel_launch(void* const* d_in, const int* in_sizes, int n_in, void* d_out, int out_size, void* d_ws, size_t ws_size, hipStream_t stream) {
    static int grid = 0;
    if (grid == 0) {
        if (n_in != 23 || out_size != NTOK * DM || ws_size < WS_END) { fprintf(stderr, "kernel_launch: unexpected shapes (n_in %d, out %d, ws %zu; need ws >= %zu)\n", n_in, out_size, ws_size, (size_t)WS_END); grid = -1; return; }
        int dev = 0, cus = 0, per_cu = 0;
        if (hipGetDevice(&dev) != hipSuccess || hipDeviceGetAttribute(&cus, hipDeviceAttributeMultiprocessorCount, dev) != hipSuccess) { grid = -1; return; }
        if (hipFuncSetAttribute((const void*)fwd_kernel, hipFuncAttributeMaxDynamicSharedMemorySize, LDS_BYTES) != hipSuccess) { fprintf(stderr, "kernel_launch: hipFuncSetAttribute failed\n"); grid = -1; return; }
        if (hipOccupancyMaxActiveBlocksPerMultiprocessor(&per_cu, (const void*)fwd_kernel, NWAVES * 64, LDS_BYTES) != hipSuccess || per_cu < 1) fprintf(stderr, "kernel_launch: occupancy query reports %d\n", per_cu);
        (void)hipGetLastError();
        grid = 256;
    }
    if (grid < 0) return;
    if (hipMemsetAsync((char*)d_ws + WS_CTL, 0, CTL_ZERO_BYTES, stream) != hipSuccess) return;
    Args a{};
    for (int i = 0; i < 23; ++i) a.in[i] = (const float*)d_in[i];
    a.out = (float*)d_out; a.ws = (unsigned char*)d_ws;
#ifndef MK_SPLIT
    a.ph_lo = 0; a.ph_hi = 19;
    hipLaunchKernelGGL(fwd_kernel, dim3(grid), dim3(NWAVES * 64), LDS_BYTES, stream, a);
#else
    for (int p = 0; p < 19; ++p) { a.ph_lo = p; a.ph_hi = p + 1; hipLaunchKernelGGL(fwd_kernel, dim3(grid), dim3(NWAVES * 64), LDS_BYTES, stream, a); }
#endif
}
```
